# Optimizing an MI355X kernel written in HIP

```python
import jax, jax.numpy as jnp
from jax import lax
import numpy as np

D_MODEL = 2048
BATCH = 4
SEQ = 4096
DEPTH = 2

CTX_LEN = 256
GRID_W = 64
N_MIXERS = 2
N_ATTN = (DEPTH + 1) // 2
N_REC = DEPTH // 2
NORM_EPS = 1e-6
N_MOD = 6

HEAD_DIM = 128
N_Q_HEADS = D_MODEL // HEAD_DIM
N_KV_HEADS = N_Q_HEADS // 4
GQA_GROUP = N_Q_HEADS // N_KV_HEADS
WINDOW = 128
ATTN_BLOCK = 128
ROPE_BASE = 10000.0
Q_DIM = N_Q_HEADS * HEAD_DIM
KV_DIM = N_KV_HEADS * HEAD_DIM
QKV_DIM = Q_DIM + 2 * KV_DIM

D_RNN = D_MODEL
RNN_BLOCKS = 8
RNN_BLOCK_W = D_RNN // RNN_BLOCKS
CONV_W = 4
CONV_LEFT = 1
LRU_C = 8.0

PEER_HEADS = 8
PEER_KEY_DIM = 128
N_KEYS = 128
N_EXPERTS = N_KEYS * N_KEYS
PEER_TOPK = 16
PEER_CHUNK = 128

kernel_name = "hybrid_swa_rglru_peer_diffusion_block"


def rmsnorm(x, gain):
    x32 = x.astype(jnp.float32)
    y = x32 * lax.rsqrt(jnp.mean(x32 * x32, axis=-1, keepdims=True) + NORM_EPS)
    return y.astype(x.dtype) * gain


def modulate(h, shift, scale):
    return h * (1.0 + scale) + shift


def axial_rope(rows, dtype):
    t = jnp.arange(rows * GRID_W)
    row = (t // GRID_W).astype(jnp.float32)
    col = (t % GRID_W).astype(jnp.float32)
    half = HEAD_DIM // 2
    inv = ROPE_BASE ** (-jnp.arange(0, half, 2, dtype=jnp.float32) / half)
    ang_r = row[:, None] * inv[None, :]
    ang_c = col[:, None] * inv[None, :]
    ang = jnp.concatenate([ang_r, ang_r, ang_c, ang_c], axis=-1)
    return jnp.cos(ang).astype(dtype), jnp.sin(ang).astype(dtype)


def apply_rope(x, cos, sin):
    half = HEAD_DIM // 2
    qtr = half // 2

    def rot(z):
        return jnp.concatenate([-z[..., qtr:], z[..., :qtr]], axis=-1)

    rotated = jnp.concatenate([rot(x[..., :half]), rot(x[..., half:])], axis=-1)
    return x * cos[None, :, None, :] + rotated * sin[None, :, None, :]


def attn_mixer(hx, hc, cos, sin, w_qkv, w_o, sink, need_ctx_out):
    B, S, _ = hx.shape
    C = hc.shape[1]
    nb = S // ATTN_BLOCK
    dt = hx.dtype
    scale = HEAD_DIM ** -0.5

    def project(h):
        qkv = h @ w_qkv
        q, k, v = jnp.split(qkv, [Q_DIM, Q_DIM + KV_DIM], axis=-1)
        T = h.shape[1]
        return (q.reshape(B, T, N_Q_HEADS, HEAD_DIM), k.reshape(B, T, N_KV_HEADS, HEAD_DIM),
                v.reshape(B, T, N_KV_HEADS, HEAD_DIM))

    qx, kx, vx = project(hx)
    qc, kc, vc = project(hc)
    qx = apply_rope(qx, cos, sin).reshape(B, nb, ATTN_BLOCK, N_KV_HEADS, GQA_GROUP, HEAD_DIM)
    kx = apply_rope(kx, cos, sin)
    sink32 = sink.astype(jnp.float32).reshape(N_KV_HEADS, GQA_GROUP)

    def band(t):
        tp = jnp.pad(t, ((0, 0), (ATTN_BLOCK, ATTN_BLOCK), (0, 0), (0, 0)))
        tp = tp.reshape(B, nb + 2, ATTN_BLOCK, N_KV_HEADS, HEAD_DIM)
        return jnp.concatenate([tp[:, :-2], tp[:, 1:-1], tp[:, 2:]], axis=2)

    kb, vb = band(kx), band(vx)
    s_w = jnp.einsum('bnqhgd,bnkhd->bnhgqk', qx, kb).astype(jnp.float32) * scale
    blk = jnp.arange(nb)[:, None]
    qpos = blk * ATTN_BLOCK + jnp.arange(ATTN_BLOCK)[None, :]
    kpos = (blk - 1) * ATTN_BLOCK + jnp.arange(3 * ATTN_BLOCK)[None, :]
    valid = ((kpos[:, None, :] >= 0) & (kpos[:, None, :] < S)
             & (jnp.abs(qpos[:, :, None] - kpos[:, None, :]) <= WINDOW))
    s_w = jnp.where(valid[None, :, None, None], s_w, -jnp.inf)
    s_c = jnp.einsum('bnqhgd,bkhd->bnhgqk', qx, kc).astype(jnp.float32) * scale
    sink_b = sink32[None, None, :, :, None]
    m = jnp.maximum(jnp.maximum(s_w.max(-1), s_c.max(-1)), sink_b)
    p_w = jnp.exp(s_w - m[..., None])
    p_c = jnp.exp(s_c - m[..., None])
    denom = p_w.sum(-1) + p_c.sum(-1) + jnp.exp(sink_b - m)
    o = (jnp.einsum('bnhgqk,bnkhd->bnqhgd', p_w.astype(dt), vb)
         + jnp.einsum('bnhgqk,bkhd->bnqhgd', p_c.astype(dt), vc))
    o = (o / jnp.moveaxis(denom, -1, 2)[..., None]).astype(dt)
    out_x = o.reshape(B, S, Q_DIM) @ w_o

    out_c = None
    if need_ctx_out:
        qc = qc.reshape(B, C, N_KV_HEADS, GQA_GROUP, HEAD_DIM)
        s_cc = jnp.einsum('bqhgd,bkhd->bhgqk', qc, kc).astype(jnp.float32) * scale
        sink_col = jnp.broadcast_to(sink32[None, :, :, None, None], (B, N_KV_HEADS, GQA_GROUP, C, 1))
        p = jax.nn.softmax(jnp.concatenate([s_cc, sink_col], axis=-1), axis=-1)[..., :C]
        o_c = jnp.einsum('bhgqk,bkhd->bqhgd', p.astype(dt), vc)
        out_c = o_c.reshape(B, C, Q_DIM) @ w_o
    return out_x, out_c


def short_conv(u, w, b):
    T = u.shape[1]
    up = jnp.pad(u, ((0, 0), (CONV_LEFT, CONV_W - 1 - CONV_LEFT), (0, 0)))
    y = b
    for k in range(CONV_W):
        y = y + up[:, k:k + T] * w[k]
    return y


def block_diag(u, w, b):
    ub = u.reshape(u.shape[:-1] + (RNN_BLOCKS, RNN_BLOCK_W))
    return jnp.einsum('...ni,nio->...no', ub, w).reshape(u.shape) + b


def rglru_coeffs(u, w_a, b_a, w_x, b_x, lam):
    r = jax.nn.sigmoid(block_diag(u, w_a, b_a).astype(jnp.float32))
    i = jax.nn.sigmoid(block_diag(u, w_x, b_x).astype(jnp.float32))
    log_a = -LRU_C * r * jax.nn.softplus(-lam.astype(jnp.float32))
    a = jnp.exp(log_a)
    bx = jnp.sqrt(-jnp.expm1(2.0 * log_a)) * i * u.astype(jnp.float32)
    return a, bx


def bidir_scan(a_f, b_f, a_b, b_b, h0):
    A = jnp.stack([a_f, jnp.flip(a_b, 1)], axis=0)
    X = jnp.stack([b_f, jnp.flip(b_b, 1)], axis=0)

    def step(h, ab):
        a, bx = ab
        h = a * h + bx
        return h, h

    h_last, ys = lax.scan(step, h0, (jnp.moveaxis(A, 2, 0), jnp.moveaxis(X, 2, 0)))
    ys = jnp.moveaxis(ys, 0, 2)
    return ys[0] + jnp.flip(ys[1], 1), h_last


def rec_mixer(hx, hc, w_in, conv_w, conv_b, w_a, b_a, w_x, b_x, lam, w_out, need_ctx_out):
    B = hx.shape[0]
    dt = hx.dtype
    w_gate, w_u = w_in[:, :D_RNN], w_in[:, D_RNN:]

    def coeffs(h):
        u = short_conv(h @ w_u, conv_w, conv_b)
        fa, fb = rglru_coeffs(u, w_a[0], b_a[0], w_x[0], b_x[0], lam[0])
        ba, bb = rglru_coeffs(u, w_a[1], b_a[1], w_x[1], b_x[1], lam[1])
        return fa, fb, ba, bb

    h0 = jnp.zeros((2, B, D_RNN), jnp.float32)
    yc, hc_final = bidir_scan(*coeffs(hc), h0)
    yx, _ = bidir_scan(*coeffs(hx), hc_final)
    out_x = (yx.astype(dt) * jax.nn.gelu(hx @ w_gate)) @ w_out
    out_c = None
    if need_ctx_out:
        out_c = (yc.astype(dt) * jax.nn.gelu(hc @ w_gate)) @ w_out
    return out_x, out_c


def peer(h, w_q, keys, u_tab, v_tab):
    T, D = h.shape
    q = (h @ w_q).reshape(T, PEER_HEADS, 2, PEER_KEY_DIM)
    s = jnp.einsum('thpd,pnd->thpn', q, keys).astype(jnp.float32)
    s1, i1 = lax.top_k(s[:, :, 0], PEER_TOPK)
    s2, i2 = lax.top_k(s[:, :, 1], PEER_TOPK)
    cand = (s1[..., :, None] + s2[..., None, :]).reshape(T, PEER_HEADS, PEER_TOPK * PEER_TOPK)
    cidx = (i1[..., :, None] * N_KEYS + i2[..., None, :]).reshape(T, PEER_HEADS, PEER_TOPK * PEER_TOPK)
    top_s, sel = lax.top_k(cand, PEER_TOPK)
    idx = jnp.take_along_axis(cidx, sel, axis=-1).reshape(T, PEER_HEADS * PEER_TOPK)
    g = jax.nn.softmax(top_s, axis=-1).astype(h.dtype).reshape(T, PEER_HEADS * PEER_TOPK)
    n = T // PEER_CHUNK

    def chunk(args):
        hc, ic, gc = args
        z = jnp.einsum('tkd,td->tk', u_tab[ic], hc)
        act = jax.nn.gelu(z) * gc
        return jnp.einsum('tk,tkd->td', act, v_tab[ic])

    out = lax.map(chunk, (h.reshape(n, PEER_CHUNK, D), idx.reshape(n, PEER_CHUNK, -1),
                          g.reshape(n, PEER_CHUNK, -1)))
    return out.reshape(T, D)


def setup_inputs(seed: int = 0) -> dict:
    key = jax.random.key(seed)
    ks = jax.random.split(key, 32)
    f32 = jnp.float32

    def nrm(k, shape, s):
        return jax.random.normal(k, shape, f32) * s

    a0 = jax.random.uniform(ks[20], (N_REC, 2, D_RNN), f32, minval=0.9, maxval=0.999)
    return {
        "x": nrm(ks[0], (BATCH, SEQ, D_MODEL), 1.0),
        "c": nrm(ks[1], (BATCH, D_MODEL), 1.0),
        "ctx": nrm(ks[2], (BATCH, CTX_LEN, D_MODEL), 1.0),
        "c_ctx": nrm(ks[3], (D_MODEL,), 1.0),
        "w_mod": nrm(ks[4], (DEPTH, D_MODEL, N_MOD * D_MODEL), 0.3 * D_MODEL ** -0.5),
        "b_mod": nrm(ks[5], (DEPTH, N_MOD * D_MODEL), 0.02),
        "norm_mix": 1.0 + nrm(ks[6], (DEPTH, D_MODEL), 0.02),
        "norm_ffn": 1.0 + nrm(ks[7], (DEPTH, D_MODEL), 0.02),
        "norm_final": 1.0 + nrm(ks[8], (D_MODEL,), 0.02),
        "attn_w_qkv": nrm(ks[9], (N_ATTN, D_MODEL, QKV_DIM), D_MODEL ** -0.5),
        "attn_w_o": nrm(ks[10], (N_ATTN, Q_DIM, D_MODEL), Q_DIM ** -0.5),
        "attn_sink": nrm(ks[11], (N_ATTN, N_Q_HEADS), 0.5),
        "rec_w_in": nrm(ks[12], (N_REC, D_MODEL, 2 * D_RNN), D_MODEL ** -0.5),
        "rec_conv_w": nrm(ks[13], (N_REC, CONV_W, D_RNN), CONV_W ** -0.5),
        "rec_conv_b": nrm(ks[14], (N_REC, D_RNN), 0.02),
        "rec_w_a": nrm(ks[15], (N_REC, 2, RNN_BLOCKS, RNN_BLOCK_W, RNN_BLOCK_W), RNN_BLOCK_W ** -0.5),
        "rec_b_a": nrm(ks[16], (N_REC, 2, D_RNN), 0.02),
        "rec_w_x": nrm(ks[17], (N_REC, 2, RNN_BLOCKS, RNN_BLOCK_W, RNN_BLOCK_W), RNN_BLOCK_W ** -0.5),
        "rec_b_x": nrm(ks[18], (N_REC, 2, D_RNN), 0.02),
        "rec_lambda": jnp.log(a0) - jnp.log1p(-a0),
        "rec_w_out": nrm(ks[19], (N_REC, D_RNN, D_MODEL), D_RNN ** -0.5),
        "peer_w_q": nrm(ks[21], (DEPTH, D_MODEL, PEER_HEADS * 2 * PEER_KEY_DIM), D_MODEL ** -0.5),
        "peer_keys": nrm(ks[22], (DEPTH, 2, N_KEYS, PEER_KEY_DIM), PEER_KEY_DIM ** -0.5),
        "peer_u": nrm(ks[23], (DEPTH, N_EXPERTS, D_MODEL), D_MODEL ** -0.5),
        "peer_v": nrm(ks[24], (DEPTH, N_EXPERTS, D_MODEL), 0.5),
    }


def reference(x, c, ctx, c_ctx, w_mod, b_mod, norm_mix, norm_ffn, norm_final,
              attn_w_qkv, attn_w_o, attn_sink,
              rec_w_in, rec_conv_w, rec_conv_b, rec_w_a, rec_b_a, rec_w_x, rec_b_x, rec_lambda, rec_w_out,
              peer_w_q, peer_keys, peer_u, peer_v):
    B, S, D = x.shape
    C = ctx.shape[1]
    rows = S // GRID_W
    cos, sin = axial_rope(rows, x.dtype)
    xs, cs = x, ctx
    for i in range(DEPTH):
        last = i == DEPTH - 1
        j = i // N_MIXERS
        mod_x = (jax.nn.silu(c) @ w_mod[i] + b_mod[i]).reshape(B, N_MOD, 1, D)
        mod_c = (jax.nn.silu(c_ctx) @ w_mod[i] + b_mod[i]).reshape(N_MOD, 1, D)

        hx = modulate(rmsnorm(xs, norm_mix[i]), mod_x[:, 0], mod_x[:, 1])
        hc = modulate(rmsnorm(cs, norm_mix[i]), mod_c[0], mod_c[1])
        if i % N_MIXERS == 0:
            yx, yc = attn_mixer(hx, hc, cos, sin, attn_w_qkv[j], attn_w_o[j], attn_sink[j], not last)
        else:
            yx, yc = rec_mixer(hx, hc, rec_w_in[j], rec_conv_w[j], rec_conv_b[j], rec_w_a[j], rec_b_a[j],
                               rec_w_x[j], rec_b_x[j], rec_lambda[j], rec_w_out[j], not last)
        xs = xs + mod_x[:, 2] * yx
        if not last:
            cs = cs + mod_c[2] * yc

        hx = modulate(rmsnorm(xs, norm_ffn[i]), mod_x[:, 3], mod_x[:, 4])
        if last:
            fx = peer(hx.reshape(B * S, D), peer_w_q[i], peer_keys[i], peer_u[i], peer_v[i]).reshape(B, S, D)
            xs = xs + mod_x[:, 5] * fx
        else:
            hc = modulate(rmsnorm(cs, norm_ffn[i]), mod_c[3], mod_c[4])
            tokens = jnp.concatenate([hx.reshape(B * S, D), hc.reshape(B * C, D)], axis=0)
            f = peer(tokens, peer_w_q[i], peer_keys[i], peer_u[i], peer_v[i])
            xs = xs + mod_x[:, 5] * f[:B * S].reshape(B, S, D)
            cs = cs + mod_c[5] * f[B * S:].reshape(B, C, D)
    return rmsnorm(xs, norm_final)
```

```cpp
#include <hip/hip_runtime.h>
#include <hip/hip_cooperative_groups.h>
#include <cstdio>
namespace cg = cooperative_groups;

typedef unsigned short bf16_t;
typedef short bf16x8 __attribute__((ext_vector_type(8)));
typedef float f32x4 __attribute__((ext_vector_type(4)));
typedef unsigned u32x4 __attribute__((ext_vector_type(4)));
typedef unsigned u32x2 __attribute__((ext_vector_type(2)));
typedef __bf16 bf16x2_t __attribute__((ext_vector_type(2)));

constexpr int D = 2048, NB = 4, S = 4096, CL = 256;
constexpr int TL = NB * S, TC = NB * CL, TT = TL + TC;
constexpr int NT = 512;
constexpr int NMOD = 6 * D;
constexpr int NEXP = 16384;
constexpr size_t kDynLds = 128 * 1024;
#ifndef SKIP
#define SKIP 0
#endif

constexpr size_t al256(size_t x) { return (x + 255) & ~(size_t)255; }
constexpr size_t OFF_WQKV = 0;
constexpr size_t OFF_WO   = OFF_WQKV + al256((size_t)3072 * 2048 * 2);
constexpr size_t OFF_WPQ  = OFF_WO + al256((size_t)2048 * 2048 * 2);
constexpr size_t OFF_WIN  = OFF_WPQ + al256((size_t)2 * 2048 * 2048 * 2);
constexpr size_t OFF_WOUT = OFF_WIN + al256((size_t)4096 * 2048 * 2);
constexpr size_t OFF_WA   = OFF_WOUT + al256((size_t)2048 * 2048 * 2);
constexpr size_t OFF_WX   = OFF_WA + al256((size_t)16 * 256 * 256 * 2);
constexpr size_t OFF_KEYS = OFF_WX + al256((size_t)16 * 256 * 256 * 2);
constexpr size_t OFF_UTAB = OFF_KEYS + al256((size_t)2 * 2 * 128 * 128 * 2);
constexpr size_t OFF_VTAB = OFF_UTAB + al256((size_t)2 * NEXP * D * 2);
constexpr size_t OFF_MODV = OFF_VTAB + al256((size_t)2 * NEXP * D * 2);
constexpr size_t OFF_ROPE = OFF_MODV + al256((size_t)2 * 5 * NMOD * 4);
constexpr size_t OFF_XS   = OFF_ROPE + al256((size_t)2 * 2048 * 4);
constexpr size_t SZ_ACT  = al256((size_t)TT * D * 2);
constexpr size_t OFF_H    = OFF_XS + al256((size_t)TT * D * 4);
constexpr size_t OFF_Q    = OFF_H + SZ_ACT;
constexpr size_t OFF_X    = OFF_Q + SZ_ACT;
constexpr size_t OFF_K    = OFF_X + 2 * SZ_ACT;
constexpr size_t OFF_VT   = OFF_K + al256((size_t)TT * 512 * 2);
constexpr size_t OFF_O    = OFF_VT + al256((size_t)TT * 512 * 2);
constexpr size_t OFF_PQ   = OFF_O + SZ_ACT;
constexpr size_t OFF_LAB  = OFF_H;
constexpr size_t OFF_CHP  = OFF_K;
constexpr size_t OFF_CHH  = OFF_CHP + al256((size_t)2 * 272 * D * 4);
constexpr size_t OFF_CIN  = OFF_CHH + al256((size_t)2 * 272 * D * 4);
constexpr size_t WS_NEED  = OFF_PQ + SZ_ACT;
static_assert(OFF_CIN + al256((size_t)2 * 272 * D * 4) <= OFF_O, "scan carries must fit in the K/VT region");
static_assert(WS_NEED <= ((size_t)1 << 30), "workspace map exceeds 1 GiB");

struct Params {
  const float *x, *c, *ctx, *c_ctx, *w_mod, *b_mod, *norm_mix, *norm_ffn, *norm_final;
  const float *attn_w_qkv, *attn_w_o, *attn_sink;
  const float *rec_w_in, *rec_conv_w, *rec_conv_b, *rec_w_a, *rec_b_a, *rec_w_x, *rec_b_x, *rec_lambda, *rec_w_out;
  const float *peer_w_q, *peer_keys, *peer_u, *peer_v;
  float* out; unsigned char* ws;
};

__device__ __forceinline__ float bf2f(bf16_t v) { return __uint_as_float((unsigned)v << 16); }
__device__ __forceinline__ bf16_t f2bf(float f) { unsigned u = __float_as_uint(f); u += 0x7fffu + ((u >> 16) & 1u); return (bf16_t)(u >> 16); }
__device__ __forceinline__ unsigned pack_bf16(float lo, float hi) { return (unsigned)f2bf(lo) | ((unsigned)f2bf(hi) << 16); }
__device__ __forceinline__ float wave_sum(float v) {
#pragma unroll
  for (int o = 32; o > 0; o >>= 1) v += __shfl_xor(v, o);
  return v;
}
__device__ __forceinline__ float wave_max(float v) {
#pragma unroll
  for (int o = 32; o > 0; o >>= 1) v = fmaxf(v, __shfl_xor(v, o));
  return v;
}
__device__ __forceinline__ float gelu_tanh(float x) {
  const float y = 0.7978845608028654f * (x + 0.044715f * x * x * x);
  const float t = 1.0f - 2.0f / (1.0f + __expf(2.0f * y));
  return 0.5f * x * (1.0f + t);
}
__device__ __forceinline__ float sigmoid_f(float x) { return 1.0f / (1.0f + __expf(-x)); }
__device__ __forceinline__ int mod_row(int r) { return r < TL ? (r >> 12) : 4; }

__device__ void mod_item(const Params& p, int item, float* lds) {
  float* sil = lds;
  float* red = lds + 5 * 2048;
  const int tid = threadIdx.x, wid = tid >> 6, lane = tid & 63;
  for (int i = tid; i < 5 * 2048; i += NT) {
    const int m = i >> 11, k = i & 2047;
    const float v = (m < 4) ? p.c[m * 2048 + k] : p.c_ctx[k];
    sil[i] = v / (1.0f + expf(-v));
  }
  __syncthreads();
  const int layer = item / 48, cgp = item % 48;
  const float* W = p.w_mod + (size_t)layer * 2048 * NMOD + cgp * 256 + lane * 4;
  float acc[5][4];
#pragma unroll
  for (int m = 0; m < 5; ++m)
#pragma unroll
    for (int j = 0; j < 4; ++j) acc[m][j] = 0.f;
  const int k0 = wid * 256;
#pragma unroll 8
  for (int k = k0; k < k0 + 256; ++k) {
    const float4 w = *(const float4*)(W + (size_t)k * NMOD);
#pragma unroll
    for (int m = 0; m < 5; ++m) {
      const float s = sil[m * 2048 + k];
      acc[m][0] += s * w.x; acc[m][1] += s * w.y; acc[m][2] += s * w.z; acc[m][3] += s * w.w;
    }
  }
#pragma unroll
  for (int m = 0; m < 5; ++m)
#pragma unroll
    for (int j = 0; j < 4; ++j) red[(wid * 5 + m) * 256 + lane * 4 + j] = acc[m][j];
  __syncthreads();
  float* MODV = (float*)(p.ws + OFF_MODV);
  for (int o = tid; o < 1280; o += NT) {
    const int m = o >> 8, n = o & 255;
    float s = 0.f;
#pragma unroll
    for (int w = 0; w < 8; ++w) s += red[(w * 5 + m) * 256 + n];
    const int col = cgp * 256 + n;
    MODV[(size_t)(layer * 5 + m) * NMOD + col] = s + p.b_mod[layer * NMOD + col];
  }
  __syncthreads();
}

__device__ void transpose_tile(const float* W, int ldw, bf16_t* Wt, int ldt, int k0, int n0, float* lds) {
  const int tid = threadIdx.x;
  const int tk = tid >> 4, tn = (tid & 15) * 4;
#pragma unroll
  for (int i = 0; i < 2; ++i) {
    const int k = tk + 32 * i;
    const float4 v = *(const float4*)(W + (size_t)(k0 + k) * ldw + n0 + tn);
    lds[k * 65 + tn + 0] = v.x; lds[k * 65 + tn + 1] = v.y; lds[k * 65 + tn + 2] = v.z; lds[k * 65 + tn + 3] = v.w;
  }
  __syncthreads();
  const int wn = tid >> 3, kc = (tid & 7) * 8;
  u32x4 o;
  o.x = pack_bf16(lds[(kc + 0) * 65 + wn], lds[(kc + 1) * 65 + wn]);
  o.y = pack_bf16(lds[(kc + 2) * 65 + wn], lds[(kc + 3) * 65 + wn]);
  o.z = pack_bf16(lds[(kc + 4) * 65 + wn], lds[(kc + 5) * 65 + wn]);
  o.w = pack_bf16(lds[(kc + 6) * 65 + wn], lds[(kc + 7) * 65 + wn]);
  *(u32x4*)(Wt + (size_t)(n0 + wn) * ldt + k0 + kc) = o;
  __syncthreads();
}

__device__ void transpose_job(const Params& p, int t, float* lds) {
  const float* W; bf16_t* Wt; int K, N;
  if (t < 1536) { W = p.attn_w_qkv; Wt = (bf16_t*)(p.ws + OFF_WQKV); K = 2048; N = 3072; }
  else if ((t -= 1536) < 1024) { W = p.attn_w_o; Wt = (bf16_t*)(p.ws + OFF_WO); K = 2048; N = 2048; }
  else if ((t -= 1024) < 2048) { const int l = t >> 10; t &= 1023; W = p.peer_w_q + (size_t)l * 2048 * 2048; Wt = (bf16_t*)(p.ws + OFF_WPQ) + (size_t)l * 2048 * 2048; K = 2048; N = 2048; }
  else if ((t -= 2048) < 2048) { W = p.rec_w_in; Wt = (bf16_t*)(p.ws + OFF_WIN); K = 2048; N = 4096; }
  else if ((t -= 2048) < 1024) { W = p.rec_w_out; Wt = (bf16_t*)(p.ws + OFF_WOUT); K = 2048; N = 2048; }
  else if ((t -= 1024) < 256) { const int mtx = t >> 4; t &= 15; W = p.rec_w_a + (size_t)mtx * 65536; Wt = (bf16_t*)(p.ws + OFF_WA) + (size_t)mtx * 65536; K = 256; N = 256; }
  else { t -= 256; const int mtx = t >> 4; t &= 15; W = p.rec_w_x + (size_t)mtx * 65536; Wt = (bf16_t*)(p.ws + OFF_WX) + (size_t)mtx * 65536; K = 256; N = 256; }
  const int ntn = N / 64;
  transpose_tile(W, N, Wt, K, (t / ntn) * 64, (t % ntn) * 64, lds);
}

__device__ __forceinline__ void convert8(const float* src, bf16_t* dst) {
  const float4 a = ((const float4*)src)[0], b = ((const float4*)src)[1];
  u32x4 o; o.x = pack_bf16(a.x, a.y); o.y = pack_bf16(a.z, a.w); o.z = pack_bf16(b.x, b.y); o.w = pack_bf16(b.z, b.w);
  *(u32x4*)dst = o;
}

constexpr int P0_MOD = 96, P0_TR = 8192, P0_KEYS = 16, P0_ROPE = 1, P0_TAB = 32768;
constexpr int P0_TOTAL = P0_MOD + P0_TR + P0_KEYS + P0_ROPE + P0_TAB;

__device__ void setup_phase(const Params& p, unsigned char* lds_raw) {
  float* lds = (float*)lds_raw;
  for (int item = blockIdx.x; item < P0_TOTAL; item += gridDim.x) {
    int t = item;
    if (t < P0_MOD) { mod_item(p, t, lds); continue; }
    t -= P0_MOD;
    if (t < P0_TR) { transpose_job(p, t, lds); continue; }
    t -= P0_TR;
    if (t < P0_KEYS) { const size_t e = (size_t)t * 4096 + threadIdx.x * 8; convert8(p.peer_keys + e, (bf16_t*)(p.ws + OFF_KEYS) + e); continue; }
    t -= P0_KEYS;
    if (t < P0_ROPE) {
      float* cosT = (float*)(p.ws + OFF_ROPE); float* sinT = cosT + 2048;
      for (int e = threadIdx.x; e < 2048; e += NT) {
        const int pos = e >> 5, j = e & 31;
        const float inv = powf(10000.0f, -(float)(2 * j) / 64.0f);
        const float ang = (float)pos * inv;
        cosT[e] = cosf(ang); sinT[e] = sinf(ang);
      }
      continue;
    }
    t -= P0_ROPE;
    {
      const int tb = t >> 14; const size_t e = (size_t)(t & 16383) * 4096 + threadIdx.x * 8;
      if (tb == 0) convert8(p.peer_u + e, (bf16_t*)(p.ws + OFF_UTAB) + e);
      else convert8(p.peer_v + e, (bf16_t*)(p.ws + OFF_VTAB) + e);
    }
  }
}

__device__ void norm_phase(const Params& p, int layer, const float* gain, int shift_idx, int nrows, bool from_input, bf16_t* H) {
  const int wid = threadIdx.x >> 6, lane = threadIdx.x & 63;
  const float* MODV = (const float*)(p.ws + OFF_MODV);
  const float* XS = (const float*)(p.ws + OFF_XS);
  for (int r = blockIdx.x * 8 + wid; r < nrows; r += gridDim.x * 8) {
    const float* src = from_input ? (r < TL ? p.x + (size_t)r * D : p.ctx + (size_t)(r - TL) * D) : XS + (size_t)r * D;
    const float* mv = MODV + (size_t)(layer * 5 + mod_row(r)) * NMOD;
    const float* sh = mv + shift_idx * D; const float* sc = sh + D;
    float4 v[8]; float ss = 0.f;
#pragma unroll
    for (int i = 0; i < 8; ++i) { v[i] = ((const float4*)src)[i * 64 + lane]; ss += v[i].x * v[i].x + v[i].y * v[i].y + v[i].z * v[i].z + v[i].w * v[i].w; }
    ss = wave_sum(ss);
    const float rs = rsqrtf(ss * (1.0f / D) + 1e-6f);
#pragma unroll
    for (int i = 0; i < 8; ++i) {
      const float4 g = ((const float4*)gain)[i * 64 + lane], a = ((const float4*)sh)[i * 64 + lane], b = ((const float4*)sc)[i * 64 + lane];
      const float o0 = v[i].x * rs * g.x * (1.0f + b.x) + a.x, o1 = v[i].y * rs * g.y * (1.0f + b.y) + a.y;
      const float o2 = v[i].z * rs * g.z * (1.0f + b.z) + a.z, o3 = v[i].w * rs * g.w * (1.0f + b.w) + a.w;
      u32x2 o; o.x = pack_bf16(o0, o1); o.y = pack_bf16(o2, o3);
      *(u32x2*)(H + (size_t)r * D + i * 256 + lane * 4) = o;
    }
  }
}

__device__ void final_norm_phase(const Params& p) {
  const int wid = threadIdx.x >> 6, lane = threadIdx.x & 63;
  const float* XS = (const float*)(p.ws + OFF_XS);
  for (int r = blockIdx.x * 8 + wid; r < TL; r += gridDim.x * 8) {
    const float4* xr = (const float4*)(XS + (size_t)r * D);
    float4 v[8]; float ss = 0.f;
#pragma unroll
    for (int i = 0; i < 8; ++i) { v[i] = xr[i * 64 + lane]; ss += v[i].x * v[i].x + v[i].y * v[i].y + v[i].z * v[i].z + v[i].w * v[i].w; }
    ss = wave_sum(ss);
    const float rs = rsqrtf(ss * (1.0f / D) + 1e-6f);
    float4* orow = (float4*)(p.out + (size_t)r * D);
#pragma unroll
    for (int i = 0; i < 8; ++i) { const float4 g = ((const float4*)p.norm_final)[i * 64 + lane]; float4 o; o.x = v[i].x * rs * g.x; o.y = v[i].y * rs * g.y; o.z = v[i].z * rs * g.z; o.w = v[i].w * rs * g.w; orow[i * 64 + lane] = o; }
  }
}

constexpr int GLD = 72;
template <bool DUAL, class Epi>
__device__ __forceinline__ void gemm_tile(const bf16_t* __restrict__ Ap, int lda, const bf16_t* __restrict__ Bp, const bf16_t* __restrict__ B2p, int ldb, int K,
                                          unsigned char* lds, const Epi& epi, int m0, int n0) {
  const int tid = threadIdx.x, wid = tid >> 6, lane = tid & 63, wm = wid >> 1, wn = wid & 1, fr = lane & 15, fq = lane >> 4;
  bf16_t* As = (bf16_t*)lds; bf16_t* Bs = As + 2 * 128 * GLD; bf16_t* B2s = Bs + 2 * 128 * GLD;
  const int lr0 = tid >> 3, lc = (tid & 7) * 8;
  f32x4 acc[2][4], acc2[2][4];
#pragma unroll
  for (int i = 0; i < 2; ++i)
#pragma unroll
    for (int j = 0; j < 4; ++j) { acc[i][j] = (f32x4){0.f, 0.f, 0.f, 0.f}; acc2[i][j] = (f32x4){0.f, 0.f, 0.f, 0.f}; }
  u32x4 ra[2], rb[2], rb2[2];
  const int nk = K >> 6;
#pragma unroll
  for (int i = 0; i < 2; ++i) {
    ra[i] = *(const u32x4*)(Ap + (size_t)(lr0 + 64 * i) * lda + lc);
    rb[i] = *(const u32x4*)(Bp + (size_t)(lr0 + 64 * i) * ldb + lc);
    if (DUAL) rb2[i] = *(const u32x4*)(B2p + (size_t)(lr0 + 64 * i) * ldb + lc);
  }
#pragma unroll
  for (int i = 0; i < 2; ++i) {
    *(u32x4*)(As + (lr0 + 64 * i) * GLD + lc) = ra[i];
    *(u32x4*)(Bs + (lr0 + 64 * i) * GLD + lc) = rb[i];
    if (DUAL) *(u32x4*)(B2s + (lr0 + 64 * i) * GLD + lc) = rb2[i];
  }
  __syncthreads();
  for (int kt = 0; kt < nk; ++kt) {
    const int buf = kt & 1;
    if (kt + 1 < nk) {
#pragma unroll
      for (int i = 0; i < 2; ++i) {
        ra[i] = *(const u32x4*)(Ap + (size_t)(lr0 + 64 * i) * lda + (kt + 1) * 64 + lc);
        rb[i] = *(const u32x4*)(Bp + (size_t)(lr0 + 64 * i) * ldb + (kt + 1) * 64 + lc);
        if (DUAL) rb2[i] = *(const u32x4*)(B2p + (size_t)(lr0 + 64 * i) * ldb + (kt + 1) * 64 + lc);
      }
    }
    const bf16_t* Ab = As + buf * 128 * GLD; const bf16_t* Bb = Bs + buf * 128 * GLD; const bf16_t* B2b = B2s + buf * 128 * GLD;
#pragma unroll
    for (int ks = 0; ks < 2; ++ks) {
      bf16x8 af[2], bfr[4];
#pragma unroll
      for (int mi = 0; mi < 2; ++mi) af[mi] = *(const bf16x8*)(Ab + (wm * 32 + mi * 16 + fr) * GLD + ks * 32 + fq * 8);
#pragma unroll
      for (int ni = 0; ni < 4; ++ni) bfr[ni] = *(const bf16x8*)(Bb + (wn * 64 + ni * 16 + fr) * GLD + ks * 32 + fq * 8);
#pragma unroll
      for (int mi = 0; mi < 2; ++mi)
#pragma unroll
        for (int ni = 0; ni < 4; ++ni) acc[mi][ni] = __builtin_amdgcn_mfma_f32_16x16x32_bf16(bfr[ni], af[mi], acc[mi][ni], 0, 0, 0);
      if (DUAL) {
#pragma unroll
        for (int ni = 0; ni < 4; ++ni) bfr[ni] = *(const bf16x8*)(B2b + (wn * 64 + ni * 16 + fr) * GLD + ks * 32 + fq * 8);
#pragma unroll
        for (int mi = 0; mi < 2; ++mi)
#pragma unroll
          for (int ni = 0; ni < 4; ++ni) acc2[mi][ni] = __builtin_amdgcn_mfma_f32_16x16x32_bf16(bfr[ni], af[mi], acc2[mi][ni], 0, 0, 0);
      }
    }
    if (kt + 1 < nk) {
      const int nb = buf ^ 1;
#pragma unroll
      for (int i = 0; i < 2; ++i) {
        *(u32x4*)(As + nb * 128 * GLD + (lr0 + 64 * i) * GLD + lc) = ra[i];
        *(u32x4*)(Bs + nb * 128 * GLD + (lr0 + 64 * i) * GLD + lc) = rb[i];
        if (DUAL) *(u32x4*)(B2s + nb * 128 * GLD + (lr0 + 64 * i) * GLD + lc) = rb2[i];
      }
    }
    __syncthreads();
  }
  epi(acc, acc2, m0 + wm * 32 + fr, n0 + wn * 64 + fq * 4);
}

struct EpiQKV {
  bf16_t *Q, *Kb, *VT; const float *cosT, *sinT;
  __device__ __forceinline__ void operator()(const f32x4 (&acc)[2][4], const f32x4 (&)[2][4], int rbase, int cbase) const {
    const int n0 = cbase & ~127;
#pragma unroll
    for (int mi = 0; mi < 2; ++mi) {
      const int r = rbase + 16 * mi;
      if (n0 < 2560) {
        const bool latent = r < TL;
        const int s = r & 4095;
        const int pos = ((cbase & 64) == 0) ? (s >> 6) : (s & 63);
        const int cl = cbase & 63;
        bf16_t* dst = (n0 < 2048) ? (Q + (size_t)r * D + cbase) : (Kb + (size_t)r * 512 + (cbase - 2048));
#pragma unroll
        for (int ni = 0; ni < 2; ++ni) {
          f32x4 x1 = acc[mi][ni], x2 = acc[mi][ni + 2], y1 = x1, y2 = x2;
          if (latent) {
            const f32x4 cs = *(const f32x4*)(cosT + pos * 32 + ni * 16 + cl), sn = *(const f32x4*)(sinT + pos * 32 + ni * 16 + cl);
            y1 = x1 * cs - x2 * sn; y2 = x2 * cs + x1 * sn;
          }
          u32x2 o1, o2; o1.x = pack_bf16(y1[0], y1[1]); o1.y = pack_bf16(y1[2], y1[3]); o2.x = pack_bf16(y2[0], y2[1]); o2.y = pack_bf16(y2[2], y2[3]);
          *(u32x2*)(dst + ni * 16) = o1; *(u32x2*)(dst + (ni + 2) * 16) = o2;
        }
      } else {
#pragma unroll
        for (int ni = 0; ni < 4; ++ni)
#pragma unroll
          for (int j = 0; j < 4; ++j) VT[(size_t)(cbase - 2560 + ni * 16 + j) * TT + r] = f2bf(acc[mi][ni][j]);
      }
    }
  }
};
struct EpiResid {
  const float *x, *ctx; float* XS; const float* gate  ; bool from_input; float mul;
  __device__ __forceinline__ void operator()(const f32x4 (&acc)[2][4], const f32x4 (&)[2][4], int rbase, int cbase) const {
#pragma unroll
    for (int mi = 0; mi < 2; ++mi) {
      const int r = rbase + 16 * mi;
      const float* src = from_input ? (r < TL ? x + (size_t)r * D : ctx + (size_t)(r - TL) * D) : XS + (size_t)r * D;
      const float* g = gate + (size_t)mod_row(r) * NMOD;
#pragma unroll
      for (int ni = 0; ni < 4; ++ni) {
        const int c = cbase + ni * 16;
        const f32x4 b = *(const f32x4*)(src + c), gg = *(const f32x4*)(g + c);
        *(f32x4*)(XS + (size_t)r * D + c) = b + gg * acc[mi][ni] * mul;
      }
    }
  }
};
struct EpiBf16 {
  bf16_t* O; int ldo;
  __device__ __forceinline__ void operator()(const f32x4 (&acc)[2][4], const f32x4 (&)[2][4], int rbase, int cbase) const {
#pragma unroll
    for (int mi = 0; mi < 2; ++mi)
#pragma unroll
      for (int ni = 0; ni < 4; ++ni) {
        u32x2 o; o.x = pack_bf16(acc[mi][ni][0], acc[mi][ni][1]); o.y = pack_bf16(acc[mi][ni][2], acc[mi][ni][3]);
        *(u32x2*)(O + (size_t)(rbase + 16 * mi) * ldo + cbase + ni * 16) = o;
      }
  }
};
struct EpiWin {
  bf16_t *GATE, *UBR;
  __device__ __forceinline__ void operator()(const f32x4 (&acc)[2][4], const f32x4 (&)[2][4], int rbase, int cbase) const {
#pragma unroll
    for (int mi = 0; mi < 2; ++mi) {
      const int r = rbase + 16 * mi;
#pragma unroll
      for (int ni = 0; ni < 4; ++ni) {
        const int c = cbase + ni * 16;
        f32x4 v = acc[mi][ni];
        if (c < 2048) {
          if (r < TL) {
            u32x2 o; o.x = pack_bf16(gelu_tanh(v[0]), gelu_tanh(v[1])); o.y = pack_bf16(gelu_tanh(v[2]), gelu_tanh(v[3]));
            *(u32x2*)(GATE + (size_t)r * D + c) = o;
          }
        } else {
          u32x2 o; o.x = pack_bf16(v[0], v[1]); o.y = pack_bf16(v[2], v[3]);
          *(u32x2*)(UBR + (size_t)r * D + (c - 2048)) = o;
        }
      }
    }
  }
};
struct EpiCoef {
  const float *b_a, *b_x, *lam; const bf16_t* UC; bf16_t *LA, *LB;
  __device__ __forceinline__ void operator()(const f32x4 (&acc)[2][4], const f32x4 (&acc2)[2][4], int rbase, int cbase) const {
#pragma unroll
    for (int ni = 0; ni < 4; ++ni) {
      const int c = cbase + ni * 16;
      const f32x4 ba = *(const f32x4*)(b_a + c), bx = *(const f32x4*)(b_x + c), lm = *(const f32x4*)(lam + c);
      float sp[4];
#pragma unroll
      for (int j = 0; j < 4; ++j) sp[j] = log1pf(expf(-lm[j]));
#pragma unroll
      for (int mi = 0; mi < 2; ++mi) {
        const int r = rbase + 16 * mi;
        const u32x2 uu = *(const u32x2*)(UC + (size_t)r * D + c);
        const float uv[4] = {__uint_as_float(uu.x << 16), __uint_as_float(uu.x & 0xffff0000u), __uint_as_float(uu.y << 16), __uint_as_float(uu.y & 0xffff0000u)};
        float lav[4], bv[4];
#pragma unroll
        for (int j = 0; j < 4; ++j) {
          const float rg = sigmoid_f(acc[mi][ni][j] + ba[j]);
          const float ig = sigmoid_f(acc2[mi][ni][j] + bx[j]);
          const float log_a = -8.0f * rg * sp[j];
          lav[j] = log_a;
          bv[j] = sqrtf(-expm1f(2.0f * log_a)) * ig * uv[j];
        }
        u32x2 o1, o2; o1.x = pack_bf16(lav[0], lav[1]); o1.y = pack_bf16(lav[2], lav[3]); o2.x = pack_bf16(bv[0], bv[1]); o2.y = pack_bf16(bv[2], bv[3]);
        *(u32x2*)(LA + (size_t)r * D + c) = o1;
        *(u32x2*)(LB + (size_t)r * D + c) = o2;
      }
    }
  }
};

template <class Epi>
__device__ void gemm_phase(const bf16_t* A, const bf16_t* Bt, int K, int mtiles, int ntiles, unsigned char* lds, const Epi& epi) {
  const int total = mtiles * ntiles;
  for (int item = blockIdx.x; item < total; item += gridDim.x) {
    const int nt = item % ntiles, mt = item / ntiles;
    gemm_tile<false>(A + (size_t)mt * 128 * K, K, Bt + (size_t)nt * 128 * K, nullptr, K, K, lds, epi, mt * 128, nt * 128);
  }
}

__device__ void coef_phase(const Params& p, unsigned char* lds) {
  const bf16_t* UC = (const bf16_t*)(p.ws + OFF_O);
  const bf16_t* WA = (const bf16_t*)(p.ws + OFF_WA); const bf16_t* WX = (const bf16_t*)(p.ws + OFF_WX);
  const int total = (TT / 128) * 32;
  for (int item = blockIdx.x; item < total; item += gridDim.x) {
    const int ct = item & 31, mt = item >> 5, dir = ct >> 4, ctile = ct & 15, blk = ctile >> 1;
    EpiCoef epi{p.rec_b_a + dir * D, p.rec_b_x + dir * D, p.rec_lambda + dir * D, UC,
                (bf16_t*)(p.ws + OFF_LAB) + (size_t)(dir * 2) * TT * D, (bf16_t*)(p.ws + OFF_LAB) + (size_t)(dir * 2 + 1) * TT * D};
    const size_t woff = ((size_t)(dir * 8 + blk) * 256 + (ctile & 1) * 128) * 256;
    gemm_tile<true>(UC + (size_t)mt * 128 * D + blk * 256, D, WA + woff, WX + woff, 256, 256, lds, epi, mt * 128, ctile * 128);
  }
}

constexpr int KLD = 136, VLD = 72, PLD = 72;
__device__ void attn_phase(const Params& p, unsigned char* lds) {
  const bf16_t* Q = (const bf16_t*)(p.ws + OFF_Q); const bf16_t* Kg = (const bf16_t*)(p.ws + OFF_K); const bf16_t* VT = (const bf16_t*)(p.ws + OFF_VT);
  bf16_t* O = (bf16_t*)(p.ws + OFF_O);
  bf16_t* Ks = (bf16_t*)lds;
  bf16_t* Vs = Ks + 64 * KLD;
  bf16_t* Ps = Vs + 128 * VLD;
  const int tid = threadIdx.x, wid = tid >> 6, lane = tid & 63, fr = lane & 15, fq = lane >> 4;
  const int g = wid >> 1, rh = wid & 1;
  bf16_t* Pw = Ps + wid * 16 * PLD;
  const float scale = 0.08838834764831845f;
  for (int item = blockIdx.x; item < 1088; item += gridDim.x) {
    int b, hk, qb, qrow0, nlat, kt0; bool is_ctx;
    if (item < 1024) { is_ctx = false; b = item >> 8; hk = (item >> 6) & 3; qb = item & 63; qrow0 = b * S + qb * 64; kt0 = qb - 2 < 0 ? 0 : qb - 2; const int kt1 = qb + 2 > 63 ? 63 : qb + 2; nlat = kt1 - kt0 + 1; }
    else { is_ctx = true; const int ci = item - 1024; b = ci >> 4; hk = (ci >> 2) & 3; qb = ci & 3; qrow0 = TL + b * CL + qb * 64; kt0 = 0; nlat = 0; }
    const int head = hk * 4 + g;
    const float sink = p.attn_sink[head];
    bf16x8 qf[2][4];
#pragma unroll
    for (int rt = 0; rt < 2; ++rt)
#pragma unroll
      for (int ks = 0; ks < 4; ++ks) qf[rt][ks] = *(const bf16x8*)(Q + (size_t)(qrow0 + rh * 32 + rt * 16 + fr) * D + head * 128 + ks * 32 + fq * 8);
    f32x4 oacc[2][8]; float mst[2][4], lst[2][4];
#pragma unroll
    for (int rt = 0; rt < 2; ++rt) {
#pragma unroll
      for (int dt = 0; dt < 8; ++dt) oacc[rt][dt] = (f32x4){0.f, 0.f, 0.f, 0.f};
#pragma unroll
      for (int j = 0; j < 4; ++j) { mst[rt][j] = sink; lst[rt][j] = 1.0f; }
    }
    const int ntiles = nlat + 4;
    for (int ti = 0; ti < ntiles; ++ti) {
      const bool lat = ti < nlat;
      const int krow0 = lat ? (b * S + (kt0 + ti) * 64) : (TL + b * CL + (ti - nlat) * 64);
      __syncthreads();
#pragma unroll
      for (int i = 0; i < 2; ++i) {
        const int id = tid + 512 * i;
        const int key = id >> 4, dc = (id & 15) * 8;
        *(u32x4*)(Ks + key * KLD + dc) = *(const u32x4*)(Kg + (size_t)(krow0 + key) * 512 + hk * 128 + dc);
        const int d = id >> 3, kc = (id & 7) * 8;
        *(u32x4*)(Vs + d * VLD + kc) = *(const u32x4*)(VT + (size_t)(hk * 128 + d) * TT + krow0 + kc);
      }
      __syncthreads();
#pragma unroll
      for (int rt = 0; rt < 2; ++rt) {
        f32x4 sc[4];
#pragma unroll
        for (int ct = 0; ct < 4; ++ct) {
          sc[ct] = (f32x4){0.f, 0.f, 0.f, 0.f};
#pragma unroll
          for (int ks = 0; ks < 4; ++ks) {
            const bf16x8 kf = *(const bf16x8*)(Ks + (ct * 16 + fr) * KLD + ks * 32 + fq * 8);
            sc[ct] = __builtin_amdgcn_mfma_f32_16x16x32_bf16(qf[rt][ks], kf, sc[ct], 0, 0, 0);
          }
        }
        float mx[4], rs[4], alpha[4];
#pragma unroll
        for (int j = 0; j < 4; ++j) mx[j] = -INFINITY;
#pragma unroll
        for (int ct = 0; ct < 4; ++ct)
#pragma unroll
          for (int j = 0; j < 4; ++j) {
            float v = sc[ct][j] * scale;
            if (lat) {
              const int ipos = qb * 64 + rh * 32 + rt * 16 + fq * 4 + j, jpos = (kt0 + ti) * 64 + ct * 16 + fr;
              const int dd = ipos - jpos;
              if (dd > 128 || dd < -128) v = -INFINITY;
            }
            sc[ct][j] = v; mx[j] = fmaxf(mx[j], v);
          }
#pragma unroll
        for (int j = 0; j < 4; ++j) {
#pragma unroll
          for (int o = 1; o < 16; o <<= 1) mx[j] = fmaxf(mx[j], __shfl_xor(mx[j], o));
          const float mn = fmaxf(mst[rt][j], mx[j]);
          alpha[j] = __expf(mst[rt][j] - mn);
          mst[rt][j] = mn; rs[j] = 0.f;
        }
#pragma unroll
        for (int ct = 0; ct < 4; ++ct)
#pragma unroll
          for (int j = 0; j < 4; ++j) {
            const float pv = __expf(sc[ct][j] - mst[rt][j]);
            rs[j] += pv;
            Pw[(fq * 4 + j) * PLD + ct * 16 + fr] = f2bf(pv);
          }
#pragma unroll
        for (int j = 0; j < 4; ++j) {
#pragma unroll
          for (int o = 1; o < 16; o <<= 1) rs[j] += __shfl_xor(rs[j], o);
          lst[rt][j] = lst[rt][j] * alpha[j] + rs[j];
        }
#pragma unroll
        for (int dt = 0; dt < 8; ++dt)
#pragma unroll
          for (int j = 0; j < 4; ++j) oacc[rt][dt][j] *= alpha[j];
        __syncthreads();
#pragma unroll
        for (int ks = 0; ks < 2; ++ks) {
          const bf16x8 pf = *(const bf16x8*)(Pw + fr * PLD + ks * 32 + fq * 8);
#pragma unroll
          for (int dt = 0; dt < 8; ++dt) {
            const bf16x8 vf = *(const bf16x8*)(Vs + (dt * 16 + fr) * VLD + ks * 32 + fq * 8);
            oacc[rt][dt] = __builtin_amdgcn_mfma_f32_16x16x32_bf16(pf, vf, oacc[rt][dt], 0, 0, 0);
          }
        }
        __syncthreads();
      }
    }
#pragma unroll
    for (int rt = 0; rt < 2; ++rt)
#pragma unroll
      for (int j = 0; j < 4; ++j) {
        const float inv = 1.0f / lst[rt][j];
        bf16_t* orow = O + (size_t)(qrow0 + rh * 32 + rt * 16 + fq * 4 + j) * D + head * 128 + fr;
#pragma unroll
        for (int dt = 0; dt < 8; ++dt) orow[dt * 16] = f2bf(oacc[rt][dt][j] * inv);
      }
    (void)is_ctx;
  }
}

__device__ void peer_phase(const Params& p, int layer, int ntok, int gate_layer, unsigned char* lds) {
  bf16_t* keyS = (bf16_t*)lds;
  float* part = (float*)(lds + 2 * 128 * 128 * 2);
  const int tid = threadIdx.x, wid = tid >> 6, lane = tid & 63;
  const bf16_t* keysG = (const bf16_t*)(p.ws + OFF_KEYS) + (size_t)layer * 2 * 128 * 128;
  for (int i = tid; i < 2 * 128 * 16; i += NT) { const int row = i >> 4, ch = i & 15; *(u32x4*)(keyS + row * 128 + ((ch ^ (row & 15)) * 8)) = *(const u32x4*)(keysG + row * 128 + ch * 8); }
  int ci = 0, cj = 0; bool cvalid = false;
  { int cnt = 0; for (int i = 0; i < 16; ++i) { const int nj = 16 / (i + 1); for (int j = 0; j < nj; ++j) { if (cnt == lane) { ci = i; cj = j; cvalid = true; } ++cnt; } } }
  __syncthreads();
  const bf16_t* H = (const bf16_t*)(p.ws + OFF_H); const bf16_t* PQ = (const bf16_t*)(p.ws + OFF_PQ);
  const bf16_t* UT = (const bf16_t*)(p.ws + OFF_UTAB) + (size_t)layer * NEXP * D; const bf16_t* VTb = (const bf16_t*)(p.ws + OFF_VTAB) + (size_t)layer * NEXP * D;
  float* XS = (float*)(p.ws + OFF_XS);
  const float* gate = (const float*)(p.ws + OFF_MODV) + (size_t)(gate_layer * 5) * NMOD + 5 * D;
  bf16_t* qw = (bf16_t*)(part + wid * 2048);
  for (int tok = blockIdx.x; tok < ntok; tok += gridDim.x) {
    float hreg[4][8];
#pragma unroll
    for (int c = 0; c < 4; ++c) {
      const u32x4 hv = *(const u32x4*)(H + (size_t)tok * D + c * 512 + lane * 8);
#pragma unroll
      for (int t = 0; t < 4; ++t) { hreg[c][2 * t] = __uint_as_float(hv[t] << 16); hreg[c][2 * t + 1] = __uint_as_float(hv[t] & 0xffff0000u); }
    }
    *(u32x2*)(qw + lane * 4) = *(const u32x2*)(PQ + (size_t)tok * D + wid * 256 + lane * 4);
    __syncthreads();
    float sv[2][2] = {{0.f, 0.f}, {0.f, 0.f}};
#pragma unroll
    for (int pp = 0; pp < 2; ++pp)
#pragma unroll 4
      for (int dc = 0; dc < 16; ++dc) {
        const u32x4 qv = *(const u32x4*)(qw + pp * 128 + dc * 8);
        const u32x4 k0 = *(const u32x4*)(keyS + (pp * 128 + lane) * 128 + ((dc ^ (lane & 15)) * 8));
        const u32x4 k1 = *(const u32x4*)(keyS + (pp * 128 + lane + 64) * 128 + ((dc ^ (lane & 15)) * 8));
#pragma unroll
        for (int t = 0; t < 4; ++t) {
          const float ql = __uint_as_float(qv[t] << 16), qh = __uint_as_float(qv[t] & 0xffff0000u);
          sv[pp][0] += ql * __uint_as_float(k0[t] << 16) + qh * __uint_as_float(k0[t] & 0xffff0000u);
          sv[pp][1] += ql * __uint_as_float(k1[t] << 16) + qh * __uint_as_float(k1[t] & 0xffff0000u);
        }
      }
    float sS[2] = {-INFINITY, -INFINITY}; int sI[2] = {0, 0};
#pragma unroll
    for (int pp = 0; pp < 2; ++pp) {
      float v0 = sv[pp][0], v1 = sv[pp][1];
      for (int it = 0; it < 16; ++it) {
        const float M = wave_max(fmaxf(v0, v1));
        const unsigned long long b0 = __ballot(v0 == M);
        int key;
        if (b0) { const int L = __ffsll((long long)b0) - 1; key = L; if (lane == L) v0 = -INFINITY; }
        else { const unsigned long long b1 = __ballot(v1 == M); const int L = __ffsll((long long)b1) - 1; key = L + 64; if (lane == L) v1 = -INFINITY; }
        if (lane == it) { sS[pp] = M; sI[pp] = key; }
      }
    }
    float cand4[4]; int cidx4[4];
#pragma unroll
    for (int q = 0; q < 4; ++q) {
      const int id = lane * 4 + q, i = id >> 4, j = id & 15;
      cand4[q] = __shfl(sS[0], i) + __shfl(sS[1], j);
      cidx4[q] = __shfl(sI[0], i) * 128 + __shfl(sI[1], j);
    }
    float tS = -INFINITY; int tE = 0;
    for (int it = 0; it < 16; ++it) {
      const float lm = fmaxf(fmaxf(cand4[0], cand4[1]), fmaxf(cand4[2], cand4[3]));
      const float M = wave_max(lm);
      const unsigned long long bb = __ballot(lm == M);
      const int L = bb ? (__ffsll((long long)bb) - 1) : 0;
      int esel = 0;
      if (lane == L) {
        if (cand4[0] == M) { esel = cidx4[0]; cand4[0] = -INFINITY; }
        else if (cand4[1] == M) { esel = cidx4[1]; cand4[1] = -INFINITY; }
        else if (cand4[2] == M) { esel = cidx4[2]; cand4[2] = -INFINITY; }
        else { esel = cidx4[3]; cand4[3] = -INFINITY; }
      }
      const int e = __shfl(esel, L);
      if (lane == it) { tS = M; tE = e; }
    }
    const float tmax = __shfl(tS, 0);
    const float ex = lane < 16 ? __expf(tS - tmax) : 0.f;
    const float gsm = ex / wave_sum(ex);
    float accv[4][8];
#pragma unroll
    for (int c = 0; c < 4; ++c)
#pragma unroll
      for (int j = 0; j < 8; ++j) accv[c][j] = 0.f;
#pragma unroll 4
    for (int k = 0; k < 16; ++k) {
      const int e = __shfl(tE, k); const float gk = __shfl(gsm, k);
      const bf16_t* ur = UT + (size_t)e * D + lane * 8; const bf16_t* vr = VTb + (size_t)e * D + lane * 8;
      u32x4 uu[4], vv[4];
#pragma unroll
      for (int c = 0; c < 4; ++c) { uu[c] = *(const u32x4*)(ur + c * 512); vv[c] = *(const u32x4*)(vr + c * 512); }
      float dsum = 0.f;
#pragma unroll
      for (int c = 0; c < 4; ++c)
#pragma unroll
        for (int t = 0; t < 4; ++t) { dsum += __uint_as_float(uu[c][t] << 16) * hreg[c][2 * t]; dsum += __uint_as_float(uu[c][t] & 0xffff0000u) * hreg[c][2 * t + 1]; }
      const float z = wave_sum(dsum);
      const float act = gelu_tanh(z) * gk;
#pragma unroll
      for (int c = 0; c < 4; ++c)
#pragma unroll
        for (int t = 0; t < 4; ++t) { accv[c][2 * t] += act * __uint_as_float(vv[c][t] << 16); accv[c][2 * t + 1] += act * __uint_as_float(vv[c][t] & 0xffff0000u); }
    }
#pragma unroll
    for (int c = 0; c < 4; ++c) {
      *(f32x4*)(part + wid * 2048 + c * 512 + lane * 8) = (f32x4){accv[c][0], accv[c][1], accv[c][2], accv[c][3]};
      *(f32x4*)(part + wid * 2048 + c * 512 + lane * 8 + 4) = (f32x4){accv[c][4], accv[c][5], accv[c][6], accv[c][7]};
    }
    __syncthreads();
    {
      f32x4 s = *(const f32x4*)(part + tid * 4);
#pragma unroll
      for (int w = 1; w < 8; ++w) s += *(const f32x4*)(part + w * 2048 + tid * 4);
      const f32x4 gg = *(const f32x4*)(gate + (size_t)mod_row(tok) * NMOD + tid * 4);
      float* xr = XS + (size_t)tok * D + tid * 4;
      *(f32x4*)xr = *(const f32x4*)xr + gg * s;
    }
    __syncthreads();
  }
}

__device__ void conv_phase(const Params& p) {
  const bf16_t* UBR = (const bf16_t*)(p.ws + OFF_Q); bf16_t* UC = (bf16_t*)(p.ws + OFF_O);
  const int total = TT * 256;
  for (int it = blockIdx.x * NT + threadIdx.x; it < total; it += gridDim.x * NT) {
    const int r = it >> 8, c = (it & 255) * 8;
    int pos, len;
    if (r < TL) { pos = r & 4095; len = S; } else { pos = (r - TL) & 255; len = CL; }
    float acc[8];
    { const float4 b0 = *(const float4*)(p.rec_conv_b + c), b1 = *(const float4*)(p.rec_conv_b + c + 4); acc[0] = b0.x; acc[1] = b0.y; acc[2] = b0.z; acc[3] = b0.w; acc[4] = b1.x; acc[5] = b1.y; acc[6] = b1.z; acc[7] = b1.w; }
#pragma unroll
    for (int k = 0; k < 4; ++k) {
      const int pp = pos - 1 + k;
      if (pp >= 0 && pp < len) {
        const u32x4 uv = *(const u32x4*)(UBR + (size_t)(r - 1 + k) * D + c);
        const float4 w0 = *(const float4*)(p.rec_conv_w + k * D + c), w1 = *(const float4*)(p.rec_conv_w + k * D + c + 4);
        const float wv[8] = {w0.x, w0.y, w0.z, w0.w, w1.x, w1.y, w1.z, w1.w};
#pragma unroll
        for (int t = 0; t < 4; ++t) { acc[2 * t] += wv[2 * t] * __uint_as_float(uv[t] << 16); acc[2 * t + 1] += wv[2 * t + 1] * __uint_as_float(uv[t] & 0xffff0000u); }
      }
    }
    u32x4 o; o.x = pack_bf16(acc[0], acc[1]); o.y = pack_bf16(acc[2], acc[3]); o.z = pack_bf16(acc[4], acc[5]); o.w = pack_bf16(acc[6], acc[7]);
    *(u32x4*)(UC + (size_t)r * D + c) = o;
  }
}

__device__ void scan1_phase(const Params& p) {
  const bf16_t* LAB = (const bf16_t*)(p.ws + OFF_LAB);
  float* CHP = (float*)(p.ws + OFF_CHP); float* CHH = (float*)(p.ws + OFF_CHH);
  const int total = 2 * 272 * 4;
  for (int item = blockIdx.x; item < total; item += gridDim.x) {
    const int cgp = item & 3, ch = (item >> 2) % 272, dir = item / (272 * 4);
    const int c = cgp * 512 + threadIdx.x;
    const bf16_t* a = LAB + ((size_t)(dir * 2) * TT + ch * 64) * D + c; const bf16_t* b = LAB + ((size_t)(dir * 2 + 1) * TT + ch * 64) * D + c;
    float h = 0.f, ls = 0.f;
    if (dir == 0) {
#pragma unroll 16
      for (int t = 0; t < 64; ++t) { const float la = bf2f(a[(size_t)t * D]), bv = bf2f(b[(size_t)t * D]); h = __expf(la) * h + bv; ls += la; }
    } else {
#pragma unroll 16
      for (int t = 63; t >= 0; --t) { const float la = bf2f(a[(size_t)t * D]), bv = bf2f(b[(size_t)t * D]); h = __expf(la) * h + bv; ls += la; }
    }
    CHP[((size_t)dir * 272 + ch) * D + c] = __expf(ls); CHH[((size_t)dir * 272 + ch) * D + c] = h;
  }
}
__device__ void scan2_phase(const Params& p) {
  const float* CHP = (const float*)(p.ws + OFF_CHP); const float* CHH = (const float*)(p.ws + OFF_CHH); float* CIN = (float*)(p.ws + OFF_CIN);
  for (int it = blockIdx.x * NT + threadIdx.x; it < 2 * NB * D; it += gridDim.x * NT) {
    const int c = it & 2047, b = (it >> 11) & 3, dir = it >> 13;
    float carry = 0.f;
    for (int s = 0; s < 68; ++s) {
      int ch;
      if (dir == 0) ch = s < 4 ? (256 + 4 * b + s) : (64 * b + (s - 4));
      else ch = s < 4 ? (256 + 4 * b + (3 - s)) : (64 * b + (63 - (s - 4)));
      const size_t o = ((size_t)dir * 272 + ch) * D + c;
      CIN[o] = carry;
      carry = CHP[o] * carry + CHH[o];
    }
  }
}
__device__ void scan3_phase(const Params& p) {
  const bf16_t* LAB = (const bf16_t*)(p.ws + OFF_LAB); const float* CIN = (const float*)(p.ws + OFF_CIN);
  const bf16_t* GATE = (const bf16_t*)(p.ws + OFF_PQ); bf16_t* A2 = (bf16_t*)(p.ws + OFF_O);
  const int total = 256 * 4;
  for (int item = blockIdx.x; item < total; item += gridDim.x) {
    const int cgp = item & 3, ch = item >> 2;
    const int c = cgp * 512 + threadIdx.x;
    const size_t base = (size_t)ch * 64 * D + c;
    float y[64];
    {
      const bf16_t* a = LAB + base; const bf16_t* b = LAB + (size_t)TT * D + base;
      float h = CIN[(size_t)ch * D + c];
#pragma unroll
      for (int t = 0; t < 64; ++t) { h = __expf(bf2f(a[(size_t)t * D])) * h + bf2f(b[(size_t)t * D]); y[t] = h; }
    }
    {
      const bf16_t* a = LAB + (size_t)2 * TT * D + base; const bf16_t* b = LAB + (size_t)3 * TT * D + base;
      float h = CIN[((size_t)272 + ch) * D + c];
#pragma unroll
      for (int t = 63; t >= 0; --t) { h = __expf(bf2f(a[(size_t)t * D])) * h + bf2f(b[(size_t)t * D]); y[t] += h; }
    }
#pragma unroll
    for (int t = 0; t < 64; ++t) A2[base + (size_t)t * D] = f2bf(y[t] * bf2f(GATE[base + (size_t)t * D]));
  }
}

__global__ void __launch_bounds__(NT) fwd_megakernel(Params p) {
  extern __shared__ __attribute__((aligned(16))) unsigned char lds[];
  cg::grid_group grid = cg::this_grid();
  unsigned char* ws = p.ws;
  float* MODV = (float*)(ws + OFF_MODV);
  float* XS = (float*)(ws + OFF_XS);
  bf16_t* H = (bf16_t*)(ws + OFF_H);

  setup_phase(p, lds);
  grid.sync();
  norm_phase(p, 0, p.norm_mix, 0, TT, true, H);
  grid.sync();
  {
    EpiQKV e{(bf16_t*)(ws + OFF_Q), (bf16_t*)(ws + OFF_K), (bf16_t*)(ws + OFF_VT), (const float*)(ws + OFF_ROPE), (const float*)(ws + OFF_ROPE) + 2048};
    gemm_phase(H, (const bf16_t*)(ws + OFF_WQKV), D, TT / 128, 3072 / 128, lds, e);
  }
  grid.sync();
  attn_phase(p, lds);
  grid.sync();
  {
    EpiResid e{p.x, p.ctx, XS, MODV + 2 * D, true, (SKIP & 1) ? 0.f : 1.f};
    gemm_phase((const bf16_t*)(ws + OFF_O), (const bf16_t*)(ws + OFF_WO), D, TT / 128, D / 128, lds, e);
  }
  grid.sync();
  norm_phase(p, 0, p.norm_ffn, 3, TT, false, H);
  grid.sync();
  {
    EpiBf16 e{(bf16_t*)(ws + OFF_PQ), D};
    gemm_phase(H, (const bf16_t*)(ws + OFF_WPQ), D, TT / 128, D / 128, lds, e);
  }
  grid.sync();
  if (!(SKIP & 2)) peer_phase(p, 0, TT, 0, lds);
  grid.sync();
  norm_phase(p, 1, p.norm_mix + D, 0, TT, false, H);
  grid.sync();
  {
    EpiWin e{(bf16_t*)(ws + OFF_PQ), (bf16_t*)(ws + OFF_Q)};
    gemm_phase(H, (const bf16_t*)(ws + OFF_WIN), D, TT / 128, 4096 / 128, lds, e);
  }
  grid.sync();
  conv_phase(p);
  grid.sync();
  coef_phase(p, lds);
  grid.sync();
  scan1_phase(p);
  grid.sync();
  scan2_phase(p);
  grid.sync();
  scan3_phase(p);
  grid.sync();
  {
    EpiResid e{p.x, p.ctx, XS, MODV + (size_t)5 * NMOD + 2 * D, false, (SKIP & 4) ? 0.f : 1.f};
    gemm_phase((const bf16_t*)(ws + OFF_O), (const bf16_t*)(ws + OFF_WOUT), D, TL / 128, D / 128, lds, e);
  }
  grid.sync();
  norm_phase(p, 1, p.norm_ffn + D, 3, TL, false, H);
  grid.sync();
  {
    EpiBf16 e{(bf16_t*)(ws + OFF_PQ), D};
    gemm_phase(H, (const bf16_t*)(ws + OFF_WPQ) + (size_t)D * D, D, TL / 128, D / 128, lds, e);
  }
  grid.sync();
  if (!(SKIP & 8)) peer_phase(p, 1, TL, 1, lds);
  grid.sync();
  final_norm_phase(p);
}

__global__ void diag_fill(float* out, int n, float v) { for (int i = blockIdx.x * blockDim.x + threadIdx.x; i < n; i += gridDim.x * blockDim.x) out[i] = v; }

extern "C" void kernel_launch(void* const* d_in, const int* in_sizes, int n_in, void* d_out, int out_size, void* d_ws, size_t ws_size, hipStream_t stream) {
  static int grid_blocks = 0;
  if (!grid_blocks) {
    int dev = 0, cus = 0, per_cu = 0;
    (void)hipGetDevice(&dev);
    (void)hipDeviceGetAttribute(&cus, hipDeviceAttributeMultiprocessorCount, dev);
    (void)hipFuncSetAttribute((const void*)fwd_megakernel, hipFuncAttributeMaxDynamicSharedMemorySize, (int)kDynLds);
    (void)hipOccupancyMaxActiveBlocksPerMultiprocessor(&per_cu, fwd_megakernel, NT, kDynLds);
    if (per_cu > 1) per_cu = 1;
    if (per_cu < 1) per_cu = 1;
    grid_blocks = cus * per_cu;
  }
  if (ws_size < WS_NEED) { fprintf(stderr, "workspace too small: %zu < %zu\n", ws_size, (size_t)WS_NEED); diag_fill<<<1024, 256, 0, stream>>>((float*)d_out, out_size, 3.0f); return; }
  Params p{};
  const float* const* in = (const float* const*)d_in;
  p.x = in[0]; p.c = in[1]; p.ctx = in[2]; p.c_ctx = in[3]; p.w_mod = in[4]; p.b_mod = in[5]; p.norm_mix = in[6]; p.norm_ffn = in[7]; p.norm_final = in[8];
  p.attn_w_qkv = in[9]; p.attn_w_o = in[10]; p.attn_sink = in[11];
  p.rec_w_in = in[12]; p.rec_conv_w = in[13]; p.rec_conv_b = in[14]; p.rec_w_a = in[15]; p.rec_b_a = in[16]; p.rec_w_x = in[17]; p.rec_b_x = in[18]; p.rec_lambda = in[19]; p.rec_w_out = in[20];
  p.peer_w_q = in[21]; p.peer_keys = in[22]; p.peer_u = in[23]; p.peer_v = in[24];
  p.out = (float*)d_out; p.ws = (unsigned char*)d_ws;
  void* args[] = {&p};
  hipError_t e = hipLaunchCooperativeKernel((void*)fwd_megakernel, dim3(grid_blocks), dim3(NT), args, kDynLds, stream);
  if (e != hipSuccess) { fprintf(stderr, "cooperative launch failed: %s (grid %d)\n", hipGetErrorString(e), grid_blocks); diag_fill<<<1024, 256, 0, stream>>>((float*)d_out, out_size, 5.0f); }
}
```

```cpp
#include <hip/hip_runtime.h>
#include <hip/hip_cooperative_groups.h>
#include <cstdio>
namespace cg = cooperative_groups;

typedef unsigned short bf16_t;
typedef short bf16x8 __attribute__((ext_vector_type(8)));
typedef float f32x4 __attribute__((ext_vector_type(4)));
typedef unsigned u32x4 __attribute__((ext_vector_type(4)));
typedef unsigned u32x2 __attribute__((ext_vector_type(2)));
typedef __bf16 bf16x2_t __attribute__((ext_vector_type(2)));

constexpr int D = 2048, NB = 4, S = 4096, CL = 256;
constexpr int TL = NB * S, TC = NB * CL, TT = TL + TC;
constexpr int NT = 512;
constexpr int NMOD = 6 * D;
constexpr int NEXP = 16384;
constexpr size_t kDynLds = 128 * 1024;
#ifndef SKIP
#define SKIP 0
#endif
#ifndef DUP
#define DUP 0
#endif

constexpr size_t al256(size_t x) { return (x + 255) & ~(size_t)255; }
constexpr size_t OFF_WQKV = 0;
constexpr size_t OFF_WO   = OFF_WQKV + al256((size_t)3072 * 2048 * 2);
constexpr size_t OFF_WPQ  = OFF_WO + al256((size_t)2048 * 2048 * 2);
constexpr size_t OFF_WIN  = OFF_WPQ + al256((size_t)2 * 2048 * 2048 * 2);
constexpr size_t OFF_WOUT = OFF_WIN + al256((size_t)4096 * 2048 * 2);
constexpr size_t OFF_WA   = OFF_WOUT + al256((size_t)2048 * 2048 * 2);
constexpr size_t OFF_WX   = OFF_WA + al256((size_t)16 * 256 * 256 * 2);
constexpr size_t OFF_KEYS = OFF_WX + al256((size_t)16 * 256 * 256 * 2);
constexpr size_t OFF_UTAB = OFF_KEYS + al256((size_t)2 * 2 * 128 * 128 * 2);
constexpr size_t OFF_VTAB = OFF_UTAB + al256((size_t)2 * NEXP * D);
constexpr size_t OFF_USC  = OFF_VTAB + al256((size_t)2 * NEXP * D);
constexpr size_t OFF_VSC  = OFF_USC + al256((size_t)2 * NEXP * 4);
constexpr size_t OFF_MODV = OFF_VSC + al256((size_t)2 * NEXP * 4);
constexpr size_t OFF_ROPE = OFF_MODV + al256((size_t)2 * 5 * NMOD * 4);
constexpr size_t OFF_XS   = OFF_ROPE + al256((size_t)2 * 2048 * 4);
constexpr size_t SZ_ACT  = al256((size_t)TT * D * 2);
constexpr size_t OFF_H    = OFF_XS + al256((size_t)TT * D * 4);
constexpr size_t OFF_Q    = OFF_H + SZ_ACT;
constexpr size_t OFF_X    = OFF_Q + SZ_ACT;
constexpr size_t OFF_K    = OFF_X + 2 * SZ_ACT;
constexpr size_t OFF_VT   = OFF_K + al256((size_t)TT * 512 * 2);
constexpr size_t OFF_O    = OFF_VT + al256((size_t)TT * 512 * 2);
constexpr size_t OFF_PQ   = OFF_O + SZ_ACT;
constexpr size_t OFF_LAB  = OFF_H;
constexpr size_t OFF_CHP  = OFF_K;
constexpr size_t OFF_CHH  = OFF_CHP + al256((size_t)2 * 272 * D * 4);
constexpr size_t OFF_CIN  = OFF_CHH + al256((size_t)2 * 272 * D * 4);
constexpr size_t OFF_IDX  = OFF_PQ + SZ_ACT;
constexpr size_t OFF_GW   = OFF_IDX + al256((size_t)TT * 128 * 4);
constexpr size_t WS_NEED  = OFF_GW + al256((size_t)TT * 128 * 4);
static_assert(OFF_CIN + al256((size_t)2 * 272 * D * 4) <= OFF_O, "scan carries must fit in the K/VT region");
static_assert(WS_NEED <= ((size_t)1 << 30), "workspace map exceeds 1 GiB");

struct Params {
  const float *x, *c, *ctx, *c_ctx, *w_mod, *b_mod, *norm_mix, *norm_ffn, *norm_final;
  const float *attn_w_qkv, *attn_w_o, *attn_sink;
  const float *rec_w_in, *rec_conv_w, *rec_conv_b, *rec_w_a, *rec_b_a, *rec_w_x, *rec_b_x, *rec_lambda, *rec_w_out;
  const float *peer_w_q, *peer_keys, *peer_u, *peer_v;
  float* out; unsigned char* ws;
};

__device__ __forceinline__ float bf2f(bf16_t v) { return __uint_as_float((unsigned)v << 16); }
__device__ __forceinline__ bf16_t f2bf(float f) { unsigned u = __float_as_uint(f); u += 0x7fffu + ((u >> 16) & 1u); return (bf16_t)(u >> 16); }
__device__ __forceinline__ unsigned pack_bf16(float lo, float hi) { return (unsigned)f2bf(lo) | ((unsigned)f2bf(hi) << 16); }
template <int CTRL, int RM, bool BC> __device__ __forceinline__ float dppf(float old, float src) {
  return __builtin_bit_cast(float, __builtin_amdgcn_update_dpp(__builtin_bit_cast(int, old), __builtin_bit_cast(int, src), CTRL, RM, 0xf, BC));
}
__device__ __forceinline__ float wave_sum(float v) {
  v += dppf<0x111, 0xf, true>(0.f, v); v += dppf<0x112, 0xf, true>(0.f, v); v += dppf<0x114, 0xf, true>(0.f, v); v += dppf<0x118, 0xf, true>(0.f, v);
  v += dppf<0x142, 0xa, false>(0.f, v); v += dppf<0x143, 0xc, false>(0.f, v);
  return __builtin_bit_cast(float, __builtin_amdgcn_readlane(__builtin_bit_cast(int, v), 63));
}
__device__ __forceinline__ float wave_max(float v) {
  v = fmaxf(v, dppf<0x111, 0xf, false>(v, v)); v = fmaxf(v, dppf<0x112, 0xf, false>(v, v)); v = fmaxf(v, dppf<0x114, 0xf, false>(v, v)); v = fmaxf(v, dppf<0x118, 0xf, false>(v, v));
  v = fmaxf(v, dppf<0x142, 0xa, false>(v, v)); v = fmaxf(v, dppf<0x143, 0xc, false>(v, v));
  return __builtin_bit_cast(float, __builtin_amdgcn_readlane(__builtin_bit_cast(int, v), 63));
}
__device__ __forceinline__ float gelu_tanh(float x) {
  const float y = 0.7978845608028654f * (x + 0.044715f * x * x * x);
  const float t = 1.0f - 2.0f / (1.0f + __expf(2.0f * y));
  return 0.5f * x * (1.0f + t);
}
__device__ __forceinline__ float sigmoid_f(float x) { return 1.0f / (1.0f + __expf(-x)); }
__device__ __forceinline__ int mod_row(int r) { return r < TL ? (r >> 12) : 4; }

__device__ __forceinline__ void mod_item(const Params& p, int item, float* lds) {
  float* sil = lds;
  float* red = lds + 5 * 2048;
  const int tid = threadIdx.x, wid = tid >> 6, lane = tid & 63;
  for (int i = tid; i < 5 * 2048; i += NT) {
    const int m = i >> 11, k = i & 2047;
    const float v = (m < 4) ? p.c[m * 2048 + k] : p.c_ctx[k];
    sil[i] = v / (1.0f + expf(-v));
  }
  __syncthreads();
  const int layer = item / 48, cgp = item % 48;
  const float* W = p.w_mod + (size_t)layer * 2048 * NMOD + cgp * 256 + lane * 4;
  float acc[5][4];
#pragma unroll
  for (int m = 0; m < 5; ++m)
#pragma unroll
    for (int j = 0; j < 4; ++j) acc[m][j] = 0.f;
  const int k0 = wid * 256;
#pragma unroll 8
  for (int k = k0; k < k0 + 256; ++k) {
    const float4 w = *(const float4*)(W + (size_t)k * NMOD);
#pragma unroll
    for (int m = 0; m < 5; ++m) {
      const float s = sil[m * 2048 + k];
      acc[m][0] += s * w.x; acc[m][1] += s * w.y; acc[m][2] += s * w.z; acc[m][3] += s * w.w;
    }
  }
#pragma unroll
  for (int m = 0; m < 5; ++m)
#pragma unroll
    for (int j = 0; j < 4; ++j) red[(wid * 5 + m) * 256 + lane * 4 + j] = acc[m][j];
  __syncthreads();
  float* MODV = (float*)(p.ws + OFF_MODV);
  for (int o = tid; o < 1280; o += NT) {
    const int m = o >> 8, n = o & 255;
    float s = 0.f;
#pragma unroll
    for (int w = 0; w < 8; ++w) s += red[(w * 5 + m) * 256 + n];
    const int col = cgp * 256 + n;
    MODV[(size_t)(layer * 5 + m) * NMOD + col] = s + p.b_mod[layer * NMOD + col];
  }
  __syncthreads();
}

__device__ __forceinline__ void transpose_tile(const float* W, int ldw, bf16_t* Wt, int ldt, int k0, int n0, float* lds) {
  const int tid = threadIdx.x;
  const int tk = tid >> 4, tn = (tid & 15) * 4;
#pragma unroll
  for (int i = 0; i < 2; ++i) {
    const int k = tk + 32 * i;
    const float4 v = *(const float4*)(W + (size_t)(k0 + k) * ldw + n0 + tn);
    lds[k * 65 + tn + 0] = v.x; lds[k * 65 + tn + 1] = v.y; lds[k * 65 + tn + 2] = v.z; lds[k * 65 + tn + 3] = v.w;
  }
  __syncthreads();
  const int wn = tid >> 3, kc = (tid & 7) * 8;
  u32x4 o;
  o.x = pack_bf16(lds[(kc + 0) * 65 + wn], lds[(kc + 1) * 65 + wn]);
  o.y = pack_bf16(lds[(kc + 2) * 65 + wn], lds[(kc + 3) * 65 + wn]);
  o.z = pack_bf16(lds[(kc + 4) * 65 + wn], lds[(kc + 5) * 65 + wn]);
  o.w = pack_bf16(lds[(kc + 6) * 65 + wn], lds[(kc + 7) * 65 + wn]);
  *(u32x4*)(Wt + (size_t)(n0 + wn) * ldt + k0 + kc) = o;
  __syncthreads();
}

__device__ __forceinline__ void transpose_job(const Params& p, int t, float* lds) {
  const float* W; bf16_t* Wt; int K, N;
  if (t < 1536) { W = p.attn_w_qkv; Wt = (bf16_t*)(p.ws + OFF_WQKV); K = 2048; N = 3072; }
  else if ((t -= 1536) < 1024) { W = p.attn_w_o; Wt = (bf16_t*)(p.ws + OFF_WO); K = 2048; N = 2048; }
  else if ((t -= 1024) < 2048) { const int l = t >> 10; t &= 1023; W = p.peer_w_q + (size_t)l * 2048 * 2048; Wt = (bf16_t*)(p.ws + OFF_WPQ) + (size_t)l * 2048 * 2048; K = 2048; N = 2048; }
  else if ((t -= 2048) < 2048) { W = p.rec_w_in; Wt = (bf16_t*)(p.ws + OFF_WIN); K = 2048; N = 4096; }
  else if ((t -= 2048) < 1024) { W = p.rec_w_out; Wt = (bf16_t*)(p.ws + OFF_WOUT); K = 2048; N = 2048; }
  else if ((t -= 1024) < 256) { const int mtx = t >> 4; t &= 15; W = p.rec_w_a + (size_t)mtx * 65536; Wt = (bf16_t*)(p.ws + OFF_WA) + (size_t)mtx * 65536; K = 256; N = 256; }
  else { t -= 256; const int mtx = t >> 4; t &= 15; W = p.rec_w_x + (size_t)mtx * 65536; Wt = (bf16_t*)(p.ws + OFF_WX) + (size_t)mtx * 65536; K = 256; N = 256; }
  const int ntn = N / 64;
  transpose_tile(W, N, Wt, K, (t / ntn) * 64, (t % ntn) * 64, lds);
}

__device__ __forceinline__ void convert8(const float* src, bf16_t* dst) {
  const float4 a = ((const float4*)src)[0], b = ((const float4*)src)[1];
  u32x4 o; o.x = pack_bf16(a.x, a.y); o.y = pack_bf16(a.z, a.w); o.z = pack_bf16(b.x, b.y); o.w = pack_bf16(b.z, b.w);
  *(u32x4*)dst = o;
}

constexpr int P0_MOD = 96, P0_TR = 8192, P0_KEYS = 16, P0_ROPE = 1, P0_TAB = 8192;
constexpr int P0_TOTAL = P0_MOD + P0_TR + P0_KEYS + P0_ROPE + P0_TAB;

__device__ __forceinline__ void setup_phase(const Params& p, unsigned char* lds_raw) {
  float* lds = (float*)lds_raw;
  for (int item = blockIdx.x; item < P0_TOTAL; item += gridDim.x) {
    int t = item;
    if (t < P0_MOD) { mod_item(p, t, lds); continue; }
    t -= P0_MOD;
    if (t < P0_TR) { transpose_job(p, t, lds); continue; }
    t -= P0_TR;
    if (t < P0_KEYS) { const size_t e = (size_t)t * 4096 + threadIdx.x * 8; convert8(p.peer_keys + e, (bf16_t*)(p.ws + OFF_KEYS) + e); continue; }
    t -= P0_KEYS;
    if (t < P0_ROPE) {
      float* cosT = (float*)(p.ws + OFF_ROPE); float* sinT = cosT + 2048;
      for (int e = threadIdx.x; e < 2048; e += NT) {
        const int pos = e >> 5, j = e & 31;
        const float inv = powf(10000.0f, -(float)(2 * j) / 64.0f);
        const float ang = (float)pos * inv;
        cosT[e] = cosf(ang); sinT[e] = sinf(ang);
      }
      continue;
    }
    t -= P0_ROPE;
    {
      const int wid = threadIdx.x >> 6, lane = threadIdx.x & 63;
      const int R = t * 8 + wid, tb = R >> 15, row = R & 32767;
      const float* src = (tb == 0 ? p.peer_u : p.peer_v) + (size_t)row * D;
      unsigned* dst = (unsigned*)(p.ws + (tb == 0 ? OFF_UTAB : OFF_VTAB) + (size_t)row * D);
      float* scp = (float*)(p.ws + (tb == 0 ? OFF_USC : OFF_VSC)) + row;
      float4 v[8]; float mx = 0.f;
#pragma unroll
      for (int i = 0; i < 8; ++i) { v[i] = ((const float4*)src)[i * 64 + lane]; mx = fmaxf(mx, fmaxf(fmaxf(fabsf(v[i].x), fabsf(v[i].y)), fmaxf(fabsf(v[i].z), fabsf(v[i].w)))); }
      mx = wave_max(mx);
      const float sc = mx > 0.f ? mx * (1.0f / 127.0f) : 1.0f, inv = 1.0f / sc;
#pragma unroll
      for (int i = 0; i < 8; ++i) {
        const unsigned q0 = (unsigned)((int)fminf(fmaxf(rintf(v[i].x * inv), -127.f), 127.f) + 128), q1 = (unsigned)((int)fminf(fmaxf(rintf(v[i].y * inv), -127.f), 127.f) + 128);
        const unsigned q2 = (unsigned)((int)fminf(fmaxf(rintf(v[i].z * inv), -127.f), 127.f) + 128), q3 = (unsigned)((int)fminf(fmaxf(rintf(v[i].w * inv), -127.f), 127.f) + 128);
        dst[i * 64 + lane] = q0 | (q1 << 8) | (q2 << 16) | (q3 << 24);
      }
      if (lane == 0) *scp = sc;
    }
  }
}

__device__ __forceinline__ void norm_phase(const Params& p, int layer, const float* gain, int shift_idx, int nrows, bool from_input, bf16_t* H) {
  const int wid = threadIdx.x >> 6, lane = threadIdx.x & 63;
  const float* MODV = (const float*)(p.ws + OFF_MODV);
  const float* XS = (const float*)(p.ws + OFF_XS);
  for (int r = blockIdx.x * 8 + wid; r < nrows; r += gridDim.x * 8) {
    const float* src = from_input ? (r < TL ? p.x + (size_t)r * D : p.ctx + (size_t)(r - TL) * D) : XS + (size_t)r * D;
    const float* mv = MODV + (size_t)(layer * 5 + mod_row(r)) * NMOD;
    const float* sh = mv + shift_idx * D; const float* sc = sh + D;
    float4 v[8]; float ss = 0.f;
#pragma unroll
    for (int i = 0; i < 8; ++i) { v[i] = ((const float4*)src)[i * 64 + lane]; ss += v[i].x * v[i].x + v[i].y * v[i].y + v[i].z * v[i].z + v[i].w * v[i].w; }
    ss = wave_sum(ss);
    const float rs = rsqrtf(ss * (1.0f / D) + 1e-6f);
#pragma unroll
    for (int i = 0; i < 8; ++i) {
      const float4 g = ((const float4*)gain)[i * 64 + lane], a = ((const float4*)sh)[i * 64 + lane], b = ((const float4*)sc)[i * 64 + lane];
      const float o0 = v[i].x * rs * g.x * (1.0f + b.x) + a.x, o1 = v[i].y * rs * g.y * (1.0f + b.y) + a.y;
      const float o2 = v[i].z * rs * g.z * (1.0f + b.z) + a.z, o3 = v[i].w * rs * g.w * (1.0f + b.w) + a.w;
      u32x2 o; o.x = pack_bf16(o0, o1); o.y = pack_bf16(o2, o3);
      *(u32x2*)(H + (size_t)r * D + i * 256 + lane * 4) = o;
    }
  }
}

__device__ __forceinline__ void final_norm_phase(const Params& p) {
  const int wid = threadIdx.x >> 6, lane = threadIdx.x & 63;
  const float* XS = (const float*)(p.ws + OFF_XS);
  for (int r = blockIdx.x * 8 + wid; r < TL; r += gridDim.x * 8) {
    const float4* xr = (const float4*)(XS + (size_t)r * D);
    float4 v[8]; float ss = 0.f;
#pragma unroll
    for (int i = 0; i < 8; ++i) { v[i] = xr[i * 64 + lane]; ss += v[i].x * v[i].x + v[i].y * v[i].y + v[i].z * v[i].z + v[i].w * v[i].w; }
    ss = wave_sum(ss);
    const float rs = rsqrtf(ss * (1.0f / D) + 1e-6f);
    float4* orow = (float4*)(p.out + (size_t)r * D);
#pragma unroll
    for (int i = 0; i < 8; ++i) { const float4 g = ((const float4*)p.norm_final)[i * 64 + lane]; float4 o; o.x = v[i].x * rs * g.x; o.y = v[i].y * rs * g.y; o.z = v[i].z * rs * g.z; o.w = v[i].w * rs * g.w; orow[i * 64 + lane] = o; }
  }
}

constexpr int GLD = 72;
template <bool DUAL, class Epi>
__device__ __forceinline__ void gemm_tile(const bf16_t* __restrict__ Ap, int lda, const bf16_t* __restrict__ Bp, const bf16_t* __restrict__ B2p, int ldb, int K,
                                          unsigned char* lds, const Epi& epi, int m0, int n0) {
  const int tid = threadIdx.x, wid = tid >> 6, lane = tid & 63, wm = wid >> 1, wn = wid & 1, fr = lane & 15, fq = lane >> 4;
  bf16_t* As = (bf16_t*)lds; bf16_t* Bs = As + 2 * 128 * GLD; bf16_t* B2s = Bs + 2 * 128 * GLD;
  const int lr0 = tid >> 3, lc = (tid & 7) * 8;
  f32x4 acc[2][4], acc2[2][4];
#pragma unroll
  for (int i = 0; i < 2; ++i)
#pragma unroll
    for (int j = 0; j < 4; ++j) { acc[i][j] = (f32x4){0.f, 0.f, 0.f, 0.f}; acc2[i][j] = (f32x4){0.f, 0.f, 0.f, 0.f}; }
  u32x4 ra[2], rb[2], rb2[2];
  const int nk = K >> 6;
#pragma unroll
  for (int i = 0; i < 2; ++i) {
    ra[i] = *(const u32x4*)(Ap + (size_t)(lr0 + 64 * i) * lda + lc);
    rb[i] = *(const u32x4*)(Bp + (size_t)(lr0 + 64 * i) * ldb + lc);
    if (DUAL) rb2[i] = *(const u32x4*)(B2p + (size_t)(lr0 + 64 * i) * ldb + lc);
  }
#pragma unroll
  for (int i = 0; i < 2; ++i) {
    *(u32x4*)(As + (lr0 + 64 * i) * GLD + lc) = ra[i];
    *(u32x4*)(Bs + (lr0 + 64 * i) * GLD + lc) = rb[i];
    if (DUAL) *(u32x4*)(B2s + (lr0 + 64 * i) * GLD + lc) = rb2[i];
  }
  __syncthreads();
  for (int kt = 0; kt < nk; ++kt) {
    const int buf = kt & 1;
    if (kt + 1 < nk) {
#pragma unroll
      for (int i = 0; i < 2; ++i) {
        ra[i] = *(const u32x4*)(Ap + (size_t)(lr0 + 64 * i) * lda + (kt + 1) * 64 + lc);
        rb[i] = *(const u32x4*)(Bp + (size_t)(lr0 + 64 * i) * ldb + (kt + 1) * 64 + lc);
        if (DUAL) rb2[i] = *(const u32x4*)(B2p + (size_t)(lr0 + 64 * i) * ldb + (kt + 1) * 64 + lc);
      }
    }
    const bf16_t* Ab = As + buf * 128 * GLD; const bf16_t* Bb = Bs + buf * 128 * GLD; const bf16_t* B2b = B2s + buf * 128 * GLD;
#pragma unroll
    for (int ks = 0; ks < 2; ++ks) {
      bf16x8 af[2], bfr[4];
#pragma unroll
      for (int mi = 0; mi < 2; ++mi) af[mi] = *(const bf16x8*)(Ab + (wm * 32 + mi * 16 + fr) * GLD + ks * 32 + fq * 8);
#pragma unroll
      for (int ni = 0; ni < 4; ++ni) bfr[ni] = *(const bf16x8*)(Bb + (wn * 64 + ni * 16 + fr) * GLD + ks * 32 + fq * 8);
#pragma unroll
      for (int mi = 0; mi < 2; ++mi)
#pragma unroll
        for (int ni = 0; ni < 4; ++ni) acc[mi][ni] = __builtin_amdgcn_mfma_f32_16x16x32_bf16(bfr[ni], af[mi], acc[mi][ni], 0, 0, 0);
      if (DUAL) {
#pragma unroll
        for (int ni = 0; ni < 4; ++ni) bfr[ni] = *(const bf16x8*)(B2b + (wn * 64 + ni * 16 + fr) * GLD + ks * 32 + fq * 8);
#pragma unroll
        for (int mi = 0; mi < 2; ++mi)
#pragma unroll
          for (int ni = 0; ni < 4; ++ni) acc2[mi][ni] = __builtin_amdgcn_mfma_f32_16x16x32_bf16(bfr[ni], af[mi], acc2[mi][ni], 0, 0, 0);
      }
    }
    if (kt + 1 < nk) {
      const int nb = buf ^ 1;
#pragma unroll
      for (int i = 0; i < 2; ++i) {
        *(u32x4*)(As + nb * 128 * GLD + (lr0 + 64 * i) * GLD + lc) = ra[i];
        *(u32x4*)(Bs + nb * 128 * GLD + (lr0 + 64 * i) * GLD + lc) = rb[i];
        if (DUAL) *(u32x4*)(B2s + nb * 128 * GLD + (lr0 + 64 * i) * GLD + lc) = rb2[i];
      }
    }
    __syncthreads();
  }
  epi(acc, acc2, m0 + wm * 32 + fr, n0 + wn * 64 + fq * 4);
}

struct EpiQKV {
  bf16_t *Q, *Kb, *VT; const float *cosT, *sinT;
  __device__ __forceinline__ void operator()(const f32x4 (&acc)[2][4], const f32x4 (&)[2][4], int rbase, int cbase) const {
    const int n0 = cbase & ~127;
#pragma unroll
    for (int mi = 0; mi < 2; ++mi) {
      const int r = rbase + 16 * mi;
      if (n0 < 2560) {
        const bool latent = r < TL;
        const int s = r & 4095;
        const int pos = ((cbase & 64) == 0) ? (s >> 6) : (s & 63);
        const int cl = cbase & 63;
        bf16_t* dst = (n0 < 2048) ? (Q + (size_t)r * D + cbase) : (Kb + (size_t)r * 512 + (cbase - 2048));
#pragma unroll
        for (int ni = 0; ni < 2; ++ni) {
          f32x4 x1 = acc[mi][ni], x2 = acc[mi][ni + 2], y1 = x1, y2 = x2;
          if (latent) {
            const f32x4 cs = *(const f32x4*)(cosT + pos * 32 + ni * 16 + cl), sn = *(const f32x4*)(sinT + pos * 32 + ni * 16 + cl);
            y1 = x1 * cs - x2 * sn; y2 = x2 * cs + x1 * sn;
          }
          u32x2 o1, o2; o1.x = pack_bf16(y1[0], y1[1]); o1.y = pack_bf16(y1[2], y1[3]); o2.x = pack_bf16(y2[0], y2[1]); o2.y = pack_bf16(y2[2], y2[3]);
          *(u32x2*)(dst + ni * 16) = o1; *(u32x2*)(dst + (ni + 2) * 16) = o2;
        }
      } else {
#pragma unroll
        for (int ni = 0; ni < 4; ++ni)
#pragma unroll
          for (int j = 0; j < 4; ++j) VT[(size_t)(cbase - 2560 + ni * 16 + j) * TT + r] = f2bf(acc[mi][ni][j]);
      }
    }
  }
};
struct EpiResid {
  const float *x, *ctx; float* XS; const float* gate  ; bool from_input; float mul;
  __device__ __forceinline__ void operator()(const f32x4 (&acc)[2][4], const f32x4 (&)[2][4], int rbase, int cbase) const {
#pragma unroll
    for (int mi = 0; mi < 2; ++mi) {
      const int r = rbase + 16 * mi;
      const float* src = from_input ? (r < TL ? x + (size_t)r * D : ctx + (size_t)(r - TL) * D) : XS + (size_t)r * D;
      const float* g = gate + (size_t)mod_row(r) * NMOD;
#pragma unroll
      for (int ni = 0; ni < 4; ++ni) {
        const int c = cbase + ni * 16;
        const f32x4 b = *(const f32x4*)(src + c), gg = *(const f32x4*)(g + c);
        *(f32x4*)(XS + (size_t)r * D + c) = b + gg * acc[mi][ni] * mul;
      }
    }
  }
};
struct EpiBf16 {
  bf16_t* O; int ldo;
  __device__ __forceinline__ void operator()(const f32x4 (&acc)[2][4], const f32x4 (&)[2][4], int rbase, int cbase) const {
#pragma unroll
    for (int mi = 0; mi < 2; ++mi)
#pragma unroll
      for (int ni = 0; ni < 4; ++ni) {
        u32x2 o; o.x = pack_bf16(acc[mi][ni][0], acc[mi][ni][1]); o.y = pack_bf16(acc[mi][ni][2], acc[mi][ni][3]);
        *(u32x2*)(O + (size_t)(rbase + 16 * mi) * ldo + cbase + ni * 16) = o;
      }
  }
};
struct EpiWin {
  bf16_t *GATE, *UBR;
  __device__ __forceinline__ void operator()(const f32x4 (&acc)[2][4], const f32x4 (&)[2][4], int rbase, int cbase) const {
#pragma unroll
    for (int mi = 0; mi < 2; ++mi) {
      const int r = rbase + 16 * mi;
#pragma unroll
      for (int ni = 0; ni < 4; ++ni) {
        const int c = cbase + ni * 16;
        f32x4 v = acc[mi][ni];
        if (c < 2048) {
          if (r < TL) {
            u32x2 o; o.x = pack_bf16(gelu_tanh(v[0]), gelu_tanh(v[1])); o.y = pack_bf16(gelu_tanh(v[2]), gelu_tanh(v[3]));
            *(u32x2*)(GATE + (size_t)r * D + c) = o;
          }
        } else {
          u32x2 o; o.x = pack_bf16(v[0], v[1]); o.y = pack_bf16(v[2], v[3]);
          *(u32x2*)(UBR + (size_t)r * D + (c - 2048)) = o;
        }
      }
    }
  }
};
struct EpiCoef {
  const float *b_a, *b_x, *lam; const bf16_t* UC; bf16_t *LA, *LB;
  __device__ __forceinline__ void operator()(const f32x4 (&acc)[2][4], const f32x4 (&acc2)[2][4], int rbase, int cbase) const {
#pragma unroll
    for (int ni = 0; ni < 4; ++ni) {
      const int c = cbase + ni * 16;
      const f32x4 ba = *(const f32x4*)(b_a + c), bx = *(const f32x4*)(b_x + c), lm = *(const f32x4*)(lam + c);
      float sp[4];
#pragma unroll
      for (int j = 0; j < 4; ++j) sp[j] = log1pf(expf(-lm[j]));
#pragma unroll
      for (int mi = 0; mi < 2; ++mi) {
        const int r = rbase + 16 * mi;
        const u32x2 uu = *(const u32x2*)(UC + (size_t)r * D + c);
        const float uv[4] = {__uint_as_float(uu.x << 16), __uint_as_float(uu.x & 0xffff0000u), __uint_as_float(uu.y << 16), __uint_as_float(uu.y & 0xffff0000u)};
        float lav[4], bv[4];
#pragma unroll
        for (int j = 0; j < 4; ++j) {
          const float rg = sigmoid_f(acc[mi][ni][j] + ba[j]);
          const float ig = sigmoid_f(acc2[mi][ni][j] + bx[j]);
          const float log_a = -8.0f * rg * sp[j];
          lav[j] = log_a;
          bv[j] = sqrtf(-expm1f(2.0f * log_a)) * ig * uv[j];
        }
        u32x2 o1, o2; o1.x = pack_bf16(lav[0], lav[1]); o1.y = pack_bf16(lav[2], lav[3]); o2.x = pack_bf16(bv[0], bv[1]); o2.y = pack_bf16(bv[2], bv[3]);
        *(u32x2*)(LA + (size_t)r * D + c) = o1;
        *(u32x2*)(LB + (size_t)r * D + c) = o2;
      }
    }
  }
};

template <class Epi>
__device__ __forceinline__ void gemm_phase(const bf16_t* A, const bf16_t* Bt, int K, int mtiles, int ntiles, unsigned char* lds, const Epi& epi) {
  const int total = mtiles * ntiles;
  for (int item = blockIdx.x; item < total; item += gridDim.x) {
    const int nt = item % ntiles, mt = item / ntiles;
    gemm_tile<false>(A + (size_t)mt * 128 * K, K, Bt + (size_t)nt * 128 * K, nullptr, K, K, lds, epi, mt * 128, nt * 128);
  }
}

__device__ __forceinline__ void coef_phase(const Params& p, unsigned char* lds) {
  const bf16_t* UC = (const bf16_t*)(p.ws + OFF_O);
  const bf16_t* WA = (const bf16_t*)(p.ws + OFF_WA); const bf16_t* WX = (const bf16_t*)(p.ws + OFF_WX);
  const int total = (TT / 128) * 32;
  for (int item = blockIdx.x; item < total; item += gridDim.x) {
    const int ct = item & 31, mt = item >> 5, dir = ct >> 4, ctile = ct & 15, blk = ctile >> 1;
    EpiCoef epi{p.rec_b_a + dir * D, p.rec_b_x + dir * D, p.rec_lambda + dir * D, UC,
                (bf16_t*)(p.ws + OFF_LAB) + (size_t)(dir * 2) * TT * D, (bf16_t*)(p.ws + OFF_LAB) + (size_t)(dir * 2 + 1) * TT * D};
    const size_t woff = ((size_t)(dir * 8 + blk) * 256 + (ctile & 1) * 128) * 256;
    gemm_tile<true>(UC + (size_t)mt * 128 * D + blk * 256, D, WA + woff, WX + woff, 256, 256, lds, epi, mt * 128, ctile * 128);
  }
}

constexpr int KLD = 136, VLD = 72, PLD = 72;
__device__ __forceinline__ void attn_phase(const Params& p, unsigned char* lds) {
  const bf16_t* Q = (const bf16_t*)(p.ws + OFF_Q); const bf16_t* Kg = (const bf16_t*)(p.ws + OFF_K); const bf16_t* VT = (const bf16_t*)(p.ws + OFF_VT);
  bf16_t* O = (bf16_t*)(p.ws + OFF_O);
  bf16_t* Ks = (bf16_t*)lds;
  bf16_t* Vs = Ks + 64 * KLD;
  bf16_t* Ps = Vs + 128 * VLD;
  const int tid = threadIdx.x, wid = tid >> 6, lane = tid & 63, fr = lane & 15, fq = lane >> 4;
  const int g = wid >> 1, rh = wid & 1;
  bf16_t* Pw = Ps + wid * 16 * PLD;
  const float scale = 0.08838834764831845f;
  for (int item = blockIdx.x; item < 1088; item += gridDim.x) {
    int b, hk, qb, qrow0, nlat, kt0; bool is_ctx;
    if (item < 1024) { is_ctx = false; b = item >> 8; hk = (item >> 6) & 3; qb = item & 63; qrow0 = b * S + qb * 64; kt0 = qb - 2 < 0 ? 0 : qb - 2; const int kt1 = qb + 2 > 63 ? 63 : qb + 2; nlat = kt1 - kt0 + 1; }
    else { is_ctx = true; const int ci = item - 1024; b = ci >> 4; hk = (ci >> 2) & 3; qb = ci & 3; qrow0 = TL + b * CL + qb * 64; kt0 = 0; nlat = 0; }
    const int head = hk * 4 + g;
    const float sink = p.attn_sink[head];
    bf16x8 qf[2][4];
#pragma unroll
    for (int rt = 0; rt < 2; ++rt)
#pragma unroll
      for (int ks = 0; ks < 4; ++ks) qf[rt][ks] = *(const bf16x8*)(Q + (size_t)(qrow0 + rh * 32 + rt * 16 + fr) * D + head * 128 + ks * 32 + fq * 8);
    f32x4 oacc[2][8]; float mst[2][4], lst[2][4];
#pragma unroll
    for (int rt = 0; rt < 2; ++rt) {
#pragma unroll
      for (int dt = 0; dt < 8; ++dt) oacc[rt][dt] = (f32x4){0.f, 0.f, 0.f, 0.f};
#pragma unroll
      for (int j = 0; j < 4; ++j) { mst[rt][j] = sink; lst[rt][j] = 1.0f; }
    }
    const int ntiles = nlat + 4;
    for (int ti = 0; ti < ntiles; ++ti) {
      const bool lat = ti < nlat;
      const int krow0 = lat ? (b * S + (kt0 + ti) * 64) : (TL + b * CL + (ti - nlat) * 64);
      __syncthreads();
#pragma unroll
      for (int i = 0; i < 2; ++i) {
        const int id = tid + 512 * i;
        const int key = id >> 4, dc = (id & 15) * 8;
        *(u32x4*)(Ks + key * KLD + dc) = *(const u32x4*)(Kg + (size_t)(krow0 + key) * 512 + hk * 128 + dc);
        const int d = id >> 3, kc = (id & 7) * 8;
        *(u32x4*)(Vs + d * VLD + kc) = *(const u32x4*)(VT + (size_t)(hk * 128 + d) * TT + krow0 + kc);
      }
      __syncthreads();
#pragma unroll
      for (int rt = 0; rt < 2; ++rt) {
        f32x4 sc[4];
#pragma unroll
        for (int ct = 0; ct < 4; ++ct) {
          sc[ct] = (f32x4){0.f, 0.f, 0.f, 0.f};
#pragma unroll
          for (int ks = 0; ks < 4; ++ks) {
            const bf16x8 kf = *(const bf16x8*)(Ks + (ct * 16 + fr) * KLD + ks * 32 + fq * 8);
            sc[ct] = __builtin_amdgcn_mfma_f32_16x16x32_bf16(qf[rt][ks], kf, sc[ct], 0, 0, 0);
          }
        }
        float mx[4], rs[4], alpha[4];
#pragma unroll
        for (int j = 0; j < 4; ++j) mx[j] = -INFINITY;
#pragma unroll
        for (int ct = 0; ct < 4; ++ct)
#pragma unroll
          for (int j = 0; j < 4; ++j) {
            float v = sc[ct][j] * scale;
            if (lat) {
              const int ipos = qb * 64 + rh * 32 + rt * 16 + fq * 4 + j, jpos = (kt0 + ti) * 64 + ct * 16 + fr;
              const int dd = ipos - jpos;
              if (dd > 128 || dd < -128) v = -INFINITY;
            }
            sc[ct][j] = v; mx[j] = fmaxf(mx[j], v);
          }
#pragma unroll
        for (int j = 0; j < 4; ++j) {
#pragma unroll
          for (int o = 1; o < 16; o <<= 1) mx[j] = fmaxf(mx[j], __shfl_xor(mx[j], o));
          const float mn = fmaxf(mst[rt][j], mx[j]);
          alpha[j] = __expf(mst[rt][j] - mn);
          mst[rt][j] = mn; rs[j] = 0.f;
        }
#pragma unroll
        for (int ct = 0; ct < 4; ++ct)
#pragma unroll
          for (int j = 0; j < 4; ++j) {
            const float pv = __expf(sc[ct][j] - mst[rt][j]);
            rs[j] += pv;
            Pw[(fq * 4 + j) * PLD + ct * 16 + fr] = f2bf(pv);
          }
#pragma unroll
        for (int j = 0; j < 4; ++j) {
#pragma unroll
          for (int o = 1; o < 16; o <<= 1) rs[j] += __shfl_xor(rs[j], o);
          lst[rt][j] = lst[rt][j] * alpha[j] + rs[j];
        }
#pragma unroll
        for (int dt = 0; dt < 8; ++dt)
#pragma unroll
          for (int j = 0; j < 4; ++j) oacc[rt][dt][j] *= alpha[j];
        __syncthreads();
#pragma unroll
        for (int ks = 0; ks < 2; ++ks) {
          const bf16x8 pf = *(const bf16x8*)(Pw + fr * PLD + ks * 32 + fq * 8);
#pragma unroll
          for (int dt = 0; dt < 8; ++dt) {
            const bf16x8 vf = *(const bf16x8*)(Vs + (dt * 16 + fr) * VLD + ks * 32 + fq * 8);
            oacc[rt][dt] = __builtin_amdgcn_mfma_f32_16x16x32_bf16(pf, vf, oacc[rt][dt], 0, 0, 0);
          }
        }
        __syncthreads();
      }
    }
#pragma unroll
    for (int rt = 0; rt < 2; ++rt)
#pragma unroll
      for (int j = 0; j < 4; ++j) {
        const float inv = 1.0f / lst[rt][j];
        bf16_t* orow = O + (size_t)(qrow0 + rh * 32 + rt * 16 + fq * 4 + j) * D + head * 128 + fr;
#pragma unroll
        for (int dt = 0; dt < 8; ++dt) orow[dt * 16] = f2bf(oacc[rt][dt][j] * inv);
      }
    (void)is_ctx;
  }
}

#ifndef CAND_TRICK
#define CAND_TRICK 1
#endif
__device__ __forceinline__ void peer_route_phase(const Params& p, int layer, int ntok, unsigned char* lds) {
  const int tid = threadIdx.x, wid = tid >> 6, lane = tid & 63, fr = lane & 15, fq = lane >> 4;
  float* Sw = (float*)(lds + wid * 9216);
  const bf16_t* keysG = (const bf16_t*)(p.ws + OFF_KEYS) + (size_t)layer * 2 * 128 * 128;
  const bf16_t* PQ = (const bf16_t*)(p.ws + OFF_PQ);
  int* IDX = (int*)(p.ws + OFF_IDX); float* GW = (float*)(p.ws + OFF_GW);
  const int total = (ntok >> 6) * 8;
  for (int id = blockIdx.x * 8 + wid; id < total; id += gridDim.x * 8) {
    const int tile = id >> 3, head = id & 7, tok0 = tile * 64;
    float Lk[2][16];
#pragma unroll
    for (int pp = 0; pp < 2; ++pp) {
      bf16x8 qf[4][4];
#pragma unroll
      for (int mt = 0; mt < 4; ++mt)
#pragma unroll
        for (int ks = 0; ks < 4; ++ks) qf[mt][ks] = *(const bf16x8*)(PQ + (size_t)(tok0 + mt * 16 + fr) * D + head * 256 + pp * 128 + ks * 32 + fq * 8);
#pragma unroll
      for (int s2 = 0; s2 < 16; ++s2) Lk[pp][s2] = -INFINITY;
#pragma unroll 1
      for (int pass = 0; pass < 4; ++pass) {
        f32x4 acc[2][4];
#pragma unroll
        for (int nt = 0; nt < 2; ++nt)
#pragma unroll
          for (int mt = 0; mt < 4; ++mt) acc[nt][mt] = (f32x4){0.f, 0.f, 0.f, 0.f};
#pragma unroll
        for (int nt = 0; nt < 2; ++nt)
#pragma unroll
          for (int ks = 0; ks < 4; ++ks) {
            const bf16x8 kf = *(const bf16x8*)(keysG + (size_t)(pp * 128 + pass * 32 + nt * 16 + fr) * 128 + ks * 32 + fq * 8);
#pragma unroll
            for (int mt = 0; mt < 4; ++mt) acc[nt][mt] = __builtin_amdgcn_mfma_f32_16x16x32_bf16(kf, qf[mt][ks], acc[nt][mt], 0, 0, 0);
          }
#pragma unroll
        for (int nt = 0; nt < 2; ++nt)
#pragma unroll
          for (int mt = 0; mt < 4; ++mt) *(f32x4*)(Sw + (mt * 16 + fr) * 36 + nt * 16 + 4 * fq) = acc[nt][mt];
        asm volatile("s_waitcnt lgkmcnt(0)" ::: "memory");
#pragma unroll
        for (int c = 0; c < 8; ++c) {
          const f32x4 sv = *(const f32x4*)(Sw + lane * 36 + c * 4);
#pragma unroll
          for (int e = 0; e < 4; ++e) {
            float x = __uint_as_float((__float_as_uint(sv[e]) & ~0x7fu) | (unsigned)(pass * 32 + c * 4 + e));
#pragma unroll
            for (int s2 = 0; s2 < 16; ++s2) { const float hi = fmaxf(Lk[pp][s2], x); x = fminf(Lk[pp][s2], x); Lk[pp][s2] = hi; }
          }
        }
        asm volatile("s_waitcnt lgkmcnt(0)" ::: "memory");
      }
    }
#pragma unroll
    for (int pp = 0; pp < 2; ++pp)
#pragma unroll
      for (int s2 = 0; s2 < 16; ++s2) Sw[(pp * 16 + s2) * 64 + lane] = Lk[pp][s2];
    asm volatile("s_waitcnt lgkmcnt(0)" ::: "memory");
    float T[16]; int E[16];
#pragma unroll
    for (int s2 = 0; s2 < 16; ++s2) { T[s2] = -INFINITY; E[s2] = 0; }
#pragma unroll 1
    for (int i = 0; i < 16; ++i) {
      const unsigned pk1 = __float_as_uint(Sw[i * 64 + lane]);
      const float v1 = __uint_as_float(pk1 & ~0x7fu); const int e1 = (int)(pk1 & 0x7fu) * 128;
      const int nj = CAND_TRICK ? 16 / (i + 1) : 16;
#pragma unroll 1
      for (int j = 0; j < nj; ++j) {
        const unsigned pk2 = __float_as_uint(Sw[(16 + j) * 64 + lane]);
        float x = v1 + __uint_as_float(pk2 & ~0x7fu); int pe = e1 + (int)(pk2 & 0x7fu);
#pragma unroll
        for (int s2 = 0; s2 < 16; ++s2) {
          const bool gt = x > T[s2];
          const float nT = gt ? x : T[s2]; const float nx = gt ? T[s2] : x; const int nE = gt ? pe : E[s2]; const int npe = gt ? E[s2] : pe;
          T[s2] = nT; x = nx; E[s2] = nE; pe = npe;
        }
      }
    }
    asm volatile("s_waitcnt lgkmcnt(0)" ::: "memory");
    const size_t o = ((size_t)(tok0 + lane) * 8 + head) * 16;
    const float tmax = T[0];
    float ssum = 0.f;
#pragma unroll
    for (int s2 = 0; s2 < 16; ++s2) { T[s2] = __expf(T[s2] - tmax); ssum += T[s2]; }
    const float inv = 1.0f / ssum;
#pragma unroll
    for (int c = 0; c < 4; ++c) {
      *(f32x4*)(GW + o + c * 4) = (f32x4){T[c * 4] * inv, T[c * 4 + 1] * inv, T[c * 4 + 2] * inv, T[c * 4 + 3] * inv};
      typedef int i32x4 __attribute__((ext_vector_type(4)));
      *(i32x4*)(IDX + o + c * 4) = (i32x4){E[c * 4], E[c * 4 + 1], E[c * 4 + 2], E[c * 4 + 3]};
    }
  }
}

constexpr int PG = 2;
struct PeerBuf { u32x4 u[PG][2], v[PG][2]; float su[PG], sv[PG], g[PG]; };
__device__ __forceinline__ void peer_load(PeerBuf& B, const unsigned char* UT8, const unsigned char* VT8, const float* USC, const float* VSC, int ireg, float greg, int k0, int lane) {
#pragma unroll
  for (int j = 0; j < PG; ++j) {
    const int e = __builtin_amdgcn_readlane(ireg, k0 + j);
    B.g[j] = __builtin_bit_cast(float, __builtin_amdgcn_readlane(__builtin_bit_cast(int, greg), k0 + j));
    const unsigned char* ur = UT8 + (size_t)e * D + lane * 16; const unsigned char* vr = VT8 + (size_t)e * D + lane * 16;
    B.u[j][0] = *(const u32x4*)ur; B.u[j][1] = *(const u32x4*)(ur + 1024);
    B.v[j][0] = *(const u32x4*)vr; B.v[j][1] = *(const u32x4*)(vr + 1024);
    B.su[j] = USC[e]; B.sv[j] = VSC[e];
  }
}
__device__ __forceinline__ void peer_compute(const PeerBuf& B, const float (&hreg)[2][16], float hsum, float (&accv)[2][16], float& corr) {
#pragma unroll
  for (int j = 0; j < PG; ++j) {
    float dsum = 0.f;
#pragma unroll
    for (int c = 0; c < 2; ++c)
#pragma unroll
      for (int t = 0; t < 4; ++t) {
        const unsigned w = B.u[j][c][t];
        dsum += (float)(w & 0xffu) * hreg[c][4 * t] + (float)((w >> 8) & 0xffu) * hreg[c][4 * t + 1] + (float)((w >> 16) & 0xffu) * hreg[c][4 * t + 2] + (float)(w >> 24) * hreg[c][4 * t + 3];
      }
    const float z = B.su[j] * (wave_sum(dsum) - 128.0f * hsum);
    const float act = gelu_tanh(z) * B.g[j] * B.sv[j];
    corr += act;
#pragma unroll
    for (int c = 0; c < 2; ++c)
#pragma unroll
      for (int t = 0; t < 4; ++t) {
        const unsigned w = B.v[j][c][t];
        accv[c][4 * t] += act * (float)(w & 0xffu); accv[c][4 * t + 1] += act * (float)((w >> 8) & 0xffu); accv[c][4 * t + 2] += act * (float)((w >> 16) & 0xffu); accv[c][4 * t + 3] += act * (float)(w >> 24);
      }
  }
}
__device__ __forceinline__ void peer_gather_phase(const Params& p, int layer, int ntok, int gate_layer, bool dry = false) {
  const int tid = threadIdx.x, wid = tid >> 6, lane = tid & 63;
  const bf16_t* H = (const bf16_t*)(p.ws + OFF_H);
  const int* IDX = (const int*)(p.ws + OFF_IDX); const float* GW = (const float*)(p.ws + OFF_GW);
  const unsigned char* UT8 = p.ws + OFF_UTAB + (size_t)layer * NEXP * D; const unsigned char* VT8 = p.ws + OFF_VTAB + (size_t)layer * NEXP * D;
  const float* USC = (const float*)(p.ws + OFF_USC) + (size_t)layer * NEXP; const float* VSC = (const float*)(p.ws + OFF_VSC) + (size_t)layer * NEXP;
  float* XS = (float*)(p.ws + OFF_XS);
  const float* gate = (const float*)(p.ws + OFF_MODV) + (size_t)(gate_layer * 5) * NMOD + 5 * D;
  for (int tok = blockIdx.x * 8 + wid; tok < ntok; tok += gridDim.x * 8) {
    const int i0 = IDX[(size_t)tok * 128 + lane], i1 = IDX[(size_t)tok * 128 + 64 + lane];
    const float g0 = GW[(size_t)tok * 128 + lane], g1 = GW[(size_t)tok * 128 + 64 + lane];
    PeerBuf A, B;
    peer_load(A, UT8, VT8, USC, VSC, i0, g0, 0, lane);
    float hreg[2][16]; float hsum = 0.f;
#pragma unroll
    for (int c = 0; c < 2; ++c)
#pragma unroll
      for (int hh = 0; hh < 2; ++hh) {
        const u32x4 hv = *(const u32x4*)(H + (size_t)tok * D + c * 1024 + lane * 16 + hh * 8);
#pragma unroll
        for (int t = 0; t < 4; ++t) { hreg[c][hh * 8 + 2 * t] = __uint_as_float(hv[t] << 16); hreg[c][hh * 8 + 2 * t + 1] = __uint_as_float(hv[t] & 0xffff0000u); hsum += hreg[c][hh * 8 + 2 * t] + hreg[c][hh * 8 + 2 * t + 1]; }
      }
    hsum = wave_sum(hsum);
    float accv[2][16]; float corr = 0.f;
#pragma unroll
    for (int c = 0; c < 2; ++c)
#pragma unroll
      for (int j = 0; j < 16; ++j) accv[c][j] = 0.f;
#pragma unroll 1
    for (int half = 0; half < 2; ++half) {
      const int ireg = half ? i1 : i0; const float greg = half ? g1 : g0;
#pragma unroll 1
      for (int k0 = 0; k0 < 64; k0 += 2 * PG) {
        peer_load(B, UT8, VT8, USC, VSC, ireg, greg, k0 + PG, lane);
        peer_compute(A, hreg, hsum, accv, corr);
        if (k0 + 2 * PG < 64) peer_load(A, UT8, VT8, USC, VSC, ireg, greg, k0 + 2 * PG, lane);
        else if (half == 0) peer_load(A, UT8, VT8, USC, VSC, i1, g1, 0, lane);
        peer_compute(B, hreg, hsum, accv, corr);
      }
    }
    corr *= 128.0f;
    const float* gr = gate + (size_t)mod_row(tok) * NMOD; float* xr = XS + (size_t)tok * D;
#pragma unroll
    for (int c = 0; c < 2; ++c)
#pragma unroll
      for (int t = 0; t < 4; ++t) {
        const int col = c * 1024 + lane * 16 + 4 * t;
        const f32x4 gg = *(const f32x4*)(gr + col);
        const f32x4 sres = (f32x4){accv[c][4 * t] - corr, accv[c][4 * t + 1] - corr, accv[c][4 * t + 2] - corr, accv[c][4 * t + 3] - corr};
        if (!dry || sres[0] == 12345.678f) *(f32x4*)(xr + col) = *(const f32x4*)(xr + col) + gg * sres;
      }
  }
}

__device__ __forceinline__ void conv_phase(const Params& p) {
  const bf16_t* UBR = (const bf16_t*)(p.ws + OFF_Q); bf16_t* UC = (bf16_t*)(p.ws + OFF_O);
  const int total = TT * 256;
  for (int it = blockIdx.x * NT + threadIdx.x; it < total; it += gridDim.x * NT) {
    const int r = it >> 8, c = (it & 255) * 8;
    int pos, len;
    if (r < TL) { pos = r & 4095; len = S; } else { pos = (r - TL) & 255; len = CL; }
    float acc[8];
    { const float4 b0 = *(const float4*)(p.rec_conv_b + c), b1 = *(const float4*)(p.rec_conv_b + c + 4); acc[0] = b0.x; acc[1] = b0.y; acc[2] = b0.z; acc[3] = b0.w; acc[4] = b1.x; acc[5] = b1.y; acc[6] = b1.z; acc[7] = b1.w; }
#pragma unroll
    for (int k = 0; k < 4; ++k) {
      const int pp = pos - 1 + k;
      if (pp >= 0 && pp < len) {
        const u32x4 uv = *(const u32x4*)(UBR + (size_t)(r - 1 + k) * D + c);
        const float4 w0 = *(const float4*)(p.rec_conv_w + k * D + c), w1 = *(const float4*)(p.rec_conv_w + k * D + c + 4);
        const float wv[8] = {w0.x, w0.y, w0.z, w0.w, w1.x, w1.y, w1.z, w1.w};
#pragma unroll
        for (int t = 0; t < 4; ++t) { acc[2 * t] += wv[2 * t] * __uint_as_float(uv[t] << 16); acc[2 * t + 1] += wv[2 * t + 1] * __uint_as_float(uv[t] & 0xffff0000u); }
      }
    }
    u32x4 o; o.x = pack_bf16(acc[0], acc[1]); o.y = pack_bf16(acc[2], acc[3]); o.z = pack_bf16(acc[4], acc[5]); o.w = pack_bf16(acc[6], acc[7]);
    *(u32x4*)(UC + (size_t)r * D + c) = o;
  }
}

__device__ __forceinline__ void scan1_phase(const Params& p) {
  const bf16_t* LAB = (const bf16_t*)(p.ws + OFF_LAB);
  float* CHP = (float*)(p.ws + OFF_CHP); float* CHH = (float*)(p.ws + OFF_CHH);
  const int total = 2 * 272 * 4;
  for (int item = blockIdx.x; item < total; item += gridDim.x) {
    const int cgp = item & 3, ch = (item >> 2) % 272, dir = item / (272 * 4);
    const int c = cgp * 512 + threadIdx.x;
    const bf16_t* a = LAB + ((size_t)(dir * 2) * TT + ch * 64) * D + c; const bf16_t* b = LAB + ((size_t)(dir * 2 + 1) * TT + ch * 64) * D + c;
    float h = 0.f, ls = 0.f;
    if (dir == 0) {
#pragma unroll 16
      for (int t = 0; t < 64; ++t) { const float la = bf2f(a[(size_t)t * D]), bv = bf2f(b[(size_t)t * D]); h = __expf(la) * h + bv; ls += la; }
    } else {
#pragma unroll 16
      for (int t = 63; t >= 0; --t) { const float la = bf2f(a[(size_t)t * D]), bv = bf2f(b[(size_t)t * D]); h = __expf(la) * h + bv; ls += la; }
    }
    CHP[((size_t)dir * 272 + ch) * D + c] = __expf(ls); CHH[((size_t)dir * 272 + ch) * D + c] = h;
  }
}
__device__ __forceinline__ void scan2_phase(const Params& p) {
  const float* CHP = (const float*)(p.ws + OFF_CHP); const float* CHH = (const float*)(p.ws + OFF_CHH); float* CIN = (float*)(p.ws + OFF_CIN);
  for (int it = blockIdx.x * NT + threadIdx.x; it < 2 * NB * D; it += gridDim.x * NT) {
    const int c = it & 2047, b = (it >> 11) & 3, dir = it >> 13;
    float carry = 0.f;
    for (int s = 0; s < 68; ++s) {
      int ch;
      if (dir == 0) ch = s < 4 ? (256 + 4 * b + s) : (64 * b + (s - 4));
      else ch = s < 4 ? (256 + 4 * b + (3 - s)) : (64 * b + (63 - (s - 4)));
      const size_t o = ((size_t)dir * 272 + ch) * D + c;
      CIN[o] = carry;
      carry = CHP[o] * carry + CHH[o];
    }
  }
}
__device__ __forceinline__ void scan3_phase(const Params& p) {
  const bf16_t* LAB = (const bf16_t*)(p.ws + OFF_LAB); const float* CIN = (const float*)(p.ws + OFF_CIN);
  const bf16_t* GATE = (const bf16_t*)(p.ws + OFF_PQ); bf16_t* A2 = (bf16_t*)(p.ws + OFF_O);
  const int total = 256 * 4;
  for (int item = blockIdx.x; item < total; item += gridDim.x) {
    const int cgp = item & 3, ch = item >> 2;
    const int c = cgp * 512 + threadIdx.x;
    const size_t base = (size_t)ch * 64 * D + c;
    float y[64];
    {
      const bf16_t* a = LAB + base; const bf16_t* b = LAB + (size_t)TT * D + base;
      float h = CIN[(size_t)ch * D + c];
#pragma unroll
      for (int t = 0; t < 64; ++t) { h = __expf(bf2f(a[(size_t)t * D])) * h + bf2f(b[(size_t)t * D]); y[t] = h; }
    }
    {
      const bf16_t* a = LAB + (size_t)2 * TT * D + base; const bf16_t* b = LAB + (size_t)3 * TT * D + base;
      float h = CIN[((size_t)272 + ch) * D + c];
#pragma unroll
      for (int t = 63; t >= 0; --t) { h = __expf(bf2f(a[(size_t)t * D])) * h + bf2f(b[(size_t)t * D]); y[t] += h; }
    }
#pragma unroll
    for (int t = 0; t < 64; ++t) A2[base + (size_t)t * D] = f2bf(y[t] * bf2f(GATE[base + (size_t)t * D]));
  }
}

__global__ void __launch_bounds__(NT) fwd_megakernel(Params p) {
  extern __shared__ __attribute__((aligned(16))) unsigned char lds[];
  cg::grid_group grid = cg::this_grid();
  unsigned char* ws = p.ws;
  float* MODV = (float*)(ws + OFF_MODV);
  float* XS = (float*)(ws + OFF_XS);
  bf16_t* H = (bf16_t*)(ws + OFF_H);

  setup_phase(p, lds);
  grid.sync();
  {
    constexpr int ntok = TT;
    norm_phase(p, 0, p.norm_mix + 0 * D, 0, TT, true, H);
    grid.sync();
      {
        EpiQKV e{(bf16_t*)(ws + OFF_Q), (bf16_t*)(ws + OFF_K), (bf16_t*)(ws + OFF_VT), (const float*)(ws + OFF_ROPE), (const float*)(ws + OFF_ROPE) + 2048};
        gemm_phase(H, (const bf16_t*)(ws + OFF_WQKV), D, TT / 128, 3072 / 128, lds, e);
      }
      grid.sync();
      attn_phase(p, lds);
      grid.sync();
    {
      EpiResid e{p.x, p.ctx, XS, MODV + (size_t)(0 * 5) * NMOD + 2 * D, true, 1.0f};
      gemm_phase((const bf16_t*)(ws + OFF_O), (const bf16_t*)(ws + (OFF_WO)), D, ntok / 128, D / 128, lds, e);
    }
    grid.sync();
    norm_phase(p, 0, p.norm_ffn + 0 * D, 3, ntok, false, H);
    grid.sync();
    {
      EpiBf16 e{(bf16_t*)(ws + OFF_PQ), D};
      gemm_phase(H, (const bf16_t*)(ws + OFF_WPQ) + (size_t)0 * D * D, D, ntok / 128, D / 128, lds, e);
    }
    grid.sync();
    peer_route_phase(p, 0, ntok, lds);
    grid.sync();
    if (DUP & 2) { peer_gather_phase(p, 0, ntok, 0, true); grid.sync(); }
    peer_gather_phase(p, 0, ntok, 0);
    grid.sync();
  }
  {
    constexpr int ntok = TL;
    norm_phase(p, 1, p.norm_mix + 1 * D, 0, TT, false, H);
    grid.sync();
      {
        EpiWin e{(bf16_t*)(ws + OFF_PQ), (bf16_t*)(ws + OFF_Q)};
        gemm_phase(H, (const bf16_t*)(ws + OFF_WIN), D, TT / 128, 4096 / 128, lds, e);
      }
      grid.sync();
      conv_phase(p);
      grid.sync();
      coef_phase(p, lds);
      grid.sync();
      scan1_phase(p);
      grid.sync();
      scan2_phase(p);
      grid.sync();
      scan3_phase(p);
      grid.sync();
    {
      EpiResid e{p.x, p.ctx, XS, MODV + (size_t)(1 * 5) * NMOD + 2 * D, false, 1.0f};
      gemm_phase((const bf16_t*)(ws + OFF_O), (const bf16_t*)(ws + (OFF_WOUT)), D, ntok / 128, D / 128, lds, e);
    }
    grid.sync();
    norm_phase(p, 1, p.norm_ffn + 1 * D, 3, ntok, false, H);
    grid.sync();
    {
      EpiBf16 e{(bf16_t*)(ws + OFF_PQ), D};
      gemm_phase(H, (const bf16_t*)(ws + OFF_WPQ) + (size_t)1 * D * D, D, ntok / 128, D / 128, lds, e);
    }
    grid.sync();
    peer_route_phase(p, 1, ntok, lds);
    grid.sync();
    if (DUP & 2) { peer_gather_phase(p, 1, ntok, 1, true); grid.sync(); }
    peer_gather_phase(p, 1, ntok, 1);
    grid.sync();
  }
  final_norm_phase(p);
}

__global__ void diag_fill(float* out, int n, float v) { for (int i = blockIdx.x * blockDim.x + threadIdx.x; i < n; i += gridDim.x * blockDim.x) out[i] = v; }

extern "C" void kernel_launch(void* const* d_in, const int* in_sizes, int n_in, void* d_out, int out_size, void* d_ws, size_t ws_size, hipStream_t stream) {
  static int grid_blocks = 0;
  if (!grid_blocks) {
    int dev = 0, cus = 0, per_cu = 0;
    (void)hipGetDevice(&dev);
    (void)hipDeviceGetAttribute(&cus, hipDeviceAttributeMultiprocessorCount, dev);
    (void)hipFuncSetAttribute((const void*)fwd_megakernel, hipFuncAttributeMaxDynamicSharedMemorySize, (int)kDynLds);
    (void)hipOccupancyMaxActiveBlocksPerMultiprocessor(&per_cu, fwd_megakernel, NT, kDynLds);
    if (per_cu > 1) per_cu = 1;
    if (per_cu < 1) per_cu = 1;
    grid_blocks = cus * per_cu;
  }
  if (ws_size < WS_NEED) { fprintf(stderr, "workspace too small: %zu < %zu\n", ws_size, (size_t)WS_NEED); diag_fill<<<1024, 256, 0, stream>>>((float*)d_out, out_size, 3.0f); return; }
  Params p{};
  const float* const* in = (const float* const*)d_in;
  p.x = in[0]; p.c = in[1]; p.ctx = in[2]; p.c_ctx = in[3]; p.w_mod = in[4]; p.b_mod = in[5]; p.norm_mix = in[6]; p.norm_ffn = in[7]; p.norm_final = in[8];
  p.attn_w_qkv = in[9]; p.attn_w_o = in[10]; p.attn_sink = in[11];
  p.rec_w_in = in[12]; p.rec_conv_w = in[13]; p.rec_conv_b = in[14]; p.rec_w_a = in[15]; p.rec_b_a = in[16]; p.rec_w_x = in[17]; p.rec_b_x = in[18]; p.rec_lambda = in[19]; p.rec_w_out = in[20];
  p.peer_w_q = in[21]; p.peer_keys = in[22]; p.peer_u = in[23]; p.peer_v = in[24];
  p.out = (float*)d_out; p.ws = (unsigned char*)d_ws;
  void* args[] = {&p};
  hipError_t e = hipLaunchCooperativeKernel((void*)fwd_megakernel, dim3(grid_blocks), dim3(NT), args, kDynLds, stream);
  if (e != hipSuccess) { fprintf(stderr, "cooperative launch failed: %s (grid %d)\n", hipGetErrorString(e), grid_blocks); diag_fill<<<1024, 256, 0, stream>>>((float*)d_out, out_size, 5.0f); }
}
```

```cpp
#include <hip/hip_runtime.h>
#include <hip/hip_cooperative_groups.h>
#include <cstdio>
namespace cg = cooperative_groups;

typedef unsigned short bf16_t;
typedef short bf16x8 __attribute__((ext_vector_type(8)));
typedef float f32x4 __attribute__((ext_vector_type(4)));
typedef unsigned u32x4 __attribute__((ext_vector_type(4)));
typedef unsigned u32x2 __attribute__((ext_vector_type(2)));
typedef __bf16 bf16x2_t __attribute__((ext_vector_type(2)));

constexpr int D = 2048, NB = 4, S = 4096, CL = 256;
constexpr int TL = NB * S, TC = NB * CL, TT = TL + TC;
constexpr int NT = 512;
constexpr int NMOD = 6 * D;
constexpr int NEXP = 16384;
constexpr size_t kDynLds = 128 * 1024;
#ifndef SKIP
#define SKIP 0
#endif
#ifndef DUP
#define DUP 0
#endif

constexpr size_t al256(size_t x) { return (x + 255) & ~(size_t)255; }
constexpr size_t OFF_WQKV = 0;
constexpr size_t OFF_WO   = OFF_WQKV + al256((size_t)3072 * 2048 * 2);
constexpr size_t OFF_WPQ  = OFF_WO + al256((size_t)2048 * 2048 * 2);
constexpr size_t OFF_WIN  = OFF_WPQ + al256((size_t)2 * 2048 * 2048 * 2);
constexpr size_t OFF_WOUT = OFF_WIN + al256((size_t)4096 * 2048 * 2);
constexpr size_t OFF_WA   = OFF_WOUT + al256((size_t)2048 * 2048 * 2);
constexpr size_t OFF_WX   = OFF_WA + al256((size_t)16 * 256 * 256 * 2);
constexpr size_t OFF_KEYS = OFF_WX + al256((size_t)16 * 256 * 256 * 2);
constexpr size_t OFF_UTAB = OFF_KEYS + al256((size_t)2 * 2 * 128 * 128 * 2);
constexpr size_t OFF_VTAB = OFF_UTAB + al256((size_t)2 * NEXP * D);
constexpr size_t OFF_USC  = OFF_VTAB + al256((size_t)2 * NEXP * D);
constexpr size_t OFF_VSC  = OFF_USC + al256((size_t)2 * NEXP * 4);
constexpr size_t OFF_MODV = OFF_VSC + al256((size_t)2 * NEXP * 4);
constexpr size_t OFF_ROPE = OFF_MODV + al256((size_t)2 * 5 * NMOD * 4);
constexpr size_t OFF_XS   = OFF_ROPE + al256((size_t)2 * 2048 * 4);
constexpr size_t SZ_ACT  = al256((size_t)TT * D * 2);
constexpr size_t OFF_H    = OFF_XS + al256((size_t)TT * D * 4);
constexpr size_t OFF_Q    = OFF_H + SZ_ACT;
constexpr size_t OFF_X    = OFF_Q + SZ_ACT;
constexpr size_t OFF_K    = OFF_X + 2 * SZ_ACT;
constexpr size_t OFF_VT   = OFF_K + al256((size_t)TT * 512 * 2);
constexpr size_t OFF_O    = OFF_VT + al256((size_t)TT * 512 * 2);
constexpr size_t OFF_PQ   = OFF_O + SZ_ACT;
constexpr size_t OFF_LAB  = OFF_H;
constexpr size_t OFF_CHP  = OFF_K;
constexpr size_t OFF_CHH  = OFF_CHP + al256((size_t)2 * 272 * D * 4);
constexpr size_t OFF_CIN  = OFF_CHH + al256((size_t)2 * 272 * D * 4);
constexpr size_t OFF_IDX  = OFF_PQ + SZ_ACT;
constexpr size_t OFF_GW   = OFF_IDX + al256((size_t)TT * 128 * 4);
constexpr size_t WS_NEED  = OFF_GW + al256((size_t)TT * 128 * 4);
static_assert(OFF_CIN + al256((size_t)2 * 272 * D * 4) <= OFF_O, "scan carries must fit in the K/VT region");
static_assert(WS_NEED <= ((size_t)1 << 30), "workspace map exceeds 1 GiB");

struct Params {
  const float *x, *c, *ctx, *c_ctx, *w_mod, *b_mod, *norm_mix, *norm_ffn, *norm_final;
  const float *attn_w_qkv, *attn_w_o, *attn_sink;
  const float *rec_w_in, *rec_conv_w, *rec_conv_b, *rec_w_a, *rec_b_a, *rec_w_x, *rec_b_x, *rec_lambda, *rec_w_out;
  const float *peer_w_q, *peer_keys, *peer_u, *peer_v;
  float* out; unsigned char* ws;
};

__device__ __forceinline__ float bf2f(bf16_t v) { return __uint_as_float((unsigned)v << 16); }
__device__ __forceinline__ bf16_t f2bf(float f) { unsigned u = __float_as_uint(f); u += 0x7fffu + ((u >> 16) & 1u); return (bf16_t)(u >> 16); }
__device__ __forceinline__ unsigned pack_bf16(float lo, float hi) { return (unsigned)f2bf(lo) | ((unsigned)f2bf(hi) << 16); }
template <int CTRL, int RM, bool BC> __device__ __forceinline__ float dppf(float old, float src) {
  return __builtin_bit_cast(float, __builtin_amdgcn_update_dpp(__builtin_bit_cast(int, old), __builtin_bit_cast(int, src), CTRL, RM, 0xf, BC));
}
__device__ __forceinline__ float wave_sum(float v) {
  v += dppf<0x111, 0xf, true>(0.f, v); v += dppf<0x112, 0xf, true>(0.f, v); v += dppf<0x114, 0xf, true>(0.f, v); v += dppf<0x118, 0xf, true>(0.f, v);
  v += dppf<0x142, 0xa, false>(0.f, v); v += dppf<0x143, 0xc, false>(0.f, v);
  return __builtin_bit_cast(float, __builtin_amdgcn_readlane(__builtin_bit_cast(int, v), 63));
}
__device__ __forceinline__ float wave_max(float v) {
  v = fmaxf(v, dppf<0x111, 0xf, false>(v, v)); v = fmaxf(v, dppf<0x112, 0xf, false>(v, v)); v = fmaxf(v, dppf<0x114, 0xf, false>(v, v)); v = fmaxf(v, dppf<0x118, 0xf, false>(v, v));
  v = fmaxf(v, dppf<0x142, 0xa, false>(v, v)); v = fmaxf(v, dppf<0x143, 0xc, false>(v, v));
  return __builtin_bit_cast(float, __builtin_amdgcn_readlane(__builtin_bit_cast(int, v), 63));
}
__device__ __forceinline__ float gelu_tanh(float x) {
  const float y = 0.7978845608028654f * (x + 0.044715f * x * x * x);
  const float t = 1.0f - 2.0f / (1.0f + __expf(2.0f * y));
  return 0.5f * x * (1.0f + t);
}
__device__ __forceinline__ float sigmoid_f(float x) { return 1.0f / (1.0f + __expf(-x)); }
__device__ __forceinline__ int mod_row(int r) { return r < TL ? (r >> 12) : 4; }

__device__ __forceinline__ void mod_item(const Params& p, int item, float* lds) {
  float* sil = lds;
  float* red = lds + 5 * 2048;
  const int tid = threadIdx.x, wid = tid >> 6, lane = tid & 63;
  for (int i = tid; i < 5 * 2048; i += NT) {
    const int m = i >> 11, k = i & 2047;
    const float v = (m < 4) ? p.c[m * 2048 + k] : p.c_ctx[k];
    sil[i] = v / (1.0f + expf(-v));
  }
  __syncthreads();
  const int layer = item / 48, cgp = item % 48;
  const float* W = p.w_mod + (size_t)layer * 2048 * NMOD + cgp * 256 + lane * 4;
  float acc[5][4];
#pragma unroll
  for (int m = 0; m < 5; ++m)
#pragma unroll
    for (int j = 0; j < 4; ++j) acc[m][j] = 0.f;
  const int k0 = wid * 256;
#pragma unroll 8
  for (int k = k0; k < k0 + 256; ++k) {
    const float4 w = *(const float4*)(W + (size_t)k * NMOD);
#pragma unroll
    for (int m = 0; m < 5; ++m) {
      const float s = sil[m * 2048 + k];
      acc[m][0] += s * w.x; acc[m][1] += s * w.y; acc[m][2] += s * w.z; acc[m][3] += s * w.w;
    }
  }
#pragma unroll
  for (int m = 0; m < 5; ++m)
#pragma unroll
    for (int j = 0; j < 4; ++j) red[(wid * 5 + m) * 256 + lane * 4 + j] = acc[m][j];
  __syncthreads();
  float* MODV = (float*)(p.ws + OFF_MODV);
  for (int o = tid; o < 1280; o += NT) {
    const int m = o >> 8, n = o & 255;
    float s = 0.f;
#pragma unroll
    for (int w = 0; w < 8; ++w) s += red[(w * 5 + m) * 256 + n];
    const int col = cgp * 256 + n;
    MODV[(size_t)(layer * 5 + m) * NMOD + col] = s + p.b_mod[layer * NMOD + col];
  }
  __syncthreads();
}

__device__ __forceinline__ void transpose_tile(const float* W, int ldw, bf16_t* Wt, int ldt, int k0, int n0, float* lds) {
  const int tid = threadIdx.x;
  const int tk = tid >> 4, tn = (tid & 15) * 4;
#pragma unroll
  for (int i = 0; i < 2; ++i) {
    const int k = tk + 32 * i;
    const float4 v = *(const float4*)(W + (size_t)(k0 + k) * ldw + n0 + tn);
    lds[k * 65 + tn + 0] = v.x; lds[k * 65 + tn + 1] = v.y; lds[k * 65 + tn + 2] = v.z; lds[k * 65 + tn + 3] = v.w;
  }
  __syncthreads();
  const int wn = tid >> 3, kc = (tid & 7) * 8;
  u32x4 o;
  o.x = pack_bf16(lds[(kc + 0) * 65 + wn], lds[(kc + 1) * 65 + wn]);
  o.y = pack_bf16(lds[(kc + 2) * 65 + wn], lds[(kc + 3) * 65 + wn]);
  o.z = pack_bf16(lds[(kc + 4) * 65 + wn], lds[(kc + 5) * 65 + wn]);
  o.w = pack_bf16(lds[(kc + 6) * 65 + wn], lds[(kc + 7) * 65 + wn]);
  *(u32x4*)(Wt + (size_t)(n0 + wn) * ldt + k0 + kc) = o;
  __syncthreads();
}

__device__ __forceinline__ void transpose_job(const Params& p, int t, float* lds) {
  const float* W; bf16_t* Wt; int K, N;
  if (t < 1536) { W = p.attn_w_qkv; Wt = (bf16_t*)(p.ws + OFF_WQKV); K = 2048; N = 3072; }
  else if ((t -= 1536) < 1024) { W = p.attn_w_o; Wt = (bf16_t*)(p.ws + OFF_WO); K = 2048; N = 2048; }
  else if ((t -= 1024) < 2048) { const int l = t >> 10; t &= 1023; W = p.peer_w_q + (size_t)l * 2048 * 2048; Wt = (bf16_t*)(p.ws + OFF_WPQ) + (size_t)l * 2048 * 2048; K = 2048; N = 2048; }
  else if ((t -= 2048) < 2048) { W = p.rec_w_in; Wt = (bf16_t*)(p.ws + OFF_WIN); K = 2048; N = 4096; }
  else if ((t -= 2048) < 1024) { W = p.rec_w_out; Wt = (bf16_t*)(p.ws + OFF_WOUT); K = 2048; N = 2048; }
  else if ((t -= 1024) < 256) { const int mtx = t >> 4; t &= 15; W = p.rec_w_a + (size_t)mtx * 65536; Wt = (bf16_t*)(p.ws + OFF_WA) + (size_t)mtx * 65536; K = 256; N = 256; }
  else { t -= 256; const int mtx = t >> 4; t &= 15; W = p.rec_w_x + (size_t)mtx * 65536; Wt = (bf16_t*)(p.ws + OFF_WX) + (size_t)mtx * 65536; K = 256; N = 256; }
  const int ntn = N / 64;
  transpose_tile(W, N, Wt, K, (t / ntn) * 64, (t % ntn) * 64, lds);
}

__device__ __forceinline__ void convert8(const float* src, bf16_t* dst) {
  const float4 a = ((const float4*)src)[0], b = ((const float4*)src)[1];
  u32x4 o; o.x = pack_bf16(a.x, a.y); o.y = pack_bf16(a.z, a.w); o.z = pack_bf16(b.x, b.y); o.w = pack_bf16(b.z, b.w);
  *(u32x4*)dst = o;
}

constexpr int P0_MOD = 96, P0_TR = 8192, P0_KEYS = 16, P0_ROPE = 1, P0_TAB = 8192;
constexpr int P0_TOTAL = P0_MOD + P0_TR + P0_KEYS + P0_ROPE + P0_TAB;

__device__ __forceinline__ void setup_phase(const Params& p, unsigned char* lds_raw) {
  float* lds = (float*)lds_raw;
  for (int item = blockIdx.x; item < P0_TOTAL; item += gridDim.x) {
    int t = item;
    if (t < P0_MOD) { mod_item(p, t, lds); continue; }
    t -= P0_MOD;
    if (t < P0_TR) { transpose_job(p, t, lds); continue; }
    t -= P0_TR;
    if (t < P0_KEYS) { const size_t e = (size_t)t * 4096 + threadIdx.x * 8; convert8(p.peer_keys + e, (bf16_t*)(p.ws + OFF_KEYS) + e); continue; }
    t -= P0_KEYS;
    if (t < P0_ROPE) {
      float* cosT = (float*)(p.ws + OFF_ROPE); float* sinT = cosT + 2048;
      for (int e = threadIdx.x; e < 2048; e += NT) {
        const int pos = e >> 5, j = e & 31;
        const float inv = powf(10000.0f, -(float)(2 * j) / 64.0f);
        const float ang = (float)pos * inv;
        cosT[e] = cosf(ang); sinT[e] = sinf(ang);
      }
      continue;
    }
    t -= P0_ROPE;
    {
      const int wid = threadIdx.x >> 6, lane = threadIdx.x & 63;
      const int R = t * 8 + wid, tb = R >> 15, row = R & 32767;
      const float* src = (tb == 0 ? p.peer_u : p.peer_v) + (size_t)row * D;
      unsigned* dst = (unsigned*)(p.ws + (tb == 0 ? OFF_UTAB : OFF_VTAB) + (size_t)row * D);
      float* scp = (float*)(p.ws + (tb == 0 ? OFF_USC : OFF_VSC)) + row;
      float4 v[8]; float mx = 0.f;
#pragma unroll
      for (int i = 0; i < 8; ++i) { v[i] = ((const float4*)src)[i * 64 + lane]; mx = fmaxf(mx, fmaxf(fmaxf(fabsf(v[i].x), fabsf(v[i].y)), fmaxf(fabsf(v[i].z), fabsf(v[i].w)))); }
      mx = wave_max(mx);
      const float sc = mx > 0.f ? mx * (1.0f / 127.0f) : 1.0f, inv = 1.0f / sc;
#pragma unroll
      for (int i = 0; i < 8; ++i) {
        const unsigned q0 = (unsigned)((int)fminf(fmaxf(rintf(v[i].x * inv), -127.f), 127.f) + 128), q1 = (unsigned)((int)fminf(fmaxf(rintf(v[i].y * inv), -127.f), 127.f) + 128);
        const unsigned q2 = (unsigned)((int)fminf(fmaxf(rintf(v[i].z * inv), -127.f), 127.f) + 128), q3 = (unsigned)((int)fminf(fmaxf(rintf(v[i].w * inv), -127.f), 127.f) + 128);
        dst[i * 64 + lane] = q0 | (q1 << 8) | (q2 << 16) | (q3 << 24);
      }
      if (lane == 0) *scp = sc;
    }
  }
}

__device__ __forceinline__ void norm_phase(const Params& p, int layer, const float* gain, int shift_idx, int nrows, bool from_input, bf16_t* H) {
  const int wid = threadIdx.x >> 6, lane = threadIdx.x & 63;
  const float* MODV = (const float*)(p.ws + OFF_MODV);
  const float* XS = (const float*)(p.ws + OFF_XS);
  for (int r = blockIdx.x * 8 + wid; r < nrows; r += gridDim.x * 8) {
    const float* src = from_input ? (r < TL ? p.x + (size_t)r * D : p.ctx + (size_t)(r - TL) * D) : XS + (size_t)r * D;
    const float* mv = MODV + (size_t)(layer * 5 + mod_row(r)) * NMOD;
    const float* sh = mv + shift_idx * D; const float* sc = sh + D;
    float4 v[8]; float ss = 0.f;
#pragma unroll
    for (int i = 0; i < 8; ++i) { v[i] = ((const float4*)src)[i * 64 + lane]; ss += v[i].x * v[i].x + v[i].y * v[i].y + v[i].z * v[i].z + v[i].w * v[i].w; }
    ss = wave_sum(ss);
    const float rs = rsqrtf(ss * (1.0f / D) + 1e-6f);
#pragma unroll
    for (int i = 0; i < 8; ++i) {
      const float4 g = ((const float4*)gain)[i * 64 + lane], a = ((const float4*)sh)[i * 64 + lane], b = ((const float4*)sc)[i * 64 + lane];
      const float o0 = v[i].x * rs * g.x * (1.0f + b.x) + a.x, o1 = v[i].y * rs * g.y * (1.0f + b.y) + a.y;
      const float o2 = v[i].z * rs * g.z * (1.0f + b.z) + a.z, o3 = v[i].w * rs * g.w * (1.0f + b.w) + a.w;
      u32x2 o; o.x = pack_bf16(o0, o1); o.y = pack_bf16(o2, o3);
      *(u32x2*)(H + (size_t)r * D + i * 256 + lane * 4) = o;
    }
  }
}

__device__ __forceinline__ void final_norm_phase(const Params& p) {
  const int wid = threadIdx.x >> 6, lane = threadIdx.x & 63;
  const float* XS = (const float*)(p.ws + OFF_XS);
  for (int r = blockIdx.x * 8 + wid; r < TL; r += gridDim.x * 8) {
    const float4* xr = (const float4*)(XS + (size_t)r * D);
    float4 v[8]; float ss = 0.f;
#pragma unroll
    for (int i = 0; i < 8; ++i) { v[i] = xr[i * 64 + lane]; ss += v[i].x * v[i].x + v[i].y * v[i].y + v[i].z * v[i].z + v[i].w * v[i].w; }
    ss = wave_sum(ss);
    const float rs = rsqrtf(ss * (1.0f / D) + 1e-6f);
    float4* orow = (float4*)(p.out + (size_t)r * D);
#pragma unroll
    for (int i = 0; i < 8; ++i) { const float4 g = ((const float4*)p.norm_final)[i * 64 + lane]; float4 o; o.x = v[i].x * rs * g.x; o.y = v[i].y * rs * g.y; o.z = v[i].z * rs * g.z; o.w = v[i].w * rs * g.w; orow[i * 64 + lane] = o; }
  }
}

constexpr int GLD = 72;
template <bool DUAL, class Epi>
__device__ __forceinline__ void gemm_tile(const bf16_t* __restrict__ Ap, int lda, const bf16_t* __restrict__ Bp, const bf16_t* __restrict__ B2p, int ldb, int K,
                                          unsigned char* lds, const Epi& epi, int m0, int n0) {
  const int tid = threadIdx.x, wid = tid >> 6, lane = tid & 63, wm = wid >> 1, wn = wid & 1, fr = lane & 15, fq = lane >> 4;
  bf16_t* As = (bf16_t*)lds; bf16_t* Bs = As + 2 * 128 * GLD; bf16_t* B2s = Bs + 2 * 128 * GLD;
  const int lr0 = tid >> 3, lc = (tid & 7) * 8;
  f32x4 acc[2][4], acc2[2][4];
#pragma unroll
  for (int i = 0; i < 2; ++i)
#pragma unroll
    for (int j = 0; j < 4; ++j) { acc[i][j] = (f32x4){0.f, 0.f, 0.f, 0.f}; acc2[i][j] = (f32x4){0.f, 0.f, 0.f, 0.f}; }
  u32x4 ra[2], rb[2], rb2[2];
  const int nk = K >> 6;
#pragma unroll
  for (int i = 0; i < 2; ++i) {
    ra[i] = *(const u32x4*)(Ap + (size_t)(lr0 + 64 * i) * lda + lc);
    rb[i] = *(const u32x4*)(Bp + (size_t)(lr0 + 64 * i) * ldb + lc);
    if (DUAL) rb2[i] = *(const u32x4*)(B2p + (size_t)(lr0 + 64 * i) * ldb + lc);
  }
#pragma unroll
  for (int i = 0; i < 2; ++i) {
    *(u32x4*)(As + (lr0 + 64 * i) * GLD + lc) = ra[i];
    *(u32x4*)(Bs + (lr0 + 64 * i) * GLD + lc) = rb[i];
    if (DUAL) *(u32x4*)(B2s + (lr0 + 64 * i) * GLD + lc) = rb2[i];
  }
  __syncthreads();
  for (int kt = 0; kt < nk; ++kt) {
    const int buf = kt & 1;
    if (kt + 1 < nk) {
#pragma unroll
      for (int i = 0; i < 2; ++i) {
        ra[i] = *(const u32x4*)(Ap + (size_t)(lr0 + 64 * i) * lda + (kt + 1) * 64 + lc);
        rb[i] = *(const u32x4*)(Bp + (size_t)(lr0 + 64 * i) * ldb + (kt + 1) * 64 + lc);
        if (DUAL) rb2[i] = *(const u32x4*)(B2p + (size_t)(lr0 + 64 * i) * ldb + (kt + 1) * 64 + lc);
      }
    }
    const bf16_t* Ab = As + buf * 128 * GLD; const bf16_t* Bb = Bs + buf * 128 * GLD; const bf16_t* B2b = B2s + buf * 128 * GLD;
#pragma unroll
    for (int ks = 0; ks < 2; ++ks) {
      bf16x8 af[2], bfr[4];
#pragma unroll
      for (int mi = 0; mi < 2; ++mi) af[mi] = *(const bf16x8*)(Ab + (wm * 32 + mi * 16 + fr) * GLD + ks * 32 + fq * 8);
#pragma unroll
      for (int ni = 0; ni < 4; ++ni) bfr[ni] = *(const bf16x8*)(Bb + (wn * 64 + ni * 16 + fr) * GLD + ks * 32 + fq * 8);
#pragma unroll
      for (int mi = 0; mi < 2; ++mi)
#pragma unroll
        for (int ni = 0; ni < 4; ++ni) acc[mi][ni] = __builtin_amdgcn_mfma_f32_16x16x32_bf16(bfr[ni], af[mi], acc[mi][ni], 0, 0, 0);
      if (DUAL) {
#pragma unroll
        for (int ni = 0; ni < 4; ++ni) bfr[ni] = *(const bf16x8*)(B2b + (wn * 64 + ni * 16 + fr) * GLD + ks * 32 + fq * 8);
#pragma unroll
        for (int mi = 0; mi < 2; ++mi)
#pragma unroll
          for (int ni = 0; ni < 4; ++ni) acc2[mi][ni] = __builtin_amdgcn_mfma_f32_16x16x32_bf16(bfr[ni], af[mi], acc2[mi][ni], 0, 0, 0);
      }
    }
    if (kt + 1 < nk) {
      const int nb = buf ^ 1;
#pragma unroll
      for (int i = 0; i < 2; ++i) {
        *(u32x4*)(As + nb * 128 * GLD + (lr0 + 64 * i) * GLD + lc) = ra[i];
        *(u32x4*)(Bs + nb * 128 * GLD + (lr0 + 64 * i) * GLD + lc) = rb[i];
        if (DUAL) *(u32x4*)(B2s + nb * 128 * GLD + (lr0 + 64 * i) * GLD + lc) = rb2[i];
      }
    }
    __syncthreads();
  }
  epi(acc, acc2, m0 + wm * 32 + fr, n0 + wn * 64 + fq * 4);
}

struct EpiQKV {
  bf16_t *Q, *Kb, *VT; const float *cosT, *sinT;
  __device__ __forceinline__ void operator()(const f32x4 (&acc)[2][4], const f32x4 (&)[2][4], int rbase, int cbase) const {
    const int n0 = cbase & ~127;
#pragma unroll
    for (int mi = 0; mi < 2; ++mi) {
      const int r = rbase + 16 * mi;
      if (n0 < 2560) {
        const bool latent = r < TL;
        const int s = r & 4095;
        const int pos = ((cbase & 64) == 0) ? (s >> 6) : (s & 63);
        const int cl = cbase & 63;
        bf16_t* dst = (n0 < 2048) ? (Q + (size_t)r * D + cbase) : (Kb + (size_t)r * 512 + (cbase - 2048));
#pragma unroll
        for (int ni = 0; ni < 2; ++ni) {
          f32x4 x1 = acc[mi][ni], x2 = acc[mi][ni + 2], y1 = x1, y2 = x2;
          if (latent) {
            const f32x4 cs = *(const f32x4*)(cosT + pos * 32 + ni * 16 + cl), sn = *(const f32x4*)(sinT + pos * 32 + ni * 16 + cl);
            y1 = x1 * cs - x2 * sn; y2 = x2 * cs + x1 * sn;
          }
          u32x2 o1, o2; o1.x = pack_bf16(y1[0], y1[1]); o1.y = pack_bf16(y1[2], y1[3]); o2.x = pack_bf16(y2[0], y2[1]); o2.y = pack_bf16(y2[2], y2[3]);
          *(u32x2*)(dst + ni * 16) = o1; *(u32x2*)(dst + (ni + 2) * 16) = o2;
        }
      } else {
#pragma unroll
        for (int ni = 0; ni < 4; ++ni)
#pragma unroll
          for (int j = 0; j < 4; ++j) VT[(size_t)(cbase - 2560 + ni * 16 + j) * TT + r] = f2bf(acc[mi][ni][j]);
      }
    }
  }
};
struct EpiResid {
  const float *x, *ctx; float* XS; const float* gate  ; bool from_input; float mul;
  __device__ __forceinline__ void operator()(const f32x4 (&acc)[2][4], const f32x4 (&)[2][4], int rbase, int cbase) const {
#pragma unroll
    for (int mi = 0; mi < 2; ++mi) {
      const int r = rbase + 16 * mi;
      const float* src = from_input ? (r < TL ? x + (size_t)r * D : ctx + (size_t)(r - TL) * D) : XS + (size_t)r * D;
      const float* g = gate + (size_t)mod_row(r) * NMOD;
#pragma unroll
      for (int ni = 0; ni < 4; ++ni) {
        const int c = cbase + ni * 16;
        const f32x4 b = *(const f32x4*)(src + c), gg = *(const f32x4*)(g + c);
        *(f32x4*)(XS + (size_t)r * D + c) = b + gg * acc[mi][ni] * mul;
      }
    }
  }
};
struct EpiBf16 {
  bf16_t* O; int ldo;
  __device__ __forceinline__ void operator()(const f32x4 (&acc)[2][4], const f32x4 (&)[2][4], int rbase, int cbase) const {
#pragma unroll
    for (int mi = 0; mi < 2; ++mi)
#pragma unroll
      for (int ni = 0; ni < 4; ++ni) {
        u32x2 o; o.x = pack_bf16(acc[mi][ni][0], acc[mi][ni][1]); o.y = pack_bf16(acc[mi][ni][2], acc[mi][ni][3]);
        *(u32x2*)(O + (size_t)(rbase + 16 * mi) * ldo + cbase + ni * 16) = o;
      }
  }
};
struct EpiWin {
  bf16_t *GATE, *UBR;
  __device__ __forceinline__ void operator()(const f32x4 (&acc)[2][4], const f32x4 (&)[2][4], int rbase, int cbase) const {
#pragma unroll
    for (int mi = 0; mi < 2; ++mi) {
      const int r = rbase + 16 * mi;
#pragma unroll
      for (int ni = 0; ni < 4; ++ni) {
        const int c = cbase + ni * 16;
        f32x4 v = acc[mi][ni];
        if (c < 2048) {
          if (r < TL) {
            u32x2 o; o.x = pack_bf16(gelu_tanh(v[0]), gelu_tanh(v[1])); o.y = pack_bf16(gelu_tanh(v[2]), gelu_tanh(v[3]));
            *(u32x2*)(GATE + (size_t)r * D + c) = o;
          }
        } else {
          u32x2 o; o.x = pack_bf16(v[0], v[1]); o.y = pack_bf16(v[2], v[3]);
          *(u32x2*)(UBR + (size_t)r * D + (c - 2048)) = o;
        }
      }
    }
  }
};
struct EpiCoef {
  const float *b_a, *b_x, *lam; const bf16_t* UC; bf16_t *LA, *LB;
  __device__ __forceinline__ void operator()(const f32x4 (&acc)[2][4], const f32x4 (&acc2)[2][4], int rbase, int cbase) const {
#pragma unroll
    for (int ni = 0; ni < 4; ++ni) {
      const int c = cbase + ni * 16;
      const f32x4 ba = *(const f32x4*)(b_a + c), bx = *(const f32x4*)(b_x + c), lm = *(const f32x4*)(lam + c);
      float sp[4];
#pragma unroll
      for (int j = 0; j < 4; ++j) sp[j] = log1pf(expf(-lm[j]));
#pragma unroll
      for (int mi = 0; mi < 2; ++mi) {
        const int r = rbase + 16 * mi;
        const u32x2 uu = *(const u32x2*)(UC + (size_t)r * D + c);
        const float uv[4] = {__uint_as_float(uu.x << 16), __uint_as_float(uu.x & 0xffff0000u), __uint_as_float(uu.y << 16), __uint_as_float(uu.y & 0xffff0000u)};
        float lav[4], bv[4];
#pragma unroll
        for (int j = 0; j < 4; ++j) {
          const float rg = sigmoid_f(acc[mi][ni][j] + ba[j]);
          const float ig = sigmoid_f(acc2[mi][ni][j] + bx[j]);
          const float log_a = -8.0f * rg * sp[j];
          lav[j] = log_a;
          bv[j] = sqrtf(-expm1f(2.0f * log_a)) * ig * uv[j];
        }
        u32x2 o1, o2; o1.x = pack_bf16(lav[0], lav[1]); o1.y = pack_bf16(lav[2], lav[3]); o2.x = pack_bf16(bv[0], bv[1]); o2.y = pack_bf16(bv[2], bv[3]);
        *(u32x2*)(LA + (size_t)r * D + c) = o1;
        *(u32x2*)(LB + (size_t)r * D + c) = o2;
      }
    }
  }
};

template <class Epi>
__device__ __forceinline__ void gemm_phase(const bf16_t* A, const bf16_t* Bt, int K, int mtiles, int ntiles, unsigned char* lds, const Epi& epi) {
  const int total = mtiles * ntiles;
  for (int item = blockIdx.x; item < total; item += gridDim.x) {
    const int nt = item % ntiles, mt = item / ntiles;
    gemm_tile<false>(A + (size_t)mt * 128 * K, K, Bt + (size_t)nt * 128 * K, nullptr, K, K, lds, epi, mt * 128, nt * 128);
  }
}


namespace pg8 {
#define PG8_LAS __attribute__((address_space(3)))
constexpr int BM = 256, BK = 64, HALF = 128, HTB = HALF * BK * 2, STAGE_BYTES = 8 * HTB, NXCD = 8, WGM = 8;
__device__ __forceinline__ int lds_byte(int r, int c) { const int st = (r >> 4) * 2 + (c >> 5), rr = r & 15, cc = c & 31, ob = rr * 64 + cc * 2; return st * 1024 + (ob ^ (((ob >> 9) & 1) << 5)); }
__device__ __forceinline__ void stage_rc(int b, int& R, int& C) { const int st = b / 1024, sb = b % 1024, swz = sb ^ (((sb >> 9) & 1) << 5); R = (st >> 1) * 16 + swz / 64; C = (st & 1) * 32 + (swz % 64) / 2; }
__device__ __forceinline__ int perm128(int rho) { const int w = rho >> 5, n = (rho >> 4) & 1, i = rho & 15; return 64 * (w >> 1) + 16 * (w & 1) + 32 * n + i; }
struct Unit { int pm, pn; };
struct Gemm { const bf16_t* A; const bf16_t* Bt; int M, N, K; };
struct StaticOrder {
  int nM, nN, nwg, G, c;
  __device__ void init(int M, int N, int G_, int c_) { nM = M / BM; nN = N / BM; nwg = nM * nN; G = G_; c = c_; }
  __device__ bool next(int i, Unit& u) const {
    const long L = (long)i * G + c; if (L >= nwg) return false;
    int wgid = (int)L; { const int q = nwg / NXCD, r = nwg % NXCD, xcd = wgid % NXCD, off = wgid / NXCD; wgid = (xcd < r ? xcd * (q + 1) : r * (q + 1) + (xcd - r) * q) + off; }
    const int nig = WGM * nN, gid = wgid / nig, fm = gid * WGM, gsz = (nM - fm) < WGM ? (nM - fm) : WGM;
    u.pm = fm + ((wgid % nig) % gsz); u.pn = (wgid % nig) / gsz; return true;
  }
};
template <class Epi>
__device__ __forceinline__ void gemm_phase(PG8_LAS unsigned char* lds, const Gemm g, const StaticOrder& S, const Epi& E) {
  const int tid = threadIdx.x, wid = __builtin_amdgcn_readfirstlane(tid >> 6), lane = tid & 63, wr = wid >> 2, wc = wid & 3, fr = lane & 15, fq = lane >> 4;
  const int K = g.K, nt = K / BK;
  unsigned voffA[2], voffB[2];
#pragma unroll
  for (int i = 0; i < 2; ++i) { int R, C; stage_rc(tid * 16 + i * 8192, R, C); const int Rb = perm128(R);
    voffA[i] = (unsigned)(R * K + C) * 2u; voffB[i] = (unsigned)(Rb * K + C) * 2u; }
  const size_t kstep = (size_t)(BK * 2);
  const size_t hstep = (size_t)HALF * K * 2;
  const size_t tstep = 2 * hstep;
  const unsigned ldsw = (unsigned)wid * 1024u;
  const int aoff = lds_byte(wr * 64 + fr, fq * 8), boff = lds_byte(wc * 32 + fr, fq * 8);
#define PG8_SA(b, h) (((b) * 2 + (h)) * HTB)
#define PG8_SB(b, h) ((4 + (b) * 2 + (h)) * HTB)
#define PG8_STAGE(bufoff, gbase, voff) do { _Pragma("unroll") for (int _i = 0; _i < 2; ++_i) \
    __builtin_amdgcn_global_load_lds((const unsigned*)((const char*)(gbase) + (voff)[_i]), (PG8_LAS unsigned*)(lds + (bufoff) + ldsw + _i * 8192), 16, 0, 0); } while (0)
#define PG8_LDA(dst, b, h) do { _Pragma("unroll") for (int m = 0; m < 4; ++m) _Pragma("unroll") for (int k = 0; k < 2; ++k) dst[m][k] = *(const PG8_LAS bf16x8*)(lds + PG8_SA(b, h) + aoff + m * 2048 + k * 1024); } while (0)
#define PG8_LDB(dst, b, h) do { _Pragma("unroll") for (int n = 0; n < 2; ++n) _Pragma("unroll") for (int k = 0; k < 2; ++k) dst[n][k] = *(const PG8_LAS bf16x8*)(lds + PG8_SB(b, h) + boff + n * 2048 + k * 1024); } while (0)
#define PG8_MMA(ai, bj, At, Bt) do { __builtin_amdgcn_s_setprio(1); _Pragma("unroll") for (int m = 0; m < 4; ++m) _Pragma("unroll") for (int n = 0; n < 2; ++n) _Pragma("unroll") for (int k = 0; k < 2; ++k) \
    acc[ai][bj][m][n] = __builtin_amdgcn_mfma_f32_16x16x32_bf16(Bt[n][k], At[m][k], acc[ai][bj][m][n], 0, 0, 0); __builtin_amdgcn_s_setprio(0); } while (0)
#define PG8_WAIT_V(n) asm volatile("s_waitcnt vmcnt(" #n ")" ::: "memory")
#define PG8_WAIT_L(n) asm volatile("s_waitcnt lgkmcnt(" #n ")" ::: "memory")
#define PG8_BAR __builtin_amdgcn_s_barrier()
#define PG8_SCHED __builtin_amdgcn_sched_barrier(0)
  Unit cur, nxt; int ui = 0;
  if (!S.next(0, cur)) return;
  f32x4 acc[2][2][4][2];
#pragma unroll
  for (int a = 0; a < 2; ++a)
#pragma unroll
    for (int b = 0; b < 2; ++b)
#pragma unroll
      for (int m = 0; m < 4; ++m)
#pragma unroll
        for (int n = 0; n < 2; ++n) acc[a][b][m][n] = (f32x4){0.f, 0.f, 0.f, 0.f};
  bf16x8 At[4][2], B0[2][2], B1[2][2];
  const char* cA = (const char*)g.A + (size_t)cur.pm * tstep; const char* cB = (const char*)g.Bt + (size_t)cur.pn * tstep;
  PG8_STAGE(PG8_SB(0, 0), cB, voffB); PG8_STAGE(PG8_SA(0, 0), cA, voffA); PG8_STAGE(PG8_SB(0, 1), cB + hstep, voffB); PG8_STAGE(PG8_SA(0, 1), cA + hstep, voffA);
  if (wr == 1) PG8_BAR;
  PG8_WAIT_V(4); PG8_BAR;
  PG8_STAGE(PG8_SB(1, 0), cB + kstep, voffB); PG8_STAGE(PG8_SA(1, 0), cA + kstep, voffA); PG8_STAGE(PG8_SB(1, 1), cB + hstep + kstep, voffB);
  PG8_WAIT_V(6); PG8_BAR;
  for (;;) {
    const bool has_next = S.next(ui + 1, nxt);
    const char* nA = has_next ? (const char*)g.A + (size_t)nxt.pm * tstep : cA; const char* nB = has_next ? (const char*)g.Bt + (size_t)nxt.pn * tstep : cB;
    for (int t = 0; t < nt; t += 2) {
      const bool last = (t == nt - 2);
      const char* a1 = cA + (size_t)(t + 1) * kstep;
      const char* a2 = last ? nA : cA + (size_t)(t + 2) * kstep; const char* b2 = last ? nB : cB + (size_t)(t + 2) * kstep;
      const char* a3 = a2 + kstep; const char* b3 = b2 + kstep;
      PG8_LDB(B0, 0, 0); PG8_SCHED; PG8_LDA(At, 0, 0); PG8_STAGE(PG8_SA(1, 1), a1 + hstep, voffA);
      PG8_WAIT_L(8); PG8_BAR; PG8_WAIT_L(0); PG8_MMA(0, 0, At, B0); PG8_BAR; PG8_SCHED;
      PG8_LDB(B1, 0, 1); PG8_STAGE(PG8_SB(0, 0), b2, voffB);
      PG8_BAR; PG8_WAIT_L(0); PG8_MMA(0, 1, At, B1); PG8_BAR;
      PG8_LDA(At, 0, 1); PG8_STAGE(PG8_SA(0, 0), a2, voffA);
      PG8_BAR; PG8_WAIT_L(0); PG8_MMA(1, 0, At, B0); PG8_BAR; PG8_SCHED;
      PG8_STAGE(PG8_SB(0, 1), b2 + hstep, voffB);
      PG8_WAIT_V(6); PG8_BAR; PG8_MMA(1, 1, At, B1); PG8_BAR;
      PG8_LDB(B0, 1, 0); PG8_SCHED; PG8_LDA(At, 1, 0); PG8_STAGE(PG8_SA(0, 1), a2 + hstep, voffA);
      PG8_WAIT_L(8); PG8_BAR; PG8_WAIT_L(0); PG8_MMA(0, 0, At, B0); PG8_BAR; PG8_SCHED;
      PG8_LDB(B1, 1, 1); PG8_STAGE(PG8_SB(1, 0), b3, voffB);
      PG8_BAR; PG8_WAIT_L(0); PG8_MMA(0, 1, At, B1); PG8_BAR;
      PG8_LDA(At, 1, 1); PG8_STAGE(PG8_SA(1, 0), a3, voffA);
      PG8_BAR; PG8_WAIT_L(0); PG8_MMA(1, 0, At, B0); PG8_BAR; PG8_SCHED;
      PG8_STAGE(PG8_SB(1, 1), b3 + hstep, voffB);
      PG8_WAIT_V(6); PG8_BAR; PG8_MMA(1, 1, At, B1); PG8_BAR;
    }
    E(acc, cur, wr, wc, fr, fq);
    if (!has_next) break;
#pragma unroll
    for (int a = 0; a < 2; ++a)
#pragma unroll
      for (int b = 0; b < 2; ++b)
#pragma unroll
        for (int m = 0; m < 4; ++m)
#pragma unroll
          for (int n = 0; n < 2; ++n) acc[a][b][m][n] = (f32x4){0.f, 0.f, 0.f, 0.f};
    cur = nxt; cA = nA; cB = nB; ++ui;
  }
  PG8_WAIT_V(0);
  if (wr == 0) PG8_BAR;
  PG8_BAR;
#undef PG8_SA
#undef PG8_SB
#undef PG8_STAGE
#undef PG8_LDA
#undef PG8_LDB
#undef PG8_MMA
#undef PG8_WAIT_V
#undef PG8_WAIT_L
#undef PG8_BAR
#undef PG8_SCHED
}
}

#define ROW256(ai, m) (u.pm * 256 + (ai) * 128 + wr * 64 + (m) * 16 + fr)
#define COL256(bj, n) (u.pn * 256 + (bj) * 128 + 64 * (wc >> 1) + 16 * (wc & 1) + 32 * (n) + 4 * fq)
struct EpiQKV256 {
  bf16_t *Q, *Kb, *VT; const float *cosT, *sinT;
  __device__ __forceinline__ void operator()(const f32x4 (&acc)[2][2][4][2], const pg8::Unit& u, int wr, int wc, int fr, int fq) const {
#pragma unroll
    for (int bj = 0; bj < 2; ++bj) {
      const int n0 = u.pn * 256 + bj * 128;
      const int c0 = COL256(bj, 0);
      if (n0 < 2560) {
        const int iidx = 16 * (wc & 1) + 4 * fq;
#pragma unroll
        for (int ai = 0; ai < 2; ++ai)
#pragma unroll
          for (int m = 0; m < 4; ++m) {
            const int r = ROW256(ai, m);
            const f32x4 x1 = acc[ai][bj][m][0], x2 = acc[ai][bj][m][1]; f32x4 y1 = x1, y2 = x2;
            if (r < TL) {
              const int s = r & 4095; const int pos = (wc >> 1) ? (s & 63) : (s >> 6);
              const f32x4 cs = *(const f32x4*)(cosT + pos * 32 + iidx), sn = *(const f32x4*)(sinT + pos * 32 + iidx);
              y1 = x1 * cs - x2 * sn; y2 = x2 * cs + x1 * sn;
            }
            bf16_t* dst = (n0 < 2048) ? (Q + (size_t)r * D + c0) : (Kb + (size_t)r * 512 + (c0 - 2048));
            u32x2 o1, o2; o1.x = pack_bf16(y1[0], y1[1]); o1.y = pack_bf16(y1[2], y1[3]); o2.x = pack_bf16(y2[0], y2[1]); o2.y = pack_bf16(y2[2], y2[3]);
            *(u32x2*)dst = o1; *(u32x2*)(dst + 32) = o2;
          }
      } else {
#pragma unroll
        for (int ai = 0; ai < 2; ++ai)
#pragma unroll
          for (int m = 0; m < 4; ++m) {
            const int r = ROW256(ai, m);
#pragma unroll
            for (int n = 0; n < 2; ++n)
#pragma unroll
              for (int j = 0; j < 4; ++j) VT[(size_t)(c0 - 2560 + 32 * n + j) * TT + r] = f2bf(acc[ai][bj][m][n][j]);
          }
      }
    }
  }
};
struct EpiResid256 {
  const float *x, *ctx; float* XS; const float* gate; bool from_input;
  __device__ __forceinline__ void operator()(const f32x4 (&acc)[2][2][4][2], const pg8::Unit& u, int wr, int wc, int fr, int fq) const {
#pragma unroll
    for (int ai = 0; ai < 2; ++ai)
#pragma unroll
      for (int m = 0; m < 4; ++m) {
        const int r = ROW256(ai, m);
        const float* src = from_input ? (r < TL ? x + (size_t)r * D : ctx + (size_t)(r - TL) * D) : XS + (size_t)r * D;
        const float* g = gate + (size_t)mod_row(r) * NMOD;
#pragma unroll
        for (int bj = 0; bj < 2; ++bj)
#pragma unroll
          for (int n = 0; n < 2; ++n) {
            const int c = COL256(bj, n);
            const f32x4 b = *(const f32x4*)(src + c), gg = *(const f32x4*)(g + c);
            *(f32x4*)(XS + (size_t)r * D + c) = b + gg * acc[ai][bj][m][n];
          }
      }
  }
};
struct EpiBf16_256 {
  bf16_t* O; int ldo;
  __device__ __forceinline__ void operator()(const f32x4 (&acc)[2][2][4][2], const pg8::Unit& u, int wr, int wc, int fr, int fq) const {
#pragma unroll
    for (int ai = 0; ai < 2; ++ai)
#pragma unroll
      for (int m = 0; m < 4; ++m)
#pragma unroll
        for (int bj = 0; bj < 2; ++bj)
#pragma unroll
          for (int n = 0; n < 2; ++n) {
            const f32x4 v = acc[ai][bj][m][n];
            u32x2 o; o.x = pack_bf16(v[0], v[1]); o.y = pack_bf16(v[2], v[3]);
            *(u32x2*)(O + (size_t)ROW256(ai, m) * ldo + COL256(bj, n)) = o;
          }
  }
};
struct EpiWin256 {
  bf16_t *GATE, *UBR;
  __device__ __forceinline__ void operator()(const f32x4 (&acc)[2][2][4][2], const pg8::Unit& u, int wr, int wc, int fr, int fq) const {
#pragma unroll
    for (int ai = 0; ai < 2; ++ai)
#pragma unroll
      for (int m = 0; m < 4; ++m) {
        const int r = ROW256(ai, m);
#pragma unroll
        for (int bj = 0; bj < 2; ++bj)
#pragma unroll
          for (int n = 0; n < 2; ++n) {
            const int c = COL256(bj, n);
            const f32x4 v = acc[ai][bj][m][n];
            if (c < 2048) {
              if (r < TL) { u32x2 o; o.x = pack_bf16(gelu_tanh(v[0]), gelu_tanh(v[1])); o.y = pack_bf16(gelu_tanh(v[2]), gelu_tanh(v[3])); *(u32x2*)(GATE + (size_t)r * D + c) = o; }
            } else {
              u32x2 o; o.x = pack_bf16(v[0], v[1]); o.y = pack_bf16(v[2], v[3]); *(u32x2*)(UBR + (size_t)r * D + (c - 2048)) = o;
            }
          }
      }
  }
};
template <class Epi>
__device__ __forceinline__ void gemm256(const bf16_t* A, const bf16_t* Bt, int M, int N, int K, unsigned char* lds, const Epi& e) {
  pg8::Gemm g{A, Bt, M, N, K}; pg8::StaticOrder S; S.init(M, N, (int)gridDim.x, (int)blockIdx.x);
  pg8::gemm_phase((PG8_LAS unsigned char*)lds, g, S, e);
}

__device__ __forceinline__ void coef_phase(const Params& p, unsigned char* lds) {
  const bf16_t* UC = (const bf16_t*)(p.ws + OFF_O);
  const bf16_t* WA = (const bf16_t*)(p.ws + OFF_WA); const bf16_t* WX = (const bf16_t*)(p.ws + OFF_WX);
  const int total = (TT / 128) * 32;
  for (int item = blockIdx.x; item < total; item += gridDim.x) {
    const int ct = item & 31, mt = item >> 5, dir = ct >> 4, ctile = ct & 15, blk = ctile >> 1;
    EpiCoef epi{p.rec_b_a + dir * D, p.rec_b_x + dir * D, p.rec_lambda + dir * D, UC,
                (bf16_t*)(p.ws + OFF_LAB) + (size_t)(dir * 2) * TT * D, (bf16_t*)(p.ws + OFF_LAB) + (size_t)(dir * 2 + 1) * TT * D};
    const size_t woff = ((size_t)(dir * 8 + blk) * 256 + (ctile & 1) * 128) * 256;
    gemm_tile<true>(UC + (size_t)mt * 128 * D + blk * 256, D, WA + woff, WX + woff, 256, 256, lds, epi, mt * 128, ctile * 128);
  }
}

constexpr int KLD = 136, VLD = 72, PLD = 72;
__device__ __forceinline__ void attn_phase(const Params& p, unsigned char* lds) {
  const bf16_t* Q = (const bf16_t*)(p.ws + OFF_Q); const bf16_t* Kg = (const bf16_t*)(p.ws + OFF_K); const bf16_t* VT = (const bf16_t*)(p.ws + OFF_VT);
  bf16_t* O = (bf16_t*)(p.ws + OFF_O);
  bf16_t* Ks = (bf16_t*)lds;
  bf16_t* Vs = Ks + 64 * KLD;
  bf16_t* Ps = Vs + 128 * VLD;
  const int tid = threadIdx.x, wid = tid >> 6, lane = tid & 63, fr = lane & 15, fq = lane >> 4;
  const int g = wid >> 1, rh = wid & 1;
  bf16_t* Pw = Ps + wid * 16 * PLD;
  const float scale = 0.08838834764831845f;
  for (int item = blockIdx.x; item < 1088; item += gridDim.x) {
    int b, hk, qb, qrow0, nlat, kt0; bool is_ctx;
    if (item < 1024) { is_ctx = false; b = item >> 8; hk = (item >> 6) & 3; qb = item & 63; qrow0 = b * S + qb * 64; kt0 = qb - 2 < 0 ? 0 : qb - 2; const int kt1 = qb + 2 > 63 ? 63 : qb + 2; nlat = kt1 - kt0 + 1; }
    else { is_ctx = true; const int ci = item - 1024; b = ci >> 4; hk = (ci >> 2) & 3; qb = ci & 3; qrow0 = TL + b * CL + qb * 64; kt0 = 0; nlat = 0; }
    const int head = hk * 4 + g;
    const float sink = p.attn_sink[head];
    bf16x8 qf[2][4];
#pragma unroll
    for (int rt = 0; rt < 2; ++rt)
#pragma unroll
      for (int ks = 0; ks < 4; ++ks) qf[rt][ks] = *(const bf16x8*)(Q + (size_t)(qrow0 + rh * 32 + rt * 16 + fr) * D + head * 128 + ks * 32 + fq * 8);
    f32x4 oacc[2][8]; float mst[2][4], lst[2][4];
#pragma unroll
    for (int rt = 0; rt < 2; ++rt) {
#pragma unroll
      for (int dt = 0; dt < 8; ++dt) oacc[rt][dt] = (f32x4){0.f, 0.f, 0.f, 0.f};
#pragma unroll
      for (int j = 0; j < 4; ++j) { mst[rt][j] = sink; lst[rt][j] = 1.0f; }
    }
    const int ntiles = nlat + 4;
    for (int ti = 0; ti < ntiles; ++ti) {
      const bool lat = ti < nlat;
      const int krow0 = lat ? (b * S + (kt0 + ti) * 64) : (TL + b * CL + (ti - nlat) * 64);
      __syncthreads();
#pragma unroll
      for (int i = 0; i < 2; ++i) {
        const int id = tid + 512 * i;
        const int key = id >> 4, dc = (id & 15) * 8;
        *(u32x4*)(Ks + key * KLD + dc) = *(const u32x4*)(Kg + (size_t)(krow0 + key) * 512 + hk * 128 + dc);
        const int d = id >> 3, kc = (id & 7) * 8;
        *(u32x4*)(Vs + d * VLD + kc) = *(const u32x4*)(VT + (size_t)(hk * 128 + d) * TT + krow0 + kc);
      }
      __syncthreads();
#pragma unroll
      for (int rt = 0; rt < 2; ++rt) {
        f32x4 sc[4];
#pragma unroll
        for (int ct = 0; ct < 4; ++ct) {
          sc[ct] = (f32x4){0.f, 0.f, 0.f, 0.f};
#pragma unroll
          for (int ks = 0; ks < 4; ++ks) {
            const bf16x8 kf = *(const bf16x8*)(Ks + (ct * 16 + fr) * KLD + ks * 32 + fq * 8);
            sc[ct] = __builtin_amdgcn_mfma_f32_16x16x32_bf16(qf[rt][ks], kf, sc[ct], 0, 0, 0);
          }
        }
        float mx[4], rs[4], alpha[4];
#pragma unroll
        for (int j = 0; j < 4; ++j) mx[j] = -INFINITY;
#pragma unroll
        for (int ct = 0; ct < 4; ++ct)
#pragma unroll
          for (int j = 0; j < 4; ++j) {
            float v = sc[ct][j] * scale;
            if (lat) {
              const int ipos = qb * 64 + rh * 32 + rt * 16 + fq * 4 + j, jpos = (kt0 + ti) * 64 + ct * 16 + fr;
              const int dd = ipos - jpos;
              if (dd > 128 || dd < -128) v = -INFINITY;
            }
            sc[ct][j] = v; mx[j] = fmaxf(mx[j], v);
          }
#pragma unroll
        for (int j = 0; j < 4; ++j) {
#pragma unroll
          for (int o = 1; o < 16; o <<= 1) mx[j] = fmaxf(mx[j], __shfl_xor(mx[j], o));
          const float mn = fmaxf(mst[rt][j], mx[j]);
          alpha[j] = __expf(mst[rt][j] - mn);
          mst[rt][j] = mn; rs[j] = 0.f;
        }
#pragma unroll
        for (int ct = 0; ct < 4; ++ct)
#pragma unroll
          for (int j = 0; j < 4; ++j) {
            const float pv = __expf(sc[ct][j] - mst[rt][j]);
            rs[j] += pv;
            Pw[(fq * 4 + j) * PLD + ct * 16 + fr] = f2bf(pv);
          }
#pragma unroll
        for (int j = 0; j < 4; ++j) {
#pragma unroll
          for (int o = 1; o < 16; o <<= 1) rs[j] += __shfl_xor(rs[j], o);
          lst[rt][j] = lst[rt][j] * alpha[j] + rs[j];
        }
#pragma unroll
        for (int dt = 0; dt < 8; ++dt)
#pragma unroll
          for (int j = 0; j < 4; ++j) oacc[rt][dt][j] *= alpha[j];
        __syncthreads();
#pragma unroll
        for (int ks = 0; ks < 2; ++ks) {
          const bf16x8 pf = *(const bf16x8*)(Pw + fr * PLD + ks * 32 + fq * 8);
#pragma unroll
          for (int dt = 0; dt < 8; ++dt) {
            const bf16x8 vf = *(const bf16x8*)(Vs + (dt * 16 + fr) * VLD + ks * 32 + fq * 8);
            oacc[rt][dt] = __builtin_amdgcn_mfma_f32_16x16x32_bf16(pf, vf, oacc[rt][dt], 0, 0, 0);
          }
        }
        __syncthreads();
      }
    }
#pragma unroll
    for (int rt = 0; rt < 2; ++rt)
#pragma unroll
      for (int j = 0; j < 4; ++j) {
        const float inv = 1.0f / lst[rt][j];
        bf16_t* orow = O + (size_t)(qrow0 + rh * 32 + rt * 16 + fq * 4 + j) * D + head * 128 + fr;
#pragma unroll
        for (int dt = 0; dt < 8; ++dt) orow[dt * 16] = f2bf(oacc[rt][dt][j] * inv);
      }
    (void)is_ctx;
  }
}

#ifndef CAND_TRICK
#define CAND_TRICK 1
#endif
__device__ __forceinline__ void peer_route_phase(const Params& p, int layer, int ntok, unsigned char* lds) {
  const int tid = threadIdx.x, wid = tid >> 6, lane = tid & 63, fr = lane & 15, fq = lane >> 4;
  float* Sw = (float*)(lds + wid * 9216);
  const bf16_t* keysG = (const bf16_t*)(p.ws + OFF_KEYS) + (size_t)layer * 2 * 128 * 128;
  const bf16_t* PQ = (const bf16_t*)(p.ws + OFF_PQ);
  int* IDX = (int*)(p.ws + OFF_IDX); float* GW = (float*)(p.ws + OFF_GW);
  const int total = (ntok >> 6) * 8;
  for (int id = blockIdx.x * 8 + wid; id < total; id += gridDim.x * 8) {
    const int tile = id >> 3, head = id & 7, tok0 = tile * 64;
    float Lk[2][16];
#pragma unroll
    for (int pp = 0; pp < 2; ++pp) {
      bf16x8 qf[4][4];
#pragma unroll
      for (int mt = 0; mt < 4; ++mt)
#pragma unroll
        for (int ks = 0; ks < 4; ++ks) qf[mt][ks] = *(const bf16x8*)(PQ + (size_t)(tok0 + mt * 16 + fr) * D + head * 256 + pp * 128 + ks * 32 + fq * 8);
#pragma unroll
      for (int s2 = 0; s2 < 16; ++s2) Lk[pp][s2] = -INFINITY;
#pragma unroll 1
      for (int pass = 0; pass < 4; ++pass) {
        f32x4 acc[2][4];
#pragma unroll
        for (int nt = 0; nt < 2; ++nt)
#pragma unroll
          for (int mt = 0; mt < 4; ++mt) acc[nt][mt] = (f32x4){0.f, 0.f, 0.f, 0.f};
#pragma unroll
        for (int nt = 0; nt < 2; ++nt)
#pragma unroll
          for (int ks = 0; ks < 4; ++ks) {
            const bf16x8 kf = *(const bf16x8*)(keysG + (size_t)(pp * 128 + pass * 32 + nt * 16 + fr) * 128 + ks * 32 + fq * 8);
#pragma unroll
            for (int mt = 0; mt < 4; ++mt) acc[nt][mt] = __builtin_amdgcn_mfma_f32_16x16x32_bf16(kf, qf[mt][ks], acc[nt][mt], 0, 0, 0);
          }
#pragma unroll
        for (int nt = 0; nt < 2; ++nt)
#pragma unroll
          for (int mt = 0; mt < 4; ++mt) *(f32x4*)(Sw + (mt * 16 + fr) * 36 + nt * 16 + 4 * fq) = acc[nt][mt];
        asm volatile("s_waitcnt lgkmcnt(0)" ::: "memory");
#pragma unroll
        for (int c = 0; c < 8; ++c) {
          const f32x4 sv = *(const f32x4*)(Sw + lane * 36 + c * 4);
#pragma unroll
          for (int e = 0; e < 4; ++e) {
            float x = __uint_as_float((__float_as_uint(sv[e]) & ~0x7fu) | (unsigned)(pass * 32 + c * 4 + e));
#pragma unroll
            for (int s2 = 0; s2 < 16; ++s2) { const float hi = fmaxf(Lk[pp][s2], x); x = fminf(Lk[pp][s2], x); Lk[pp][s2] = hi; }
          }
        }
        asm volatile("s_waitcnt lgkmcnt(0)" ::: "memory");
      }
    }
#pragma unroll
    for (int pp = 0; pp < 2; ++pp)
#pragma unroll
      for (int s2 = 0; s2 < 16; ++s2) Sw[(pp * 16 + s2) * 64 + lane] = Lk[pp][s2];
    asm volatile("s_waitcnt lgkmcnt(0)" ::: "memory");
    float T[16]; int E[16];
#pragma unroll
    for (int s2 = 0; s2 < 16; ++s2) { T[s2] = -INFINITY; E[s2] = 0; }
#pragma unroll 1
    for (int i = 0; i < 16; ++i) {
      const unsigned pk1 = __float_as_uint(Sw[i * 64 + lane]);
      const float v1 = __uint_as_float(pk1 & ~0x7fu); const int e1 = (int)(pk1 & 0x7fu) * 128;
      const int nj = CAND_TRICK ? 16 / (i + 1) : 16;
#pragma unroll 1
      for (int j = 0; j < nj; ++j) {
        const unsigned pk2 = __float_as_uint(Sw[(16 + j) * 64 + lane]);
        float x = v1 + __uint_as_float(pk2 & ~0x7fu); int pe = e1 + (int)(pk2 & 0x7fu);
#pragma unroll
        for (int s2 = 0; s2 < 16; ++s2) {
          const bool gt = x > T[s2];
          const float nT = gt ? x : T[s2]; const float nx = gt ? T[s2] : x; const int nE = gt ? pe : E[s2]; const int npe = gt ? E[s2] : pe;
          T[s2] = nT; x = nx; E[s2] = nE; pe = npe;
        }
      }
    }
    asm volatile("s_waitcnt lgkmcnt(0)" ::: "memory");
    const size_t o = ((size_t)(tok0 + lane) * 8 + head) * 16;
    const float tmax = T[0];
    float ssum = 0.f;
#pragma unroll
    for (int s2 = 0; s2 < 16; ++s2) { T[s2] = __expf(T[s2] - tmax); ssum += T[s2]; }
    const float inv = 1.0f / ssum;
#pragma unroll
    for (int c = 0; c < 4; ++c) {
      *(f32x4*)(GW + o + c * 4) = (f32x4){T[c * 4] * inv, T[c * 4 + 1] * inv, T[c * 4 + 2] * inv, T[c * 4 + 3] * inv};
      typedef int i32x4 __attribute__((ext_vector_type(4)));
      *(i32x4*)(IDX + o + c * 4) = (i32x4){E[c * 4], E[c * 4 + 1], E[c * 4 + 2], E[c * 4 + 3]};
    }
  }
}

constexpr int PG = 2;
struct PeerBuf { u32x4 u[PG][2], v[PG][2]; float su[PG], sv[PG], g[PG]; };
__device__ __forceinline__ void peer_load(PeerBuf& B, const unsigned char* UT8, const unsigned char* VT8, const float* USC, const float* VSC, int ireg, float greg, int k0, int lane) {
#pragma unroll
  for (int j = 0; j < PG; ++j) {
    const int e = __builtin_amdgcn_readlane(ireg, k0 + j);
    B.g[j] = __builtin_bit_cast(float, __builtin_amdgcn_readlane(__builtin_bit_cast(int, greg), k0 + j));
    const unsigned char* ur = UT8 + (size_t)e * D + lane * 16; const unsigned char* vr = VT8 + (size_t)e * D + lane * 16;
    B.u[j][0] = *(const u32x4*)ur; B.u[j][1] = *(const u32x4*)(ur + 1024);
    B.v[j][0] = *(const u32x4*)vr; B.v[j][1] = *(const u32x4*)(vr + 1024);
    B.su[j] = USC[e]; B.sv[j] = VSC[e];
  }
}
__device__ __forceinline__ void peer_compute(const PeerBuf& B, const float (&hreg)[2][16], float hsum, float (&accv)[2][16], float& corr) {
#pragma unroll
  for (int j = 0; j < PG; ++j) {
    float dsum = 0.f;
#pragma unroll
    for (int c = 0; c < 2; ++c)
#pragma unroll
      for (int t = 0; t < 4; ++t) {
        const unsigned w = B.u[j][c][t];
        dsum += (float)(w & 0xffu) * hreg[c][4 * t] + (float)((w >> 8) & 0xffu) * hreg[c][4 * t + 1] + (float)((w >> 16) & 0xffu) * hreg[c][4 * t + 2] + (float)(w >> 24) * hreg[c][4 * t + 3];
      }
    const float z = B.su[j] * (wave_sum(dsum) - 128.0f * hsum);
    const float act = gelu_tanh(z) * B.g[j] * B.sv[j];
    corr += act;
#pragma unroll
    for (int c = 0; c < 2; ++c)
#pragma unroll
      for (int t = 0; t < 4; ++t) {
        const unsigned w = B.v[j][c][t];
        accv[c][4 * t] += act * (float)(w & 0xffu); accv[c][4 * t + 1] += act * (float)((w >> 8) & 0xffu); accv[c][4 * t + 2] += act * (float)((w >> 16) & 0xffu); accv[c][4 * t + 3] += act * (float)(w >> 24);
      }
  }
}
__device__ __forceinline__ void peer_gather_phase(const Params& p, int layer, int ntok, int gate_layer, bool dry = false) {
  const int tid = threadIdx.x, wid = tid >> 6, lane = tid & 63;
  const bf16_t* H = (const bf16_t*)(p.ws + OFF_H);
  const int* IDX = (const int*)(p.ws + OFF_IDX); const float* GW = (const float*)(p.ws + OFF_GW);
  const unsigned char* UT8 = p.ws + OFF_UTAB + (size_t)layer * NEXP * D; const unsigned char* VT8 = p.ws + OFF_VTAB + (size_t)layer * NEXP * D;
  const float* USC = (const float*)(p.ws + OFF_USC) + (size_t)layer * NEXP; const float* VSC = (const float*)(p.ws + OFF_VSC) + (size_t)layer * NEXP;
  float* XS = (float*)(p.ws + OFF_XS);
  const float* gate = (const float*)(p.ws + OFF_MODV) + (size_t)(gate_layer * 5) * NMOD + 5 * D;
  for (int tok = blockIdx.x * 8 + wid; tok < ntok; tok += gridDim.x * 8) {
    const int i0 = IDX[(size_t)tok * 128 + lane], i1 = IDX[(size_t)tok * 128 + 64 + lane];
    const float g0 = GW[(size_t)tok * 128 + lane], g1 = GW[(size_t)tok * 128 + 64 + lane];
    PeerBuf A, B;
    peer_load(A, UT8, VT8, USC, VSC, i0, g0, 0, lane);
    float hreg[2][16]; float hsum = 0.f;
#pragma unroll
    for (int c = 0; c < 2; ++c)
#pragma unroll
      for (int hh = 0; hh < 2; ++hh) {
        const u32x4 hv = *(const u32x4*)(H + (size_t)tok * D + c * 1024 + lane * 16 + hh * 8);
#pragma unroll
        for (int t = 0; t < 4; ++t) { hreg[c][hh * 8 + 2 * t] = __uint_as_float(hv[t] << 16); hreg[c][hh * 8 + 2 * t + 1] = __uint_as_float(hv[t] & 0xffff0000u); hsum += hreg[c][hh * 8 + 2 * t] + hreg[c][hh * 8 + 2 * t + 1]; }
      }
    hsum = wave_sum(hsum);
    float accv[2][16]; float corr = 0.f;
#pragma unroll
    for (int c = 0; c < 2; ++c)
#pragma unroll
      for (int j = 0; j < 16; ++j) accv[c][j] = 0.f;
#pragma unroll 1
    for (int half = 0; half < 2; ++half) {
      const int ireg = half ? i1 : i0; const float greg = half ? g1 : g0;
#pragma unroll 1
      for (int k0 = 0; k0 < 64; k0 += 2 * PG) {
        peer_load(B, UT8, VT8, USC, VSC, ireg, greg, k0 + PG, lane);
        peer_compute(A, hreg, hsum, accv, corr);
        if (k0 + 2 * PG < 64) peer_load(A, UT8, VT8, USC, VSC, ireg, greg, k0 + 2 * PG, lane);
        else if (half == 0) peer_load(A, UT8, VT8, USC, VSC, i1, g1, 0, lane);
        peer_compute(B, hreg, hsum, accv, corr);
      }
    }
    corr *= 128.0f;
    const float* gr = gate + (size_t)mod_row(tok) * NMOD; float* xr = XS + (size_t)tok * D;
#pragma unroll
    for (int c = 0; c < 2; ++c)
#pragma unroll
      for (int t = 0; t < 4; ++t) {
        const int col = c * 1024 + lane * 16 + 4 * t;
        const f32x4 gg = *(const f32x4*)(gr + col);
        const f32x4 sres = (f32x4){accv[c][4 * t] - corr, accv[c][4 * t + 1] - corr, accv[c][4 * t + 2] - corr, accv[c][4 * t + 3] - corr};
        if (!dry || sres[0] == 12345.678f) *(f32x4*)(xr + col) = *(const f32x4*)(xr + col) + gg * sres;
      }
  }
}

__device__ __forceinline__ void conv_phase(const Params& p) {
  const bf16_t* UBR = (const bf16_t*)(p.ws + OFF_Q); bf16_t* UC = (bf16_t*)(p.ws + OFF_O);
  const int total = TT * 256;
  for (int it = blockIdx.x * NT + threadIdx.x; it < total; it += gridDim.x * NT) {
    const int r = it >> 8, c = (it & 255) * 8;
    int pos, len;
    if (r < TL) { pos = r & 4095; len = S; } else { pos = (r - TL) & 255; len = CL; }
    float acc[8];
    { const float4 b0 = *(const float4*)(p.rec_conv_b + c), b1 = *(const float4*)(p.rec_conv_b + c + 4); acc[0] = b0.x; acc[1] = b0.y; acc[2] = b0.z; acc[3] = b0.w; acc[4] = b1.x; acc[5] = b1.y; acc[6] = b1.z; acc[7] = b1.w; }
#pragma unroll
    for (int k = 0; k < 4; ++k) {
      const int pp = pos - 1 + k;
      if (pp >= 0 && pp < len) {
        const u32x4 uv = *(const u32x4*)(UBR + (size_t)(r - 1 + k) * D + c);
        const float4 w0 = *(const float4*)(p.rec_conv_w + k * D + c), w1 = *(const float4*)(p.rec_conv_w + k * D + c + 4);
        const float wv[8] = {w0.x, w0.y, w0.z, w0.w, w1.x, w1.y, w1.z, w1.w};
#pragma unroll
        for (int t = 0; t < 4; ++t) { acc[2 * t] += wv[2 * t] * __uint_as_float(uv[t] << 16); acc[2 * t + 1] += wv[2 * t + 1] * __uint_as_float(uv[t] & 0xffff0000u); }
      }
    }
    u32x4 o; o.x = pack_bf16(acc[0], acc[1]); o.y = pack_bf16(acc[2], acc[3]); o.z = pack_bf16(acc[4], acc[5]); o.w = pack_bf16(acc[6], acc[7]);
    *(u32x4*)(UC + (size_t)r * D + c) = o;
  }
}

__device__ __forceinline__ void scan1_phase(const Params& p) {
  const bf16_t* LAB = (const bf16_t*)(p.ws + OFF_LAB);
  float* CHP = (float*)(p.ws + OFF_CHP); float* CHH = (float*)(p.ws + OFF_CHH);
  const int total = 2 * 272 * 4;
  for (int item = blockIdx.x; item < total; item += gridDim.x) {
    const int cgp = item & 3, ch = (item >> 2) % 272, dir = item / (272 * 4);
    const int c = cgp * 512 + threadIdx.x;
    const bf16_t* a = LAB + ((size_t)(dir * 2) * TT + ch * 64) * D + c; const bf16_t* b = LAB + ((size_t)(dir * 2 + 1) * TT + ch * 64) * D + c;
    float h = 0.f, ls = 0.f;
    if (dir == 0) {
#pragma unroll 16
      for (int t = 0; t < 64; ++t) { const float la = bf2f(a[(size_t)t * D]), bv = bf2f(b[(size_t)t * D]); h = __expf(la) * h + bv; ls += la; }
    } else {
#pragma unroll 16
      for (int t = 63; t >= 0; --t) { const float la = bf2f(a[(size_t)t * D]), bv = bf2f(b[(size_t)t * D]); h = __expf(la) * h + bv; ls += la; }
    }
    CHP[((size_t)dir * 272 + ch) * D + c] = __expf(ls); CHH[((size_t)dir * 272 + ch) * D + c] = h;
  }
}
__device__ __forceinline__ void scan2_phase(const Params& p) {
  const float* CHP = (const float*)(p.ws + OFF_CHP); const float* CHH = (const float*)(p.ws + OFF_CHH); float* CIN = (float*)(p.ws + OFF_CIN);
  for (int it = blockIdx.x * NT + threadIdx.x; it < 2 * NB * D; it += gridDim.x * NT) {
    const int c = it & 2047, b = (it >> 11) & 3, dir = it >> 13;
    float carry = 0.f;
    for (int s = 0; s < 68; ++s) {
      int ch;
      if (dir == 0) ch = s < 4 ? (256 + 4 * b + s) : (64 * b + (s - 4));
      else ch = s < 4 ? (256 + 4 * b + (3 - s)) : (64 * b + (63 - (s - 4)));
      const size_t o = ((size_t)dir * 272 + ch) * D + c;
      CIN[o] = carry;
      carry = CHP[o] * carry + CHH[o];
    }
  }
}
__device__ __forceinline__ void scan3_phase(const Params& p) {
  const bf16_t* LAB = (const bf16_t*)(p.ws + OFF_LAB); const float* CIN = (const float*)(p.ws + OFF_CIN);
  const bf16_t* GATE = (const bf16_t*)(p.ws + OFF_PQ); bf16_t* A2 = (bf16_t*)(p.ws + OFF_O);
  const int total = 256 * 4;
  for (int item = blockIdx.x; item < total; item += gridDim.x) {
    const int cgp = item & 3, ch = item >> 2;
    const int c = cgp * 512 + threadIdx.x;
    const size_t base = (size_t)ch * 64 * D + c;
    float y[64];
    {
      const bf16_t* a = LAB + base; const bf16_t* b = LAB + (size_t)TT * D + base;
      float h = CIN[(size_t)ch * D + c];
#pragma unroll
      for (int t = 0; t < 64; ++t) { h = __expf(bf2f(a[(size_t)t * D])) * h + bf2f(b[(size_t)t * D]); y[t] = h; }
    }
    {
      const bf16_t* a = LAB + (size_t)2 * TT * D + base; const bf16_t* b = LAB + (size_t)3 * TT * D + base;
      float h = CIN[((size_t)272 + ch) * D + c];
#pragma unroll
      for (int t = 63; t >= 0; --t) { h = __expf(bf2f(a[(size_t)t * D])) * h + bf2f(b[(size_t)t * D]); y[t] += h; }
    }
#pragma unroll
    for (int t = 0; t < 64; ++t) A2[base + (size_t)t * D] = f2bf(y[t] * bf2f(GATE[base + (size_t)t * D]));
  }
}

__global__ void __launch_bounds__(NT) fwd_megakernel(Params p) {
  extern __shared__ __attribute__((aligned(16))) unsigned char lds[];
  cg::grid_group grid = cg::this_grid();
  unsigned char* ws = p.ws;
  float* MODV = (float*)(ws + OFF_MODV);
  float* XS = (float*)(ws + OFF_XS);
  bf16_t* H = (bf16_t*)(ws + OFF_H);

  setup_phase(p, lds);
  grid.sync();
  {
    constexpr int ntok = TT;
    norm_phase(p, 0, p.norm_mix + 0 * D, 0, TT, true, H);
    grid.sync();
      {
        EpiQKV256 e{(bf16_t*)(ws + OFF_Q), (bf16_t*)(ws + OFF_K), (bf16_t*)(ws + OFF_VT), (const float*)(ws + OFF_ROPE), (const float*)(ws + OFF_ROPE) + 2048};
        gemm256(H, (const bf16_t*)(ws + OFF_WQKV), TT, 3072, D, lds, e);
      }
      grid.sync();
      attn_phase(p, lds);
      grid.sync();
    {
      EpiResid256 e{p.x, p.ctx, XS, MODV + (size_t)(0 * 5) * NMOD + 2 * D, true};
      gemm256((const bf16_t*)(ws + OFF_O), (const bf16_t*)(ws + (OFF_WO)), ntok, D, D, lds, e);
    }
    grid.sync();
    norm_phase(p, 0, p.norm_ffn + 0 * D, 3, ntok, false, H);
    grid.sync();
    {
      EpiBf16_256 e{(bf16_t*)(ws + OFF_PQ), D};
      gemm256(H, (const bf16_t*)(ws + OFF_WPQ) + (size_t)0 * D * D, ntok, D, D, lds, e);
    }
    grid.sync();
    peer_route_phase(p, 0, ntok, lds);
    grid.sync();
    if (DUP & 2) { peer_gather_phase(p, 0, ntok, 0, true); grid.sync(); }
    peer_gather_phase(p, 0, ntok, 0);
    grid.sync();
  }
  {
    constexpr int ntok = TL;
    norm_phase(p, 1, p.norm_mix + 1 * D, 0, TT, false, H);
    grid.sync();
      {
        EpiWin256 e{(bf16_t*)(ws + OFF_PQ), (bf16_t*)(ws + OFF_Q)};
        gemm256(H, (const bf16_t*)(ws + OFF_WIN), TT, 4096, D, lds, e);
      }
      grid.sync();
      conv_phase(p);
      grid.sync();
      coef_phase(p, lds);
      grid.sync();
      scan1_phase(p);
      grid.sync();
      scan2_phase(p);
      grid.sync();
      scan3_phase(p);
      grid.sync();
    {
      EpiResid256 e{p.x, p.ctx, XS, MODV + (size_t)(1 * 5) * NMOD + 2 * D, false};
      gemm256((const bf16_t*)(ws + OFF_O), (const bf16_t*)(ws + (OFF_WOUT)), ntok, D, D, lds, e);
    }
    grid.sync();
    norm_phase(p, 1, p.norm_ffn + 1 * D, 3, ntok, false, H);
    grid.sync();
    {
      EpiBf16_256 e{(bf16_t*)(ws + OFF_PQ), D};
      gemm256(H, (const bf16_t*)(ws + OFF_WPQ) + (size_t)1 * D * D, ntok, D, D, lds, e);
    }
    grid.sync();
    peer_route_phase(p, 1, ntok, lds);
    grid.sync();
    if (DUP & 2) { peer_gather_phase(p, 1, ntok, 1, true); grid.sync(); }
    peer_gather_phase(p, 1, ntok, 1);
    grid.sync();
  }
  final_norm_phase(p);
}

__global__ void diag_fill(float* out, int n, float v) { for (int i = blockIdx.x * blockDim.x + threadIdx.x; i < n; i += gridDim.x * blockDim.x) out[i] = v; }

extern "C" void kernel_launch(void* const* d_in, const int* in_sizes, int n_in, void* d_out, int out_size, void* d_ws, size_t ws_size, hipStream_t stream) {
  static int grid_blocks = 0;
  if (!grid_blocks) {
    int dev = 0, cus = 0, per_cu = 0;
    (void)hipGetDevice(&dev);
    (void)hipDeviceGetAttribute(&cus, hipDeviceAttributeMultiprocessorCount, dev);
    (void)hipFuncSetAttribute((const void*)fwd_megakernel, hipFuncAttributeMaxDynamicSharedMemorySize, (int)kDynLds);
    (void)hipOccupancyMaxActiveBlocksPerMultiprocessor(&per_cu, fwd_megakernel, NT, kDynLds);
    if (per_cu > 1) per_cu = 1;
    if (per_cu < 1) per_cu = 1;
    grid_blocks = cus * per_cu;
  }
  if (ws_size < WS_NEED) { fprintf(stderr, "workspace too small: %zu < %zu\n", ws_size, (size_t)WS_NEED); diag_fill<<<1024, 256, 0, stream>>>((float*)d_out, out_size, 3.0f); return; }
  Params p{};
  const float* const* in = (const float* const*)d_in;
  p.x = in[0]; p.c = in[1]; p.ctx = in[2]; p.c_ctx = in[3]; p.w_mod = in[4]; p.b_mod = in[5]; p.norm_mix = in[6]; p.norm_ffn = in[7]; p.norm_final = in[8];
  p.attn_w_qkv = in[9]; p.attn_w_o = in[10]; p.attn_sink = in[11];
  p.rec_w_in = in[12]; p.rec_conv_w = in[13]; p.rec_conv_b = in[14]; p.rec_w_a = in[15]; p.rec_b_a = in[16]; p.rec_w_x = in[17]; p.rec_b_x = in[18]; p.rec_lambda = in[19]; p.rec_w_out = in[20];
  p.peer_w_q = in[21]; p.peer_keys = in[22]; p.peer_u = in[23]; p.peer_v = in[24];
  p.out = (float*)d_out; p.ws = (unsigned char*)d_ws;
  void* args[] = {&p};
  hipError_t e = hipLaunchCooperativeKernel((void*)fwd_megakernel, dim3(grid_blocks), dim3(NT), args, kDynLds, stream);
  if (e != hipSuccess) { fprintf(stderr, "cooperative launch failed: %s (grid %d)\n", hipGetErrorString(e), grid_blocks); diag_fill<<<1024, 256, 0, stream>>>((float*)d_out, out_size, 5.0f); }
}
```

```cpp
#include <hip/hip_runtime.h>
#include <hip/hip_cooperative_groups.h>
#include <cstdio>
namespace cg = cooperative_groups;

typedef unsigned short bf16_t;
typedef short bf16x8 __attribute__((ext_vector_type(8)));
typedef float f32x4 __attribute__((ext_vector_type(4)));
typedef unsigned u32x4 __attribute__((ext_vector_type(4)));
typedef unsigned u32x2 __attribute__((ext_vector_type(2)));
typedef __bf16 bf16x2_t __attribute__((ext_vector_type(2)));

constexpr int D = 2048, NB = 4, S = 4096, CL = 256;
constexpr int TL = NB * S, TC = NB * CL, TT = TL + TC;
constexpr int NT = 512;
constexpr int NMOD = 6 * D;
constexpr int NEXP = 16384;
constexpr size_t kDynLds = 128 * 1024 + 64;
#ifndef SKIP
#define SKIP 0
#endif
#ifndef DUP
#define DUP 0
#endif
#ifndef PROBE
#define PROBE 0
#endif
#define PH(k, ...) do { __VA_ARGS__; if (PROBE == (k)) { GSYNC(); __VA_ARGS__; } } while (0)

constexpr size_t al256(size_t x) { return (x + 255) & ~(size_t)255; }
constexpr size_t OFF_WQKV = 0;
constexpr size_t OFF_WO   = OFF_WQKV + al256((size_t)3072 * 2048 * 2);
constexpr size_t OFF_WPQ  = OFF_WO + al256((size_t)2048 * 2048 * 2);
constexpr size_t OFF_WIN  = OFF_WPQ + al256((size_t)2 * 2048 * 2048 * 2);
constexpr size_t OFF_WOUT = OFF_WIN + al256((size_t)4096 * 2048 * 2);
constexpr size_t OFF_WA   = OFF_WOUT + al256((size_t)2048 * 2048 * 2);
constexpr size_t OFF_SP   = OFF_WA + al256((size_t)32 * 256 * 256 * 2);
constexpr size_t OFF_KEYS = OFF_SP + al256((size_t)2 * 2048 * 4);
constexpr size_t OFF_UTAB = OFF_KEYS + al256((size_t)2 * 2 * 128 * 128 * 2);
constexpr size_t OFF_VTAB = OFF_UTAB + al256((size_t)2 * NEXP * D);
constexpr size_t OFF_USC  = OFF_VTAB + al256((size_t)2 * NEXP * D);
constexpr size_t OFF_VSC  = OFF_USC + al256((size_t)2 * NEXP * 4);
constexpr size_t OFF_MODV = OFF_VSC + al256((size_t)2 * NEXP * 4);
constexpr size_t OFF_ROPE = OFF_MODV + al256((size_t)2 * 5 * NMOD * 4);
constexpr size_t OFF_XS   = OFF_ROPE + al256((size_t)2 * 2048 * 4);
constexpr size_t SZ_ACT  = al256((size_t)TT * D * 2);
constexpr size_t OFF_H    = OFF_XS + al256((size_t)TT * D * 4);
constexpr size_t OFF_Q    = OFF_H + SZ_ACT;
constexpr size_t OFF_X    = OFF_Q + SZ_ACT;
constexpr size_t OFF_K    = OFF_X + 2 * SZ_ACT;
constexpr size_t OFF_VT   = OFF_K + al256((size_t)TT * 512 * 2);
constexpr size_t OFF_O    = OFF_VT + al256((size_t)TT * 512 * 2);
constexpr size_t OFF_PQ   = OFF_O + SZ_ACT;
constexpr size_t OFF_LAB  = OFF_H;
constexpr size_t OFF_CHP  = OFF_K;
constexpr size_t OFF_CHH  = OFF_CHP + al256((size_t)2 * 272 * D * 4);
constexpr size_t OFF_CIN  = OFF_CHH + al256((size_t)2 * 272 * D * 4);
constexpr size_t OFF_IDX  = OFF_PQ + SZ_ACT;
constexpr size_t OFF_GW   = OFF_IDX + al256((size_t)TT * 128 * 4);
constexpr size_t OFF_BAR  = OFF_GW + al256((size_t)TT * 128 * 4);
constexpr size_t WS_NEED  = OFF_BAR + 16384;
static_assert(OFF_CIN + al256((size_t)2 * 272 * D * 4) <= OFF_O, "scan carries must fit in the K/VT region");
static_assert(WS_NEED <= ((size_t)1 << 30), "workspace map exceeds 1 GiB");

struct Params {
  const float *x, *c, *ctx, *c_ctx, *w_mod, *b_mod, *norm_mix, *norm_ffn, *norm_final;
  const float *attn_w_qkv, *attn_w_o, *attn_sink;
  const float *rec_w_in, *rec_conv_w, *rec_conv_b, *rec_w_a, *rec_b_a, *rec_w_x, *rec_b_x, *rec_lambda, *rec_w_out;
  const float *peer_w_q, *peer_keys, *peer_u, *peer_v;
  float* out; unsigned char* ws;
};

__device__ __forceinline__ float bf2f(bf16_t v) { return __uint_as_float((unsigned)v << 16); }
__device__ __forceinline__ bf16_t f2bf(float f) { unsigned u = __float_as_uint(f); u += 0x7fffu + ((u >> 16) & 1u); return (bf16_t)(u >> 16); }
typedef float f32x2_t __attribute__((ext_vector_type(2)));
__device__ __forceinline__ unsigned pack_bf16(float lo, float hi) { const f32x2_t v = {lo, hi}; return __builtin_bit_cast(unsigned, __builtin_convertvector(v, bf16x2_t)); }
template <int CTRL, int RM, bool BC> __device__ __forceinline__ float dppf(float old, float src) {
  return __builtin_bit_cast(float, __builtin_amdgcn_update_dpp(__builtin_bit_cast(int, old), __builtin_bit_cast(int, src), CTRL, RM, 0xf, BC));
}
__device__ __forceinline__ float wave_sum(float v) {
  v += dppf<0x111, 0xf, true>(0.f, v); v += dppf<0x112, 0xf, true>(0.f, v); v += dppf<0x114, 0xf, true>(0.f, v); v += dppf<0x118, 0xf, true>(0.f, v);
  v += dppf<0x142, 0xa, false>(0.f, v); v += dppf<0x143, 0xc, false>(0.f, v);
  return __builtin_bit_cast(float, __builtin_amdgcn_readlane(__builtin_bit_cast(int, v), 63));
}
__device__ __forceinline__ float wave_max(float v) {
  v = fmaxf(v, dppf<0x111, 0xf, false>(v, v)); v = fmaxf(v, dppf<0x112, 0xf, false>(v, v)); v = fmaxf(v, dppf<0x114, 0xf, false>(v, v)); v = fmaxf(v, dppf<0x118, 0xf, false>(v, v));
  v = fmaxf(v, dppf<0x142, 0xa, false>(v, v)); v = fmaxf(v, dppf<0x143, 0xc, false>(v, v));
  return __builtin_bit_cast(float, __builtin_amdgcn_readlane(__builtin_bit_cast(int, v), 63));
}
__device__ __forceinline__ float gelu_tanh(float x) {
  const float y = 0.7978845608028654f * (x + 0.044715f * x * x * x);
  const float t = 1.0f - 2.0f / (1.0f + __expf(2.0f * y));
  return 0.5f * x * (1.0f + t);
}
__device__ __forceinline__ float sigmoid_f(float x) { return 1.0f / (1.0f + __expf(-x)); }
__device__ __forceinline__ int mod_row(int r) { return r < TL ? (r >> 12) : 4; }
__device__ __forceinline__ int tidx() { int t = threadIdx.x; asm volatile("" : "+v"(t)); return t; }

__device__ __forceinline__ void mod_item(const Params& p, int item, float* lds) {
  float* sil = lds;
  float* red = lds + 5 * 2048;
  const int tid = tidx(), wid = tid >> 6, lane = tid & 63;
  for (int i = tid; i < 5 * 2048; i += NT) {
    const int m = i >> 11, k = i & 2047;
    const float v = (m < 4) ? p.c[m * 2048 + k] : p.c_ctx[k];
    sil[i] = v / (1.0f + expf(-v));
  }
  __syncthreads();
  const int layer = item / 48, cgp = item % 48;
  const float* W = p.w_mod + (size_t)layer * 2048 * NMOD + cgp * 256 + lane * 4;
  float acc[5][4];
#pragma unroll
  for (int m = 0; m < 5; ++m)
#pragma unroll
    for (int j = 0; j < 4; ++j) acc[m][j] = 0.f;
  const int k0 = wid * 256;
#pragma unroll 8
  for (int k = k0; k < k0 + 256; ++k) {
    const float4 w = *(const float4*)(W + (size_t)k * NMOD);
#pragma unroll
    for (int m = 0; m < 5; ++m) {
      const float s = sil[m * 2048 + k];
      acc[m][0] += s * w.x; acc[m][1] += s * w.y; acc[m][2] += s * w.z; acc[m][3] += s * w.w;
    }
  }
#pragma unroll
  for (int m = 0; m < 5; ++m)
#pragma unroll
    for (int j = 0; j < 4; ++j) red[(wid * 5 + m) * 256 + lane * 4 + j] = acc[m][j];
  __syncthreads();
  float* MODV = (float*)(p.ws + OFF_MODV);
  for (int o = tid; o < 1280; o += NT) {
    const int m = o >> 8, n = o & 255;
    float s = 0.f;
#pragma unroll
    for (int w = 0; w < 8; ++w) s += red[(w * 5 + m) * 256 + n];
    const int col = cgp * 256 + n;
    MODV[(size_t)(layer * 5 + m) * NMOD + col] = s + p.b_mod[layer * NMOD + col];
  }
  __syncthreads();
}

__device__ __forceinline__ void transpose_tile(const float* W, int ldw, bf16_t* Wt, int ldt, int k0, int n0, int n0w, float* lds) {
  const int tid = tidx();
  const int tk = tid >> 4, tn = (tid & 15) * 4;
#pragma unroll
  for (int i = 0; i < 2; ++i) {
    const int k = tk + 32 * i;
    const float4 v = *(const float4*)(W + (size_t)(k0 + k) * ldw + n0 + tn);
    lds[k * 65 + tn + 0] = v.x; lds[k * 65 + tn + 1] = v.y; lds[k * 65 + tn + 2] = v.z; lds[k * 65 + tn + 3] = v.w;
  }
  __syncthreads();
  const int wn = tid >> 3, kc = (tid & 7) * 8;
  u32x4 o;
  o.x = pack_bf16(lds[(kc + 0) * 65 + wn], lds[(kc + 1) * 65 + wn]);
  o.y = pack_bf16(lds[(kc + 2) * 65 + wn], lds[(kc + 3) * 65 + wn]);
  o.z = pack_bf16(lds[(kc + 4) * 65 + wn], lds[(kc + 5) * 65 + wn]);
  o.w = pack_bf16(lds[(kc + 6) * 65 + wn], lds[(kc + 7) * 65 + wn]);
  *(u32x4*)(Wt + (size_t)(n0w + wn) * ldt + k0 + kc) = o;
  __syncthreads();
}

__device__ __forceinline__ void transpose_job(const Params& p, int t, float* lds) {
  const float* W; bf16_t* Wt; int K, N;
  if (t < 1536) { W = p.attn_w_qkv; Wt = (bf16_t*)(p.ws + OFF_WQKV); K = 2048; N = 3072; }
  else if ((t -= 1536) < 1024) { W = p.attn_w_o; Wt = (bf16_t*)(p.ws + OFF_WO); K = 2048; N = 2048; }
  else if ((t -= 1024) < 2048) { const int l = t >> 10; t &= 1023; W = p.peer_w_q + (size_t)l * 2048 * 2048; Wt = (bf16_t*)(p.ws + OFF_WPQ) + (size_t)l * 2048 * 2048; K = 2048; N = 2048; }
  else if ((t -= 2048) < 2048) { W = p.rec_w_in; Wt = (bf16_t*)(p.ws + OFF_WIN); K = 2048; N = 4096; }
  else if ((t -= 2048) < 1024) { W = p.rec_w_out; Wt = (bf16_t*)(p.ws + OFF_WOUT); K = 2048; N = 2048; }
  else {
    t -= 1024; const int isx = t >> 8; t &= 255; const int mtx = t >> 4; t &= 15;
    W = (isx ? p.rec_w_x : p.rec_w_a) + (size_t)mtx * 65536; K = 256; N = 256;
    const int k0 = (t >> 2) * 64, n0 = (t & 3) * 64;
    Wt = (bf16_t*)(p.ws + OFF_WA) + ((size_t)(mtx * 2 + (n0 >> 7)) * 256 + isx * 128) * 256;
    transpose_tile(W, N, Wt, K, k0, n0, n0 & 127, lds);
    return;
  }
  const int ntn = N / 64;
  transpose_tile(W, N, Wt, K, (t / ntn) * 64, (t % ntn) * 64, (t % ntn) * 64, lds);
}

__device__ __forceinline__ void convert8(const float* src, bf16_t* dst) {
  const float4 a = ((const float4*)src)[0], b = ((const float4*)src)[1];
  u32x4 o; o.x = pack_bf16(a.x, a.y); o.y = pack_bf16(a.z, a.w); o.z = pack_bf16(b.x, b.y); o.w = pack_bf16(b.z, b.w);
  *(u32x4*)dst = o;
}

constexpr int IT_MOD = 0, IT_TR = 96, IT_KEYS = IT_TR + 8192, IT_ROPE = IT_KEYS + 16, IT_TAB = IT_ROPE + 1;
struct ItemRanges { int lo1, n1, lo2, n2; };

__device__ __forceinline__ void quant_rows_item(const Params& p, int t, int tid0) {
  const int wid = tid0 >> 6, lane = tid0 & 63;
  float4 v[2][8]; float mx[2] = {0.f, 0.f};
#pragma unroll
  for (int h = 0; h < 2; ++h) {
    const int R = t * 16 + h * 8 + wid, tb = R >> 15, row = R & 32767;
    const float* src = (tb == 0 ? p.peer_u : p.peer_v) + (size_t)row * D;
#pragma unroll
    for (int i = 0; i < 8; ++i) v[h][i] = ((const float4*)src)[i * 64 + lane];
  }
#pragma unroll
  for (int h = 0; h < 2; ++h) {
    const int R = t * 16 + h * 8 + wid, tb = R >> 15, row = R & 32767;
    unsigned* dst = (unsigned*)(p.ws + (tb == 0 ? OFF_UTAB : OFF_VTAB) + (size_t)row * D);
    float* scp = (float*)(p.ws + (tb == 0 ? OFF_USC : OFF_VSC)) + row;
#pragma unroll
    for (int i = 0; i < 8; ++i) mx[h] = fmaxf(mx[h], fmaxf(fmaxf(fabsf(v[h][i].x), fabsf(v[h][i].y)), fmaxf(fabsf(v[h][i].z), fabsf(v[h][i].w))));
    mx[h] = wave_max(mx[h]);
    const float sc = mx[h] > 0.f ? mx[h] * (1.0f / 127.0f) : 1.0f, inv = 1.0f / sc;
#pragma unroll
    for (int i = 0; i < 8; ++i) {
      const unsigned q0 = (unsigned)((int)fminf(fmaxf(rintf(v[h][i].x * inv), -127.f), 127.f) + 128), q1 = (unsigned)((int)fminf(fmaxf(rintf(v[h][i].y * inv), -127.f), 127.f) + 128);
      const unsigned q2 = (unsigned)((int)fminf(fmaxf(rintf(v[h][i].z * inv), -127.f), 127.f) + 128), q3 = (unsigned)((int)fminf(fmaxf(rintf(v[h][i].w * inv), -127.f), 127.f) + 128);
      dst[i * 64 + lane] = q0 | (q1 << 8) | (q2 << 16) | (q3 << 24);
    }
    if (lane == 0) *scp = sc;
  }
}

__device__ __forceinline__ void setup_phase(const Params& p, unsigned char* lds_raw) {
  float* lds = (float*)lds_raw;
  const int tid0 = tidx();
  constexpr int NSMALL = 8192 + 4096 + 17, NPOOL_A = 96 * 35;
  const int b = (int)blockIdx.x;
  int j, stride, jend;
  if (b < 96) { mod_item(p, b, lds); j = b; stride = 96; jend = NPOOL_A; } else { j = NPOOL_A + (b - 96); stride = (int)gridDim.x - 96; jend = NSMALL; }
  for (; j < jend; j += stride) {
    if (j < 8192) { transpose_job(p, j, lds); continue; }
    if (j < 8192 + 4096) { quant_rows_item(p, j - 8192, tid0); continue; }
    const int t = j - (8192 + 4096);
    if (t < 16) { const size_t e = (size_t)t * 4096 + tid0 * 8; convert8(p.peer_keys + e, (bf16_t*)(p.ws + OFF_KEYS) + e); continue; }
    float* cosT = (float*)(p.ws + OFF_ROPE); float* sinT = cosT + 2048;
    for (int e = tid0; e < 2048; e += NT) {
      const int pos = e >> 5, jj = e & 31;
      const float inv = powf(10000.0f, -(float)(2 * jj) / 64.0f);
      const float ang = (float)pos * inv;
      cosT[e] = cosf(ang); sinT[e] = sinf(ang);
    }
    float* SP = (float*)(p.ws + OFF_SP);
    for (int e = tid0; e < 2 * 2048; e += NT) SP[e] = log1pf(expf(-p.rec_lambda[e]));
  }
}
__device__ __forceinline__ void run_filler(const Params& p, const ItemRanges r, int first, int stride, unsigned char* lds_raw) {
  const int tid0 = tidx();
  for (int k = first; k < r.n1 + r.n2; k += stride) {
    const int item = k < r.n1 ? r.lo1 + k : r.lo2 + (k - r.n1);
    if (item >= IT_TAB) quant_rows_item(p, item - IT_TAB, tid0);
    else transpose_job(p, item - IT_TR, (float*)lds_raw);
  }
}

__device__ __forceinline__ void norm_phase(const Params& p, int layer, const float* gain, int shift_idx, int nrows, bool from_input, bf16_t* H) {
  const int tid_ = tidx(), wid = tid_ >> 6, lane = tid_ & 63;
  const float* MODV = (const float*)(p.ws + OFF_MODV);
  const float* XS = (const float*)(p.ws + OFF_XS);
  for (int r = blockIdx.x * 8 + wid; r < nrows; r += gridDim.x * 8) {
    const float* src = from_input ? (r < TL ? p.x + (size_t)r * D : p.ctx + (size_t)(r - TL) * D) : XS + (size_t)r * D;
    const float* mv = MODV + (size_t)(layer * 5 + mod_row(r)) * NMOD;
    const float* sh = mv + shift_idx * D; const float* sc = sh + D;
    float4 v[8]; float ss = 0.f;
#pragma unroll
    for (int i = 0; i < 8; ++i) { v[i] = ((const float4*)src)[i * 64 + lane]; ss += v[i].x * v[i].x + v[i].y * v[i].y + v[i].z * v[i].z + v[i].w * v[i].w; }
    ss = wave_sum(ss);
    const float rs = rsqrtf(ss * (1.0f / D) + 1e-6f);
#pragma unroll
    for (int i = 0; i < 8; ++i) {
      const float4 g = ((const float4*)gain)[i * 64 + lane], a = ((const float4*)sh)[i * 64 + lane], b = ((const float4*)sc)[i * 64 + lane];
      const float o0 = v[i].x * rs * g.x * (1.0f + b.x) + a.x, o1 = v[i].y * rs * g.y * (1.0f + b.y) + a.y;
      const float o2 = v[i].z * rs * g.z * (1.0f + b.z) + a.z, o3 = v[i].w * rs * g.w * (1.0f + b.w) + a.w;
      u32x2 o; o.x = pack_bf16(o0, o1); o.y = pack_bf16(o2, o3);
      *(u32x2*)(H + (size_t)r * D + i * 256 + lane * 4) = o;
    }
  }
}

__device__ __forceinline__ void final_norm_phase(const Params& p) {
  const int tid_ = tidx(), wid = tid_ >> 6, lane = tid_ & 63;
  const float* XS = (const float*)(p.ws + OFF_XS);
  for (int r = blockIdx.x * 8 + wid; r < TL; r += gridDim.x * 8) {
    const float4* xr = (const float4*)(XS + (size_t)r * D);
    float4 v[8]; float ss = 0.f;
#pragma unroll
    for (int i = 0; i < 8; ++i) { v[i] = xr[i * 64 + lane]; ss += v[i].x * v[i].x + v[i].y * v[i].y + v[i].z * v[i].z + v[i].w * v[i].w; }
    ss = wave_sum(ss);
    const float rs = rsqrtf(ss * (1.0f / D) + 1e-6f);
    float4* orow = (float4*)(p.out + (size_t)r * D);
#pragma unroll
    for (int i = 0; i < 8; ++i) { const float4 g = ((const float4*)p.norm_final)[i * 64 + lane]; float4 o; o.x = v[i].x * rs * g.x; o.y = v[i].y * rs * g.y; o.z = v[i].z * rs * g.z; o.w = v[i].w * rs * g.w; orow[i * 64 + lane] = o; }
  }
}

constexpr int GLD = 72;
template <bool DUAL, class Epi>
__device__ __forceinline__ void gemm_tile(const bf16_t* __restrict__ Ap, int lda, const bf16_t* __restrict__ Bp, const bf16_t* __restrict__ B2p, int ldb, int K,
                                          unsigned char* lds, const Epi& epi, int m0, int n0) {
  const int tid = tidx(), wid = tid >> 6, lane = tid & 63, wm = wid >> 1, wn = wid & 1, fr = lane & 15, fq = lane >> 4;
  bf16_t* As = (bf16_t*)lds; bf16_t* Bs = As + 2 * 128 * GLD; bf16_t* B2s = Bs + 2 * 128 * GLD;
  const int lr0 = tid >> 3, lc = (tid & 7) * 8;
  f32x4 acc[2][4], acc2[2][4];
#pragma unroll
  for (int i = 0; i < 2; ++i)
#pragma unroll
    for (int j = 0; j < 4; ++j) { acc[i][j] = (f32x4){0.f, 0.f, 0.f, 0.f}; acc2[i][j] = (f32x4){0.f, 0.f, 0.f, 0.f}; }
  u32x4 ra[2], rb[2], rb2[2];
  const int nk = K >> 6;
#pragma unroll
  for (int i = 0; i < 2; ++i) {
    ra[i] = *(const u32x4*)(Ap + (size_t)(lr0 + 64 * i) * lda + lc);
    rb[i] = *(const u32x4*)(Bp + (size_t)(lr0 + 64 * i) * ldb + lc);
    if (DUAL) rb2[i] = *(const u32x4*)(B2p + (size_t)(lr0 + 64 * i) * ldb + lc);
  }
#pragma unroll
  for (int i = 0; i < 2; ++i) {
    *(u32x4*)(As + (lr0 + 64 * i) * GLD + lc) = ra[i];
    *(u32x4*)(Bs + (lr0 + 64 * i) * GLD + lc) = rb[i];
    if (DUAL) *(u32x4*)(B2s + (lr0 + 64 * i) * GLD + lc) = rb2[i];
  }
  __syncthreads();
  for (int kt = 0; kt < nk; ++kt) {
    const int buf = kt & 1;
    if (kt + 1 < nk) {
#pragma unroll
      for (int i = 0; i < 2; ++i) {
        ra[i] = *(const u32x4*)(Ap + (size_t)(lr0 + 64 * i) * lda + (kt + 1) * 64 + lc);
        rb[i] = *(const u32x4*)(Bp + (size_t)(lr0 + 64 * i) * ldb + (kt + 1) * 64 + lc);
        if (DUAL) rb2[i] = *(const u32x4*)(B2p + (size_t)(lr0 + 64 * i) * ldb + (kt + 1) * 64 + lc);
      }
    }
    const bf16_t* Ab = As + buf * 128 * GLD; const bf16_t* Bb = Bs + buf * 128 * GLD; const bf16_t* B2b = B2s + buf * 128 * GLD;
#pragma unroll
    for (int ks = 0; ks < 2; ++ks) {
      bf16x8 af[2], bfr[4];
#pragma unroll
      for (int mi = 0; mi < 2; ++mi) af[mi] = *(const bf16x8*)(Ab + (wm * 32 + mi * 16 + fr) * GLD + ks * 32 + fq * 8);
#pragma unroll
      for (int ni = 0; ni < 4; ++ni) bfr[ni] = *(const bf16x8*)(Bb + (wn * 64 + ni * 16 + fr) * GLD + ks * 32 + fq * 8);
#pragma unroll
      for (int mi = 0; mi < 2; ++mi)
#pragma unroll
        for (int ni = 0; ni < 4; ++ni) acc[mi][ni] = __builtin_amdgcn_mfma_f32_16x16x32_bf16(bfr[ni], af[mi], acc[mi][ni], 0, 0, 0);
      if (DUAL) {
#pragma unroll
        for (int ni = 0; ni < 4; ++ni) bfr[ni] = *(const bf16x8*)(B2b + (wn * 64 + ni * 16 + fr) * GLD + ks * 32 + fq * 8);
#pragma unroll
        for (int mi = 0; mi < 2; ++mi)
#pragma unroll
          for (int ni = 0; ni < 4; ++ni) acc2[mi][ni] = __builtin_amdgcn_mfma_f32_16x16x32_bf16(bfr[ni], af[mi], acc2[mi][ni], 0, 0, 0);
      }
    }
    if (kt + 1 < nk) {
      const int nb = buf ^ 1;
#pragma unroll
      for (int i = 0; i < 2; ++i) {
        *(u32x4*)(As + nb * 128 * GLD + (lr0 + 64 * i) * GLD + lc) = ra[i];
        *(u32x4*)(Bs + nb * 128 * GLD + (lr0 + 64 * i) * GLD + lc) = rb[i];
        if (DUAL) *(u32x4*)(B2s + nb * 128 * GLD + (lr0 + 64 * i) * GLD + lc) = rb2[i];
      }
    }
    __syncthreads();
  }
  epi(acc, acc2, m0 + wm * 32 + fr, n0 + wn * 64 + fq * 4);
}

struct EpiQKV {
  bf16_t *Q, *Kb, *VT; const float *cosT, *sinT;
  __device__ __forceinline__ void operator()(const f32x4 (&acc)[2][4], const f32x4 (&)[2][4], int rbase, int cbase) const {
    const int n0 = cbase & ~127;
#pragma unroll
    for (int mi = 0; mi < 2; ++mi) {
      const int r = rbase + 16 * mi;
      if (n0 < 2560) {
        const bool latent = r < TL;
        const int s = r & 4095;
        const int pos = ((cbase & 64) == 0) ? (s >> 6) : (s & 63);
        const int cl = cbase & 63;
        bf16_t* dst = (n0 < 2048) ? (Q + (size_t)r * D + cbase) : (Kb + (size_t)r * 512 + (cbase - 2048));
#pragma unroll
        for (int ni = 0; ni < 2; ++ni) {
          f32x4 x1 = acc[mi][ni], x2 = acc[mi][ni + 2], y1 = x1, y2 = x2;
          if (latent) {
            const f32x4 cs = *(const f32x4*)(cosT + pos * 32 + ni * 16 + cl), sn = *(const f32x4*)(sinT + pos * 32 + ni * 16 + cl);
            y1 = x1 * cs - x2 * sn; y2 = x2 * cs + x1 * sn;
          }
          u32x2 o1, o2; o1.x = pack_bf16(y1[0], y1[1]); o1.y = pack_bf16(y1[2], y1[3]); o2.x = pack_bf16(y2[0], y2[1]); o2.y = pack_bf16(y2[2], y2[3]);
          *(u32x2*)(dst + ni * 16) = o1; *(u32x2*)(dst + (ni + 2) * 16) = o2;
        }
      } else {
#pragma unroll
        for (int ni = 0; ni < 4; ++ni)
#pragma unroll
          for (int j = 0; j < 4; ++j) VT[(size_t)(cbase - 2560 + ni * 16 + j) * TT + r] = f2bf(acc[mi][ni][j]);
      }
    }
  }
};
struct EpiResid {
  const float *x, *ctx; float* XS; const float* gate  ; bool from_input; float mul;
  __device__ __forceinline__ void operator()(const f32x4 (&acc)[2][4], const f32x4 (&)[2][4], int rbase, int cbase) const {
#pragma unroll
    for (int mi = 0; mi < 2; ++mi) {
      const int r = rbase + 16 * mi;
      const float* src = from_input ? (r < TL ? x + (size_t)r * D : ctx + (size_t)(r - TL) * D) : XS + (size_t)r * D;
      const float* g = gate + (size_t)mod_row(r) * NMOD;
#pragma unroll
      for (int ni = 0; ni < 4; ++ni) {
        const int c = cbase + ni * 16;
        const f32x4 b = *(const f32x4*)(src + c), gg = *(const f32x4*)(g + c);
        *(f32x4*)(XS + (size_t)r * D + c) = b + gg * acc[mi][ni] * mul;
      }
    }
  }
};
struct EpiBf16 {
  bf16_t* O; int ldo;
  __device__ __forceinline__ void operator()(const f32x4 (&acc)[2][4], const f32x4 (&)[2][4], int rbase, int cbase) const {
#pragma unroll
    for (int mi = 0; mi < 2; ++mi)
#pragma unroll
      for (int ni = 0; ni < 4; ++ni) {
        u32x2 o; o.x = pack_bf16(acc[mi][ni][0], acc[mi][ni][1]); o.y = pack_bf16(acc[mi][ni][2], acc[mi][ni][3]);
        *(u32x2*)(O + (size_t)(rbase + 16 * mi) * ldo + cbase + ni * 16) = o;
      }
  }
};
struct EpiWin {
  bf16_t *GATE, *UBR;
  __device__ __forceinline__ void operator()(const f32x4 (&acc)[2][4], const f32x4 (&)[2][4], int rbase, int cbase) const {
#pragma unroll
    for (int mi = 0; mi < 2; ++mi) {
      const int r = rbase + 16 * mi;
#pragma unroll
      for (int ni = 0; ni < 4; ++ni) {
        const int c = cbase + ni * 16;
        f32x4 v = acc[mi][ni];
        if (c < 2048) {
          if (r < TL) {
            u32x2 o; o.x = pack_bf16(gelu_tanh(v[0]), gelu_tanh(v[1])); o.y = pack_bf16(gelu_tanh(v[2]), gelu_tanh(v[3]));
            *(u32x2*)(GATE + (size_t)r * D + c) = o;
          }
        } else {
          u32x2 o; o.x = pack_bf16(v[0], v[1]); o.y = pack_bf16(v[2], v[3]);
          *(u32x2*)(UBR + (size_t)r * D + (c - 2048)) = o;
        }
      }
    }
  }
};
struct EpiCoef {
  const float *b_a, *b_x, *lam; const bf16_t* UC; bf16_t *LA, *LB;
  __device__ __forceinline__ void operator()(const f32x4 (&acc)[2][4], const f32x4 (&acc2)[2][4], int rbase, int cbase) const {
#pragma unroll
    for (int ni = 0; ni < 4; ++ni) {
      const int c = cbase + ni * 16;
      const f32x4 ba = *(const f32x4*)(b_a + c), bx = *(const f32x4*)(b_x + c), lm = *(const f32x4*)(lam + c);
      float sp[4];
#pragma unroll
      for (int j = 0; j < 4; ++j) sp[j] = log1pf(expf(-lm[j]));
#pragma unroll
      for (int mi = 0; mi < 2; ++mi) {
        const int r = rbase + 16 * mi;
        const u32x2 uu = *(const u32x2*)(UC + (size_t)r * D + c);
        const float uv[4] = {__uint_as_float(uu.x << 16), __uint_as_float(uu.x & 0xffff0000u), __uint_as_float(uu.y << 16), __uint_as_float(uu.y & 0xffff0000u)};
        float lav[4], bv[4];
#pragma unroll
        for (int j = 0; j < 4; ++j) {
          const float rg = sigmoid_f(acc[mi][ni][j] + ba[j]);
          const float ig = sigmoid_f(acc2[mi][ni][j] + bx[j]);
          const float log_a = -8.0f * rg * sp[j];
          lav[j] = log_a;
          bv[j] = sqrtf(-expm1f(2.0f * log_a)) * ig * uv[j];
        }
        u32x2 o1, o2; o1.x = pack_bf16(lav[0], lav[1]); o1.y = pack_bf16(lav[2], lav[3]); o2.x = pack_bf16(bv[0], bv[1]); o2.y = pack_bf16(bv[2], bv[3]);
        *(u32x2*)(LA + (size_t)r * D + c) = o1;
        *(u32x2*)(LB + (size_t)r * D + c) = o2;
      }
    }
  }
};

template <class Epi>
__device__ __forceinline__ void gemm_phase(const bf16_t* A, const bf16_t* Bt, int K, int mtiles, int ntiles, unsigned char* lds, const Epi& epi) {
  const int total = mtiles * ntiles;
  for (int item = blockIdx.x; item < total; item += gridDim.x) {
    const int nt = item % ntiles, mt = item / ntiles;
    gemm_tile<false>(A + (size_t)mt * 128 * K, K, Bt + (size_t)nt * 128 * K, nullptr, K, K, lds, epi, mt * 128, nt * 128);
  }
}


namespace pg8 {
#define PG8_LAS __attribute__((address_space(3)))
constexpr int BM = 256, BK = 64, HALF = 128, HTB = HALF * BK * 2, STAGE_BYTES = 8 * HTB, NXCD = 8, WGM = 8;
__device__ __forceinline__ int lds_byte(int r, int c) { const int st = (r >> 4) * 2 + (c >> 5), rr = r & 15, cc = c & 31, ob = rr * 64 + cc * 2; return st * 1024 + (ob ^ (((ob >> 9) & 1) << 5)); }
__device__ __forceinline__ void stage_rc(int b, int& R, int& C) { const int st = b / 1024, sb = b % 1024, swz = sb ^ (((sb >> 9) & 1) << 5); R = (st >> 1) * 16 + swz / 64; C = (st & 1) * 32 + (swz % 64) / 2; }
__device__ __forceinline__ int perm128(int rho) { const int w = rho >> 5, n = (rho >> 4) & 1, i = rho & 15; return 64 * (w >> 1) + 16 * (w & 1) + 32 * n + i; }
struct Unit { int pm, pn; unsigned aoff, boff; };
struct Gemm { const bf16_t* A; const bf16_t* Bt; int K, lda; };
struct StaticOrder {
  int nM, nN, nwg, G, c; unsigned tA, tB;
  __device__ void init(int M, int N, int K, int lda, int G_, int c_) { nM = M / BM; nN = N / BM; nwg = nM * nN; G = G_; c = c_; tA = (unsigned)(BM * lda * 2); tB = (unsigned)(BM * K * 2); }
  __device__ bool next(int i, Unit& u) const {
    const long L = (long)i * G + c; if (L >= nwg) return false;
    int wgid = (int)L; { const int q = nwg / NXCD, r = nwg % NXCD, xcd = wgid % NXCD, off = wgid / NXCD; wgid = (xcd < r ? xcd * (q + 1) : r * (q + 1) + (xcd - r) * q) + off; }
    const int nig = WGM * nN, gid = wgid / nig, fm = gid * WGM, gsz = (nM - fm) < WGM ? (nM - fm) : WGM;
    u.pm = fm + ((wgid % nig) % gsz); u.pn = (wgid % nig) / gsz; u.aoff = (unsigned)u.pm * tA; u.boff = (unsigned)u.pn * tB; return true;
  }
};
struct CoefOrder {
  int G, c;
  __device__ void init(int G_, int c_) { G = G_; c = c_; }
  __device__ bool next(int i, Unit& u) const {
    const long L = (long)i * G + c; if (L >= (long)(TT / 256) * 32) return false;
    u.pm = (int)(L >> 5); u.pn = (int)(L & 31); const int blk = (u.pn >> 1) & 7;
    u.aoff = (unsigned)((u.pm * 256 * D + blk * 256) * 2); u.boff = (unsigned)(u.pn * 256 * 256 * 2); return true;
  }
};
template <class Epi, class Sched>
__device__ __forceinline__ void gemm_phase(PG8_LAS unsigned char* lds, const Gemm g, const Sched& S, const Epi& E) {
  const int tid = tidx(), wid = __builtin_amdgcn_readfirstlane(tid >> 6), lane = tid & 63, wr = wid >> 2, wc = wid & 3, fr = lane & 15, fq = lane >> 4;
  const int K = g.K, nt = K / BK;
  unsigned voffA[2], voffB[2];
#pragma unroll
  for (int i = 0; i < 2; ++i) { int R, C; stage_rc(tid * 16 + i * 8192, R, C); const int Rb = perm128(R);
    voffA[i] = (unsigned)(R * g.lda + C) * 2u; voffB[i] = (unsigned)(Rb * K + C) * 2u; }
  const unsigned kstep = (unsigned)(BK * 2);
  const unsigned hstepA = (unsigned)(HALF * g.lda * 2), hstepB = (unsigned)(HALF * K * 2);
  const unsigned ldsw = (unsigned)wid * 1024u;
  const int aoff = lds_byte(wr * 64 + fr, fq * 8), boff = lds_byte(wc * 32 + fr, fq * 8);
#define PG8_SA(b, h) (((b) * 2 + (h)) * HTB)
#define PG8_SB(b, h) ((4 + (b) * 2 + (h)) * HTB)
#define PG8_STAGE(bufoff, gbase, voff) do { _Pragma("unroll") for (int _i = 0; _i < 2; ++_i) \
    __builtin_amdgcn_global_load_lds((const unsigned*)((const char*)(gbase) + (voff)[_i]), (PG8_LAS unsigned*)(lds + (bufoff) + ldsw + _i * 8192), 16, 0, 0); } while (0)
#define PG8_LDA(dst, b, h) do { _Pragma("unroll") for (int m = 0; m < 4; ++m) _Pragma("unroll") for (int k = 0; k < 2; ++k) dst[m][k] = *(const PG8_LAS bf16x8*)(lds + PG8_SA(b, h) + aoff + m * 2048 + k * 1024); } while (0)
#define PG8_LDB(dst, b, h) do { _Pragma("unroll") for (int n = 0; n < 2; ++n) _Pragma("unroll") for (int k = 0; k < 2; ++k) dst[n][k] = *(const PG8_LAS bf16x8*)(lds + PG8_SB(b, h) + boff + n * 2048 + k * 1024); } while (0)
#define PG8_MMA(ai, bj, At, Bt) do { __builtin_amdgcn_s_setprio(1); _Pragma("unroll") for (int m = 0; m < 4; ++m) _Pragma("unroll") for (int n = 0; n < 2; ++n) _Pragma("unroll") for (int k = 0; k < 2; ++k) \
    acc[ai][bj][m][n] = __builtin_amdgcn_mfma_f32_16x16x32_bf16(Bt[n][k], At[m][k], acc[ai][bj][m][n], 0, 0, 0); __builtin_amdgcn_s_setprio(0); } while (0)
#define PG8_WAIT_V(n) asm volatile("s_waitcnt vmcnt(" #n ")" ::: "memory")
#define PG8_WAIT_L(n) asm volatile("s_waitcnt lgkmcnt(" #n ")" ::: "memory")
#define PG8_BAR __builtin_amdgcn_s_barrier()
#define PG8_SCHED __builtin_amdgcn_sched_barrier(0)
  Unit cur, nxt; int ui = 0;
  if (!S.next(0, cur)) return;
  f32x4 acc[2][2][4][2];
#pragma unroll
  for (int a = 0; a < 2; ++a)
#pragma unroll
    for (int b = 0; b < 2; ++b)
#pragma unroll
      for (int m = 0; m < 4; ++m)
#pragma unroll
        for (int n = 0; n < 2; ++n) acc[a][b][m][n] = (f32x4){0.f, 0.f, 0.f, 0.f};
  bf16x8 At[4][2], B0[2][2], B1[2][2];
  const char* cA = (const char*)g.A + cur.aoff; const char* cB = (const char*)g.Bt + cur.boff;
  PG8_STAGE(PG8_SB(0, 0), cB, voffB); PG8_STAGE(PG8_SA(0, 0), cA, voffA); PG8_STAGE(PG8_SB(0, 1), cB + hstepB, voffB); PG8_STAGE(PG8_SA(0, 1), cA + hstepA, voffA);
  if (wr == 1) PG8_BAR;
  PG8_WAIT_V(4); PG8_BAR;
  PG8_STAGE(PG8_SB(1, 0), cB + kstep, voffB); PG8_STAGE(PG8_SA(1, 0), cA + kstep, voffA); PG8_STAGE(PG8_SB(1, 1), cB + hstepB + kstep, voffB);
  PG8_WAIT_V(6); PG8_BAR;
  for (;;) {
    const bool has_next = S.next(ui + 1, nxt);
    const char* nA = has_next ? (const char*)g.A + nxt.aoff : cA; const char* nB = has_next ? (const char*)g.Bt + nxt.boff : cB;
    for (int t = 0; t < nt; t += 2) {
      const bool last = (t == nt - 2);
      const char* a1 = cA + (unsigned)(t + 1) * kstep;
      const char* a2 = last ? nA : cA + (unsigned)(t + 2) * kstep; const char* b2 = last ? nB : cB + (unsigned)(t + 2) * kstep;
      const char* a3 = a2 + kstep; const char* b3 = b2 + kstep;
      PG8_LDB(B0, 0, 0); PG8_SCHED; PG8_LDA(At, 0, 0); PG8_STAGE(PG8_SA(1, 1), a1 + hstepA, voffA);
      PG8_WAIT_L(8); PG8_BAR; PG8_WAIT_L(0); PG8_MMA(0, 0, At, B0); PG8_BAR; PG8_SCHED;
      PG8_LDB(B1, 0, 1); PG8_STAGE(PG8_SB(0, 0), b2, voffB);
      PG8_BAR; PG8_WAIT_L(0); PG8_MMA(0, 1, At, B1); PG8_BAR;
      PG8_LDA(At, 0, 1); PG8_STAGE(PG8_SA(0, 0), a2, voffA);
      PG8_BAR; PG8_WAIT_L(0); PG8_MMA(1, 0, At, B0); PG8_BAR; PG8_SCHED;
      PG8_STAGE(PG8_SB(0, 1), b2 + hstepB, voffB);
      PG8_WAIT_V(6); PG8_BAR; PG8_MMA(1, 1, At, B1); PG8_BAR;
      PG8_LDB(B0, 1, 0); PG8_SCHED; PG8_LDA(At, 1, 0); PG8_STAGE(PG8_SA(0, 1), a2 + hstepA, voffA);
      PG8_WAIT_L(8); PG8_BAR; PG8_WAIT_L(0); PG8_MMA(0, 0, At, B0); PG8_BAR; PG8_SCHED;
      PG8_LDB(B1, 1, 1); PG8_STAGE(PG8_SB(1, 0), b3, voffB);
      PG8_BAR; PG8_WAIT_L(0); PG8_MMA(0, 1, At, B1); PG8_BAR;
      PG8_LDA(At, 1, 1); PG8_STAGE(PG8_SA(1, 0), a3, voffA);
      PG8_BAR; PG8_WAIT_L(0); PG8_MMA(1, 0, At, B0); PG8_BAR; PG8_SCHED;
      PG8_STAGE(PG8_SB(1, 1), b3 + hstepB, voffB);
      PG8_WAIT_V(6); PG8_BAR; PG8_MMA(1, 1, At, B1); PG8_BAR;
    }
    E(acc, cur, wr, wc, fr, fq);
    if (!has_next) break;
#pragma unroll
    for (int a = 0; a < 2; ++a)
#pragma unroll
      for (int b = 0; b < 2; ++b)
#pragma unroll
        for (int m = 0; m < 4; ++m)
#pragma unroll
          for (int n = 0; n < 2; ++n) acc[a][b][m][n] = (f32x4){0.f, 0.f, 0.f, 0.f};
    cur = nxt; cA = nA; cB = nB; ++ui;
  }
  PG8_WAIT_V(0);
  if (wr == 0) PG8_BAR;
  PG8_BAR;
#undef PG8_SA
#undef PG8_SB
#undef PG8_STAGE
#undef PG8_LDA
#undef PG8_LDB
#undef PG8_MMA
#undef PG8_WAIT_V
#undef PG8_WAIT_L
#undef PG8_BAR
#undef PG8_SCHED
}
}

#define ROW256(ai, m) (u.pm * 256 + (ai) * 128 + wr * 64 + (m) * 16 + fr)
#define COL256(bj, n) (u.pn * 256 + (bj) * 128 + 64 * (wc >> 1) + 16 * (wc & 1) + 32 * (n) + 4 * fq)
struct EpiQKV256 {
  bf16_t *Q, *Kb, *VT; const float *cosT, *sinT;
  __device__ __forceinline__ void operator()(const f32x4 (&acc)[2][2][4][2], const pg8::Unit& u, int wr, int wc, int fr, int fq) const {
#pragma unroll
    for (int bj = 0; bj < 2; ++bj) {
      const int n0 = u.pn * 256 + bj * 128;
      const int c0 = COL256(bj, 0);
      if (n0 < 2560) {
        const int iidx = 16 * (wc & 1) + 4 * fq;
#pragma unroll
        for (int ai = 0; ai < 2; ++ai)
#pragma unroll
          for (int m = 0; m < 4; ++m) {
            const int r = ROW256(ai, m);
            const f32x4 x1 = acc[ai][bj][m][0], x2 = acc[ai][bj][m][1]; f32x4 y1 = x1, y2 = x2;
            if (r < TL) {
              const int s = r & 4095; const int pos = (wc >> 1) ? (s & 63) : (s >> 6);
              const f32x4 cs = *(const f32x4*)(cosT + pos * 32 + iidx), sn = *(const f32x4*)(sinT + pos * 32 + iidx);
              y1 = x1 * cs - x2 * sn; y2 = x2 * cs + x1 * sn;
            }
            bf16_t* dst = (n0 < 2048) ? (Q + (size_t)r * D + c0) : (Kb + (size_t)r * 512 + (c0 - 2048));
            u32x2 o1, o2; o1.x = pack_bf16(y1[0], y1[1]); o1.y = pack_bf16(y1[2], y1[3]); o2.x = pack_bf16(y2[0], y2[1]); o2.y = pack_bf16(y2[2], y2[3]);
            *(u32x2*)dst = o1; *(u32x2*)(dst + 32) = o2;
          }
      } else {
#pragma unroll
        for (int ai = 0; ai < 2; ++ai)
#pragma unroll
          for (int m = 0; m < 4; ++m) {
            const int r = ROW256(ai, m);
#pragma unroll
            for (int n = 0; n < 2; ++n)
#pragma unroll
              for (int j = 0; j < 4; ++j) VT[(size_t)(c0 - 2560 + 32 * n + j) * TT + r] = f2bf(acc[ai][bj][m][n][j]);
          }
      }
    }
  }
};
struct EpiResid256 {
  const float *x, *ctx; float* XS; const float* gate; bool from_input;
  __device__ __forceinline__ void operator()(const f32x4 (&acc)[2][2][4][2], const pg8::Unit& u, int wr, int wc, int fr, int fq) const {
#pragma unroll
    for (int ai = 0; ai < 2; ++ai)
#pragma unroll
      for (int m = 0; m < 4; ++m) {
        const int r = ROW256(ai, m);
        const float* src = from_input ? (r < TL ? x + (size_t)r * D : ctx + (size_t)(r - TL) * D) : XS + (size_t)r * D;
        const float* g = gate + (size_t)mod_row(r) * NMOD;
#pragma unroll
        for (int bj = 0; bj < 2; ++bj)
#pragma unroll
          for (int n = 0; n < 2; ++n) {
            const int c = COL256(bj, n);
            const f32x4 b = *(const f32x4*)(src + c), gg = *(const f32x4*)(g + c);
            *(f32x4*)(XS + (size_t)r * D + c) = b + gg * acc[ai][bj][m][n];
          }
      }
  }
};
struct EpiBf16_256 {
  bf16_t* O; int ldo;
  __device__ __forceinline__ void operator()(const f32x4 (&acc)[2][2][4][2], const pg8::Unit& u, int wr, int wc, int fr, int fq) const {
#pragma unroll
    for (int ai = 0; ai < 2; ++ai)
#pragma unroll
      for (int m = 0; m < 4; ++m)
#pragma unroll
        for (int bj = 0; bj < 2; ++bj)
#pragma unroll
          for (int n = 0; n < 2; ++n) {
            const f32x4 v = acc[ai][bj][m][n];
            u32x2 o; o.x = pack_bf16(v[0], v[1]); o.y = pack_bf16(v[2], v[3]);
            *(u32x2*)(O + (size_t)ROW256(ai, m) * ldo + COL256(bj, n)) = o;
          }
  }
};
struct EpiWin256 {
  bf16_t *GATE, *UBR;
  __device__ __forceinline__ void operator()(const f32x4 (&acc)[2][2][4][2], const pg8::Unit& u, int wr, int wc, int fr, int fq) const {
#pragma unroll
    for (int ai = 0; ai < 2; ++ai)
#pragma unroll
      for (int m = 0; m < 4; ++m) {
        const int r = ROW256(ai, m);
#pragma unroll
        for (int bj = 0; bj < 2; ++bj)
#pragma unroll
          for (int n = 0; n < 2; ++n) {
            const int c = COL256(bj, n);
            const f32x4 v = acc[ai][bj][m][n];
            if (c < 2048) {
              if (r < TL) { u32x2 o; o.x = pack_bf16(gelu_tanh(v[0]), gelu_tanh(v[1])); o.y = pack_bf16(gelu_tanh(v[2]), gelu_tanh(v[3])); *(u32x2*)(GATE + (size_t)r * D + c) = o; }
            } else {
              u32x2 o; o.x = pack_bf16(v[0], v[1]); o.y = pack_bf16(v[2], v[3]); *(u32x2*)(UBR + (size_t)r * D + (c - 2048)) = o;
            }
          }
      }
  }
};
template <class Epi>
__device__ __forceinline__ void gemm256(const Params& p, const bf16_t* A, const bf16_t* Bt, int M, int N, int K, unsigned char* lds, const Epi& e, const ItemRanges fill) {
  pg8::Gemm g{A, Bt, K, K}; pg8::StaticOrder S; S.init(M, N, K, K, (int)gridDim.x, (int)blockIdx.x);
  pg8::gemm_phase((PG8_LAS unsigned char*)lds, g, S, e);
  if (fill.n1 + fill.n2 > 0) {
    const int G = (int)gridDim.x, rem = ((M / 256) * (N / 256)) % G, c = (int)blockIdx.x;
    if (rem != 0 && c >= rem) run_filler(p, fill, c - rem, G - rem, lds);
  }
}

struct EpiCoef256 {
  const float *b_a, *b_x, *SP; const bf16_t* UC; bf16_t* LAB;
  __device__ __forceinline__ void operator()(const f32x4 (&acc)[2][2][4][2], const pg8::Unit& u, int wr, int wc, int fr_, int fq_) const {
    int fr = fr_, fq = fq_; asm volatile("" : "+v"(fr), "+v"(fq));
    const int dir = u.pn >> 4, blk = (u.pn >> 1) & 7, half = u.pn & 1;
    bf16_t* LA = LAB + (size_t)(dir * 2) * TT * D; bf16_t* LB = LA + (size_t)TT * D;
#pragma unroll
    for (int n = 0; n < 2; ++n) {
      const int c = blk * 256 + half * 128 + 64 * (wc >> 1) + 16 * (wc & 1) + 32 * n + 4 * fq;
      const f32x4 ba = *(const f32x4*)(b_a + dir * D + c), bx = *(const f32x4*)(b_x + dir * D + c), sp = *(const f32x4*)(SP + dir * D + c);
#pragma unroll
      for (int ai = 0; ai < 2; ++ai)
#pragma unroll
        for (int m = 0; m < 4; ++m) {
          const int r = u.pm * 256 + ai * 128 + wr * 64 + m * 16 + fr;
          const u32x2 uu = *(const u32x2*)(UC + (size_t)r * D + c);
          const float uv[4] = {__uint_as_float(uu.x << 16), __uint_as_float(uu.x & 0xffff0000u), __uint_as_float(uu.y << 16), __uint_as_float(uu.y & 0xffff0000u)};
          float lav[4], bv[4];
#pragma unroll
          for (int j = 0; j < 4; ++j) {
            const float rg = __builtin_amdgcn_rcpf(1.0f + __expf(-(acc[ai][0][m][n][j] + ba[j])));
            const float ig = __builtin_amdgcn_rcpf(1.0f + __expf(-(acc[ai][1][m][n][j] + bx[j])));
            const float log_a = -8.0f * rg * sp[j];
            lav[j] = log_a;
            bv[j] = __builtin_amdgcn_sqrtf(fmaxf(1.0f - __expf(2.0f * log_a), 0.f)) * ig * uv[j];
          }
          u32x2 o1, o2; o1.x = pack_bf16(lav[0], lav[1]); o1.y = pack_bf16(lav[2], lav[3]); o2.x = pack_bf16(bv[0], bv[1]); o2.y = pack_bf16(bv[2], bv[3]);
          *(u32x2*)(LA + (size_t)r * D + c) = o1;
          *(u32x2*)(LB + (size_t)r * D + c) = o2;
        }
      __builtin_amdgcn_sched_barrier(0);
    }
  }
};
__device__ __forceinline__ void coef_phase(const Params& p, unsigned char* lds) {
  EpiCoef256 e{p.rec_b_a, p.rec_b_x, (const float*)(p.ws + OFF_SP), (const bf16_t*)(p.ws + OFF_O), (bf16_t*)(p.ws + OFF_LAB)};
  pg8::Gemm g{(const bf16_t*)(p.ws + OFF_O), (const bf16_t*)(p.ws + OFF_WA), 256, D}; pg8::CoefOrder S; S.init((int)gridDim.x, (int)blockIdx.x);
  pg8::gemm_phase((PG8_LAS unsigned char*)lds, g, S, e);
}

constexpr int KLD = 136, VLD = 72;
__device__ __forceinline__ void attn_phase(const Params& p, unsigned char* lds) {
  const bf16_t* Q = (const bf16_t*)(p.ws + OFF_Q); const bf16_t* Kg = (const bf16_t*)(p.ws + OFF_K); const bf16_t* VT = (const bf16_t*)(p.ws + OFF_VT);
  bf16_t* O = (bf16_t*)(p.ws + OFF_O);
  bf16_t* Ks = (bf16_t*)lds;
  bf16_t* Vs = Ks + 64 * KLD;
  const int tid = tidx(), wid = tid >> 6, lane = tid & 63, fr = lane & 15, fq = lane >> 4;
  const int g = wid >> 1, rh = wid & 1;
  const float scale = 0.08838834764831845f;
  for (int item = blockIdx.x; item < 1088; item += gridDim.x) {
    int b, hk, qb, qrow0, nlat, kt0;
    if (item < 1024) { b = item >> 8; hk = (item >> 6) & 3; qb = item & 63; qrow0 = b * S + qb * 64; kt0 = qb - 2 < 0 ? 0 : qb - 2; const int kt1 = qb + 2 > 63 ? 63 : qb + 2; nlat = kt1 - kt0 + 1; }
    else { const int ci = item - 1024; b = ci >> 4; hk = (ci >> 2) & 3; qb = ci & 3; qrow0 = TL + b * CL + qb * 64; kt0 = 0; nlat = 0; }
    const int head = hk * 4 + g;
    const float sink = p.attn_sink[head];
    bf16x8 qf[2][4];
#pragma unroll
    for (int rt = 0; rt < 2; ++rt)
#pragma unroll
      for (int ks = 0; ks < 4; ++ks) qf[rt][ks] = *(const bf16x8*)(Q + (size_t)(qrow0 + rh * 32 + rt * 16 + fr) * D + head * 128 + ks * 32 + fq * 8);
    f32x4 oacc[2][8]; float mst[2], lst[2];
#pragma unroll
    for (int rt = 0; rt < 2; ++rt) {
#pragma unroll
      for (int dt = 0; dt < 8; ++dt) oacc[rt][dt] = (f32x4){0.f, 0.f, 0.f, 0.f};
      mst[rt] = sink; lst[rt] = fq == 0 ? 1.0f : 0.f;
    }
    const int ntiles = nlat + 4;
    for (int ti = 0; ti < ntiles; ++ti) {
      const bool lat = ti < nlat;
      const int krow0 = lat ? (b * S + (kt0 + ti) * 64) : (TL + b * CL + (ti - nlat) * 64);
      __syncthreads();
#pragma unroll
      for (int i = 0; i < 2; ++i) {
        const int id = tid + 512 * i;
        const int key = id >> 4, dc = (id & 15) * 8;
        const int kk = key & 31, prow = (key & 32) + ((kk >> 2) & 1) * 16 + (kk >> 3) * 4 + (kk & 3);
        *(u32x4*)(Ks + prow * KLD + dc) = *(const u32x4*)(Kg + (size_t)(krow0 + key) * 512 + hk * 128 + dc);
        const int d = id >> 3, kc = (id & 7) * 8;
        *(u32x4*)(Vs + d * VLD + kc) = *(const u32x4*)(VT + (size_t)(hk * 128 + d) * TT + krow0 + kc);
      }
      __syncthreads();
#pragma unroll
      for (int rt = 0; rt < 2; ++rt) {
        f32x4 st[2][2];
#pragma unroll
        for (int kp = 0; kp < 2; ++kp)
#pragma unroll
          for (int t = 0; t < 2; ++t) {
            st[kp][t] = (f32x4){0.f, 0.f, 0.f, 0.f};
#pragma unroll
            for (int ks = 0; ks < 4; ++ks) {
              const bf16x8 kf = *(const bf16x8*)(Ks + (kp * 32 + t * 16 + fr) * KLD + ks * 32 + fq * 8);
              st[kp][t] = __builtin_amdgcn_mfma_f32_16x16x32_bf16(kf, qf[rt][ks], st[kp][t], 0, 0, 0);
            }
          }
        __builtin_amdgcn_sched_barrier(0);
        const int ipos = qb * 64 + rh * 32 + rt * 16 + fr;
        float mx = -INFINITY;
#pragma unroll
        for (int kp = 0; kp < 2; ++kp)
#pragma unroll
          for (int t = 0; t < 2; ++t)
#pragma unroll
            for (int j = 0; j < 4; ++j) {
              float v = st[kp][t][j] * scale;
              if (lat) { const int dd = ipos - ((kt0 + ti) * 64 + kp * 32 + fq * 8 + t * 4 + j); if (dd > 128 || dd < -128) v = -INFINITY; }
              st[kp][t][j] = v; mx = fmaxf(mx, v);
            }
        mx = fmaxf(mx, __shfl_xor(mx, 16)); mx = fmaxf(mx, __shfl_xor(mx, 32));
        const float mn = fmaxf(mst[rt], mx);
        const float alpha = __expf(mst[rt] - mn);
        mst[rt] = mn;
        float rs = 0.f; unsigned pk[2][4];
#pragma unroll
        for (int kp = 0; kp < 2; ++kp)
#pragma unroll
          for (int t = 0; t < 2; ++t) {
            const float p0 = __expf(st[kp][t][0] - mn), p1 = __expf(st[kp][t][1] - mn), p2 = __expf(st[kp][t][2] - mn), p3 = __expf(st[kp][t][3] - mn);
            rs += (p0 + p1) + (p2 + p3);
            pk[kp][t * 2] = pack_bf16(p0, p1); pk[kp][t * 2 + 1] = pack_bf16(p2, p3);
          }
        lst[rt] = lst[rt] * alpha + rs;
#pragma unroll
        for (int dt = 0; dt < 8; ++dt) oacc[rt][dt] *= alpha;
#pragma unroll
        for (int kp = 0; kp < 2; ++kp) {
          const u32x4 pw = (u32x4){pk[kp][0], pk[kp][1], pk[kp][2], pk[kp][3]};
          const bf16x8 pf = __builtin_bit_cast(bf16x8, pw);
#pragma unroll
          for (int dt = 0; dt < 8; ++dt) {
            const bf16x8 vf = *(const bf16x8*)(Vs + (dt * 16 + fr) * VLD + kp * 32 + fq * 8);
            oacc[rt][dt] = __builtin_amdgcn_mfma_f32_16x16x32_bf16(vf, pf, oacc[rt][dt], 0, 0, 0);
          }
        }
        __builtin_amdgcn_sched_barrier(0);
      }
    }
#pragma unroll
    for (int rt = 0; rt < 2; ++rt) {
      float l = lst[rt]; l += __shfl_xor(l, 16); l += __shfl_xor(l, 32);
      const float inv = 1.0f / l;
      bf16_t* orow = O + (size_t)(qrow0 + rh * 32 + rt * 16 + fr) * D + head * 128 + 4 * fq;
#pragma unroll
      for (int dt = 0; dt < 8; ++dt) {
        u32x2 o; o.x = pack_bf16(oacc[rt][dt][0] * inv, oacc[rt][dt][1] * inv); o.y = pack_bf16(oacc[rt][dt][2] * inv, oacc[rt][dt][3] * inv);
        *(u32x2*)(orow + dt * 16) = o;
      }
    }
  }
}

#define CE_DESC(a, b) { const float _hi = fmaxf(a, b), _lo = fminf(a, b); a = _hi; b = _lo; }
__device__ __forceinline__ void bitonic_sort_desc16(float (&a)[16]) {
#pragma unroll
  for (int ks = 1; ks <= 4; ++ks)
#pragma unroll
    for (int js = ks - 1; js >= 0; --js)
#pragma unroll
      for (int i = 0; i < 16; ++i) { const int k = 1 << ks, j = 1 << js, l = i ^ j; if (l > i) { if ((i & k) == 0) CE_DESC(a[i], a[l]) else CE_DESC(a[l], a[i]) } }
}
__device__ __forceinline__ void bitonic_merge_desc16(float (&a)[16]) {
#pragma unroll
  for (int js = 3; js >= 0; --js)
#pragma unroll
    for (int i = 0; i < 16; ++i) { const int j = 1 << js, l = i ^ j; if (l > i) CE_DESC(a[i], a[l]) }
}
__device__ __forceinline__ void top16_merge(float (&L)[16], float (&G)[16]) {
  bitonic_sort_desc16(G);
#pragma unroll
  for (int i = 0; i < 16; ++i) L[i] = fmaxf(L[i], G[15 - i]);
  bitonic_merge_desc16(L);
}
__host__ __device__ constexpr int cand_code(int c) {
  int n = 0;
  for (int i = 0; i < 16; ++i) for (int j = 0; j < 16 / (i + 1); ++j) { if (n == c) return (i << 4) | j; ++n; }
  return -1;
}
template <int C> struct CandCode { static constexpr int value = cand_code(C); };

__device__ __forceinline__ void peer_route_phase(const Params& p, int layer, int ntok, unsigned char* lds) {
  const int tid = tidx(), wid = tid >> 6, lane = tid & 63, fr = lane & 15, fq = lane >> 4;
  float* Sw = (float*)(lds + wid * 9216);
  const bf16_t* keysG = (const bf16_t*)(p.ws + OFF_KEYS) + (size_t)layer * 2 * 128 * 128;
  const bf16_t* PQ = (const bf16_t*)(p.ws + OFF_PQ);
  int* IDX = (int*)(p.ws + OFF_IDX); float* GW = (float*)(p.ws + OFF_GW);
  const int total = (ntok >> 6) * 8;
  for (int id = blockIdx.x * 8 + wid; id < total; id += gridDim.x * 8) {
    const int tile = id >> 3, head = id & 7, tok0 = tile * 64;
    float Lk[2][16];
#pragma unroll
    for (int pp = 0; pp < 2; ++pp) {
      bf16x8 qf[4][4];
#pragma unroll
      for (int mt = 0; mt < 4; ++mt)
#pragma unroll
        for (int ks = 0; ks < 4; ++ks) qf[mt][ks] = *(const bf16x8*)(PQ + (size_t)(tok0 + mt * 16 + fr) * D + head * 256 + pp * 128 + ks * 32 + fq * 8);
#pragma unroll
      for (int s2 = 0; s2 < 16; ++s2) Lk[pp][s2] = -INFINITY;
      bf16x8 kf[2][4], kfn[2][4];
#pragma unroll
      for (int nt = 0; nt < 2; ++nt)
#pragma unroll
        for (int ks = 0; ks < 4; ++ks) kf[nt][ks] = *(const bf16x8*)(keysG + (size_t)(pp * 128 + nt * 16 + fr) * 128 + ks * 32 + fq * 8);
#pragma unroll 1
      for (int pass = 0; pass < 4; ++pass) {
        const int pn = pass < 3 ? pass + 1 : 3;
#pragma unroll
        for (int nt = 0; nt < 2; ++nt)
#pragma unroll
          for (int ks = 0; ks < 4; ++ks) kfn[nt][ks] = *(const bf16x8*)(keysG + (size_t)(pp * 128 + pn * 32 + nt * 16 + fr) * 128 + ks * 32 + fq * 8);
        f32x4 acc[2][4];
#pragma unroll
        for (int nt = 0; nt < 2; ++nt)
#pragma unroll
          for (int mt = 0; mt < 4; ++mt) acc[nt][mt] = (f32x4){0.f, 0.f, 0.f, 0.f};
#pragma unroll
        for (int nt = 0; nt < 2; ++nt)
#pragma unroll
          for (int ks = 0; ks < 4; ++ks)
#pragma unroll
            for (int mt = 0; mt < 4; ++mt) acc[nt][mt] = __builtin_amdgcn_mfma_f32_16x16x32_bf16(kf[nt][ks], qf[mt][ks], acc[nt][mt], 0, 0, 0);
#pragma unroll
        for (int nt = 0; nt < 2; ++nt)
#pragma unroll
          for (int mt = 0; mt < 4; ++mt) *(f32x4*)(Sw + (mt * 16 + fr) * 36 + nt * 16 + 4 * fq) = acc[nt][mt];
        __builtin_amdgcn_fence(__ATOMIC_RELEASE, "wavefront"); __builtin_amdgcn_wave_barrier(); __builtin_amdgcn_fence(__ATOMIC_ACQUIRE, "wavefront");
#pragma unroll
        for (int g = 0; g < 2; ++g) {
          float G[16];
#pragma unroll
          for (int c = 0; c < 4; ++c) {
            const f32x4 sv = *(const f32x4*)(Sw + lane * 36 + g * 16 + c * 4);
#pragma unroll
            for (int e = 0; e < 4; ++e) G[c * 4 + e] = __uint_as_float((__float_as_uint(sv[e]) & ~0x7fu) | (unsigned)(pass * 32 + g * 16 + c * 4 + e));
          }
          top16_merge(Lk[pp], G);
        }
#pragma unroll
        for (int nt = 0; nt < 2; ++nt)
#pragma unroll
          for (int ks = 0; ks < 4; ++ks) kf[nt][ks] = kfn[nt][ks];
      }
    }
#pragma unroll
    for (int pp = 0; pp < 2; ++pp)
#pragma unroll
      for (int s2 = 0; s2 < 16; ++s2) Sw[(pp * 16 + s2) * 64 + lane] = Lk[pp][s2];
    float v1[16], v2[16];
#pragma unroll
    for (int s2 = 0; s2 < 16; ++s2) { v1[s2] = __uint_as_float(__float_as_uint(Lk[0][s2]) & ~0x7fu); v2[s2] = __uint_as_float(__float_as_uint(Lk[1][s2]) & ~0x7fu); }
    float T[16];
#pragma unroll
    for (int s2 = 0; s2 < 16; ++s2) T[s2] = -INFINITY;
#define ROUTE_GROUP(G0) { float G[16]; \
      _Pragma("unroll") for (int q = 0; q < 16; ++q) G[q] = -INFINITY; \
      ROUTE_FILL(G0 + 0) ROUTE_FILL(G0 + 1) ROUTE_FILL(G0 + 2) ROUTE_FILL(G0 + 3) ROUTE_FILL(G0 + 4) ROUTE_FILL(G0 + 5) ROUTE_FILL(G0 + 6) ROUTE_FILL(G0 + 7) \
      ROUTE_FILL(G0 + 8) ROUTE_FILL(G0 + 9) ROUTE_FILL(G0 + 10) ROUTE_FILL(G0 + 11) ROUTE_FILL(G0 + 12) ROUTE_FILL(G0 + 13) ROUTE_FILL(G0 + 14) ROUTE_FILL(G0 + 15) \
      top16_merge(T, G); }
#define ROUTE_FILL(C) { constexpr int code = CandCode<(C)>::value; if constexpr (code >= 0) G[(C) & 15] = __uint_as_float((__float_as_uint(v1[code >> 4] + v2[code & 15]) & ~0xffu) | (unsigned)code); }
    ROUTE_GROUP(0) ROUTE_GROUP(16) ROUTE_GROUP(32) ROUTE_GROUP(48)
#undef ROUTE_FILL
#undef ROUTE_GROUP
    asm volatile("s_waitcnt lgkmcnt(0)" ::: "memory");
    int E[16];
#pragma unroll
    for (int s2 = 0; s2 < 16; ++s2) {
      const unsigned code = __float_as_uint(T[s2]) & 0xffu;
      const unsigned k1 = __float_as_uint(Sw[(code >> 4) * 64 + lane]) & 0x7fu, k2 = __float_as_uint(Sw[(16 + (code & 15u)) * 64 + lane]) & 0x7fu;
      E[s2] = (int)(k1 * 128u + k2);
      T[s2] = __uint_as_float(__float_as_uint(T[s2]) & ~0xffu);
    }
    asm volatile("s_waitcnt lgkmcnt(0)" ::: "memory");
    const size_t o = ((size_t)(tok0 + lane) * 8 + head) * 16;
    const float tmax = T[0];
    float ssum = 0.f;
#pragma unroll
    for (int s2 = 0; s2 < 16; ++s2) { T[s2] = __expf(T[s2] - tmax); ssum += T[s2]; }
    const float inv = 1.0f / ssum;
#pragma unroll
    for (int c = 0; c < 4; ++c) {
      *(f32x4*)(GW + o + c * 4) = (f32x4){T[c * 4] * inv, T[c * 4 + 1] * inv, T[c * 4 + 2] * inv, T[c * 4 + 3] * inv};
      typedef int i32x4 __attribute__((ext_vector_type(4)));
      *(i32x4*)(IDX + o + c * 4) = (i32x4){E[c * 4], E[c * 4 + 1], E[c * 4 + 2], E[c * 4 + 3]};
    }
  }
}

constexpr int PG = 2;
struct PeerBuf { u32x4 u[PG][2], v[PG][2]; float su[PG], sv[PG], g[PG]; };
__device__ __forceinline__ void peer_load(PeerBuf& B, const unsigned char* UT8, const unsigned char* VT8, const float* USC, const float* VSC, int ireg, float greg, int k0, int lane) {
#pragma unroll
  for (int j = 0; j < PG; ++j) {
    const int e = __builtin_amdgcn_readlane(ireg, k0 + j);
    B.g[j] = __builtin_bit_cast(float, __builtin_amdgcn_readlane(__builtin_bit_cast(int, greg), k0 + j));
    const unsigned char* ur = UT8 + (size_t)e * D + lane * 16; const unsigned char* vr = VT8 + (size_t)e * D + lane * 16;
    B.u[j][0] = *(const u32x4*)ur; B.u[j][1] = *(const u32x4*)(ur + 1024);
    B.v[j][0] = *(const u32x4*)vr; B.v[j][1] = *(const u32x4*)(vr + 1024);
    B.su[j] = USC[e]; B.sv[j] = VSC[e];
  }
}
__device__ __forceinline__ void peer_compute(const PeerBuf& B, const float (&hreg)[2][16], float hsum, float (&accv)[2][16], float& corr) {
#pragma unroll
  for (int j = 0; j < PG; ++j) {
    float dsum = 0.f;
#pragma unroll
    for (int c = 0; c < 2; ++c)
#pragma unroll
      for (int t = 0; t < 4; ++t) {
        const unsigned w = B.u[j][c][t];
        dsum += (float)(w & 0xffu) * hreg[c][4 * t] + (float)((w >> 8) & 0xffu) * hreg[c][4 * t + 1] + (float)((w >> 16) & 0xffu) * hreg[c][4 * t + 2] + (float)(w >> 24) * hreg[c][4 * t + 3];
      }
    const float z = B.su[j] * (wave_sum(dsum) - 128.0f * hsum);
    const float act = gelu_tanh(z) * B.g[j] * B.sv[j];
    corr += act;
#pragma unroll
    for (int c = 0; c < 2; ++c)
#pragma unroll
      for (int t = 0; t < 4; ++t) {
        const unsigned w = B.v[j][c][t];
        accv[c][4 * t] += act * (float)(w & 0xffu); accv[c][4 * t + 1] += act * (float)((w >> 8) & 0xffu); accv[c][4 * t + 2] += act * (float)((w >> 16) & 0xffu); accv[c][4 * t + 3] += act * (float)(w >> 24);
      }
  }
}
__device__ __forceinline__ void peer_gather_phase(const Params& p, int layer, int ntok, int gate_layer, bool dry = false) {
  const int tid = tidx(), wid = tid >> 6, lane = tid & 63;
  const bf16_t* H = (const bf16_t*)(p.ws + OFF_H);
  const int* IDX = (const int*)(p.ws + OFF_IDX); const float* GW = (const float*)(p.ws + OFF_GW);
  const unsigned char* UT8 = p.ws + OFF_UTAB + (size_t)layer * NEXP * D; const unsigned char* VT8 = p.ws + OFF_VTAB + (size_t)layer * NEXP * D;
  const float* USC = (const float*)(p.ws + OFF_USC) + (size_t)layer * NEXP; const float* VSC = (const float*)(p.ws + OFF_VSC) + (size_t)layer * NEXP;
  float* XS = (float*)(p.ws + OFF_XS);
  const float* gate = (const float*)(p.ws + OFF_MODV) + (size_t)(gate_layer * 5) * NMOD + 5 * D;
  for (int tok = blockIdx.x * 8 + wid; tok < ntok; tok += gridDim.x * 8) {
    const int i0 = IDX[(size_t)tok * 128 + lane], i1 = IDX[(size_t)tok * 128 + 64 + lane];
    const float g0 = GW[(size_t)tok * 128 + lane], g1 = GW[(size_t)tok * 128 + 64 + lane];
    PeerBuf A, B;
    peer_load(A, UT8, VT8, USC, VSC, i0, g0, 0, lane);
    float hreg[2][16]; float hsum = 0.f;
#pragma unroll
    for (int c = 0; c < 2; ++c)
#pragma unroll
      for (int hh = 0; hh < 2; ++hh) {
        const u32x4 hv = *(const u32x4*)(H + (size_t)tok * D + c * 1024 + lane * 16 + hh * 8);
#pragma unroll
        for (int t = 0; t < 4; ++t) { hreg[c][hh * 8 + 2 * t] = __uint_as_float(hv[t] << 16); hreg[c][hh * 8 + 2 * t + 1] = __uint_as_float(hv[t] & 0xffff0000u); hsum += hreg[c][hh * 8 + 2 * t] + hreg[c][hh * 8 + 2 * t + 1]; }
      }
    hsum = wave_sum(hsum);
    float accv[2][16]; float corr = 0.f;
#pragma unroll
    for (int c = 0; c < 2; ++c)
#pragma unroll
      for (int j = 0; j < 16; ++j) accv[c][j] = 0.f;
#pragma unroll 1
    for (int half = 0; half < 2; ++half) {
      const int ireg = half ? i1 : i0; const float greg = half ? g1 : g0;
#pragma unroll 1
      for (int k0 = 0; k0 < 64; k0 += 2 * PG) {
        peer_load(B, UT8, VT8, USC, VSC, ireg, greg, k0 + PG, lane);
        peer_compute(A, hreg, hsum, accv, corr);
        if (k0 + 2 * PG < 64) peer_load(A, UT8, VT8, USC, VSC, ireg, greg, k0 + 2 * PG, lane);
        else if (half == 0) peer_load(A, UT8, VT8, USC, VSC, i1, g1, 0, lane);
        peer_compute(B, hreg, hsum, accv, corr);
      }
    }
    corr *= 128.0f;
    const int mrow = mod_row(tok);
    const float* gr = gate + (size_t)mrow * NMOD; float* xr = XS + (size_t)tok * D;
    float ss = 0.f;
#pragma unroll
    for (int c = 0; c < 2; ++c)
#pragma unroll
      for (int t = 0; t < 4; ++t) {
        const int col = c * 1024 + lane * 16 + 4 * t;
        const f32x4 gg = *(const f32x4*)(gr + col), xo = *(const f32x4*)(xr + col);
#pragma unroll
        for (int j = 0; j < 4; ++j) { const float xn = xo[j] + gg[j] * (accv[c][4 * t + j] - corr); accv[c][4 * t + j] = xn; ss += xn * xn; }
      }
    ss = wave_sum(ss);
    const float rs = rsqrtf(ss * (1.0f / D) + 1e-6f);
    if (dry && rs != 12345.678f) continue;
    if (layer == 0) {
      const float* mv = (const float*)(p.ws + OFF_MODV) + (size_t)(5 + mrow) * NMOD;
      const float* gn = p.norm_mix + D;
      bf16_t* hr = (bf16_t*)(p.ws + OFF_H) + (size_t)tok * D;
#pragma unroll
      for (int c = 0; c < 2; ++c)
#pragma unroll
        for (int t = 0; t < 4; ++t) {
          const int col = c * 1024 + lane * 16 + 4 * t;
          *(f32x4*)(xr + col) = (f32x4){accv[c][4 * t], accv[c][4 * t + 1], accv[c][4 * t + 2], accv[c][4 * t + 3]};
          const f32x4 g = *(const f32x4*)(gn + col), sh = *(const f32x4*)(mv + col), sc = *(const f32x4*)(mv + D + col);
          u32x2 o; o.x = pack_bf16(accv[c][4 * t] * rs * g[0] * (1.0f + sc[0]) + sh[0], accv[c][4 * t + 1] * rs * g[1] * (1.0f + sc[1]) + sh[1]);
          o.y = pack_bf16(accv[c][4 * t + 2] * rs * g[2] * (1.0f + sc[2]) + sh[2], accv[c][4 * t + 3] * rs * g[3] * (1.0f + sc[3]) + sh[3]);
          *(u32x2*)(hr + col) = o;
        }
    } else {
      float* orow = p.out + (size_t)tok * D;
#pragma unroll
      for (int c = 0; c < 2; ++c)
#pragma unroll
        for (int t = 0; t < 4; ++t) {
          const int col = c * 1024 + lane * 16 + 4 * t;
          const f32x4 g = *(const f32x4*)(p.norm_final + col);
          *(f32x4*)(orow + col) = (f32x4){accv[c][4 * t] * rs * g[0], accv[c][4 * t + 1] * rs * g[1], accv[c][4 * t + 2] * rs * g[2], accv[c][4 * t + 3] * rs * g[3]};
        }
    }
  }
}

__device__ __forceinline__ void conv_phase(const Params& p) {
  const bf16_t* UBR = (const bf16_t*)(p.ws + OFF_Q); bf16_t* UC = (bf16_t*)(p.ws + OFF_O);
  const int tid = tidx(), c = (tid & 255) * 8, hrow = tid >> 8;
  float w[4][8], bias[8];
#pragma unroll
  for (int k = 0; k < 4; ++k) { const float4 w0 = *(const float4*)(p.rec_conv_w + k * D + c), w1 = *(const float4*)(p.rec_conv_w + k * D + c + 4); w[k][0] = w0.x; w[k][1] = w0.y; w[k][2] = w0.z; w[k][3] = w0.w; w[k][4] = w1.x; w[k][5] = w1.y; w[k][6] = w1.z; w[k][7] = w1.w; }
  { const float4 b0 = *(const float4*)(p.rec_conv_b + c), b1 = *(const float4*)(p.rec_conv_b + c + 4); bias[0] = b0.x; bias[1] = b0.y; bias[2] = b0.z; bias[3] = b0.w; bias[4] = b1.x; bias[5] = b1.y; bias[6] = b1.z; bias[7] = b1.w; }
  const int nhalf = 2 * (int)gridDim.x, rows_per = (TT + nhalf - 1) / nhalf;
  const int r0 = ((int)blockIdx.x * 2 + hrow) * rows_per, r1 = r0 + rows_per < TT ? r0 + rows_per : TT;
  if (r0 < TT) {
    u32x4 win[4];
    const u32x4 zero = (u32x4){0u, 0u, 0u, 0u};
#pragma unroll
    for (int k = 0; k < 3; ++k) { const int rr = r0 - 1 + k; win[k] = (rr >= 0 && rr < TT) ? *(const u32x4*)(UBR + (size_t)rr * D + c) : zero; }
#pragma unroll 2
    for (int r = r0; r < r1; ++r) {
      const int rr = r + 2;
      win[3] = (rr < TT) ? *(const u32x4*)(UBR + (size_t)rr * D + c) : zero;
      const int seq_lo = r < TL ? (r & ~4095) : TL + ((r - TL) & ~255), seq_hi = seq_lo + (r < TL ? S : CL);
      float acc[8];
#pragma unroll
      for (int j = 0; j < 8; ++j) acc[j] = bias[j];
#pragma unroll
      for (int k = 0; k < 4; ++k) {
        const int rk = r - 1 + k; const bool ok = rk >= seq_lo && rk < seq_hi;
#pragma unroll
        for (int t = 0; t < 4; ++t) { const unsigned d = ok ? win[k][t] : 0u; acc[2 * t] += w[k][2 * t] * __uint_as_float(d << 16); acc[2 * t + 1] += w[k][2 * t + 1] * __uint_as_float(d & 0xffff0000u); }
      }
      u32x4 o; o.x = pack_bf16(acc[0], acc[1]); o.y = pack_bf16(acc[2], acc[3]); o.z = pack_bf16(acc[4], acc[5]); o.w = pack_bf16(acc[6], acc[7]);
      *(u32x4*)(UC + (size_t)r * D + c) = o;
      win[0] = win[1]; win[1] = win[2]; win[2] = win[3];
    }
  }
}

__device__ __forceinline__ void scan1_phase(const Params& p) {
  const bf16_t* LAB = (const bf16_t*)(p.ws + OFF_LAB);
  float* CHP = (float*)(p.ws + OFF_CHP); float* CHH = (float*)(p.ws + OFF_CHH);
  const int total = 2 * 272 * 4; const int tid = tidx();
  for (int item = blockIdx.x; item < total; item += gridDim.x) {
    const int cgp = item & 3, ch = (item >> 2) % 272, dir = item / (272 * 4);
    const int c = cgp * 512 + tid;
    const bf16_t* a = LAB + ((size_t)(dir * 2) * TT + ch * 64) * D + c; const bf16_t* b = LAB + ((size_t)(dir * 2 + 1) * TT + ch * 64) * D + c;
    float h = 0.f, ls = 0.f;
    if (dir == 0) {
#pragma unroll 16
      for (int t = 0; t < 64; ++t) { const float la = bf2f(a[(size_t)t * D]), bv = bf2f(b[(size_t)t * D]); h = __expf(la) * h + bv; ls += la; }
    } else {
#pragma unroll 16
      for (int t = 63; t >= 0; --t) { const float la = bf2f(a[(size_t)t * D]), bv = bf2f(b[(size_t)t * D]); h = __expf(la) * h + bv; ls += la; }
    }
    CHP[((size_t)dir * 272 + ch) * D + c] = __expf(ls); CHH[((size_t)dir * 272 + ch) * D + c] = h;
  }
}
__device__ __forceinline__ void scan2_phase(const Params& p) {
  const float* CHP = (const float*)(p.ws + OFF_CHP); const float* CHH = (const float*)(p.ws + OFF_CHH); float* CIN = (float*)(p.ws + OFF_CIN);
  for (int it = blockIdx.x * NT + tidx(); it < 2 * NB * D; it += gridDim.x * NT) {
    const int c = it & 2047, b = (it >> 11) & 3, dir = it >> 13;
    float carry = 0.f;
    for (int s = 0; s < 68; ++s) {
      int ch;
      if (dir == 0) ch = s < 4 ? (256 + 4 * b + s) : (64 * b + (s - 4));
      else ch = s < 4 ? (256 + 4 * b + (3 - s)) : (64 * b + (63 - (s - 4)));
      const size_t o = ((size_t)dir * 272 + ch) * D + c;
      CIN[o] = carry;
      carry = CHP[o] * carry + CHH[o];
    }
  }
}
__device__ __forceinline__ void scan3_phase(const Params& p) {
  const bf16_t* LAB = (const bf16_t*)(p.ws + OFF_LAB); const float* CIN = (const float*)(p.ws + OFF_CIN);
  const bf16_t* GATE = (const bf16_t*)(p.ws + OFF_PQ); bf16_t* A2 = (bf16_t*)(p.ws + OFF_O);
  const int total = 256 * 4; const int tid = tidx();
  for (int item = blockIdx.x; item < total; item += gridDim.x) {
    const int cgp = item & 3, ch = item >> 2;
    const int c = cgp * 512 + tid;
    const size_t base = (size_t)ch * 64 * D + c;
    float y[64];
    {
      const bf16_t* a = LAB + base; const bf16_t* b = LAB + (size_t)TT * D + base;
      float h = CIN[(size_t)ch * D + c];
#pragma unroll
      for (int t = 0; t < 64; ++t) { h = __expf(bf2f(a[(size_t)t * D])) * h + bf2f(b[(size_t)t * D]); y[t] = h; }
    }
    {
      const bf16_t* a = LAB + (size_t)2 * TT * D + base; const bf16_t* b = LAB + (size_t)3 * TT * D + base;
      float h = CIN[((size_t)272 + ch) * D + c];
#pragma unroll
      for (int t = 63; t >= 0; --t) { h = __expf(bf2f(a[(size_t)t * D])) * h + bf2f(b[(size_t)t * D]); y[t] += h; }
    }
#pragma unroll
    for (int t = 0; t < 64; ++t) A2[base + (size_t)t * D] = f2bf(y[t] * bf2f(GATE[base + (size_t)t * D]));
  }
}


#define XB_TMO      128
#define XB_XCNT(j)  (256  + 64 * (j))
#define XB_XSUB(j)  (1280 + 64 * (j))
#define XB_XGEN(j)  (2304 + 64 * (j))
#define XB_TOP      3328
#define XB_TOPGEN   3392
#define XCD_BAR_WORDS 3456
#define XB_SPIN_CAP (1u << 22)
#define LAS3 __attribute__((address_space(3)))
__device__ __forceinline__ unsigned xb_ld(unsigned* p)              { return __hip_atomic_load(p, __ATOMIC_RELAXED, __HIP_MEMORY_SCOPE_AGENT); }
__device__ __forceinline__ unsigned xb_add(unsigned* p, unsigned v) { return __hip_atomic_fetch_add(p, v, __ATOMIC_RELAXED, __HIP_MEMORY_SCOPE_AGENT); }
__device__ __forceinline__ unsigned xb_xcc_id() { return (unsigned)__builtin_amdgcn_s_getreg((3 << 11) | 20) & 0xFu; }
#define XB_SPIN(cond, bar) do { unsigned _sp = 0; while (cond) { __builtin_amdgcn_s_sleep(1); \
    if ((++_sp & 255u) == 0u) { if (xb_ld(&(bar)[XB_TMO])) break; if (_sp > XB_SPIN_CAP) { atomicAdd(&(bar)[XB_TMO], 1u); break; } } } } while (0)
struct XcdBarrier { unsigned* bar; unsigned x; volatile LAS3 unsigned* st; };
__device__ __forceinline__ XcdBarrier xcd_barrier_post(unsigned* bar, volatile LAS3 unsigned* st) {
  XcdBarrier b; b.bar = bar; b.x = xb_xcc_id(); b.st = st;
  if (threadIdx.x == 0) (void)xb_add(&bar[XB_XCNT(b.x)], 1u);
  return b;
}
__device__ __forceinline__ void xcd_barrier_complete(unsigned* bar, unsigned x, unsigned& nloc, unsigned& nx) {
  const unsigned G = gridDim.x * gridDim.y * gridDim.z;
  unsigned sum, cnt, mine, sp = 0u;
  for (;;) {
    sum = 0u; cnt = 0u; mine = 0u;
#pragma unroll
    for (unsigned j = 0; j < 16; ++j) { const unsigned c = xb_ld(&bar[XB_XCNT(j)]); sum += c; cnt += (c > 0u) ? 1u : 0u; mine = (j == x) ? c : mine; }
    if (sum == G) break;
    __builtin_amdgcn_s_sleep(1);
    if ((++sp & 255u) == 0u) { if (xb_ld(&bar[XB_TMO])) break; if (sp > XB_SPIN_CAP) { atomicAdd(&bar[XB_TMO], 1u); break; } }
  }
  nloc = mine > 0u ? mine : 1u; nx = cnt > 0u ? cnt : 1u;
}
__device__ __forceinline__ void xcd_barrier(const XcdBarrier& b) {
  asm volatile("s_waitcnt vmcnt(0)" ::: "memory");
  __syncthreads();
  if (threadIdx.x == 0) {
    unsigned* bar = b.bar;
    __builtin_amdgcn_s_waitcnt(0);
    unsigned nloc = b.st[0], nx = b.st[1];
    if (nloc == 0u) { xcd_barrier_complete(bar, b.x, nloc, nx); b.st[0] = nloc; b.st[1] = nx; }
    const unsigned old = xb_add(&bar[XB_XSUB(b.x)], 1u);
    const unsigned gen = old / nloc;
    if (old + 1u == (gen + 1u) * nloc) {
      __builtin_amdgcn_fence(__ATOMIC_RELEASE, "agent");
      asm volatile("s_waitcnt vmcnt(0)" ::: "memory");
      const unsigned og = xb_add(&bar[XB_TOP], 1u);
      const unsigned tg = og / nx;
      if (og + 1u == (tg + 1u) * nx) xb_add(&bar[XB_TOPGEN], 1u);
      else XB_SPIN(xb_ld(&bar[XB_TOPGEN]) == tg, bar);
      __builtin_amdgcn_fence(__ATOMIC_ACQUIRE, "agent");
      xb_add(&bar[XB_XGEN(b.x)], 1u);
      asm volatile("s_waitcnt vmcnt(0)" ::: "memory");
    } else {
      XB_SPIN(xb_ld(&bar[XB_XGEN(b.x)]) == gen, bar);
      __builtin_amdgcn_fence(__ATOMIC_ACQUIRE, "agent");
      asm volatile("s_waitcnt vmcnt(0)" ::: "memory");
    }
  }
  __syncthreads();
}

__global__ void __launch_bounds__(NT) fwd_megakernel(Params p) {
  extern __shared__ __attribute__((aligned(16))) unsigned char lds[];
  cg::grid_group grid = cg::this_grid();
  unsigned char* ws = p.ws;
  float* MODV = (float*)(ws + OFF_MODV);
  float* XS = (float*)(ws + OFF_XS);
  bf16_t* H = (bf16_t*)(ws + OFF_H);

  unsigned* bar = (unsigned*)(ws + OFF_BAR);
  if (blockIdx.x == 0) for (int i = threadIdx.x; i < XCD_BAR_WORDS; i += NT) bar[i] = 0u;
  volatile LAS3 unsigned* st = (volatile LAS3 unsigned*)((LAS3 unsigned char*)lds + 128 * 1024);
  if (threadIdx.x == 0) { st[0] = 0u; st[1] = 0u; }
  setup_phase(p, lds);
  if (PROBE == 1) { grid.sync(); setup_phase(p, lds); }
  grid.sync();
  const XcdBarrier xb = xcd_barrier_post(bar, st);
#define GSYNC() xcd_barrier(xb)
  {
    constexpr int ntok = TT;
    PH(2, norm_phase(p, 0, p.norm_mix + 0 * D, 0, TT, true, H));
    GSYNC();
      {
        EpiQKV256 e{(bf16_t*)(ws + OFF_Q), (bf16_t*)(ws + OFF_K), (bf16_t*)(ws + OFF_VT), (const float*)(ws + OFF_ROPE), (const float*)(ws + OFF_ROPE) + 2048};
        PH(3, gemm256(p, H, (const bf16_t*)(ws + OFF_WQKV), TT, 3072, D, lds, e, ItemRanges{0, 0, 0, 0}));
      }
      GSYNC();
      PH(4, attn_phase(p, lds));
      GSYNC();
    {
      EpiResid256 e{p.x, p.ctx, XS, MODV + (size_t)(0 * 5) * NMOD + 2 * D, true};
      gemm256(p, (const bf16_t*)(ws + OFF_O), (const bf16_t*)(ws + (OFF_WO)), ntok, D, D, lds, e, ItemRanges{0, 0, 0, 0});
    }
    GSYNC();
    PH(6, norm_phase(p, 0, p.norm_ffn + 0 * D, 3, ntok, false, H));
    GSYNC();
    {
      EpiBf16_256 e{(bf16_t*)(ws + OFF_PQ), D};
      gemm256(p, H, (const bf16_t*)(ws + OFF_WPQ) + (size_t)0 * D * D, ntok, D, D, lds, e, ItemRanges{0, 0, 0, 0});
    }
    GSYNC();
    PH(8, peer_route_phase(p, 0, ntok, lds));
    GSYNC();
    if (DUP & 2) { peer_gather_phase(p, 0, ntok, 0, true); GSYNC(); }
    peer_gather_phase(p, 0, ntok, 0);
    GSYNC();
  }
  {
    constexpr int ntok = TL;
      {
        EpiWin256 e{(bf16_t*)(ws + OFF_PQ), (bf16_t*)(ws + OFF_Q)};
        PH(10, gemm256(p, H, (const bf16_t*)(ws + OFF_WIN), TT, 4096, D, lds, e, ItemRanges{0, 0, 0, 0}));
      }
      GSYNC();
      PH(11, conv_phase(p));
      GSYNC();
      PH(12, coef_phase(p, lds));
      GSYNC();
      PH(13, scan1_phase(p));
      GSYNC();
      PH(14, scan2_phase(p));
      GSYNC();
      if (DUP & 16) { scan1_phase(p); GSYNC(); scan2_phase(p); GSYNC(); }
      if (DUP & 32) { coef_phase(p, lds); GSYNC(); }
      if (DUP & 64) { for (int q = 0; q < 20; ++q) GSYNC(); }
      if (DUP & 128) { conv_phase(p); GSYNC(); }
      scan3_phase(p);
      GSYNC();
    {
      EpiResid256 e{p.x, p.ctx, XS, MODV + (size_t)(1 * 5) * NMOD + 2 * D, false};
      gemm256(p, (const bf16_t*)(ws + OFF_O), (const bf16_t*)(ws + (OFF_WOUT)), ntok, D, D, lds, e, ItemRanges{0, 0, 0, 0});
    }
    GSYNC();
    norm_phase(p, 1, p.norm_ffn + 1 * D, 3, ntok, false, H);
    GSYNC();
    {
      EpiBf16_256 e{(bf16_t*)(ws + OFF_PQ), D};
      PH(18, gemm256(p, H, (const bf16_t*)(ws + OFF_WPQ) + (size_t)1 * D * D, ntok, D, D, lds, e, ItemRanges{0, 0, 0, 0}));
    }
    GSYNC();
    PH(19, peer_route_phase(p, 1, ntok, lds));
    GSYNC();
    if (DUP & 2) { peer_gather_phase(p, 1, ntok, 1, true); GSYNC(); }
    peer_gather_phase(p, 1, ntok, 1);
  }
}

__global__ void diag_fill(float* out, int n, float v) { for (int i = blockIdx.x * blockDim.x + threadIdx.x; i < n; i += gridDim.x * blockDim.x) out[i] = v; }

extern "C" void kernel_launch(void* const* d_in, const int* in_sizes, int n_in, void* d_out, int out_size, void* d_ws, size_t ws_size, hipStream_t stream) {
  static int grid_blocks = 0;
  if (!grid_blocks) {
    int dev = 0, cus = 0, per_cu = 0;
    (void)hipGetDevice(&dev);
    (void)hipDeviceGetAttribute(&cus, hipDeviceAttributeMultiprocessorCount, dev);
    (void)hipFuncSetAttribute((const void*)fwd_megakernel, hipFuncAttributeMaxDynamicSharedMemorySize, (int)kDynLds);
    (void)hipOccupancyMaxActiveBlocksPerMultiprocessor(&per_cu, fwd_megakernel, NT, kDynLds);
    if (per_cu > 1) per_cu = 1;
    if (per_cu < 1) per_cu = 1;
    grid_blocks = cus * per_cu;
  }
  if (ws_size < WS_NEED) { fprintf(stderr, "workspace too small: %zu < %zu\n", ws_size, (size_t)WS_NEED); diag_fill<<<1024, 256, 0, stream>>>((float*)d_out, out_size, 3.0f); return; }
  Params p{};
  const float* const* in = (const float* const*)d_in;
  p.x = in[0]; p.c = in[1]; p.ctx = in[2]; p.c_ctx = in[3]; p.w_mod = in[4]; p.b_mod = in[5]; p.norm_mix = in[6]; p.norm_ffn = in[7]; p.norm_final = in[8];
  p.attn_w_qkv = in[9]; p.attn_w_o = in[10]; p.attn_sink = in[11];
  p.rec_w_in = in[12]; p.rec_conv_w = in[13]; p.rec_conv_b = in[14]; p.rec_w_a = in[15]; p.rec_b_a = in[16]; p.rec_w_x = in[17]; p.rec_b_x = in[18]; p.rec_lambda = in[19]; p.rec_w_out = in[20];
  p.peer_w_q = in[21]; p.peer_keys = in[22]; p.peer_u = in[23]; p.peer_v = in[24];
  p.out = (float*)d_out; p.ws = (unsigned char*)d_ws;
  void* args[] = {&p};
  hipError_t e = hipLaunchCooperativeKernel((void*)fwd_megakernel, dim3(grid_blocks), dim3(NT), args, kDynLds, stream);
  if (e != hipSuccess) { fprintf(stderr, "cooperative launch failed: %s (grid %d)\n", hipGetErrorString(e), grid_blocks); diag_fill<<<1024, 256, 0, stream>>>((float*)d_out, out_size, 5.0f); }
}
```

```cpp
#include <hip/hip_runtime.h>
#include <hip/hip_cooperative_groups.h>
#include <cstdio>
namespace cg = cooperative_groups;

typedef unsigned short bf16_t;
typedef short bf16x8 __attribute__((ext_vector_type(8)));
typedef float f32x4 __attribute__((ext_vector_type(4)));
typedef unsigned u32x4 __attribute__((ext_vector_type(4)));
typedef unsigned u32x2 __attribute__((ext_vector_type(2)));
typedef __bf16 bf16x2_t __attribute__((ext_vector_type(2)));

constexpr int D = 2048, NB = 4, S = 4096, CL = 256;
constexpr int TL = NB * S, TC = NB * CL, TT = TL + TC;
constexpr int NT = 512;
constexpr int NMOD = 6 * D;
constexpr int NEXP = 16384;
constexpr size_t kDynLds = 128 * 1024 + 64;
#ifndef SKIP
#define SKIP 0
#endif
#ifndef DUP
#define DUP 0
#endif
#ifndef PROBE
#define PROBE 0
#endif
#define PH(k, ...) do { __VA_ARGS__; if (PROBE == (k)) { GSYNC(); __VA_ARGS__; } } while (0)

constexpr size_t al256(size_t x) { return (x + 255) & ~(size_t)255; }
constexpr size_t OFF_WQKV = 0;
constexpr size_t OFF_WO   = OFF_WQKV + al256((size_t)3072 * 2048 * 2);
constexpr size_t OFF_WPQ  = OFF_WO + al256((size_t)2048 * 2048 * 2);
constexpr size_t OFF_WIN  = OFF_WPQ + al256((size_t)2 * 2048 * 2048 * 2);
constexpr size_t OFF_WOUT = OFF_WIN + al256((size_t)4096 * 2048 * 2);
constexpr size_t OFF_WA   = OFF_WOUT + al256((size_t)2048 * 2048 * 2);
constexpr size_t OFF_SP   = OFF_WA + al256((size_t)32 * 256 * 256 * 2);
constexpr size_t OFF_KEYS = OFF_SP + al256((size_t)2 * 2048 * 4);
constexpr size_t OFF_UTAB = OFF_KEYS + al256((size_t)2 * 2 * 128 * 128 * 2);
constexpr size_t OFF_VTAB = OFF_UTAB + al256((size_t)2 * NEXP * D);
constexpr size_t OFF_USC  = OFF_VTAB + al256((size_t)2 * NEXP * D);
constexpr size_t OFF_VSC  = OFF_USC + al256((size_t)2 * NEXP * 4);
constexpr size_t OFF_MODV = OFF_VSC + al256((size_t)2 * NEXP * 4);
constexpr size_t OFF_ROPE = OFF_MODV + al256((size_t)2 * 5 * NMOD * 4);
constexpr size_t OFF_XS   = OFF_ROPE + al256((size_t)2 * 2048 * 4);
constexpr size_t SZ_ACT  = al256((size_t)TT * D * 2);
constexpr size_t OFF_H    = OFF_XS + al256((size_t)TT * D * 4);
constexpr size_t OFF_Q    = OFF_H + SZ_ACT;
constexpr size_t OFF_X    = OFF_Q + SZ_ACT;
constexpr size_t OFF_K    = OFF_X + 2 * SZ_ACT;
constexpr size_t OFF_VT   = OFF_K + al256((size_t)TT * 512 * 2);
constexpr size_t OFF_O    = OFF_VT + al256((size_t)TT * 512 * 2);
constexpr size_t OFF_PQ   = OFF_O + SZ_ACT;
constexpr size_t OFF_LAB  = OFF_H;
constexpr size_t OFF_CHP  = OFF_K;
constexpr size_t OFF_CHH  = OFF_CHP + al256((size_t)2 * 272 * D * 4);
constexpr size_t OFF_CIN  = OFF_CHH + al256((size_t)2 * 272 * D * 4);
constexpr size_t OFF_IDX  = OFF_PQ + SZ_ACT;
constexpr size_t OFF_GW   = OFF_IDX + al256((size_t)TT * 128 * 4);
constexpr size_t OFF_BAR  = OFF_GW + al256((size_t)TT * 128 * 4);
constexpr size_t WS_NEED  = OFF_BAR + 16384;
static_assert(OFF_CIN + al256((size_t)2 * 272 * D * 4) <= OFF_O, "scan carries must fit in the K/VT region");
static_assert(WS_NEED <= ((size_t)1 << 30), "workspace map exceeds 1 GiB");

struct Params {
  const float *x, *c, *ctx, *c_ctx, *w_mod, *b_mod, *norm_mix, *norm_ffn, *norm_final;
  const float *attn_w_qkv, *attn_w_o, *attn_sink;
  const float *rec_w_in, *rec_conv_w, *rec_conv_b, *rec_w_a, *rec_b_a, *rec_w_x, *rec_b_x, *rec_lambda, *rec_w_out;
  const float *peer_w_q, *peer_keys, *peer_u, *peer_v;
  float* out; unsigned char* ws;
};

__device__ __forceinline__ float bf2f(bf16_t v) { return __uint_as_float((unsigned)v << 16); }
__device__ __forceinline__ bf16_t f2bf(float f) { unsigned u = __float_as_uint(f); u += 0x7fffu + ((u >> 16) & 1u); return (bf16_t)(u >> 16); }
typedef float f32x2_t __attribute__((ext_vector_type(2)));
__device__ __forceinline__ unsigned pack_bf16(float lo, float hi) { const f32x2_t v = {lo, hi}; return __builtin_bit_cast(unsigned, __builtin_convertvector(v, bf16x2_t)); }
template <int CTRL, int RM, bool BC> __device__ __forceinline__ float dppf(float old, float src) {
  return __builtin_bit_cast(float, __builtin_amdgcn_update_dpp(__builtin_bit_cast(int, old), __builtin_bit_cast(int, src), CTRL, RM, 0xf, BC));
}
__device__ __forceinline__ float wave_sum(float v) {
  v += dppf<0x111, 0xf, true>(0.f, v); v += dppf<0x112, 0xf, true>(0.f, v); v += dppf<0x114, 0xf, true>(0.f, v); v += dppf<0x118, 0xf, true>(0.f, v);
  v += dppf<0x142, 0xa, false>(0.f, v); v += dppf<0x143, 0xc, false>(0.f, v);
  return __builtin_bit_cast(float, __builtin_amdgcn_readlane(__builtin_bit_cast(int, v), 63));
}
__device__ __forceinline__ float wave_max(float v) {
  v = fmaxf(v, dppf<0x111, 0xf, false>(v, v)); v = fmaxf(v, dppf<0x112, 0xf, false>(v, v)); v = fmaxf(v, dppf<0x114, 0xf, false>(v, v)); v = fmaxf(v, dppf<0x118, 0xf, false>(v, v));
  v = fmaxf(v, dppf<0x142, 0xa, false>(v, v)); v = fmaxf(v, dppf<0x143, 0xc, false>(v, v));
  return __builtin_bit_cast(float, __builtin_amdgcn_readlane(__builtin_bit_cast(int, v), 63));
}
__device__ __forceinline__ float gelu_tanh(float x) {
  const float y = 0.7978845608028654f * (x + 0.044715f * x * x * x);
  const float t = 1.0f - 2.0f / (1.0f + __expf(2.0f * y));
  return 0.5f * x * (1.0f + t);
}
__device__ __forceinline__ float sigmoid_f(float x) { return 1.0f / (1.0f + __expf(-x)); }
__device__ __forceinline__ int mod_row(int r) { return r < TL ? (r >> 12) : 4; }
__device__ __forceinline__ int tidx() { int t = threadIdx.x; asm volatile("" : "+v"(t)); return t; }

__device__ __forceinline__ void mod_item(const Params& p, int item, float* lds) {
  float* sil = lds;
  float* red = lds + 5 * 2048;
  const int tid = tidx(), wid = tid >> 6, lane = tid & 63;
  for (int i = tid; i < 5 * 2048; i += NT) {
    const int m = i >> 11, k = i & 2047;
    const float v = (m < 4) ? p.c[m * 2048 + k] : p.c_ctx[k];
    sil[i] = v / (1.0f + expf(-v));
  }
  __syncthreads();
  const int layer = item / 48, cgp = item % 48;
  const float* W = p.w_mod + (size_t)layer * 2048 * NMOD + cgp * 256 + lane * 4;
  float acc[5][4];
#pragma unroll
  for (int m = 0; m < 5; ++m)
#pragma unroll
    for (int j = 0; j < 4; ++j) acc[m][j] = 0.f;
  const int k0 = wid * 256;
#pragma unroll 32
  for (int k = k0; k < k0 + 256; ++k) {
    const float4 w = *(const float4*)(W + (size_t)k * NMOD);
#pragma unroll
    for (int m = 0; m < 5; ++m) {
      const float s = sil[m * 2048 + k];
      acc[m][0] += s * w.x; acc[m][1] += s * w.y; acc[m][2] += s * w.z; acc[m][3] += s * w.w;
    }
  }
#pragma unroll
  for (int m = 0; m < 5; ++m)
#pragma unroll
    for (int j = 0; j < 4; ++j) red[(wid * 5 + m) * 256 + lane * 4 + j] = acc[m][j];
  __syncthreads();
  float* MODV = (float*)(p.ws + OFF_MODV);
  for (int o = tid; o < 1280; o += NT) {
    const int m = o >> 8, n = o & 255;
    float s = 0.f;
#pragma unroll
    for (int w = 0; w < 8; ++w) s += red[(w * 5 + m) * 256 + n];
    const int col = cgp * 256 + n;
    MODV[(size_t)(layer * 5 + m) * NMOD + col] = s + p.b_mod[layer * NMOD + col];
  }
  __syncthreads();
}

__device__ __forceinline__ void transpose_quad(const Params& p, int q, float* lds) {
  const float* W; bf16_t* Wt; int K, N; int rnn = -1, isx = 0, mtx = 0;
  if (q < 384) { W = p.attn_w_qkv; Wt = (bf16_t*)(p.ws + OFF_WQKV); K = 2048; N = 3072; }
  else if ((q -= 384) < 256) { W = p.attn_w_o; Wt = (bf16_t*)(p.ws + OFF_WO); K = 2048; N = 2048; }
  else if ((q -= 256) < 512) { const int l = q >> 8; q &= 255; W = p.peer_w_q + (size_t)l * 2048 * 2048; Wt = (bf16_t*)(p.ws + OFF_WPQ) + (size_t)l * 2048 * 2048; K = 2048; N = 2048; }
  else if ((q -= 512) < 512) { W = p.rec_w_in; Wt = (bf16_t*)(p.ws + OFF_WIN); K = 2048; N = 4096; }
  else if ((q -= 512) < 256) { W = p.rec_w_out; Wt = (bf16_t*)(p.ws + OFF_WOUT); K = 2048; N = 2048; }
  else { q -= 256; isx = q >> 6; q &= 63; mtx = q >> 2; q &= 3; rnn = 1; W = (isx ? p.rec_w_x : p.rec_w_a) + (size_t)mtx * 65536; Wt = (bf16_t*)(p.ws + OFF_WA); K = 256; N = 256; }
  const int nq = N >> 8, k0 = (q / nq) * 64, n0 = (q % nq) * 256;
  const int tid = tidx();
  {
    const int r = tid >> 6, c4 = (tid & 63) * 4;
    float4 v[8];
#pragma unroll
    for (int i = 0; i < 8; ++i) v[i] = *(const float4*)(W + (size_t)(k0 + r + 8 * i) * N + n0 + c4);
#pragma unroll
    for (int i = 0; i < 8; ++i) { float* d = lds + (r + 8 * i) * 257 + c4; d[0] = v[i].x; d[1] = v[i].y; d[2] = v[i].z; d[3] = v[i].w; }
  }
  __syncthreads();
  {
    const int n = tid >> 1, kh = (tid & 1) * 32;
    bf16_t* drow = (rnn < 0) ? Wt + (size_t)(n0 + n) * K + k0 + kh : Wt + ((size_t)(mtx * 2 + (n >> 7)) * 256 + isx * 128 + (n & 127)) * 256 + k0 + kh;
#pragma unroll
    for (int c = 0; c < 4; ++c) {
      u32x4 o;
      o.x = pack_bf16(lds[(kh + c * 8 + 0) * 257 + n], lds[(kh + c * 8 + 1) * 257 + n]);
      o.y = pack_bf16(lds[(kh + c * 8 + 2) * 257 + n], lds[(kh + c * 8 + 3) * 257 + n]);
      o.z = pack_bf16(lds[(kh + c * 8 + 4) * 257 + n], lds[(kh + c * 8 + 5) * 257 + n]);
      o.w = pack_bf16(lds[(kh + c * 8 + 6) * 257 + n], lds[(kh + c * 8 + 7) * 257 + n]);
      *(u32x4*)(drow + c * 8) = o;
    }
  }
  __syncthreads();
}

__device__ __forceinline__ void convert8(const float* src, bf16_t* dst) {
  const float4 a = ((const float4*)src)[0], b = ((const float4*)src)[1];
  u32x4 o; o.x = pack_bf16(a.x, a.y); o.y = pack_bf16(a.z, a.w); o.z = pack_bf16(b.x, b.y); o.w = pack_bf16(b.z, b.w);
  *(u32x4*)dst = o;
}

constexpr int IT_MOD = 0, IT_TR = 96, IT_KEYS = IT_TR + 8192, IT_ROPE = IT_KEYS + 16, IT_TAB = IT_ROPE + 1;
struct ItemRanges { int lo1, n1, lo2, n2; };

__device__ __forceinline__ void quant_rows_item(const Params& p, int t, int tid0) {
  const int wid = tid0 >> 6, lane = tid0 & 63;
  float4 v[2][8]; float mx[2] = {0.f, 0.f};
#pragma unroll
  for (int h = 0; h < 2; ++h) {
    const int R = t * 16 + h * 8 + wid, tb = R >> 15, row = R & 32767;
    const float* src = (tb == 0 ? p.peer_u : p.peer_v) + (size_t)row * D;
#pragma unroll
    for (int i = 0; i < 8; ++i) v[h][i] = ((const float4*)src)[i * 64 + lane];
  }
#pragma unroll
  for (int h = 0; h < 2; ++h) {
    const int R = t * 16 + h * 8 + wid, tb = R >> 15, row = R & 32767;
    unsigned* dst = (unsigned*)(p.ws + (tb == 0 ? OFF_UTAB : OFF_VTAB) + (size_t)row * D);
    float* scp = (float*)(p.ws + (tb == 0 ? OFF_USC : OFF_VSC)) + row;
#pragma unroll
    for (int i = 0; i < 8; ++i) mx[h] = fmaxf(mx[h], fmaxf(fmaxf(fabsf(v[h][i].x), fabsf(v[h][i].y)), fmaxf(fabsf(v[h][i].z), fabsf(v[h][i].w))));
    mx[h] = wave_max(mx[h]);
    const float sc = mx[h] > 0.f ? mx[h] * (1.0f / 127.0f) : 1.0f, inv = 1.0f / sc;
#pragma unroll
    for (int i = 0; i < 8; ++i) {
      const unsigned q0 = (unsigned)((int)fminf(fmaxf(rintf(v[h][i].x * inv), -127.f), 127.f) + 128), q1 = (unsigned)((int)fminf(fmaxf(rintf(v[h][i].y * inv), -127.f), 127.f) + 128);
      const unsigned q2 = (unsigned)((int)fminf(fmaxf(rintf(v[h][i].z * inv), -127.f), 127.f) + 128), q3 = (unsigned)((int)fminf(fmaxf(rintf(v[h][i].w * inv), -127.f), 127.f) + 128);
      dst[i * 64 + lane] = q0 | (q1 << 8) | (q2 << 16) | (q3 << 24);
    }
    if (lane == 0) *scp = sc;
  }
}

__device__ __forceinline__ void setup_phase(const Params& p, unsigned char* lds_raw) {
  float* lds = (float*)lds_raw;
  const int tid0 = tidx();
  const int b = (int)blockIdx.x;
  if (b < 96) { mod_item(p, b, lds); return; }
  for (int j = b - 96; j < 2048 + 17; j += (int)gridDim.x - 96) {
    if (j < 2048) { transpose_quad(p, j, lds); continue; }
    const int t = j - 2048;
    if (t < 16) { const size_t e = (size_t)t * 4096 + tid0 * 8; convert8(p.peer_keys + e, (bf16_t*)(p.ws + OFF_KEYS) + e); continue; }
    float* cosT = (float*)(p.ws + OFF_ROPE); float* sinT = cosT + 2048;
    for (int e = tid0; e < 2048; e += NT) {
      const int pos = e >> 5, jj = e & 31;
      const float inv = powf(10000.0f, -(float)(2 * jj) / 64.0f);
      const float ang = (float)pos * inv;
      cosT[e] = cosf(ang); sinT[e] = sinf(ang);
    }
    float* SP = (float*)(p.ws + OFF_SP);
    for (int e = tid0; e < 2 * 2048; e += NT) SP[e] = log1pf(expf(-p.rec_lambda[e]));
  }
}
__device__ __forceinline__ void norm_phase(const Params& p, int layer, const float* gain, int shift_idx, int nrows, bool from_input, bf16_t* H) {
  const int tid_ = tidx(), wid = tid_ >> 6, lane = tid_ & 63;
  const float* MODV = (const float*)(p.ws + OFF_MODV);
  const float* XS = (const float*)(p.ws + OFF_XS);
  for (int r = blockIdx.x * 8 + wid; r < nrows; r += gridDim.x * 8) {
    const float* src = from_input ? (r < TL ? p.x + (size_t)r * D : p.ctx + (size_t)(r - TL) * D) : XS + (size_t)r * D;
    const float* mv = MODV + (size_t)(layer * 5 + mod_row(r)) * NMOD;
    const float* sh = mv + shift_idx * D; const float* sc = sh + D;
    float4 v[8]; float ss = 0.f;
#pragma unroll
    for (int i = 0; i < 8; ++i) { v[i] = ((const float4*)src)[i * 64 + lane]; ss += v[i].x * v[i].x + v[i].y * v[i].y + v[i].z * v[i].z + v[i].w * v[i].w; }
    ss = wave_sum(ss);
    const float rs = rsqrtf(ss * (1.0f / D) + 1e-6f);
#pragma unroll
    for (int i = 0; i < 8; ++i) {
      const float4 g = ((const float4*)gain)[i * 64 + lane], a = ((const float4*)sh)[i * 64 + lane], b = ((const float4*)sc)[i * 64 + lane];
      const float o0 = v[i].x * rs * g.x * (1.0f + b.x) + a.x, o1 = v[i].y * rs * g.y * (1.0f + b.y) + a.y;
      const float o2 = v[i].z * rs * g.z * (1.0f + b.z) + a.z, o3 = v[i].w * rs * g.w * (1.0f + b.w) + a.w;
      u32x2 o; o.x = pack_bf16(o0, o1); o.y = pack_bf16(o2, o3);
      *(u32x2*)(H + (size_t)r * D + i * 256 + lane * 4) = o;
    }
  }
}

__device__ __forceinline__ void final_norm_phase(const Params& p) {
  const int tid_ = tidx(), wid = tid_ >> 6, lane = tid_ & 63;
  const float* XS = (const float*)(p.ws + OFF_XS);
  for (int r = blockIdx.x * 8 + wid; r < TL; r += gridDim.x * 8) {
    const float4* xr = (const float4*)(XS + (size_t)r * D);
    float4 v[8]; float ss = 0.f;
#pragma unroll
    for (int i = 0; i < 8; ++i) { v[i] = xr[i * 64 + lane]; ss += v[i].x * v[i].x + v[i].y * v[i].y + v[i].z * v[i].z + v[i].w * v[i].w; }
    ss = wave_sum(ss);
    const float rs = rsqrtf(ss * (1.0f / D) + 1e-6f);
    float4* orow = (float4*)(p.out + (size_t)r * D);
#pragma unroll
    for (int i = 0; i < 8; ++i) { const float4 g = ((const float4*)p.norm_final)[i * 64 + lane]; float4 o; o.x = v[i].x * rs * g.x; o.y = v[i].y * rs * g.y; o.z = v[i].z * rs * g.z; o.w = v[i].w * rs * g.w; orow[i * 64 + lane] = o; }
  }
}

constexpr int GLD = 72;
template <bool DUAL, class Epi>
__device__ __forceinline__ void gemm_tile(const bf16_t* __restrict__ Ap, int lda, const bf16_t* __restrict__ Bp, const bf16_t* __restrict__ B2p, int ldb, int K,
                                          unsigned char* lds, const Epi& epi, int m0, int n0) {
  const int tid = tidx(), wid = tid >> 6, lane = tid & 63, wm = wid >> 1, wn = wid & 1, fr = lane & 15, fq = lane >> 4;
  bf16_t* As = (bf16_t*)lds; bf16_t* Bs = As + 2 * 128 * GLD; bf16_t* B2s = Bs + 2 * 128 * GLD;
  const int lr0 = tid >> 3, lc = (tid & 7) * 8;
  f32x4 acc[2][4], acc2[2][4];
#pragma unroll
  for (int i = 0; i < 2; ++i)
#pragma unroll
    for (int j = 0; j < 4; ++j) { acc[i][j] = (f32x4){0.f, 0.f, 0.f, 0.f}; acc2[i][j] = (f32x4){0.f, 0.f, 0.f, 0.f}; }
  u32x4 ra[2], rb[2], rb2[2];
  const int nk = K >> 6;
#pragma unroll
  for (int i = 0; i < 2; ++i) {
    ra[i] = *(const u32x4*)(Ap + (size_t)(lr0 + 64 * i) * lda + lc);
    rb[i] = *(const u32x4*)(Bp + (size_t)(lr0 + 64 * i) * ldb + lc);
    if (DUAL) rb2[i] = *(const u32x4*)(B2p + (size_t)(lr0 + 64 * i) * ldb + lc);
  }
#pragma unroll
  for (int i = 0; i < 2; ++i) {
    *(u32x4*)(As + (lr0 + 64 * i) * GLD + lc) = ra[i];
    *(u32x4*)(Bs + (lr0 + 64 * i) * GLD + lc) = rb[i];
    if (DUAL) *(u32x4*)(B2s + (lr0 + 64 * i) * GLD + lc) = rb2[i];
  }
  __syncthreads();
  for (int kt = 0; kt < nk; ++kt) {
    const int buf = kt & 1;
    if (kt + 1 < nk) {
#pragma unroll
      for (int i = 0; i < 2; ++i) {
        ra[i] = *(const u32x4*)(Ap + (size_t)(lr0 + 64 * i) * lda + (kt + 1) * 64 + lc);
        rb[i] = *(const u32x4*)(Bp + (size_t)(lr0 + 64 * i) * ldb + (kt + 1) * 64 + lc);
        if (DUAL) rb2[i] = *(const u32x4*)(B2p + (size_t)(lr0 + 64 * i) * ldb + (kt + 1) * 64 + lc);
      }
    }
    const bf16_t* Ab = As + buf * 128 * GLD; const bf16_t* Bb = Bs + buf * 128 * GLD; const bf16_t* B2b = B2s + buf * 128 * GLD;
#pragma unroll
    for (int ks = 0; ks < 2; ++ks) {
      bf16x8 af[2], bfr[4];
#pragma unroll
      for (int mi = 0; mi < 2; ++mi) af[mi] = *(const bf16x8*)(Ab + (wm * 32 + mi * 16 + fr) * GLD + ks * 32 + fq * 8);
#pragma unroll
      for (int ni = 0; ni < 4; ++ni) bfr[ni] = *(const bf16x8*)(Bb + (wn * 64 + ni * 16 + fr) * GLD + ks * 32 + fq * 8);
#pragma unroll
      for (int mi = 0; mi < 2; ++mi)
#pragma unroll
        for (int ni = 0; ni < 4; ++ni) acc[mi][ni] = __builtin_amdgcn_mfma_f32_16x16x32_bf16(bfr[ni], af[mi], acc[mi][ni], 0, 0, 0);
      if (DUAL) {
#pragma unroll
        for (int ni = 0; ni < 4; ++ni) bfr[ni] = *(const bf16x8*)(B2b + (wn * 64 + ni * 16 + fr) * GLD + ks * 32 + fq * 8);
#pragma unroll
        for (int mi = 0; mi < 2; ++mi)
#pragma unroll
          for (int ni = 0; ni < 4; ++ni) acc2[mi][ni] = __builtin_amdgcn_mfma_f32_16x16x32_bf16(bfr[ni], af[mi], acc2[mi][ni], 0, 0, 0);
      }
    }
    if (kt + 1 < nk) {
      const int nb = buf ^ 1;
#pragma unroll
      for (int i = 0; i < 2; ++i) {
        *(u32x4*)(As + nb * 128 * GLD + (lr0 + 64 * i) * GLD + lc) = ra[i];
        *(u32x4*)(Bs + nb * 128 * GLD + (lr0 + 64 * i) * GLD + lc) = rb[i];
        if (DUAL) *(u32x4*)(B2s + nb * 128 * GLD + (lr0 + 64 * i) * GLD + lc) = rb2[i];
      }
    }
    __syncthreads();
  }
  epi(acc, acc2, m0 + wm * 32 + fr, n0 + wn * 64 + fq * 4);
}

struct EpiQKV {
  bf16_t *Q, *Kb, *VT; const float *cosT, *sinT;
  __device__ __forceinline__ void operator()(const f32x4 (&acc)[2][4], const f32x4 (&)[2][4], int rbase, int cbase) const {
    const int n0 = cbase & ~127;
#pragma unroll
    for (int mi = 0; mi < 2; ++mi) {
      const int r = rbase + 16 * mi;
      if (n0 < 2560) {
        const bool latent = r < TL;
        const int s = r & 4095;
        const int pos = ((cbase & 64) == 0) ? (s >> 6) : (s & 63);
        const int cl = cbase & 63;
        bf16_t* dst = (n0 < 2048) ? (Q + (size_t)r * D + cbase) : (Kb + (size_t)r * 512 + (cbase - 2048));
#pragma unroll
        for (int ni = 0; ni < 2; ++ni) {
          f32x4 x1 = acc[mi][ni], x2 = acc[mi][ni + 2], y1 = x1, y2 = x2;
          if (latent) {
            const f32x4 cs = *(const f32x4*)(cosT + pos * 32 + ni * 16 + cl), sn = *(const f32x4*)(sinT + pos * 32 + ni * 16 + cl);
            y1 = x1 * cs - x2 * sn; y2 = x2 * cs + x1 * sn;
          }
          u32x2 o1, o2; o1.x = pack_bf16(y1[0], y1[1]); o1.y = pack_bf16(y1[2], y1[3]); o2.x = pack_bf16(y2[0], y2[1]); o2.y = pack_bf16(y2[2], y2[3]);
          *(u32x2*)(dst + ni * 16) = o1; *(u32x2*)(dst + (ni + 2) * 16) = o2;
        }
      } else {
#pragma unroll
        for (int ni = 0; ni < 4; ++ni)
#pragma unroll
          for (int j = 0; j < 4; ++j) VT[(size_t)(cbase - 2560 + ni * 16 + j) * TT + r] = f2bf(acc[mi][ni][j]);
      }
    }
  }
};
struct EpiResid {
  const float *x, *ctx; float* XS; const float* gate  ; bool from_input; float mul;
  __device__ __forceinline__ void operator()(const f32x4 (&acc)[2][4], const f32x4 (&)[2][4], int rbase, int cbase) const {
#pragma unroll
    for (int mi = 0; mi < 2; ++mi) {
      const int r = rbase + 16 * mi;
      const float* src = from_input ? (r < TL ? x + (size_t)r * D : ctx + (size_t)(r - TL) * D) : XS + (size_t)r * D;
      const float* g = gate + (size_t)mod_row(r) * NMOD;
#pragma unroll
      for (int ni = 0; ni < 4; ++ni) {
        const int c = cbase + ni * 16;
        const f32x4 b = *(const f32x4*)(src + c), gg = *(const f32x4*)(g + c);
        *(f32x4*)(XS + (size_t)r * D + c) = b + gg * acc[mi][ni] * mul;
      }
    }
  }
};
struct EpiBf16 {
  bf16_t* O; int ldo;
  __device__ __forceinline__ void operator()(const f32x4 (&acc)[2][4], const f32x4 (&)[2][4], int rbase, int cbase) const {
#pragma unroll
    for (int mi = 0; mi < 2; ++mi)
#pragma unroll
      for (int ni = 0; ni < 4; ++ni) {
        u32x2 o; o.x = pack_bf16(acc[mi][ni][0], acc[mi][ni][1]); o.y = pack_bf16(acc[mi][ni][2], acc[mi][ni][3]);
        *(u32x2*)(O + (size_t)(rbase + 16 * mi) * ldo + cbase + ni * 16) = o;
      }
  }
};
struct EpiWin {
  bf16_t *GATE, *UBR;
  __device__ __forceinline__ void operator()(const f32x4 (&acc)[2][4], const f32x4 (&)[2][4], int rbase, int cbase) const {
#pragma unroll
    for (int mi = 0; mi < 2; ++mi) {
      const int r = rbase + 16 * mi;
#pragma unroll
      for (int ni = 0; ni < 4; ++ni) {
        const int c = cbase + ni * 16;
        f32x4 v = acc[mi][ni];
        if (c < 2048) {
          if (r < TL) {
            u32x2 o; o.x = pack_bf16(gelu_tanh(v[0]), gelu_tanh(v[1])); o.y = pack_bf16(gelu_tanh(v[2]), gelu_tanh(v[3]));
            *(u32x2*)(GATE + (size_t)r * D + c) = o;
          }
        } else {
          u32x2 o; o.x = pack_bf16(v[0], v[1]); o.y = pack_bf16(v[2], v[3]);
          *(u32x2*)(UBR + (size_t)r * D + (c - 2048)) = o;
        }
      }
    }
  }
};
struct EpiCoef {
  const float *b_a, *b_x, *lam; const bf16_t* UC; bf16_t *LA, *LB;
  __device__ __forceinline__ void operator()(const f32x4 (&acc)[2][4], const f32x4 (&acc2)[2][4], int rbase, int cbase) const {
#pragma unroll
    for (int ni = 0; ni < 4; ++ni) {
      const int c = cbase + ni * 16;
      const f32x4 ba = *(const f32x4*)(b_a + c), bx = *(const f32x4*)(b_x + c), lm = *(const f32x4*)(lam + c);
      float sp[4];
#pragma unroll
      for (int j = 0; j < 4; ++j) sp[j] = log1pf(expf(-lm[j]));
#pragma unroll
      for (int mi = 0; mi < 2; ++mi) {
        const int r = rbase + 16 * mi;
        const u32x2 uu = *(const u32x2*)(UC + (size_t)r * D + c);
        const float uv[4] = {__uint_as_float(uu.x << 16), __uint_as_float(uu.x & 0xffff0000u), __uint_as_float(uu.y << 16), __uint_as_float(uu.y & 0xffff0000u)};
        float lav[4], bv[4];
#pragma unroll
        for (int j = 0; j < 4; ++j) {
          const float rg = sigmoid_f(acc[mi][ni][j] + ba[j]);
          const float ig = sigmoid_f(acc2[mi][ni][j] + bx[j]);
          const float log_a = -8.0f * rg * sp[j];
          lav[j] = log_a;
          bv[j] = sqrtf(-expm1f(2.0f * log_a)) * ig * uv[j];
        }
        u32x2 o1, o2; o1.x = pack_bf16(lav[0], lav[1]); o1.y = pack_bf16(lav[2], lav[3]); o2.x = pack_bf16(bv[0], bv[1]); o2.y = pack_bf16(bv[2], bv[3]);
        *(u32x2*)(LA + (size_t)r * D + c) = o1;
        *(u32x2*)(LB + (size_t)r * D + c) = o2;
      }
    }
  }
};

template <class Epi>
__device__ __forceinline__ void gemm_phase(const bf16_t* A, const bf16_t* Bt, int K, int mtiles, int ntiles, unsigned char* lds, const Epi& epi) {
  const int total = mtiles * ntiles;
  for (int item = blockIdx.x; item < total; item += gridDim.x) {
    const int nt = item % ntiles, mt = item / ntiles;
    gemm_tile<false>(A + (size_t)mt * 128 * K, K, Bt + (size_t)nt * 128 * K, nullptr, K, K, lds, epi, mt * 128, nt * 128);
  }
}


namespace pg8 {
#define PG8_LAS __attribute__((address_space(3)))
constexpr int BM = 256, BK = 64, HALF = 128, HTB = HALF * BK * 2, STAGE_BYTES = 8 * HTB, NXCD = 8, WGM = 8;
__device__ __forceinline__ int lds_byte(int r, int c) { const int st = (r >> 4) * 2 + (c >> 5), rr = r & 15, cc = c & 31, ob = rr * 64 + cc * 2; return st * 1024 + (ob ^ (((ob >> 9) & 1) << 5)); }
__device__ __forceinline__ void stage_rc(int b, int& R, int& C) { const int st = b / 1024, sb = b % 1024, swz = sb ^ (((sb >> 9) & 1) << 5); R = (st >> 1) * 16 + swz / 64; C = (st & 1) * 32 + (swz % 64) / 2; }
__device__ __forceinline__ int perm128(int rho) { const int w = rho >> 5, n = (rho >> 4) & 1, i = rho & 15; return 64 * (w >> 1) + 16 * (w & 1) + 32 * n + i; }
struct Unit { int pm, pn; unsigned aoff, boff; };
struct Gemm { const bf16_t* A; const bf16_t* Bt; int K, lda; };
struct StaticOrder {
  int nM, nN, nwg, G, c; unsigned tA, tB;
  __device__ void init(int M, int N, int K, int lda, int G_, int c_) { nM = M / BM; nN = N / BM; nwg = nM * nN; G = G_; c = c_; tA = (unsigned)(BM * lda * 2); tB = (unsigned)(BM * K * 2); }
  __device__ bool next(int i, Unit& u) const {
    const long L = (long)i * G + c; if (L >= nwg) return false;
    int wgid = (int)L; { const int q = nwg / NXCD, r = nwg % NXCD, xcd = wgid % NXCD, off = wgid / NXCD; wgid = (xcd < r ? xcd * (q + 1) : r * (q + 1) + (xcd - r) * q) + off; }
    const int nig = WGM * nN, gid = wgid / nig, fm = gid * WGM, gsz = (nM - fm) < WGM ? (nM - fm) : WGM;
    u.pm = fm + ((wgid % nig) % gsz); u.pn = (wgid % nig) / gsz; u.aoff = (unsigned)u.pm * tA; u.boff = (unsigned)u.pn * tB; return true;
  }
};
struct CoefOrder {
  int G, c;
  __device__ void init(int G_, int c_) { G = G_; c = c_; }
  __device__ bool next(int i, Unit& u) const {
    const long L = (long)i * G + c; if (L >= (long)(TT / 256) * 32) return false;
    u.pm = (int)(L >> 5); u.pn = (int)(L & 31); const int blk = (u.pn >> 1) & 7;
    u.aoff = (unsigned)((u.pm * 256 * D + blk * 256) * 2); u.boff = (unsigned)(u.pn * 256 * 256 * 2); return true;
  }
};
template <class Epi, class Sched>
__device__ __forceinline__ void gemm_phase(PG8_LAS unsigned char* lds, const Gemm g, const Sched& S, const Epi& E) {
  const int tid = tidx(), wid = __builtin_amdgcn_readfirstlane(tid >> 6), lane = tid & 63, wr = wid >> 2, wc = wid & 3, fr = lane & 15, fq = lane >> 4;
  const int K = g.K, nt = K / BK;
  unsigned voffA[2], voffB[2];
#pragma unroll
  for (int i = 0; i < 2; ++i) { int R, C; stage_rc(tid * 16 + i * 8192, R, C); const int Rb = perm128(R);
    voffA[i] = (unsigned)(R * g.lda + C) * 2u; voffB[i] = (unsigned)(Rb * K + C) * 2u; }
  const unsigned kstep = (unsigned)(BK * 2);
  const unsigned hstepA = (unsigned)(HALF * g.lda * 2), hstepB = (unsigned)(HALF * K * 2);
  const unsigned ldsw = (unsigned)wid * 1024u;
  const int aoff = lds_byte(wr * 64 + fr, fq * 8), boff = lds_byte(wc * 32 + fr, fq * 8);
#define PG8_SA(b, h) (((b) * 2 + (h)) * HTB)
#define PG8_SB(b, h) ((4 + (b) * 2 + (h)) * HTB)
#define PG8_STAGE(bufoff, gbase, voff) do { _Pragma("unroll") for (int _i = 0; _i < 2; ++_i) \
    __builtin_amdgcn_global_load_lds((const unsigned*)((const char*)(gbase) + (voff)[_i]), (PG8_LAS unsigned*)(lds + (bufoff) + ldsw + _i * 8192), 16, 0, 0); } while (0)
#define PG8_LDA(dst, b, h) do { _Pragma("unroll") for (int m = 0; m < 4; ++m) _Pragma("unroll") for (int k = 0; k < 2; ++k) dst[m][k] = *(const PG8_LAS bf16x8*)(lds + PG8_SA(b, h) + aoff + m * 2048 + k * 1024); } while (0)
#define PG8_LDB(dst, b, h) do { _Pragma("unroll") for (int n = 0; n < 2; ++n) _Pragma("unroll") for (int k = 0; k < 2; ++k) dst[n][k] = *(const PG8_LAS bf16x8*)(lds + PG8_SB(b, h) + boff + n * 2048 + k * 1024); } while (0)
#define PG8_MMA(ai, bj, At, Bt) do { __builtin_amdgcn_s_setprio(1); _Pragma("unroll") for (int m = 0; m < 4; ++m) _Pragma("unroll") for (int n = 0; n < 2; ++n) _Pragma("unroll") for (int k = 0; k < 2; ++k) \
    acc[ai][bj][m][n] = __builtin_amdgcn_mfma_f32_16x16x32_bf16(Bt[n][k], At[m][k], acc[ai][bj][m][n], 0, 0, 0); __builtin_amdgcn_s_setprio(0); } while (0)
#define PG8_WAIT_V(n) asm volatile("s_waitcnt vmcnt(" #n ")" ::: "memory")
#define PG8_WAIT_L(n) asm volatile("s_waitcnt lgkmcnt(" #n ")" ::: "memory")
#define PG8_BAR __builtin_amdgcn_s_barrier()
#define PG8_SCHED __builtin_amdgcn_sched_barrier(0)
  Unit cur, nxt; int ui = 0;
  if (!S.next(0, cur)) return;
  f32x4 acc[2][2][4][2];
#pragma unroll
  for (int a = 0; a < 2; ++a)
#pragma unroll
    for (int b = 0; b < 2; ++b)
#pragma unroll
      for (int m = 0; m < 4; ++m)
#pragma unroll
        for (int n = 0; n < 2; ++n) acc[a][b][m][n] = (f32x4){0.f, 0.f, 0.f, 0.f};
  bf16x8 At[4][2], B0[2][2], B1[2][2];
  const char* cA = (const char*)g.A + cur.aoff; const char* cB = (const char*)g.Bt + cur.boff;
  PG8_STAGE(PG8_SB(0, 0), cB, voffB); PG8_STAGE(PG8_SA(0, 0), cA, voffA); PG8_STAGE(PG8_SB(0, 1), cB + hstepB, voffB); PG8_STAGE(PG8_SA(0, 1), cA + hstepA, voffA);
  if (wr == 1) PG8_BAR;
  PG8_WAIT_V(4); PG8_BAR;
  PG8_STAGE(PG8_SB(1, 0), cB + kstep, voffB); PG8_STAGE(PG8_SA(1, 0), cA + kstep, voffA); PG8_STAGE(PG8_SB(1, 1), cB + hstepB + kstep, voffB);
  PG8_WAIT_V(6); PG8_BAR;
  for (;;) {
    const bool has_next = S.next(ui + 1, nxt);
    const char* nA = has_next ? (const char*)g.A + nxt.aoff : cA; const char* nB = has_next ? (const char*)g.Bt + nxt.boff : cB;
    for (int t = 0; t < nt; t += 2) {
      const bool last = (t == nt - 2);
      const char* a1 = cA + (unsigned)(t + 1) * kstep;
      const char* a2 = last ? nA : cA + (unsigned)(t + 2) * kstep; const char* b2 = last ? nB : cB + (unsigned)(t + 2) * kstep;
      const char* a3 = a2 + kstep; const char* b3 = b2 + kstep;
      PG8_LDB(B0, 0, 0); PG8_SCHED; PG8_LDA(At, 0, 0); PG8_STAGE(PG8_SA(1, 1), a1 + hstepA, voffA);
      PG8_WAIT_L(8); PG8_BAR; PG8_WAIT_L(0); PG8_MMA(0, 0, At, B0); PG8_BAR; PG8_SCHED;
      PG8_LDB(B1, 0, 1); PG8_STAGE(PG8_SB(0, 0), b2, voffB);
      PG8_BAR; PG8_WAIT_L(0); PG8_MMA(0, 1, At, B1); PG8_BAR;
      PG8_LDA(At, 0, 1); PG8_STAGE(PG8_SA(0, 0), a2, voffA);
      PG8_BAR; PG8_WAIT_L(0); PG8_MMA(1, 0, At, B0); PG8_BAR; PG8_SCHED;
      PG8_STAGE(PG8_SB(0, 1), b2 + hstepB, voffB);
      PG8_WAIT_V(6); PG8_BAR; PG8_MMA(1, 1, At, B1); PG8_BAR;
      PG8_LDB(B0, 1, 0); PG8_SCHED; PG8_LDA(At, 1, 0); PG8_STAGE(PG8_SA(0, 1), a2 + hstepA, voffA);
      PG8_WAIT_L(8); PG8_BAR; PG8_WAIT_L(0); PG8_MMA(0, 0, At, B0); PG8_BAR; PG8_SCHED;
      PG8_LDB(B1, 1, 1); PG8_STAGE(PG8_SB(1, 0), b3, voffB);
      PG8_BAR; PG8_WAIT_L(0); PG8_MMA(0, 1, At, B1); PG8_BAR;
      PG8_LDA(At, 1, 1); PG8_STAGE(PG8_SA(1, 0), a3, voffA);
      PG8_BAR; PG8_WAIT_L(0); PG8_MMA(1, 0, At, B0); PG8_BAR; PG8_SCHED;
      PG8_STAGE(PG8_SB(1, 1), b3 + hstepB, voffB);
      PG8_WAIT_V(6); PG8_BAR; PG8_MMA(1, 1, At, B1); PG8_BAR;
    }
    E(acc, cur, wr, wc, fr, fq);
    if (!has_next) break;
#pragma unroll
    for (int a = 0; a < 2; ++a)
#pragma unroll
      for (int b = 0; b < 2; ++b)
#pragma unroll
        for (int m = 0; m < 4; ++m)
#pragma unroll
          for (int n = 0; n < 2; ++n) acc[a][b][m][n] = (f32x4){0.f, 0.f, 0.f, 0.f};
    cur = nxt; cA = nA; cB = nB; ++ui;
  }
  PG8_WAIT_V(0);
  if (wr == 0) PG8_BAR;
  PG8_BAR;
#undef PG8_SA
#undef PG8_SB
#undef PG8_STAGE
#undef PG8_LDA
#undef PG8_LDB
#undef PG8_MMA
#undef PG8_WAIT_V
#undef PG8_WAIT_L
#undef PG8_BAR
#undef PG8_SCHED
}
}

#define ROW256(ai, m) (u.pm * 256 + (ai) * 128 + wr * 64 + (m) * 16 + fr)
#define COL256(bj, n) (u.pn * 256 + (bj) * 128 + 64 * (wc >> 1) + 16 * (wc & 1) + 32 * (n) + 4 * fq)
struct EpiQKV256 {
  bf16_t *Q, *Kb, *VT; const float *cosT, *sinT;
  __device__ __forceinline__ void operator()(const f32x4 (&acc)[2][2][4][2], const pg8::Unit& u, int wr, int wc, int fr, int fq) const {
#pragma unroll
    for (int bj = 0; bj < 2; ++bj) {
      const int n0 = u.pn * 256 + bj * 128;
      const int c0 = COL256(bj, 0);
      if (n0 < 2560) {
        const int iidx = 16 * (wc & 1) + 4 * fq;
#pragma unroll
        for (int ai = 0; ai < 2; ++ai)
#pragma unroll
          for (int m = 0; m < 4; ++m) {
            const int r = ROW256(ai, m);
            const f32x4 x1 = acc[ai][bj][m][0], x2 = acc[ai][bj][m][1]; f32x4 y1 = x1, y2 = x2;
            if (r < TL) {
              const int s = r & 4095; const int pos = (wc >> 1) ? (s & 63) : (s >> 6);
              const f32x4 cs = *(const f32x4*)(cosT + pos * 32 + iidx), sn = *(const f32x4*)(sinT + pos * 32 + iidx);
              y1 = x1 * cs - x2 * sn; y2 = x2 * cs + x1 * sn;
            }
            bf16_t* dst = (n0 < 2048) ? (Q + (size_t)r * D + c0) : (Kb + (size_t)r * 512 + (c0 - 2048));
            u32x2 o1, o2; o1.x = pack_bf16(y1[0], y1[1]); o1.y = pack_bf16(y1[2], y1[3]); o2.x = pack_bf16(y2[0], y2[1]); o2.y = pack_bf16(y2[2], y2[3]);
            *(u32x2*)dst = o1; *(u32x2*)(dst + 32) = o2;
          }
      } else {
#pragma unroll
        for (int ai = 0; ai < 2; ++ai)
#pragma unroll
          for (int m = 0; m < 4; ++m) {
            const int r = ROW256(ai, m);
#pragma unroll
            for (int n = 0; n < 2; ++n)
#pragma unroll
              for (int j = 0; j < 4; ++j) VT[(size_t)(c0 - 2560 + 32 * n + j) * TT + r] = f2bf(acc[ai][bj][m][n][j]);
          }
      }
    }
  }
};
struct EpiResid256 {
  const float *x, *ctx; float* XS; const float* gate; bool from_input;
  __device__ __forceinline__ void operator()(const f32x4 (&acc)[2][2][4][2], const pg8::Unit& u, int wr, int wc, int fr, int fq) const {
#pragma unroll
    for (int ai = 0; ai < 2; ++ai)
#pragma unroll
      for (int m = 0; m < 4; ++m) {
        const int r = ROW256(ai, m);
        const float* src = from_input ? (r < TL ? x + (size_t)r * D : ctx + (size_t)(r - TL) * D) : XS + (size_t)r * D;
        const float* g = gate + (size_t)mod_row(r) * NMOD;
#pragma unroll
        for (int bj = 0; bj < 2; ++bj)
#pragma unroll
          for (int n = 0; n < 2; ++n) {
            const int c = COL256(bj, n);
            const f32x4 b = *(const f32x4*)(src + c), gg = *(const f32x4*)(g + c);
            *(f32x4*)(XS + (size_t)r * D + c) = b + gg * acc[ai][bj][m][n];
          }
      }
  }
};
struct EpiBf16_256 {
  bf16_t* O; int ldo;
  __device__ __forceinline__ void operator()(const f32x4 (&acc)[2][2][4][2], const pg8::Unit& u, int wr, int wc, int fr, int fq) const {
#pragma unroll
    for (int ai = 0; ai < 2; ++ai)
#pragma unroll
      for (int m = 0; m < 4; ++m)
#pragma unroll
        for (int bj = 0; bj < 2; ++bj)
#pragma unroll
          for (int n = 0; n < 2; ++n) {
            const f32x4 v = acc[ai][bj][m][n];
            u32x2 o; o.x = pack_bf16(v[0], v[1]); o.y = pack_bf16(v[2], v[3]);
            *(u32x2*)(O + (size_t)ROW256(ai, m) * ldo + COL256(bj, n)) = o;
          }
  }
};
struct EpiWin256 {
  bf16_t *GATE, *UBR;
  __device__ __forceinline__ void operator()(const f32x4 (&acc)[2][2][4][2], const pg8::Unit& u, int wr, int wc, int fr, int fq) const {
#pragma unroll
    for (int ai = 0; ai < 2; ++ai)
#pragma unroll
      for (int m = 0; m < 4; ++m) {
        const int r = ROW256(ai, m);
#pragma unroll
        for (int bj = 0; bj < 2; ++bj)
#pragma unroll
          for (int n = 0; n < 2; ++n) {
            const int c = COL256(bj, n);
            const f32x4 v = acc[ai][bj][m][n];
            if (c < 2048) {
              if (r < TL) { u32x2 o; o.x = pack_bf16(gelu_tanh(v[0]), gelu_tanh(v[1])); o.y = pack_bf16(gelu_tanh(v[2]), gelu_tanh(v[3])); *(u32x2*)(GATE + (size_t)r * D + c) = o; }
            } else {
              u32x2 o; o.x = pack_bf16(v[0], v[1]); o.y = pack_bf16(v[2], v[3]); *(u32x2*)(UBR + (size_t)r * D + (c - 2048)) = o;
            }
          }
      }
  }
};
constexpr int NSB = 32;
template <class Epi>
__device__ __forceinline__ void gemm256(const Params& p, const bf16_t* A, const bf16_t* Bt, int M, int N, int K, unsigned char* lds, const Epi& e, const ItemRanges fill) {
  const bool streaming = fill.n1 + fill.n2 > 0;
  if (streaming && (int)blockIdx.x < NSB) {
    const int tid0 = tidx();
    for (int k = (int)blockIdx.x; k < fill.n1 + fill.n2; k += NSB) quant_rows_item(p, k < fill.n1 ? fill.lo1 + k : fill.lo2 + (k - fill.n1), tid0);
    return;
  }
  const int nsb = streaming ? NSB : 0;
  pg8::Gemm g{A, Bt, K, K}; pg8::StaticOrder S; S.init(M, N, K, K, (int)gridDim.x - nsb, (int)blockIdx.x - nsb);
  pg8::gemm_phase((PG8_LAS unsigned char*)lds, g, S, e);
}
struct EpiCoef256 {
  const float *b_a, *b_x, *SP; const bf16_t* UC; bf16_t* LAB;
  __device__ __forceinline__ void operator()(const f32x4 (&acc)[2][2][4][2], const pg8::Unit& u, int wr, int wc, int fr_, int fq_) const {
    int fr = fr_, fq = fq_; asm volatile("" : "+v"(fr), "+v"(fq));
    const int dir = u.pn >> 4, blk = (u.pn >> 1) & 7, half = u.pn & 1;
    bf16_t* LA = LAB + (size_t)(dir * 2) * TT * D; bf16_t* LB = LA + (size_t)TT * D;
#pragma unroll
    for (int n = 0; n < 2; ++n) {
      const int c = blk * 256 + half * 128 + 64 * (wc >> 1) + 16 * (wc & 1) + 32 * n + 4 * fq;
      const f32x4 ba = *(const f32x4*)(b_a + dir * D + c), bx = *(const f32x4*)(b_x + dir * D + c), sp = *(const f32x4*)(SP + dir * D + c);
#pragma unroll
      for (int ai = 0; ai < 2; ++ai)
#pragma unroll
        for (int m = 0; m < 4; ++m) {
          const int r = u.pm * 256 + ai * 128 + wr * 64 + m * 16 + fr;
          const u32x2 uu = *(const u32x2*)(UC + (size_t)r * D + c);
          const float uv[4] = {__uint_as_float(uu.x << 16), __uint_as_float(uu.x & 0xffff0000u), __uint_as_float(uu.y << 16), __uint_as_float(uu.y & 0xffff0000u)};
          float lav[4], bv[4];
#pragma unroll
          for (int j = 0; j < 4; ++j) {
            const float rg = __builtin_amdgcn_rcpf(1.0f + __expf(-(acc[ai][0][m][n][j] + ba[j])));
            const float ig = __builtin_amdgcn_rcpf(1.0f + __expf(-(acc[ai][1][m][n][j] + bx[j])));
            const float log_a = -8.0f * rg * sp[j];
            lav[j] = log_a;
            bv[j] = __builtin_amdgcn_sqrtf(fmaxf(1.0f - __expf(2.0f * log_a), 0.f)) * ig * uv[j];
          }
          u32x2 o1, o2; o1.x = pack_bf16(lav[0], lav[1]); o1.y = pack_bf16(lav[2], lav[3]); o2.x = pack_bf16(bv[0], bv[1]); o2.y = pack_bf16(bv[2], bv[3]);
          *(u32x2*)(LA + (size_t)r * D + c) = o1;
          *(u32x2*)(LB + (size_t)r * D + c) = o2;
        }
    }
  }
};
__device__ __forceinline__ void coef_phase(const Params& p, unsigned char* lds) {
  EpiCoef256 e{p.rec_b_a, p.rec_b_x, (const float*)(p.ws + OFF_SP), (const bf16_t*)(p.ws + OFF_O), (bf16_t*)(p.ws + OFF_LAB)};
  pg8::Gemm g{(const bf16_t*)(p.ws + OFF_O), (const bf16_t*)(p.ws + OFF_WA), 256, D}; pg8::CoefOrder S; S.init((int)gridDim.x, (int)blockIdx.x);
  pg8::gemm_phase((PG8_LAS unsigned char*)lds, g, S, e);
}

constexpr int KLD = 136, VLD = 72;
__device__ __forceinline__ void attn_phase(const Params& p, unsigned char* lds) {
  const bf16_t* Q = (const bf16_t*)(p.ws + OFF_Q); const bf16_t* Kg = (const bf16_t*)(p.ws + OFF_K); const bf16_t* VT = (const bf16_t*)(p.ws + OFF_VT);
  bf16_t* O = (bf16_t*)(p.ws + OFF_O);
  bf16_t* Ks = (bf16_t*)lds;
  bf16_t* Vs = Ks + 64 * KLD;
  const int tid = tidx(), wid = tid >> 6, lane = tid & 63, fr = lane & 15, fq = lane >> 4;
  const int g = wid >> 1, rh = wid & 1;
  const float scale = 0.08838834764831845f;
  for (int item = blockIdx.x; item < 1088; item += gridDim.x) {
    int b, hk, qb, qrow0, nlat, kt0;
    if (item < 1024) { b = item >> 8; hk = (item >> 6) & 3; qb = item & 63; qrow0 = b * S + qb * 64; kt0 = qb - 2 < 0 ? 0 : qb - 2; const int kt1 = qb + 2 > 63 ? 63 : qb + 2; nlat = kt1 - kt0 + 1; }
    else { const int ci = item - 1024; b = ci >> 4; hk = (ci >> 2) & 3; qb = ci & 3; qrow0 = TL + b * CL + qb * 64; kt0 = 0; nlat = 0; }
    const int head = hk * 4 + g;
    const float sink = p.attn_sink[head];
    bf16x8 qf[2][4];
#pragma unroll
    for (int rt = 0; rt < 2; ++rt)
#pragma unroll
      for (int ks = 0; ks < 4; ++ks) qf[rt][ks] = *(const bf16x8*)(Q + (size_t)(qrow0 + rh * 32 + rt * 16 + fr) * D + head * 128 + ks * 32 + fq * 8);
    f32x4 oacc[2][8]; float mst[2], lst[2];
#pragma unroll
    for (int rt = 0; rt < 2; ++rt) {
#pragma unroll
      for (int dt = 0; dt < 8; ++dt) oacc[rt][dt] = (f32x4){0.f, 0.f, 0.f, 0.f};
      mst[rt] = sink; lst[rt] = fq == 0 ? 1.0f : 0.f;
    }
    const int ntiles = nlat + 4;
    int kdst[2], vdst[2]; size_t ksrc[2], vsrc[2];
#pragma unroll
    for (int i = 0; i < 2; ++i) {
      const int id = tid + 512 * i;
      const int key = id >> 4, dc = (id & 15) * 8;
      const int kk = key & 31, prow = (key & 32) + ((kk >> 2) & 1) * 16 + (kk >> 3) * 4 + (kk & 3);
      kdst[i] = prow * KLD + dc; ksrc[i] = (size_t)key * 512 + hk * 128 + dc;
      const int d = id >> 3, kc = (id & 7) * 8;
      vdst[i] = d * VLD + kc; vsrc[i] = (size_t)(hk * 128 + d) * TT + kc;
    }
    u32x4 kreg[2], vreg[2];
    {
      const int krow0 = nlat > 0 ? (b * S + kt0 * 64) : (TL + b * CL);
#pragma unroll
      for (int i = 0; i < 2; ++i) { kreg[i] = *(const u32x4*)(Kg + (size_t)krow0 * 512 + ksrc[i]); vreg[i] = *(const u32x4*)(VT + vsrc[i] + krow0); }
    }
    for (int ti = 0; ti < ntiles; ++ti) {
      const bool lat = ti < nlat;
      __syncthreads();
#pragma unroll
      for (int i = 0; i < 2; ++i) { *(u32x4*)(Ks + kdst[i]) = kreg[i]; *(u32x4*)(Vs + vdst[i]) = vreg[i]; }
      if (ti + 1 < ntiles) {
        const int tn = ti + 1;
        const int krow0 = tn < nlat ? (b * S + (kt0 + tn) * 64) : (TL + b * CL + (tn - nlat) * 64);
#pragma unroll
        for (int i = 0; i < 2; ++i) { kreg[i] = *(const u32x4*)(Kg + (size_t)krow0 * 512 + ksrc[i]); vreg[i] = *(const u32x4*)(VT + vsrc[i] + krow0); }
      }
      __syncthreads();
      f32x4 st[2][2][2];
#pragma unroll
      for (int rt = 0; rt < 2; ++rt)
#pragma unroll
        for (int kp = 0; kp < 2; ++kp)
#pragma unroll
          for (int t = 0; t < 2; ++t) st[rt][kp][t] = (f32x4){0.f, 0.f, 0.f, 0.f};
#pragma unroll
      for (int kp = 0; kp < 2; ++kp)
#pragma unroll
        for (int t = 0; t < 2; ++t)
#pragma unroll
          for (int ks = 0; ks < 4; ++ks) {
            const bf16x8 kf = *(const bf16x8*)(Ks + (kp * 32 + t * 16 + fr) * KLD + ks * 32 + fq * 8);
            st[0][kp][t] = __builtin_amdgcn_mfma_f32_16x16x32_bf16(kf, qf[0][ks], st[0][kp][t], 0, 0, 0);
            st[1][kp][t] = __builtin_amdgcn_mfma_f32_16x16x32_bf16(kf, qf[1][ks], st[1][kp][t], 0, 0, 0);
          }
      unsigned pk[2][2][4];
#pragma unroll
      for (int rt = 0; rt < 2; ++rt) {
        const int ipos = qb * 64 + rh * 32 + rt * 16 + fr;
        float mx = -INFINITY;
#pragma unroll
        for (int kp = 0; kp < 2; ++kp)
#pragma unroll
          for (int t = 0; t < 2; ++t)
#pragma unroll
            for (int j = 0; j < 4; ++j) {
              float v = st[rt][kp][t][j] * scale;
              if (lat) { const int dd = ipos - ((kt0 + ti) * 64 + kp * 32 + fq * 8 + t * 4 + j); if (dd > 128 || dd < -128) v = -INFINITY; }
              st[rt][kp][t][j] = v; mx = fmaxf(mx, v);
            }
        mx = fmaxf(mx, __shfl_xor(mx, 16)); mx = fmaxf(mx, __shfl_xor(mx, 32));
        const float mn = fmaxf(mst[rt], mx);
        const float alpha = __expf(mst[rt] - mn);
        mst[rt] = mn;
        float rs = 0.f;
#pragma unroll
        for (int kp = 0; kp < 2; ++kp)
#pragma unroll
          for (int t = 0; t < 2; ++t) {
            const float p0 = __expf(st[rt][kp][t][0] - mn), p1 = __expf(st[rt][kp][t][1] - mn), p2 = __expf(st[rt][kp][t][2] - mn), p3 = __expf(st[rt][kp][t][3] - mn);
            rs += (p0 + p1) + (p2 + p3);
            pk[rt][kp][t * 2] = pack_bf16(p0, p1); pk[rt][kp][t * 2 + 1] = pack_bf16(p2, p3);
          }
        lst[rt] = lst[rt] * alpha + rs;
#pragma unroll
        for (int dt = 0; dt < 8; ++dt) oacc[rt][dt] *= alpha;
      }
#pragma unroll
      for (int kp = 0; kp < 2; ++kp) {
        const bf16x8 pf0 = __builtin_bit_cast(bf16x8, (u32x4){pk[0][kp][0], pk[0][kp][1], pk[0][kp][2], pk[0][kp][3]});
        const bf16x8 pf1 = __builtin_bit_cast(bf16x8, (u32x4){pk[1][kp][0], pk[1][kp][1], pk[1][kp][2], pk[1][kp][3]});
#pragma unroll
        for (int dt = 0; dt < 8; ++dt) {
          const bf16x8 vf = *(const bf16x8*)(Vs + (dt * 16 + fr) * VLD + kp * 32 + fq * 8);
          oacc[0][dt] = __builtin_amdgcn_mfma_f32_16x16x32_bf16(vf, pf0, oacc[0][dt], 0, 0, 0);
          oacc[1][dt] = __builtin_amdgcn_mfma_f32_16x16x32_bf16(vf, pf1, oacc[1][dt], 0, 0, 0);
        }
      }
    }
#pragma unroll
    for (int rt = 0; rt < 2; ++rt) {
      float l = lst[rt]; l += __shfl_xor(l, 16); l += __shfl_xor(l, 32);
      const float inv = 1.0f / l;
      bf16_t* orow = O + (size_t)(qrow0 + rh * 32 + rt * 16 + fr) * D + head * 128 + 4 * fq;
#pragma unroll
      for (int dt = 0; dt < 8; ++dt) {
        u32x2 o; o.x = pack_bf16(oacc[rt][dt][0] * inv, oacc[rt][dt][1] * inv); o.y = pack_bf16(oacc[rt][dt][2] * inv, oacc[rt][dt][3] * inv);
        *(u32x2*)(orow + dt * 16) = o;
      }
    }
  }
}

#define CE_DESC(a, b) { const float _hi = fmaxf(a, b), _lo = fminf(a, b); a = _hi; b = _lo; }
__device__ __forceinline__ void bitonic_sort_desc16(float (&a)[16]) {
#pragma unroll
  for (int ks = 1; ks <= 4; ++ks)
#pragma unroll
    for (int js = ks - 1; js >= 0; --js)
#pragma unroll
      for (int i = 0; i < 16; ++i) { const int k = 1 << ks, j = 1 << js, l = i ^ j; if (l > i) { if ((i & k) == 0) CE_DESC(a[i], a[l]) else CE_DESC(a[l], a[i]) } }
}
__device__ __forceinline__ void bitonic_merge_desc16(float (&a)[16]) {
#pragma unroll
  for (int js = 3; js >= 0; --js)
#pragma unroll
    for (int i = 0; i < 16; ++i) { const int j = 1 << js, l = i ^ j; if (l > i) CE_DESC(a[i], a[l]) }
}
__device__ __forceinline__ void top16_merge(float (&L)[16], float (&G)[16]) {
  bitonic_sort_desc16(G);
#pragma unroll
  for (int i = 0; i < 16; ++i) L[i] = fmaxf(L[i], G[15 - i]);
  bitonic_merge_desc16(L);
}
__host__ __device__ constexpr int cand_code(int c) {
  int n = 0;
  for (int i = 0; i < 16; ++i) for (int j = 0; j < 16 / (i + 1); ++j) { if (n == c) return (i << 4) | j; ++n; }
  return -1;
}
template <int C> struct CandCode { static constexpr int value = cand_code(C); };

__device__ __forceinline__ void peer_route_phase(const Params& p, int layer, int ntok, unsigned char* lds) {
  const int tid = tidx(), wid = tid >> 6, lane = tid & 63, fr = lane & 15, fq = lane >> 4;
  float* Sw = (float*)(lds + wid * 9216);
  const bf16_t* keysG = (const bf16_t*)(p.ws + OFF_KEYS) + (size_t)layer * 2 * 128 * 128;
  const bf16_t* PQ = (const bf16_t*)(p.ws + OFF_PQ);
  int* IDX = (int*)(p.ws + OFF_IDX); float* GW = (float*)(p.ws + OFF_GW);
  const int total = (ntok >> 6) * 8;
  for (int id = blockIdx.x * 8 + wid; id < total; id += gridDim.x * 8) {
    const int tile = id >> 3, head = id & 7, tok0 = tile * 64;
    float Lk[2][16];
#pragma unroll
    for (int pp = 0; pp < 2; ++pp) {
      bf16x8 qf[4][4];
#pragma unroll
      for (int mt = 0; mt < 4; ++mt)
#pragma unroll
        for (int ks = 0; ks < 4; ++ks) qf[mt][ks] = *(const bf16x8*)(PQ + (size_t)(tok0 + mt * 16 + fr) * D + head * 256 + pp * 128 + ks * 32 + fq * 8);
#pragma unroll
      for (int s2 = 0; s2 < 16; ++s2) Lk[pp][s2] = -INFINITY;
      bf16x8 kf[2][4], kfn[2][4];
#pragma unroll
      for (int nt = 0; nt < 2; ++nt)
#pragma unroll
        for (int ks = 0; ks < 4; ++ks) kf[nt][ks] = *(const bf16x8*)(keysG + (size_t)(pp * 128 + nt * 16 + fr) * 128 + ks * 32 + fq * 8);
#pragma unroll 1
      for (int pass = 0; pass < 4; ++pass) {
        const int pn = pass < 3 ? pass + 1 : 3;
#pragma unroll
        for (int nt = 0; nt < 2; ++nt)
#pragma unroll
          for (int ks = 0; ks < 4; ++ks) kfn[nt][ks] = *(const bf16x8*)(keysG + (size_t)(pp * 128 + pn * 32 + nt * 16 + fr) * 128 + ks * 32 + fq * 8);
        f32x4 acc[2][4];
#pragma unroll
        for (int nt = 0; nt < 2; ++nt)
#pragma unroll
          for (int mt = 0; mt < 4; ++mt) acc[nt][mt] = (f32x4){0.f, 0.f, 0.f, 0.f};
#pragma unroll
        for (int nt = 0; nt < 2; ++nt)
#pragma unroll
          for (int ks = 0; ks < 4; ++ks)
#pragma unroll
            for (int mt = 0; mt < 4; ++mt) acc[nt][mt] = __builtin_amdgcn_mfma_f32_16x16x32_bf16(kf[nt][ks], qf[mt][ks], acc[nt][mt], 0, 0, 0);
#pragma unroll
        for (int nt = 0; nt < 2; ++nt)
#pragma unroll
          for (int mt = 0; mt < 4; ++mt) *(f32x4*)(Sw + (mt * 16 + fr) * 36 + nt * 16 + 4 * fq) = acc[nt][mt];
        __builtin_amdgcn_fence(__ATOMIC_RELEASE, "wavefront"); __builtin_amdgcn_wave_barrier(); __builtin_amdgcn_fence(__ATOMIC_ACQUIRE, "wavefront");
#pragma unroll
        for (int g = 0; g < 2; ++g) {
          float G[16];
#pragma unroll
          for (int c = 0; c < 4; ++c) {
            const f32x4 sv = *(const f32x4*)(Sw + lane * 36 + g * 16 + c * 4);
#pragma unroll
            for (int e = 0; e < 4; ++e) G[c * 4 + e] = __uint_as_float((__float_as_uint(sv[e]) & ~0x7fu) | (unsigned)(pass * 32 + g * 16 + c * 4 + e));
          }
          top16_merge(Lk[pp], G);
        }
#pragma unroll
        for (int nt = 0; nt < 2; ++nt)
#pragma unroll
          for (int ks = 0; ks < 4; ++ks) kf[nt][ks] = kfn[nt][ks];
      }
    }
#pragma unroll
    for (int pp = 0; pp < 2; ++pp)
#pragma unroll
      for (int s2 = 0; s2 < 16; ++s2) Sw[(pp * 16 + s2) * 64 + lane] = Lk[pp][s2];
    float v1[16], v2[16];
#pragma unroll
    for (int s2 = 0; s2 < 16; ++s2) { v1[s2] = __uint_as_float(__float_as_uint(Lk[0][s2]) & ~0x7fu); v2[s2] = __uint_as_float(__float_as_uint(Lk[1][s2]) & ~0x7fu); }
    float T[16];
#pragma unroll
    for (int s2 = 0; s2 < 16; ++s2) T[s2] = -INFINITY;
#define ROUTE_GROUP(G0) { float G[16]; \
      _Pragma("unroll") for (int q = 0; q < 16; ++q) G[q] = -INFINITY; \
      ROUTE_FILL(G0 + 0) ROUTE_FILL(G0 + 1) ROUTE_FILL(G0 + 2) ROUTE_FILL(G0 + 3) ROUTE_FILL(G0 + 4) ROUTE_FILL(G0 + 5) ROUTE_FILL(G0 + 6) ROUTE_FILL(G0 + 7) \
      ROUTE_FILL(G0 + 8) ROUTE_FILL(G0 + 9) ROUTE_FILL(G0 + 10) ROUTE_FILL(G0 + 11) ROUTE_FILL(G0 + 12) ROUTE_FILL(G0 + 13) ROUTE_FILL(G0 + 14) ROUTE_FILL(G0 + 15) \
      top16_merge(T, G); }
#define ROUTE_FILL(C) { constexpr int code = CandCode<(C)>::value; if constexpr (code >= 0) G[(C) & 15] = __uint_as_float((__float_as_uint(v1[code >> 4] + v2[code & 15]) & ~0xffu) | (unsigned)code); }
    ROUTE_GROUP(0) ROUTE_GROUP(16) ROUTE_GROUP(32) ROUTE_GROUP(48)
#undef ROUTE_FILL
#undef ROUTE_GROUP
    asm volatile("s_waitcnt lgkmcnt(0)" ::: "memory");
    int E[16];
#pragma unroll
    for (int s2 = 0; s2 < 16; ++s2) {
      const unsigned code = __float_as_uint(T[s2]) & 0xffu;
      const unsigned k1 = __float_as_uint(Sw[(code >> 4) * 64 + lane]) & 0x7fu, k2 = __float_as_uint(Sw[(16 + (code & 15u)) * 64 + lane]) & 0x7fu;
      E[s2] = (int)(k1 * 128u + k2);
      T[s2] = __uint_as_float(__float_as_uint(T[s2]) & ~0xffu);
    }
    asm volatile("s_waitcnt lgkmcnt(0)" ::: "memory");
    const size_t o = ((size_t)(tok0 + lane) * 8 + head) * 16;
    const float tmax = T[0];
    float ssum = 0.f;
#pragma unroll
    for (int s2 = 0; s2 < 16; ++s2) { T[s2] = __expf(T[s2] - tmax); ssum += T[s2]; }
    const float inv = 1.0f / ssum;
#pragma unroll
    for (int c = 0; c < 4; ++c) {
      *(f32x4*)(GW + o + c * 4) = (f32x4){T[c * 4] * inv, T[c * 4 + 1] * inv, T[c * 4 + 2] * inv, T[c * 4 + 3] * inv};
      typedef int i32x4 __attribute__((ext_vector_type(4)));
      *(i32x4*)(IDX + o + c * 4) = (i32x4){E[c * 4], E[c * 4 + 1], E[c * 4 + 2], E[c * 4 + 3]};
    }
  }
}

constexpr int PG = 2;
struct PeerBuf { u32x4 u[PG][2], v[PG][2]; float su[PG], sv[PG], g[PG]; };
__device__ __forceinline__ void peer_load(PeerBuf& B, const unsigned char* UT8, const unsigned char* VT8, const float* USC, const float* VSC, int ireg, float greg, int k0, int lane) {
#pragma unroll
  for (int j = 0; j < PG; ++j) {
    const int e = __builtin_amdgcn_readlane(ireg, k0 + j);
    B.g[j] = __builtin_bit_cast(float, __builtin_amdgcn_readlane(__builtin_bit_cast(int, greg), k0 + j));
    const unsigned char* ur = UT8 + (size_t)e * D + lane * 16; const unsigned char* vr = VT8 + (size_t)e * D + lane * 16;
    B.u[j][0] = *(const u32x4*)ur; B.u[j][1] = *(const u32x4*)(ur + 1024);
    B.v[j][0] = *(const u32x4*)vr; B.v[j][1] = *(const u32x4*)(vr + 1024);
    B.su[j] = USC[e]; B.sv[j] = VSC[e];
  }
}
__device__ __forceinline__ void peer_compute(const PeerBuf& B, const float (&hreg)[2][16], float hsum, float (&accv)[2][16], float& corr) {
#pragma unroll
  for (int j = 0; j < PG; ++j) {
    float dsum = 0.f;
#pragma unroll
    for (int c = 0; c < 2; ++c)
#pragma unroll
      for (int t = 0; t < 4; ++t) {
        const unsigned w = B.u[j][c][t];
        dsum += (float)(w & 0xffu) * hreg[c][4 * t] + (float)((w >> 8) & 0xffu) * hreg[c][4 * t + 1] + (float)((w >> 16) & 0xffu) * hreg[c][4 * t + 2] + (float)(w >> 24) * hreg[c][4 * t + 3];
      }
    const float z = B.su[j] * (wave_sum(dsum) - 128.0f * hsum);
    const float act = gelu_tanh(z) * B.g[j] * B.sv[j];
    corr += act;
#pragma unroll
    for (int c = 0; c < 2; ++c)
#pragma unroll
      for (int t = 0; t < 4; ++t) {
        const unsigned w = B.v[j][c][t];
        accv[c][4 * t] += act * (float)(w & 0xffu); accv[c][4 * t + 1] += act * (float)((w >> 8) & 0xffu); accv[c][4 * t + 2] += act * (float)((w >> 16) & 0xffu); accv[c][4 * t + 3] += act * (float)(w >> 24);
      }
  }
}
__device__ __forceinline__ void peer_gather_phase(const Params& p, int layer, int ntok, int gate_layer, bool dry = false) {
  const int tid = tidx(), wid = tid >> 6, lane = tid & 63;
  const bf16_t* H = (const bf16_t*)(p.ws + OFF_H);
  const int* IDX = (const int*)(p.ws + OFF_IDX); const float* GW = (const float*)(p.ws + OFF_GW);
  const unsigned char* UT8 = p.ws + OFF_UTAB + (size_t)layer * NEXP * D; const unsigned char* VT8 = p.ws + OFF_VTAB + (size_t)layer * NEXP * D;
  const float* USC = (const float*)(p.ws + OFF_USC) + (size_t)layer * NEXP; const float* VSC = (const float*)(p.ws + OFF_VSC) + (size_t)layer * NEXP;
  float* XS = (float*)(p.ws + OFF_XS);
  const float* gate = (const float*)(p.ws + OFF_MODV) + (size_t)(gate_layer * 5) * NMOD + 5 * D;
  for (int tok = blockIdx.x * 8 + wid; tok < ntok; tok += gridDim.x * 8) {
    const int i0 = IDX[(size_t)tok * 128 + lane], i1 = IDX[(size_t)tok * 128 + 64 + lane];
    const float g0 = GW[(size_t)tok * 128 + lane], g1 = GW[(size_t)tok * 128 + 64 + lane];
    PeerBuf A, B;
    peer_load(A, UT8, VT8, USC, VSC, i0, g0, 0, lane);
    float hreg[2][16]; float hsum = 0.f;
#pragma unroll
    for (int c = 0; c < 2; ++c)
#pragma unroll
      for (int hh = 0; hh < 2; ++hh) {
        const u32x4 hv = *(const u32x4*)(H + (size_t)tok * D + c * 1024 + lane * 16 + hh * 8);
#pragma unroll
        for (int t = 0; t < 4; ++t) { hreg[c][hh * 8 + 2 * t] = __uint_as_float(hv[t] << 16); hreg[c][hh * 8 + 2 * t + 1] = __uint_as_float(hv[t] & 0xffff0000u); hsum += hreg[c][hh * 8 + 2 * t] + hreg[c][hh * 8 + 2 * t + 1]; }
      }
    hsum = wave_sum(hsum);
    float accv[2][16]; float corr = 0.f;
#pragma unroll
    for (int c = 0; c < 2; ++c)
#pragma unroll
      for (int j = 0; j < 16; ++j) accv[c][j] = 0.f;
#pragma unroll 1
    for (int half = 0; half < 2; ++half) {
      const int ireg = half ? i1 : i0; const float greg = half ? g1 : g0;
#pragma unroll 1
      for (int k0 = 0; k0 < 64; k0 += 2 * PG) {
        peer_load(B, UT8, VT8, USC, VSC, ireg, greg, k0 + PG, lane);
        peer_compute(A, hreg, hsum, accv, corr);
        if (k0 + 2 * PG < 64) peer_load(A, UT8, VT8, USC, VSC, ireg, greg, k0 + 2 * PG, lane);
        else if (half == 0) peer_load(A, UT8, VT8, USC, VSC, i1, g1, 0, lane);
        peer_compute(B, hreg, hsum, accv, corr);
      }
    }
    corr *= 128.0f;
    const int mrow = mod_row(tok);
    const float* gr = gate + (size_t)mrow * NMOD; float* xr = XS + (size_t)tok * D;
    float ss = 0.f;
#pragma unroll
    for (int c = 0; c < 2; ++c)
#pragma unroll
      for (int t = 0; t < 4; ++t) {
        const int col = c * 1024 + lane * 16 + 4 * t;
        const f32x4 gg = *(const f32x4*)(gr + col), xo = *(const f32x4*)(xr + col);
#pragma unroll
        for (int j = 0; j < 4; ++j) { const float xn = xo[j] + gg[j] * (accv[c][4 * t + j] - corr); accv[c][4 * t + j] = xn; ss += xn * xn; }
      }
    ss = wave_sum(ss);
    const float rs = rsqrtf(ss * (1.0f / D) + 1e-6f);
    if (dry && rs != 12345.678f) continue;
    if (layer == 0) {
      const float* mv = (const float*)(p.ws + OFF_MODV) + (size_t)(5 + mrow) * NMOD;
      const float* gn = p.norm_mix + D;
      bf16_t* hr = (bf16_t*)(p.ws + OFF_H) + (size_t)tok * D;
#pragma unroll
      for (int c = 0; c < 2; ++c)
#pragma unroll
        for (int t = 0; t < 4; ++t) {
          const int col = c * 1024 + lane * 16 + 4 * t;
          *(f32x4*)(xr + col) = (f32x4){accv[c][4 * t], accv[c][4 * t + 1], accv[c][4 * t + 2], accv[c][4 * t + 3]};
          const f32x4 g = *(const f32x4*)(gn + col), sh = *(const f32x4*)(mv + col), sc = *(const f32x4*)(mv + D + col);
          u32x2 o; o.x = pack_bf16(accv[c][4 * t] * rs * g[0] * (1.0f + sc[0]) + sh[0], accv[c][4 * t + 1] * rs * g[1] * (1.0f + sc[1]) + sh[1]);
          o.y = pack_bf16(accv[c][4 * t + 2] * rs * g[2] * (1.0f + sc[2]) + sh[2], accv[c][4 * t + 3] * rs * g[3] * (1.0f + sc[3]) + sh[3]);
          *(u32x2*)(hr + col) = o;
        }
    } else {
      float* orow = p.out + (size_t)tok * D;
#pragma unroll
      for (int c = 0; c < 2; ++c)
#pragma unroll
        for (int t = 0; t < 4; ++t) {
          const int col = c * 1024 + lane * 16 + 4 * t;
          const f32x4 g = *(const f32x4*)(p.norm_final + col);
          *(f32x4*)(orow + col) = (f32x4){accv[c][4 * t] * rs * g[0], accv[c][4 * t + 1] * rs * g[1], accv[c][4 * t + 2] * rs * g[2], accv[c][4 * t + 3] * rs * g[3]};
        }
    }
  }
}

__device__ __forceinline__ void conv_phase(const Params& p) {
  const bf16_t* UBR = (const bf16_t*)(p.ws + OFF_Q); bf16_t* UC = (bf16_t*)(p.ws + OFF_O);
  const int tid = tidx(), c = (tid & 255) * 8, hrow = tid >> 8;
  float w[4][8], bias[8];
#pragma unroll
  for (int k = 0; k < 4; ++k) { const float4 w0 = *(const float4*)(p.rec_conv_w + k * D + c), w1 = *(const float4*)(p.rec_conv_w + k * D + c + 4); w[k][0] = w0.x; w[k][1] = w0.y; w[k][2] = w0.z; w[k][3] = w0.w; w[k][4] = w1.x; w[k][5] = w1.y; w[k][6] = w1.z; w[k][7] = w1.w; }
  { const float4 b0 = *(const float4*)(p.rec_conv_b + c), b1 = *(const float4*)(p.rec_conv_b + c + 4); bias[0] = b0.x; bias[1] = b0.y; bias[2] = b0.z; bias[3] = b0.w; bias[4] = b1.x; bias[5] = b1.y; bias[6] = b1.z; bias[7] = b1.w; }
  const int nhalf = 2 * (int)gridDim.x, rows_per = (TT + nhalf - 1) / nhalf;
  const int r0 = ((int)blockIdx.x * 2 + hrow) * rows_per, r1 = r0 + rows_per < TT ? r0 + rows_per : TT;
  if (r0 < TT) {
    u32x4 win[4];
    const u32x4 zero = (u32x4){0u, 0u, 0u, 0u};
#pragma unroll
    for (int k = 0; k < 3; ++k) { const int rr = r0 - 1 + k; win[k] = (rr >= 0 && rr < TT) ? *(const u32x4*)(UBR + (size_t)rr * D + c) : zero; }
#pragma unroll 2
    for (int r = r0; r < r1; ++r) {
      const int rr = r + 2;
      win[3] = (rr < TT) ? *(const u32x4*)(UBR + (size_t)rr * D + c) : zero;
      const int seq_lo = r < TL ? (r & ~4095) : TL + ((r - TL) & ~255), seq_hi = seq_lo + (r < TL ? S : CL);
      float acc[8];
#pragma unroll
      for (int j = 0; j < 8; ++j) acc[j] = bias[j];
#pragma unroll
      for (int k = 0; k < 4; ++k) {
        const int rk = r - 1 + k; const bool ok = rk >= seq_lo && rk < seq_hi;
#pragma unroll
        for (int t = 0; t < 4; ++t) { const unsigned d = ok ? win[k][t] : 0u; acc[2 * t] += w[k][2 * t] * __uint_as_float(d << 16); acc[2 * t + 1] += w[k][2 * t + 1] * __uint_as_float(d & 0xffff0000u); }
      }
      u32x4 o; o.x = pack_bf16(acc[0], acc[1]); o.y = pack_bf16(acc[2], acc[3]); o.z = pack_bf16(acc[4], acc[5]); o.w = pack_bf16(acc[6], acc[7]);
      *(u32x4*)(UC + (size_t)r * D + c) = o;
      win[0] = win[1]; win[1] = win[2]; win[2] = win[3];
    }
  }
}

__device__ __forceinline__ void scan1_phase(const Params& p) {
  const bf16_t* LAB = (const bf16_t*)(p.ws + OFF_LAB);
  float* CHP = (float*)(p.ws + OFF_CHP); float* CHH = (float*)(p.ws + OFF_CHH);
  const int total = 2 * 272 * 4; const int tid = tidx();
  for (int item = blockIdx.x; item < total; item += gridDim.x) {
    const int cgp = item & 3, ch = (item >> 2) % 272, dir = item / (272 * 4);
    const int c = cgp * 512 + tid;
    const bf16_t* a = LAB + ((size_t)(dir * 2) * TT + ch * 64) * D + c; const bf16_t* b = LAB + ((size_t)(dir * 2 + 1) * TT + ch * 64) * D + c;
    float h = 0.f, ls = 0.f;
    if (dir == 0) {
#pragma unroll 16
      for (int t = 0; t < 64; ++t) { const float la = bf2f(a[(size_t)t * D]), bv = bf2f(b[(size_t)t * D]); h = __expf(la) * h + bv; ls += la; }
    } else {
#pragma unroll 16
      for (int t = 63; t >= 0; --t) { const float la = bf2f(a[(size_t)t * D]), bv = bf2f(b[(size_t)t * D]); h = __expf(la) * h + bv; ls += la; }
    }
    CHP[((size_t)dir * 272 + ch) * D + c] = __expf(ls); CHH[((size_t)dir * 272 + ch) * D + c] = h;
  }
}
__device__ __forceinline__ void scan2_phase(const Params& p) {
  const float* CHP = (const float*)(p.ws + OFF_CHP); const float* CHH = (const float*)(p.ws + OFF_CHH); float* CIN = (float*)(p.ws + OFF_CIN);
  for (int it = blockIdx.x * NT + tidx(); it < 2 * NB * D; it += gridDim.x * NT) {
    const int c = it & 2047, b = (it >> 11) & 3, dir = it >> 13;
    float carry = 0.f;
    for (int s = 0; s < 68; ++s) {
      int ch;
      if (dir == 0) ch = s < 4 ? (256 + 4 * b + s) : (64 * b + (s - 4));
      else ch = s < 4 ? (256 + 4 * b + (3 - s)) : (64 * b + (63 - (s - 4)));
      const size_t o = ((size_t)dir * 272 + ch) * D + c;
      CIN[o] = carry;
      carry = CHP[o] * carry + CHH[o];
    }
  }
}
__device__ __forceinline__ void scan3_phase(const Params& p, unsigned char* lds) {
  const bf16_t* LAB = (const bf16_t*)(p.ws + OFF_LAB); const float* CIN = (const float*)(p.ws + OFF_CIN);
  const bf16_t* GATE = (const bf16_t*)(p.ws + OFF_PQ); bf16_t* A2 = (bf16_t*)(p.ws + OFF_O);
  float* yf = (float*)lds;
  const int total = 256 * 4; const int tid = tidx();
  for (int item = blockIdx.x; item < total; item += gridDim.x) {
    const int cgp = item & 3, ch = item >> 2;
    const int c = cgp * 512 + tid;
    const size_t base = (size_t)ch * 64 * D + c;
    {
      const bf16_t* a = LAB + base; const bf16_t* b = LAB + (size_t)TT * D + base;
      float h = CIN[(size_t)ch * D + c];
#pragma unroll 1
      for (int t0 = 0; t0 < 64; t0 += 16) {
        bf16_t av[16], bv[16];
#pragma unroll
        for (int i = 0; i < 16; ++i) { av[i] = a[(size_t)(t0 + i) * D]; bv[i] = b[(size_t)(t0 + i) * D]; }
#pragma unroll
        for (int i = 0; i < 16; ++i) { h = __expf(bf2f(av[i])) * h + bf2f(bv[i]); yf[(t0 + i) * 512 + tid] = h; }
      }
    }
    {
      const bf16_t* a = LAB + (size_t)2 * TT * D + base; const bf16_t* b = LAB + (size_t)3 * TT * D + base;
      float h = CIN[((size_t)272 + ch) * D + c];
#pragma unroll 1
      for (int t0 = 48; t0 >= 0; t0 -= 16) {
        bf16_t av[16], bv[16], gv[16];
#pragma unroll
        for (int i = 0; i < 16; ++i) { av[i] = a[(size_t)(t0 + i) * D]; bv[i] = b[(size_t)(t0 + i) * D]; gv[i] = GATE[base + (size_t)(t0 + i) * D]; }
#pragma unroll
        for (int i = 15; i >= 0; --i) { h = __expf(bf2f(av[i])) * h + bf2f(bv[i]); A2[base + (size_t)(t0 + i) * D] = f2bf((yf[(t0 + i) * 512 + tid] + h) * bf2f(gv[i])); }
      }
    }
  }
}

#define XB_TMO      128
#define XB_XCNT(j)  (256  + 64 * (j))
#define XB_XSUB(j)  (1280 + 64 * (j))
#define XB_XGEN(j)  (2304 + 64 * (j))
#define XB_TOP      3328
#define XB_TOPGEN   3392
#define XCD_BAR_WORDS 3456
#define XB_SPIN_CAP (1u << 22)
#define LAS3 __attribute__((address_space(3)))
__device__ __forceinline__ unsigned xb_ld(unsigned* p)              { return __hip_atomic_load(p, __ATOMIC_RELAXED, __HIP_MEMORY_SCOPE_AGENT); }
__device__ __forceinline__ unsigned xb_add(unsigned* p, unsigned v) { return __hip_atomic_fetch_add(p, v, __ATOMIC_RELAXED, __HIP_MEMORY_SCOPE_AGENT); }
__device__ __forceinline__ unsigned xb_xcc_id() { return (unsigned)__builtin_amdgcn_s_getreg((3 << 11) | 20) & 0xFu; }
#define XB_SPIN(cond, bar) do { unsigned _sp = 0; while (cond) { __builtin_amdgcn_s_sleep(1); \
    if ((++_sp & 255u) == 0u) { if (xb_ld(&(bar)[XB_TMO])) break; if (_sp > XB_SPIN_CAP) { atomicAdd(&(bar)[XB_TMO], 1u); break; } } } } while (0)
struct XcdBarrier { unsigned* bar; unsigned x; volatile LAS3 unsigned* st; };
__device__ __forceinline__ XcdBarrier xcd_barrier_post(unsigned* bar, volatile LAS3 unsigned* st) {
  XcdBarrier b; b.bar = bar; b.x = xb_xcc_id(); b.st = st;
  if (threadIdx.x == 0) (void)xb_add(&bar[XB_XCNT(b.x)], 1u);
  return b;
}
__device__ __forceinline__ void xcd_barrier_complete(unsigned* bar, unsigned x, unsigned& nloc, unsigned& nx) {
  const unsigned G = gridDim.x * gridDim.y * gridDim.z;
  unsigned sum, cnt, mine, sp = 0u;
  for (;;) {
    sum = 0u; cnt = 0u; mine = 0u;
#pragma unroll
    for (unsigned j = 0; j < 16; ++j) { const unsigned c = xb_ld(&bar[XB_XCNT(j)]); sum += c; cnt += (c > 0u) ? 1u : 0u; mine = (j == x) ? c : mine; }
    if (sum == G) break;
    __builtin_amdgcn_s_sleep(1);
    if ((++sp & 255u) == 0u) { if (xb_ld(&bar[XB_TMO])) break; if (sp > XB_SPIN_CAP) { atomicAdd(&bar[XB_TMO], 1u); break; } }
  }
  nloc = mine > 0u ? mine : 1u; nx = cnt > 0u ? cnt : 1u;
}
__device__ __forceinline__ void xcd_barrier(const XcdBarrier& b) {
  asm volatile("s_waitcnt vmcnt(0)" ::: "memory");
  __syncthreads();
  if (threadIdx.x == 0) {
    unsigned* bar = b.bar;
    __builtin_amdgcn_s_waitcnt(0);
    unsigned nloc = b.st[0], nx = b.st[1];
    if (nloc == 0u) { xcd_barrier_complete(bar, b.x, nloc, nx); b.st[0] = nloc; b.st[1] = nx; }
    const unsigned old = xb_add(&bar[XB_XSUB(b.x)], 1u);
    const unsigned gen = old / nloc;
    if (old + 1u == (gen + 1u) * nloc) {
      __builtin_amdgcn_fence(__ATOMIC_RELEASE, "agent");
      asm volatile("s_waitcnt vmcnt(0)" ::: "memory");
      const unsigned og = xb_add(&bar[XB_TOP], 1u);
      const unsigned tg = og / nx;
      if (og + 1u == (tg + 1u) * nx) xb_add(&bar[XB_TOPGEN], 1u);
      else XB_SPIN(xb_ld(&bar[XB_TOPGEN]) == tg, bar);
      __builtin_amdgcn_fence(__ATOMIC_ACQUIRE, "agent");
      xb_add(&bar[XB_XGEN(b.x)], 1u);
      asm volatile("s_waitcnt vmcnt(0)" ::: "memory");
    } else {
      XB_SPIN(xb_ld(&bar[XB_XGEN(b.x)]) == gen, bar);
      __builtin_amdgcn_fence(__ATOMIC_ACQUIRE, "agent");
      asm volatile("s_waitcnt vmcnt(0)" ::: "memory");
    }
  }
  __syncthreads();
}

__global__ void __launch_bounds__(NT) fwd_megakernel(Params p) {
  extern __shared__ __attribute__((aligned(16))) unsigned char lds[];
  cg::grid_group grid = cg::this_grid();
  unsigned char* ws = p.ws;
  float* MODV = (float*)(ws + OFF_MODV);
  float* XS = (float*)(ws + OFF_XS);
  bf16_t* H = (bf16_t*)(ws + OFF_H);

  unsigned* bar = (unsigned*)(ws + OFF_BAR);
  if (blockIdx.x == 0) for (int i = threadIdx.x; i < XCD_BAR_WORDS; i += NT) bar[i] = 0u;
  volatile LAS3 unsigned* st = (volatile LAS3 unsigned*)((LAS3 unsigned char*)lds + 128 * 1024);
  if (threadIdx.x == 0) { st[0] = 0u; st[1] = 0u; }
  setup_phase(p, lds);
  if (PROBE == 1) { grid.sync(); setup_phase(p, lds); }
  grid.sync();
  const XcdBarrier xb = xcd_barrier_post(bar, st);
#define GSYNC() xcd_barrier(xb)
  {
    constexpr int ntok = TT;
    PH(2, norm_phase(p, 0, p.norm_mix + 0 * D, 0, TT, true, H));
    GSYNC();
      {
        EpiQKV256 e{(bf16_t*)(ws + OFF_Q), (bf16_t*)(ws + OFF_K), (bf16_t*)(ws + OFF_VT), (const float*)(ws + OFF_ROPE), (const float*)(ws + OFF_ROPE) + 2048};
        PH(3, gemm256(p, H, (const bf16_t*)(ws + OFF_WQKV), TT, 3072, D, lds, e, ItemRanges{0, 1024, 0, 0}));
      }
      GSYNC();
      PH(4, attn_phase(p, lds));
      GSYNC();
    {
      EpiResid256 e{p.x, p.ctx, XS, MODV + (size_t)(0 * 5) * NMOD + 2 * D, true};
      gemm256(p, (const bf16_t*)(ws + OFF_O), (const bf16_t*)(ws + (OFF_WO)), ntok, D, D, lds, e, ItemRanges{2048, 1024, 0, 0});
    }
    GSYNC();
    PH(6, norm_phase(p, 0, p.norm_ffn + 0 * D, 3, ntok, false, H));
    GSYNC();
    {
      EpiBf16_256 e{(bf16_t*)(ws + OFF_PQ), D};
      gemm256(p, H, (const bf16_t*)(ws + OFF_WPQ) + (size_t)0 * D * D, ntok, D, D, lds, e, ItemRanges{1024, 1024, 0, 0});
    }
    GSYNC();
    PH(8, peer_route_phase(p, 0, ntok, lds));
    GSYNC();
    if (DUP & 2) { peer_gather_phase(p, 0, ntok, 0, true); GSYNC(); }
    peer_gather_phase(p, 0, ntok, 0);
    GSYNC();
  }
  {
    constexpr int ntok = TL;
      {
        EpiWin256 e{(bf16_t*)(ws + OFF_PQ), (bf16_t*)(ws + OFF_Q)};
        PH(10, gemm256(p, H, (const bf16_t*)(ws + OFF_WIN), TT, 4096, D, lds, e, ItemRanges{3072, 1024, 0, 0}));
      }
      GSYNC();
      PH(11, conv_phase(p));
      GSYNC();
      PH(12, coef_phase(p, lds));
      GSYNC();
      PH(13, scan1_phase(p));
      GSYNC();
      PH(14, scan2_phase(p));
      GSYNC();
      if (DUP & 16) { scan1_phase(p); GSYNC(); scan2_phase(p); GSYNC(); }
      if (DUP & 32) { coef_phase(p, lds); GSYNC(); }
      if (DUP & 64) { for (int q = 0; q < 20; ++q) GSYNC(); }
      if (DUP & 128) { conv_phase(p); GSYNC(); }
      scan3_phase(p, lds);
      GSYNC();
    {
      EpiResid256 e{p.x, p.ctx, XS, MODV + (size_t)(1 * 5) * NMOD + 2 * D, false};
      gemm256(p, (const bf16_t*)(ws + OFF_O), (const bf16_t*)(ws + (OFF_WOUT)), ntok, D, D, lds, e, ItemRanges{0, 0, 0, 0});
    }
    GSYNC();
    norm_phase(p, 1, p.norm_ffn + 1 * D, 3, ntok, false, H);
    GSYNC();
    {
      EpiBf16_256 e{(bf16_t*)(ws + OFF_PQ), D};
      PH(18, gemm256(p, H, (const bf16_t*)(ws + OFF_WPQ) + (size_t)1 * D * D, ntok, D, D, lds, e, ItemRanges{0, 0, 0, 0}));
    }
    GSYNC();
    PH(19, peer_route_phase(p, 1, ntok, lds));
    GSYNC();
    if (DUP & 2) { peer_gather_phase(p, 1, ntok, 1, true); GSYNC(); }
    peer_gather_phase(p, 1, ntok, 1);
  }
}

__global__ void diag_fill(float* out, int n, float v) { for (int i = blockIdx.x * blockDim.x + threadIdx.x; i < n; i += gridDim.x * blockDim.x) out[i] = v; }

extern "C" void kernel_launch(void* const* d_in, const int* in_sizes, int n_in, void* d_out, int out_size, void* d_ws, size_t ws_size, hipStream_t stream) {
  static int grid_blocks = 0;
  if (!grid_blocks) {
    int dev = 0, cus = 0, per_cu = 0;
    (void)hipGetDevice(&dev);
    (void)hipDeviceGetAttribute(&cus, hipDeviceAttributeMultiprocessorCount, dev);
    (void)hipFuncSetAttribute((const void*)fwd_megakernel, hipFuncAttributeMaxDynamicSharedMemorySize, (int)kDynLds);
    (void)hipOccupancyMaxActiveBlocksPerMultiprocessor(&per_cu, fwd_megakernel, NT, kDynLds);
    if (per_cu > 1) per_cu = 1;
    if (per_cu < 1) per_cu = 1;
    grid_blocks = cus * per_cu;
  }
  if (ws_size < WS_NEED) { fprintf(stderr, "workspace too small: %zu < %zu\n", ws_size, (size_t)WS_NEED); diag_fill<<<1024, 256, 0, stream>>>((float*)d_out, out_size, 3.0f); return; }
  Params p{};
  const float* const* in = (const float* const*)d_in;
  p.x = in[0]; p.c = in[1]; p.ctx = in[2]; p.c_ctx = in[3]; p.w_mod = in[4]; p.b_mod = in[5]; p.norm_mix = in[6]; p.norm_ffn = in[7]; p.norm_final = in[8];
  p.attn_w_qkv = in[9]; p.attn_w_o = in[10]; p.attn_sink = in[11];
  p.rec_w_in = in[12]; p.rec_conv_w = in[13]; p.rec_conv_b = in[14]; p.rec_w_a = in[15]; p.rec_b_a = in[16]; p.rec_w_x = in[17]; p.rec_b_x = in[18]; p.rec_lambda = in[19]; p.rec_w_out = in[20];
  p.peer_w_q = in[21]; p.peer_keys = in[22]; p.peer_u = in[23]; p.peer_v = in[24];
  p.out = (float*)d_out; p.ws = (unsigned char*)d_ws;
  void* args[] = {&p};
  hipError_t e = hipLaunchCooperativeKernel((void*)fwd_megakernel, dim3(grid_blocks), dim3(NT), args, kDynLds, stream);
  if (e != hipSuccess) { fprintf(stderr, "cooperative launch failed: %s (grid %d)\n", hipGetErrorString(e), grid_blocks); diag_fill<<<1024, 256, 0, stream>>>((float*)d_out, out_size, 5.0f); }
}
```

```cpp
#include <hip/hip_runtime.h>
#include <hip/hip_cooperative_groups.h>
#include <cstdio>
namespace cg = cooperative_groups;

typedef unsigned short bf16_t;
typedef short bf16x8 __attribute__((ext_vector_type(8)));
typedef float f32x4 __attribute__((ext_vector_type(4)));
typedef unsigned u32x4 __attribute__((ext_vector_type(4)));
typedef unsigned u32x2 __attribute__((ext_vector_type(2)));
typedef __bf16 bf16x2_t __attribute__((ext_vector_type(2)));

constexpr int D = 2048, NB = 4, S = 4096, CL = 256;
constexpr int TL = NB * S, TC = NB * CL, TT = TL + TC;
constexpr int NT = 512;
constexpr int NMOD = 6 * D;
constexpr int NEXP = 16384;
constexpr size_t kDynLds = 128 * 1024 + 64;
#ifndef SKIP
#define SKIP 0
#endif
#ifndef DUP
#define DUP 0
#endif
#ifndef PROBE
#define PROBE 0
#endif
#define PH(k, ...) do { __VA_ARGS__; if (PROBE == (k)) { GSYNC(); __VA_ARGS__; } } while (0)

constexpr size_t al256(size_t x) { return (x + 255) & ~(size_t)255; }
constexpr size_t OFF_WQKV = 0;
constexpr size_t OFF_WO   = OFF_WQKV + al256((size_t)3072 * 2048 * 2);
constexpr size_t OFF_WPQ  = OFF_WO + al256((size_t)2048 * 2048 * 2);
constexpr size_t OFF_WIN  = OFF_WPQ + al256((size_t)2 * 2048 * 2048 * 2);
constexpr size_t OFF_WOUT = OFF_WIN + al256((size_t)4096 * 2048 * 2);
constexpr size_t OFF_WA   = OFF_WOUT + al256((size_t)2048 * 2048 * 2);
constexpr size_t OFF_SP   = OFF_WA + al256((size_t)32 * 256 * 256 * 2);
constexpr size_t OFF_KEYS = OFF_SP + al256((size_t)2 * 2048 * 4);
constexpr size_t OFF_UTAB = OFF_KEYS + al256((size_t)2 * 2 * 128 * 128 * 2);
constexpr size_t OFF_VTAB = OFF_UTAB + al256((size_t)2 * NEXP * D);
constexpr size_t OFF_USC  = OFF_VTAB + al256((size_t)2 * NEXP * D);
constexpr size_t OFF_VSC  = OFF_USC + al256((size_t)2 * NEXP * 4);
constexpr size_t OFF_MODV = OFF_VSC + al256((size_t)2 * NEXP * 4);
constexpr size_t OFF_ROPE = OFF_MODV + al256((size_t)2 * 5 * NMOD * 4);
constexpr size_t OFF_XS   = OFF_ROPE + al256((size_t)2 * 2048 * 4);
constexpr size_t SZ_ACT  = al256((size_t)TT * D * 2);
constexpr size_t OFF_H    = OFF_XS + al256((size_t)TT * D * 4);
constexpr size_t OFF_Q    = OFF_H + SZ_ACT;
constexpr size_t OFF_X    = OFF_Q + SZ_ACT;
constexpr size_t OFF_K    = OFF_X + 2 * SZ_ACT;
constexpr size_t OFF_VT   = OFF_K + al256((size_t)TT * 512 * 2);
constexpr size_t OFF_O    = OFF_VT + al256((size_t)TT * 512 * 2);
constexpr size_t OFF_PQ   = OFF_O + SZ_ACT;
constexpr size_t OFF_LAB  = OFF_H;
constexpr size_t OFF_CHP  = OFF_K;
constexpr size_t OFF_CHH  = OFF_CHP + al256((size_t)2 * 272 * D * 4);
constexpr size_t OFF_CIN  = OFF_CHH + al256((size_t)2 * 272 * D * 4);
constexpr size_t OFF_IDX  = OFF_PQ + SZ_ACT;
constexpr size_t OFF_GW   = OFF_IDX + al256((size_t)TT * 128 * 4);
constexpr size_t OFF_BAR  = OFF_GW + al256((size_t)TT * 128 * 4);
constexpr size_t WS_NEED  = OFF_BAR + 16384;
static_assert(OFF_CIN + al256((size_t)2 * 272 * D * 4) <= OFF_O, "scan carries must fit in the K/VT region");
static_assert(WS_NEED <= ((size_t)1 << 30), "workspace map exceeds 1 GiB");

struct Params {
  const float *x, *c, *ctx, *c_ctx, *w_mod, *b_mod, *norm_mix, *norm_ffn, *norm_final;
  const float *attn_w_qkv, *attn_w_o, *attn_sink;
  const float *rec_w_in, *rec_conv_w, *rec_conv_b, *rec_w_a, *rec_b_a, *rec_w_x, *rec_b_x, *rec_lambda, *rec_w_out;
  const float *peer_w_q, *peer_keys, *peer_u, *peer_v;
  float* out; unsigned char* ws;
};

__device__ __forceinline__ float bf2f(bf16_t v) { return __uint_as_float((unsigned)v << 16); }
__device__ __forceinline__ bf16_t f2bf(float f) { unsigned u = __float_as_uint(f); u += 0x7fffu + ((u >> 16) & 1u); return (bf16_t)(u >> 16); }
typedef float f32x2_t __attribute__((ext_vector_type(2)));
__device__ __forceinline__ unsigned pack_bf16(float lo, float hi) { const f32x2_t v = {lo, hi}; return __builtin_bit_cast(unsigned, __builtin_convertvector(v, bf16x2_t)); }
template <int CTRL, int RM, bool BC> __device__ __forceinline__ float dppf(float old, float src) {
  return __builtin_bit_cast(float, __builtin_amdgcn_update_dpp(__builtin_bit_cast(int, old), __builtin_bit_cast(int, src), CTRL, RM, 0xf, BC));
}
__device__ __forceinline__ float wave_sum(float v) {
  v += dppf<0x111, 0xf, true>(0.f, v); v += dppf<0x112, 0xf, true>(0.f, v); v += dppf<0x114, 0xf, true>(0.f, v); v += dppf<0x118, 0xf, true>(0.f, v);
  v += dppf<0x142, 0xa, false>(0.f, v); v += dppf<0x143, 0xc, false>(0.f, v);
  return __builtin_bit_cast(float, __builtin_amdgcn_readlane(__builtin_bit_cast(int, v), 63));
}
__device__ __forceinline__ float wave_max(float v) {
  v = fmaxf(v, dppf<0x111, 0xf, false>(v, v)); v = fmaxf(v, dppf<0x112, 0xf, false>(v, v)); v = fmaxf(v, dppf<0x114, 0xf, false>(v, v)); v = fmaxf(v, dppf<0x118, 0xf, false>(v, v));
  v = fmaxf(v, dppf<0x142, 0xa, false>(v, v)); v = fmaxf(v, dppf<0x143, 0xc, false>(v, v));
  return __builtin_bit_cast(float, __builtin_amdgcn_readlane(__builtin_bit_cast(int, v), 63));
}
__device__ __forceinline__ float gelu_tanh(float x) {
  const float y = 0.7978845608028654f * (x + 0.044715f * x * x * x);
  const float t = 1.0f - 2.0f / (1.0f + __expf(2.0f * y));
  return 0.5f * x * (1.0f + t);
}
__device__ __forceinline__ float sigmoid_f(float x) { return 1.0f / (1.0f + __expf(-x)); }
__device__ __forceinline__ int mod_row(int r) { return r < TL ? (r >> 12) : 4; }
__device__ __forceinline__ int tidx() { int t = threadIdx.x; asm volatile("" : "+v"(t)); return t; }

__device__ __forceinline__ void mod_item(const Params& p, int item, float* lds) {
  float* sil = lds;
  float* red = lds + 5 * 2048;
  const int tid = tidx(), wid = tid >> 6, lane = tid & 63;
  for (int i = tid; i < 5 * 2048; i += NT) {
    const int m = i >> 11, k = i & 2047;
    const float v = (m < 4) ? p.c[m * 2048 + k] : p.c_ctx[k];
    sil[i] = v / (1.0f + expf(-v));
  }
  __syncthreads();
  const int layer = item / 48, cgp = item % 48;
  const float* W = p.w_mod + (size_t)layer * 2048 * NMOD + cgp * 256 + lane * 4;
  float acc[5][4];
#pragma unroll
  for (int m = 0; m < 5; ++m)
#pragma unroll
    for (int j = 0; j < 4; ++j) acc[m][j] = 0.f;
  const int k0 = wid * 256;
#pragma unroll 32
  for (int k = k0; k < k0 + 256; ++k) {
    const float4 w = *(const float4*)(W + (size_t)k * NMOD);
#pragma unroll
    for (int m = 0; m < 5; ++m) {
      const float s = sil[m * 2048 + k];
      acc[m][0] += s * w.x; acc[m][1] += s * w.y; acc[m][2] += s * w.z; acc[m][3] += s * w.w;
    }
  }
#pragma unroll
  for (int m = 0; m < 5; ++m)
#pragma unroll
    for (int j = 0; j < 4; ++j) red[(wid * 5 + m) * 256 + lane * 4 + j] = acc[m][j];
  __syncthreads();
  float* MODV = (float*)(p.ws + OFF_MODV);
  for (int o = tid; o < 1280; o += NT) {
    const int m = o >> 8, n = o & 255;
    float s = 0.f;
#pragma unroll
    for (int w = 0; w < 8; ++w) s += red[(w * 5 + m) * 256 + n];
    const int col = cgp * 256 + n;
    MODV[(size_t)(layer * 5 + m) * NMOD + col] = s + p.b_mod[layer * NMOD + col];
  }
  __syncthreads();
}

__device__ __forceinline__ void transpose_quad(const Params& p, int q, float* lds) {
  const float* W; bf16_t* Wt; int K, N; int rnn = -1, isx = 0, mtx = 0;
  if (q < 384) { W = p.attn_w_qkv; Wt = (bf16_t*)(p.ws + OFF_WQKV); K = 2048; N = 3072; }
  else if ((q -= 384) < 256) { W = p.attn_w_o; Wt = (bf16_t*)(p.ws + OFF_WO); K = 2048; N = 2048; }
  else if ((q -= 256) < 512) { const int l = q >> 8; q &= 255; W = p.peer_w_q + (size_t)l * 2048 * 2048; Wt = (bf16_t*)(p.ws + OFF_WPQ) + (size_t)l * 2048 * 2048; K = 2048; N = 2048; }
  else if ((q -= 512) < 512) { W = p.rec_w_in; Wt = (bf16_t*)(p.ws + OFF_WIN); K = 2048; N = 4096; }
  else if ((q -= 512) < 256) { W = p.rec_w_out; Wt = (bf16_t*)(p.ws + OFF_WOUT); K = 2048; N = 2048; }
  else { q -= 256; isx = q >> 6; q &= 63; mtx = q >> 2; q &= 3; rnn = 1; W = (isx ? p.rec_w_x : p.rec_w_a) + (size_t)mtx * 65536; Wt = (bf16_t*)(p.ws + OFF_WA); K = 256; N = 256; }
  const int nq = N >> 8, k0 = (q / nq) * 64, n0 = (q % nq) * 256;
  const int tid = tidx();
  {
    const int r = tid >> 6, c4 = (tid & 63) * 4;
    float4 v[8];
#pragma unroll
    for (int i = 0; i < 8; ++i) v[i] = *(const float4*)(W + (size_t)(k0 + r + 8 * i) * N + n0 + c4);
#pragma unroll
    for (int i = 0; i < 8; ++i) { float* d = lds + (r + 8 * i) * 257 + c4; d[0] = v[i].x; d[1] = v[i].y; d[2] = v[i].z; d[3] = v[i].w; }
  }
  __syncthreads();
  {
    const int n = tid >> 1, kh = (tid & 1) * 32;
    bf16_t* drow = (rnn < 0) ? Wt + (size_t)(n0 + n) * K + k0 + kh : Wt + ((size_t)(mtx * 2 + (n >> 7)) * 256 + isx * 128 + (n & 127)) * 256 + k0 + kh;
#pragma unroll
    for (int c = 0; c < 4; ++c) {
      u32x4 o;
      o.x = pack_bf16(lds[(kh + c * 8 + 0) * 257 + n], lds[(kh + c * 8 + 1) * 257 + n]);
      o.y = pack_bf16(lds[(kh + c * 8 + 2) * 257 + n], lds[(kh + c * 8 + 3) * 257 + n]);
      o.z = pack_bf16(lds[(kh + c * 8 + 4) * 257 + n], lds[(kh + c * 8 + 5) * 257 + n]);
      o.w = pack_bf16(lds[(kh + c * 8 + 6) * 257 + n], lds[(kh + c * 8 + 7) * 257 + n]);
      *(u32x4*)(drow + c * 8) = o;
    }
  }
  __syncthreads();
}

__device__ __forceinline__ void convert8(const float* src, bf16_t* dst) {
  const float4 a = ((const float4*)src)[0], b = ((const float4*)src)[1];
  u32x4 o; o.x = pack_bf16(a.x, a.y); o.y = pack_bf16(a.z, a.w); o.z = pack_bf16(b.x, b.y); o.w = pack_bf16(b.z, b.w);
  *(u32x4*)dst = o;
}

constexpr int IT_MOD = 0, IT_TR = 96, IT_KEYS = IT_TR + 8192, IT_ROPE = IT_KEYS + 16, IT_TAB = IT_ROPE + 1;
struct ItemRanges { int lo1, n1, lo2, n2; };

__device__ __forceinline__ void quant_rows_item(const Params& p, int t, int tid0) {
  const int wid = tid0 >> 6, lane = tid0 & 63;
  float4 v[2][8]; float mx[2] = {0.f, 0.f};
#pragma unroll
  for (int h = 0; h < 2; ++h) {
    const int R = t * 16 + h * 8 + wid, tb = R >> 15, row = R & 32767;
    const float* src = (tb == 0 ? p.peer_u : p.peer_v) + (size_t)row * D;
#pragma unroll
    for (int i = 0; i < 8; ++i) v[h][i] = ((const float4*)src)[i * 64 + lane];
  }
#pragma unroll
  for (int h = 0; h < 2; ++h) {
    const int R = t * 16 + h * 8 + wid, tb = R >> 15, row = R & 32767;
    unsigned* dst = (unsigned*)(p.ws + (tb == 0 ? OFF_UTAB : OFF_VTAB) + (size_t)row * D);
    float* scp = (float*)(p.ws + (tb == 0 ? OFF_USC : OFF_VSC)) + row;
#pragma unroll
    for (int i = 0; i < 8; ++i) mx[h] = fmaxf(mx[h], fmaxf(fmaxf(fabsf(v[h][i].x), fabsf(v[h][i].y)), fmaxf(fabsf(v[h][i].z), fabsf(v[h][i].w))));
    mx[h] = wave_max(mx[h]);
    const float sc = mx[h] > 0.f ? mx[h] * (1.0f / 127.0f) : 1.0f, inv = 1.0f / sc;
    const int off = tb == 0 ? 0 : 128;
#pragma unroll
    for (int i = 0; i < 8; ++i) {
      const unsigned q0 = (unsigned)((int)fminf(fmaxf(rintf(v[h][i].x * inv), -127.f), 127.f) + off) & 0xffu, q1 = (unsigned)((int)fminf(fmaxf(rintf(v[h][i].y * inv), -127.f), 127.f) + off) & 0xffu;
      const unsigned q2 = (unsigned)((int)fminf(fmaxf(rintf(v[h][i].z * inv), -127.f), 127.f) + off) & 0xffu, q3 = (unsigned)((int)fminf(fmaxf(rintf(v[h][i].w * inv), -127.f), 127.f) + off) & 0xffu;
      dst[i * 64 + lane] = q0 | (q1 << 8) | (q2 << 16) | (q3 << 24);
    }
    if (lane == 0) *scp = sc;
  }
}

__device__ __forceinline__ void setup_phase(const Params& p, unsigned char* lds_raw) {
  float* lds = (float*)lds_raw;
  const int tid0 = tidx();
  const int b = (int)blockIdx.x;
  if (b < 96) { mod_item(p, b, lds); return; }
  for (int j = b - 96; j < 2048 + 17; j += (int)gridDim.x - 96) {
    if (j < 2048) { transpose_quad(p, j, lds); continue; }
    const int t = j - 2048;
    if (t < 16) { const size_t e = (size_t)t * 4096 + tid0 * 8; convert8(p.peer_keys + e, (bf16_t*)(p.ws + OFF_KEYS) + e); continue; }
    float* cosT = (float*)(p.ws + OFF_ROPE); float* sinT = cosT + 2048;
    for (int e = tid0; e < 2048; e += NT) {
      const int pos = e >> 5, jj = e & 31;
      const float inv = powf(10000.0f, -(float)(2 * jj) / 64.0f);
      const float ang = (float)pos * inv;
      cosT[e] = cosf(ang); sinT[e] = sinf(ang);
    }
    float* SP = (float*)(p.ws + OFF_SP);
    for (int e = tid0; e < 2 * 2048; e += NT) SP[e] = log1pf(expf(-p.rec_lambda[e]));
  }
}
__device__ __forceinline__ void norm_phase(const Params& p, int layer, const float* gain, int shift_idx, int nrows, bool from_input, bf16_t* H) {
  const int tid_ = tidx(), wid = tid_ >> 6, lane = tid_ & 63;
  const float* MODV = (const float*)(p.ws + OFF_MODV);
  const float* XS = (const float*)(p.ws + OFF_XS);
  for (int r = blockIdx.x * 8 + wid; r < nrows; r += gridDim.x * 8) {
    const float* src = from_input ? (r < TL ? p.x + (size_t)r * D : p.ctx + (size_t)(r - TL) * D) : XS + (size_t)r * D;
    const float* mv = MODV + (size_t)(layer * 5 + mod_row(r)) * NMOD;
    const float* sh = mv + shift_idx * D; const float* sc = sh + D;
    float4 v[8]; float ss = 0.f;
#pragma unroll
    for (int i = 0; i < 8; ++i) { v[i] = ((const float4*)src)[i * 64 + lane]; ss += v[i].x * v[i].x + v[i].y * v[i].y + v[i].z * v[i].z + v[i].w * v[i].w; }
    ss = wave_sum(ss);
    const float rs = rsqrtf(ss * (1.0f / D) + 1e-6f);
#pragma unroll
    for (int i = 0; i < 8; ++i) {
      const float4 g = ((const float4*)gain)[i * 64 + lane], a = ((const float4*)sh)[i * 64 + lane], b = ((const float4*)sc)[i * 64 + lane];
      const float o0 = v[i].x * rs * g.x * (1.0f + b.x) + a.x, o1 = v[i].y * rs * g.y * (1.0f + b.y) + a.y;
      const float o2 = v[i].z * rs * g.z * (1.0f + b.z) + a.z, o3 = v[i].w * rs * g.w * (1.0f + b.w) + a.w;
      u32x2 o; o.x = pack_bf16(o0, o1); o.y = pack_bf16(o2, o3);
      *(u32x2*)(H + (size_t)r * D + i * 256 + lane * 4) = o;
    }
  }
}

__device__ __forceinline__ void final_norm_phase(const Params& p) {
  const int tid_ = tidx(), wid = tid_ >> 6, lane = tid_ & 63;
  const float* XS = (const float*)(p.ws + OFF_XS);
  for (int r = blockIdx.x * 8 + wid; r < TL; r += gridDim.x * 8) {
    const float4* xr = (const float4*)(XS + (size_t)r * D);
    float4 v[8]; float ss = 0.f;
#pragma unroll
    for (int i = 0; i < 8; ++i) { v[i] = xr[i * 64 + lane]; ss += v[i].x * v[i].x + v[i].y * v[i].y + v[i].z * v[i].z + v[i].w * v[i].w; }
    ss = wave_sum(ss);
    const float rs = rsqrtf(ss * (1.0f / D) + 1e-6f);
    float4* orow = (float4*)(p.out + (size_t)r * D);
#pragma unroll
    for (int i = 0; i < 8; ++i) { const float4 g = ((const float4*)p.norm_final)[i * 64 + lane]; float4 o; o.x = v[i].x * rs * g.x; o.y = v[i].y * rs * g.y; o.z = v[i].z * rs * g.z; o.w = v[i].w * rs * g.w; orow[i * 64 + lane] = o; }
  }
}

constexpr int GLD = 72;
template <bool DUAL, class Epi>
__device__ __forceinline__ void gemm_tile(const bf16_t* __restrict__ Ap, int lda, const bf16_t* __restrict__ Bp, const bf16_t* __restrict__ B2p, int ldb, int K,
                                          unsigned char* lds, const Epi& epi, int m0, int n0) {
  const int tid = tidx(), wid = tid >> 6, lane = tid & 63, wm = wid >> 1, wn = wid & 1, fr = lane & 15, fq = lane >> 4;
  bf16_t* As = (bf16_t*)lds; bf16_t* Bs = As + 2 * 128 * GLD; bf16_t* B2s = Bs + 2 * 128 * GLD;
  const int lr0 = tid >> 3, lc = (tid & 7) * 8;
  f32x4 acc[2][4], acc2[2][4];
#pragma unroll
  for (int i = 0; i < 2; ++i)
#pragma unroll
    for (int j = 0; j < 4; ++j) { acc[i][j] = (f32x4){0.f, 0.f, 0.f, 0.f}; acc2[i][j] = (f32x4){0.f, 0.f, 0.f, 0.f}; }
  u32x4 ra[2], rb[2], rb2[2];
  const int nk = K >> 6;
#pragma unroll
  for (int i = 0; i < 2; ++i) {
    ra[i] = *(const u32x4*)(Ap + (size_t)(lr0 + 64 * i) * lda + lc);
    rb[i] = *(const u32x4*)(Bp + (size_t)(lr0 + 64 * i) * ldb + lc);
    if (DUAL) rb2[i] = *(const u32x4*)(B2p + (size_t)(lr0 + 64 * i) * ldb + lc);
  }
#pragma unroll
  for (int i = 0; i < 2; ++i) {
    *(u32x4*)(As + (lr0 + 64 * i) * GLD + lc) = ra[i];
    *(u32x4*)(Bs + (lr0 + 64 * i) * GLD + lc) = rb[i];
    if (DUAL) *(u32x4*)(B2s + (lr0 + 64 * i) * GLD + lc) = rb2[i];
  }
  __syncthreads();
  for (int kt = 0; kt < nk; ++kt) {
    const int buf = kt & 1;
    if (kt + 1 < nk) {
#pragma unroll
      for (int i = 0; i < 2; ++i) {
        ra[i] = *(const u32x4*)(Ap + (size_t)(lr0 + 64 * i) * lda + (kt + 1) * 64 + lc);
        rb[i] = *(const u32x4*)(Bp + (size_t)(lr0 + 64 * i) * ldb + (kt + 1) * 64 + lc);
        if (DUAL) rb2[i] = *(const u32x4*)(B2p + (size_t)(lr0 + 64 * i) * ldb + (kt + 1) * 64 + lc);
      }
    }
    const bf16_t* Ab = As + buf * 128 * GLD; const bf16_t* Bb = Bs + buf * 128 * GLD; const bf16_t* B2b = B2s + buf * 128 * GLD;
#pragma unroll
    for (int ks = 0; ks < 2; ++ks) {
      bf16x8 af[2], bfr[4];
#pragma unroll
      for (int mi = 0; mi < 2; ++mi) af[mi] = *(const bf16x8*)(Ab + (wm * 32 + mi * 16 + fr) * GLD + ks * 32 + fq * 8);
#pragma unroll
      for (int ni = 0; ni < 4; ++ni) bfr[ni] = *(const bf16x8*)(Bb + (wn * 64 + ni * 16 + fr) * GLD + ks * 32 + fq * 8);
#pragma unroll
      for (int mi = 0; mi < 2; ++mi)
#pragma unroll
        for (int ni = 0; ni < 4; ++ni) acc[mi][ni] = __builtin_amdgcn_mfma_f32_16x16x32_bf16(bfr[ni], af[mi], acc[mi][ni], 0, 0, 0);
      if (DUAL) {
#pragma unroll
        for (int ni = 0; ni < 4; ++ni) bfr[ni] = *(const bf16x8*)(B2b + (wn * 64 + ni * 16 + fr) * GLD + ks * 32 + fq * 8);
#pragma unroll
        for (int mi = 0; mi < 2; ++mi)
#pragma unroll
          for (int ni = 0; ni < 4; ++ni) acc2[mi][ni] = __builtin_amdgcn_mfma_f32_16x16x32_bf16(bfr[ni], af[mi], acc2[mi][ni], 0, 0, 0);
      }
    }
    if (kt + 1 < nk) {
      const int nb = buf ^ 1;
#pragma unroll
      for (int i = 0; i < 2; ++i) {
        *(u32x4*)(As + nb * 128 * GLD + (lr0 + 64 * i) * GLD + lc) = ra[i];
        *(u32x4*)(Bs + nb * 128 * GLD + (lr0 + 64 * i) * GLD + lc) = rb[i];
        if (DUAL) *(u32x4*)(B2s + nb * 128 * GLD + (lr0 + 64 * i) * GLD + lc) = rb2[i];
      }
    }
    __syncthreads();
  }
  epi(acc, acc2, m0 + wm * 32 + fr, n0 + wn * 64 + fq * 4);
}

struct EpiQKV {
  bf16_t *Q, *Kb, *VT; const float *cosT, *sinT;
  __device__ __forceinline__ void operator()(const f32x4 (&acc)[2][4], const f32x4 (&)[2][4], int rbase, int cbase) const {
    const int n0 = cbase & ~127;
#pragma unroll
    for (int mi = 0; mi < 2; ++mi) {
      const int r = rbase + 16 * mi;
      if (n0 < 2560) {
        const bool latent = r < TL;
        const int s = r & 4095;
        const int pos = ((cbase & 64) == 0) ? (s >> 6) : (s & 63);
        const int cl = cbase & 63;
        bf16_t* dst = (n0 < 2048) ? (Q + (size_t)r * D + cbase) : (Kb + (size_t)r * 512 + (cbase - 2048));
#pragma unroll
        for (int ni = 0; ni < 2; ++ni) {
          f32x4 x1 = acc[mi][ni], x2 = acc[mi][ni + 2], y1 = x1, y2 = x2;
          if (latent) {
            const f32x4 cs = *(const f32x4*)(cosT + pos * 32 + ni * 16 + cl), sn = *(const f32x4*)(sinT + pos * 32 + ni * 16 + cl);
            y1 = x1 * cs - x2 * sn; y2 = x2 * cs + x1 * sn;
          }
          u32x2 o1, o2; o1.x = pack_bf16(y1[0], y1[1]); o1.y = pack_bf16(y1[2], y1[3]); o2.x = pack_bf16(y2[0], y2[1]); o2.y = pack_bf16(y2[2], y2[3]);
          *(u32x2*)(dst + ni * 16) = o1; *(u32x2*)(dst + (ni + 2) * 16) = o2;
        }
      } else {
#pragma unroll
        for (int ni = 0; ni < 4; ++ni)
#pragma unroll
          for (int j = 0; j < 4; ++j) VT[(size_t)(cbase - 2560 + ni * 16 + j) * TT + r] = f2bf(acc[mi][ni][j]);
      }
    }
  }
};
struct EpiResid {
  const float *x, *ctx; float* XS; const float* gate  ; bool from_input; float mul;
  __device__ __forceinline__ void operator()(const f32x4 (&acc)[2][4], const f32x4 (&)[2][4], int rbase, int cbase) const {
#pragma unroll
    for (int mi = 0; mi < 2; ++mi) {
      const int r = rbase + 16 * mi;
      const float* src = from_input ? (r < TL ? x + (size_t)r * D : ctx + (size_t)(r - TL) * D) : XS + (size_t)r * D;
      const float* g = gate + (size_t)mod_row(r) * NMOD;
#pragma unroll
      for (int ni = 0; ni < 4; ++ni) {
        const int c = cbase + ni * 16;
        const f32x4 b = *(const f32x4*)(src + c), gg = *(const f32x4*)(g + c);
        *(f32x4*)(XS + (size_t)r * D + c) = b + gg * acc[mi][ni] * mul;
      }
    }
  }
};
struct EpiBf16 {
  bf16_t* O; int ldo;
  __device__ __forceinline__ void operator()(const f32x4 (&acc)[2][4], const f32x4 (&)[2][4], int rbase, int cbase) const {
#pragma unroll
    for (int mi = 0; mi < 2; ++mi)
#pragma unroll
      for (int ni = 0; ni < 4; ++ni) {
        u32x2 o; o.x = pack_bf16(acc[mi][ni][0], acc[mi][ni][1]); o.y = pack_bf16(acc[mi][ni][2], acc[mi][ni][3]);
        *(u32x2*)(O + (size_t)(rbase + 16 * mi) * ldo + cbase + ni * 16) = o;
      }
  }
};
struct EpiWin {
  bf16_t *GATE, *UBR;
  __device__ __forceinline__ void operator()(const f32x4 (&acc)[2][4], const f32x4 (&)[2][4], int rbase, int cbase) const {
#pragma unroll
    for (int mi = 0; mi < 2; ++mi) {
      const int r = rbase + 16 * mi;
#pragma unroll
      for (int ni = 0; ni < 4; ++ni) {
        const int c = cbase + ni * 16;
        f32x4 v = acc[mi][ni];
        if (c < 2048) {
          if (r < TL) {
            u32x2 o; o.x = pack_bf16(gelu_tanh(v[0]), gelu_tanh(v[1])); o.y = pack_bf16(gelu_tanh(v[2]), gelu_tanh(v[3]));
            *(u32x2*)(GATE + (size_t)r * D + c) = o;
          }
        } else {
          u32x2 o; o.x = pack_bf16(v[0], v[1]); o.y = pack_bf16(v[2], v[3]);
          *(u32x2*)(UBR + (size_t)r * D + (c - 2048)) = o;
        }
      }
    }
  }
};
struct EpiCoef {
  const float *b_a, *b_x, *lam; const bf16_t* UC; bf16_t *LA, *LB;
  __device__ __forceinline__ void operator()(const f32x4 (&acc)[2][4], const f32x4 (&acc2)[2][4], int rbase, int cbase) const {
#pragma unroll
    for (int ni = 0; ni < 4; ++ni) {
      const int c = cbase + ni * 16;
      const f32x4 ba = *(const f32x4*)(b_a + c), bx = *(const f32x4*)(b_x + c), lm = *(const f32x4*)(lam + c);
      float sp[4];
#pragma unroll
      for (int j = 0; j < 4; ++j) sp[j] = log1pf(expf(-lm[j]));
#pragma unroll
      for (int mi = 0; mi < 2; ++mi) {
        const int r = rbase + 16 * mi;
        const u32x2 uu = *(const u32x2*)(UC + (size_t)r * D + c);
        const float uv[4] = {__uint_as_float(uu.x << 16), __uint_as_float(uu.x & 0xffff0000u), __uint_as_float(uu.y << 16), __uint_as_float(uu.y & 0xffff0000u)};
        float lav[4], bv[4];
#pragma unroll
        for (int j = 0; j < 4; ++j) {
          const float rg = sigmoid_f(acc[mi][ni][j] + ba[j]);
          const float ig = sigmoid_f(acc2[mi][ni][j] + bx[j]);
          const float log_a = -8.0f * rg * sp[j];
          lav[j] = log_a;
          bv[j] = sqrtf(-expm1f(2.0f * log_a)) * ig * uv[j];
        }
        u32x2 o1, o2; o1.x = pack_bf16(lav[0], lav[1]); o1.y = pack_bf16(lav[2], lav[3]); o2.x = pack_bf16(bv[0], bv[1]); o2.y = pack_bf16(bv[2], bv[3]);
        *(u32x2*)(LA + (size_t)r * D + c) = o1;
        *(u32x2*)(LB + (size_t)r * D + c) = o2;
      }
    }
  }
};

template <class Epi>
__device__ __forceinline__ void gemm_phase(const bf16_t* A, const bf16_t* Bt, int K, int mtiles, int ntiles, unsigned char* lds, const Epi& epi) {
  const int total = mtiles * ntiles;
  for (int item = blockIdx.x; item < total; item += gridDim.x) {
    const int nt = item % ntiles, mt = item / ntiles;
    gemm_tile<false>(A + (size_t)mt * 128 * K, K, Bt + (size_t)nt * 128 * K, nullptr, K, K, lds, epi, mt * 128, nt * 128);
  }
}


namespace pg8 {
#define PG8_LAS __attribute__((address_space(3)))
constexpr int BM = 256, BK = 64, HALF = 128, HTB = HALF * BK * 2, STAGE_BYTES = 8 * HTB, NXCD = 8, WGM = 8;
__device__ __forceinline__ int lds_byte(int r, int c) { const int st = (r >> 4) * 2 + (c >> 5), rr = r & 15, cc = c & 31, ob = rr * 64 + cc * 2; return st * 1024 + (ob ^ (((ob >> 9) & 1) << 5)); }
__device__ __forceinline__ void stage_rc(int b, int& R, int& C) { const int st = b / 1024, sb = b % 1024, swz = sb ^ (((sb >> 9) & 1) << 5); R = (st >> 1) * 16 + swz / 64; C = (st & 1) * 32 + (swz % 64) / 2; }
__device__ __forceinline__ int perm128(int rho) { const int w = rho >> 5, n = (rho >> 4) & 1, i = rho & 15; return 64 * (w >> 1) + 16 * (w & 1) + 32 * n + i; }
struct Unit { int pm, pn; unsigned aoff, boff; };
struct Gemm { const bf16_t* A; const bf16_t* Bt; int K, lda; };
struct StaticOrder {
  int nM, nN, nwg, G, c; unsigned tA, tB;
  __device__ void init(int M, int N, int K, int lda, int G_, int c_) { nM = M / BM; nN = N / BM; nwg = nM * nN; G = G_; c = c_; tA = (unsigned)(BM * lda * 2); tB = (unsigned)(BM * K * 2); }
  __device__ bool next(int i, Unit& u) const {
    const long L = (long)i * G + c; if (L >= nwg) return false;
    int wgid = (int)L; { const int q = nwg / NXCD, r = nwg % NXCD, xcd = wgid % NXCD, off = wgid / NXCD; wgid = (xcd < r ? xcd * (q + 1) : r * (q + 1) + (xcd - r) * q) + off; }
    const int nig = WGM * nN, gid = wgid / nig, fm = gid * WGM, gsz = (nM - fm) < WGM ? (nM - fm) : WGM;
    u.pm = fm + ((wgid % nig) % gsz); u.pn = (wgid % nig) / gsz; u.aoff = (unsigned)u.pm * tA; u.boff = (unsigned)u.pn * tB; return true;
  }
};
struct CoefOrder {
  int G, c;
  __device__ void init(int G_, int c_) { G = G_; c = c_; }
  __device__ bool next(int i, Unit& u) const {
    const long L = (long)i * G + c; if (L >= (long)(TT / 256) * 32) return false;
    u.pm = (int)(L >> 5); u.pn = (int)(L & 31); const int blk = (u.pn >> 1) & 7;
    u.aoff = (unsigned)((u.pm * 256 * D + blk * 256) * 2); u.boff = (unsigned)(u.pn * 256 * 256 * 2); return true;
  }
};
template <class Epi, class Sched>
__device__ __forceinline__ void gemm_phase(PG8_LAS unsigned char* lds, const Gemm g, const Sched& S, const Epi& E) {
  const int tid = tidx(), wid = __builtin_amdgcn_readfirstlane(tid >> 6), lane = tid & 63, wr = wid >> 2, wc = wid & 3, fr = lane & 15, fq = lane >> 4;
  const int K = g.K, nt = K / BK;
  unsigned voffA[2], voffB[2];
#pragma unroll
  for (int i = 0; i < 2; ++i) { int R, C; stage_rc(tid * 16 + i * 8192, R, C); const int Rb = perm128(R);
    voffA[i] = (unsigned)(R * g.lda + C) * 2u; voffB[i] = (unsigned)(Rb * K + C) * 2u; }
  const unsigned kstep = (unsigned)(BK * 2);
  const unsigned hstepA = (unsigned)(HALF * g.lda * 2), hstepB = (unsigned)(HALF * K * 2);
  const unsigned ldsw = (unsigned)wid * 1024u;
  const int aoff = lds_byte(wr * 64 + fr, fq * 8), boff = lds_byte(wc * 32 + fr, fq * 8);
#define PG8_SA(b, h) (((b) * 2 + (h)) * HTB)
#define PG8_SB(b, h) ((4 + (b) * 2 + (h)) * HTB)
#define PG8_STAGE(bufoff, gbase, voff) do { _Pragma("unroll") for (int _i = 0; _i < 2; ++_i) \
    __builtin_amdgcn_global_load_lds((const unsigned*)((const char*)(gbase) + (voff)[_i]), (PG8_LAS unsigned*)(lds + (bufoff) + ldsw + _i * 8192), 16, 0, 0); } while (0)
#define PG8_LDA(dst, b, h) do { _Pragma("unroll") for (int m = 0; m < 4; ++m) _Pragma("unroll") for (int k = 0; k < 2; ++k) dst[m][k] = *(const PG8_LAS bf16x8*)(lds + PG8_SA(b, h) + aoff + m * 2048 + k * 1024); } while (0)
#define PG8_LDB(dst, b, h) do { _Pragma("unroll") for (int n = 0; n < 2; ++n) _Pragma("unroll") for (int k = 0; k < 2; ++k) dst[n][k] = *(const PG8_LAS bf16x8*)(lds + PG8_SB(b, h) + boff + n * 2048 + k * 1024); } while (0)
#define PG8_MMA(ai, bj, At, Bt) do { __builtin_amdgcn_s_setprio(1); _Pragma("unroll") for (int m = 0; m < 4; ++m) _Pragma("unroll") for (int n = 0; n < 2; ++n) _Pragma("unroll") for (int k = 0; k < 2; ++k) \
    acc[ai][bj][m][n] = __builtin_amdgcn_mfma_f32_16x16x32_bf16(Bt[n][k], At[m][k], acc[ai][bj][m][n], 0, 0, 0); __builtin_amdgcn_s_setprio(0); } while (0)
#define PG8_WAIT_V(n) asm volatile("s_waitcnt vmcnt(" #n ")" ::: "memory")
#define PG8_WAIT_L(n) asm volatile("s_waitcnt lgkmcnt(" #n ")" ::: "memory")
#define PG8_BAR __builtin_amdgcn_s_barrier()
#define PG8_SCHED __builtin_amdgcn_sched_barrier(0)
  Unit cur, nxt; int ui = 0;
  if (!S.next(0, cur)) return;
  f32x4 acc[2][2][4][2];
#pragma unroll
  for (int a = 0; a < 2; ++a)
#pragma unroll
    for (int b = 0; b < 2; ++b)
#pragma unroll
      for (int m = 0; m < 4; ++m)
#pragma unroll
        for (int n = 0; n < 2; ++n) acc[a][b][m][n] = (f32x4){0.f, 0.f, 0.f, 0.f};
  bf16x8 At[4][2], B0[2][2], B1[2][2];
  const char* cA = (const char*)g.A + cur.aoff; const char* cB = (const char*)g.Bt + cur.boff;
  PG8_STAGE(PG8_SB(0, 0), cB, voffB); PG8_STAGE(PG8_SA(0, 0), cA, voffA); PG8_STAGE(PG8_SB(0, 1), cB + hstepB, voffB); PG8_STAGE(PG8_SA(0, 1), cA + hstepA, voffA);
  if (wr == 1) PG8_BAR;
  PG8_WAIT_V(4); PG8_BAR;
  PG8_STAGE(PG8_SB(1, 0), cB + kstep, voffB); PG8_STAGE(PG8_SA(1, 0), cA + kstep, voffA); PG8_STAGE(PG8_SB(1, 1), cB + hstepB + kstep, voffB);
  PG8_WAIT_V(6); PG8_BAR;
  for (;;) {
    const bool has_next = S.next(ui + 1, nxt);
    const char* nA = has_next ? (const char*)g.A + nxt.aoff : cA; const char* nB = has_next ? (const char*)g.Bt + nxt.boff : cB;
    for (int t = 0; t < nt; t += 2) {
      const bool last = (t == nt - 2);
      const char* a1 = cA + (unsigned)(t + 1) * kstep;
      const char* a2 = last ? nA : cA + (unsigned)(t + 2) * kstep; const char* b2 = last ? nB : cB + (unsigned)(t + 2) * kstep;
      const char* a3 = a2 + kstep; const char* b3 = b2 + kstep;
      PG8_LDB(B0, 0, 0); PG8_SCHED; PG8_LDA(At, 0, 0); PG8_STAGE(PG8_SA(1, 1), a1 + hstepA, voffA);
      PG8_WAIT_L(8); PG8_BAR; PG8_WAIT_L(0); PG8_MMA(0, 0, At, B0); PG8_BAR; PG8_SCHED;
      PG8_LDB(B1, 0, 1); PG8_STAGE(PG8_SB(0, 0), b2, voffB);
      PG8_BAR; PG8_WAIT_L(0); PG8_MMA(0, 1, At, B1); PG8_BAR;
      PG8_LDA(At, 0, 1); PG8_STAGE(PG8_SA(0, 0), a2, voffA);
      PG8_BAR; PG8_WAIT_L(0); PG8_MMA(1, 0, At, B0); PG8_BAR; PG8_SCHED;
      PG8_STAGE(PG8_SB(0, 1), b2 + hstepB, voffB);
      PG8_WAIT_V(6); PG8_BAR; PG8_MMA(1, 1, At, B1); PG8_BAR;
      PG8_LDB(B0, 1, 0); PG8_SCHED; PG8_LDA(At, 1, 0); PG8_STAGE(PG8_SA(0, 1), a2 + hstepA, voffA);
      PG8_WAIT_L(8); PG8_BAR; PG8_WAIT_L(0); PG8_MMA(0, 0, At, B0); PG8_BAR; PG8_SCHED;
      PG8_LDB(B1, 1, 1); PG8_STAGE(PG8_SB(1, 0), b3, voffB);
      PG8_BAR; PG8_WAIT_L(0); PG8_MMA(0, 1, At, B1); PG8_BAR;
      PG8_LDA(At, 1, 1); PG8_STAGE(PG8_SA(1, 0), a3, voffA);
      PG8_BAR; PG8_WAIT_L(0); PG8_MMA(1, 0, At, B0); PG8_BAR; PG8_SCHED;
      PG8_STAGE(PG8_SB(1, 1), b3 + hstepB, voffB);
      PG8_WAIT_V(6); PG8_BAR; PG8_MMA(1, 1, At, B1); PG8_BAR;
    }
    E(acc, cur, wr, wc, fr, fq);
    if (!has_next) break;
#pragma unroll
    for (int a = 0; a < 2; ++a)
#pragma unroll
      for (int b = 0; b < 2; ++b)
#pragma unroll
        for (int m = 0; m < 4; ++m)
#pragma unroll
          for (int n = 0; n < 2; ++n) acc[a][b][m][n] = (f32x4){0.f, 0.f, 0.f, 0.f};
    cur = nxt; cA = nA; cB = nB; ++ui;
  }
  PG8_WAIT_V(0);
  if (wr == 0) PG8_BAR;
  PG8_BAR;
#undef PG8_SA
#undef PG8_SB
#undef PG8_STAGE
#undef PG8_LDA
#undef PG8_LDB
#undef PG8_MMA
#undef PG8_WAIT_V
#undef PG8_WAIT_L
#undef PG8_BAR
#undef PG8_SCHED
}
}

#define ROW256(ai, m) (u.pm * 256 + (ai) * 128 + wr * 64 + (m) * 16 + fr)
#define COL256(bj, n) (u.pn * 256 + (bj) * 128 + 64 * (wc >> 1) + 16 * (wc & 1) + 32 * (n) + 4 * fq)
struct EpiQKV256 {
  bf16_t *Q, *Kb, *VT; const float *cosT, *sinT;
  __device__ __forceinline__ void operator()(const f32x4 (&acc)[2][2][4][2], const pg8::Unit& u, int wr, int wc, int fr, int fq) const {
#pragma unroll
    for (int bj = 0; bj < 2; ++bj) {
      const int n0 = u.pn * 256 + bj * 128;
      const int c0 = COL256(bj, 0);
      if (n0 < 2560) {
        const int iidx = 16 * (wc & 1) + 4 * fq;
#pragma unroll
        for (int ai = 0; ai < 2; ++ai)
#pragma unroll
          for (int m = 0; m < 4; ++m) {
            const int r = ROW256(ai, m);
            const f32x4 x1 = acc[ai][bj][m][0], x2 = acc[ai][bj][m][1]; f32x4 y1 = x1, y2 = x2;
            if (r < TL) {
              const int s = r & 4095; const int pos = (wc >> 1) ? (s & 63) : (s >> 6);
              const f32x4 cs = *(const f32x4*)(cosT + pos * 32 + iidx), sn = *(const f32x4*)(sinT + pos * 32 + iidx);
              y1 = x1 * cs - x2 * sn; y2 = x2 * cs + x1 * sn;
            }
            bf16_t* dst = (n0 < 2048) ? (Q + (size_t)r * D + c0) : (Kb + (size_t)r * 512 + (c0 - 2048));
            u32x2 o1, o2; o1.x = pack_bf16(y1[0], y1[1]); o1.y = pack_bf16(y1[2], y1[3]); o2.x = pack_bf16(y2[0], y2[1]); o2.y = pack_bf16(y2[2], y2[3]);
            *(u32x2*)dst = o1; *(u32x2*)(dst + 32) = o2;
          }
      } else {
#pragma unroll
        for (int ai = 0; ai < 2; ++ai)
#pragma unroll
          for (int m = 0; m < 4; ++m) {
            const int r = ROW256(ai, m);
#pragma unroll
            for (int n = 0; n < 2; ++n)
#pragma unroll
              for (int j = 0; j < 4; ++j) VT[(size_t)(c0 - 2560 + 32 * n + j) * TT + r] = f2bf(acc[ai][bj][m][n][j]);
          }
      }
    }
  }
};
struct EpiResid256 {
  const float *x, *ctx; float* XS; const float* gate; bool from_input;
  __device__ __forceinline__ void operator()(const f32x4 (&acc)[2][2][4][2], const pg8::Unit& u, int wr, int wc, int fr, int fq) const {
#pragma unroll
    for (int ai = 0; ai < 2; ++ai)
#pragma unroll
      for (int m = 0; m < 4; ++m) {
        const int r = ROW256(ai, m);
        const float* src = from_input ? (r < TL ? x + (size_t)r * D : ctx + (size_t)(r - TL) * D) : XS + (size_t)r * D;
        const float* g = gate + (size_t)mod_row(r) * NMOD;
#pragma unroll
        for (int bj = 0; bj < 2; ++bj)
#pragma unroll
          for (int n = 0; n < 2; ++n) {
            const int c = COL256(bj, n);
            const f32x4 b = *(const f32x4*)(src + c), gg = *(const f32x4*)(g + c);
            *(f32x4*)(XS + (size_t)r * D + c) = b + gg * acc[ai][bj][m][n];
          }
      }
  }
};
struct EpiBf16_256 {
  bf16_t* O; int ldo;
  __device__ __forceinline__ void operator()(const f32x4 (&acc)[2][2][4][2], const pg8::Unit& u, int wr, int wc, int fr, int fq) const {
#pragma unroll
    for (int ai = 0; ai < 2; ++ai)
#pragma unroll
      for (int m = 0; m < 4; ++m)
#pragma unroll
        for (int bj = 0; bj < 2; ++bj)
#pragma unroll
          for (int n = 0; n < 2; ++n) {
            const f32x4 v = acc[ai][bj][m][n];
            u32x2 o; o.x = pack_bf16(v[0], v[1]); o.y = pack_bf16(v[2], v[3]);
            *(u32x2*)(O + (size_t)ROW256(ai, m) * ldo + COL256(bj, n)) = o;
          }
  }
};
struct EpiWin256 {
  bf16_t *GATE, *UBR;
  __device__ __forceinline__ void operator()(const f32x4 (&acc)[2][2][4][2], const pg8::Unit& u, int wr, int wc, int fr, int fq) const {
#pragma unroll
    for (int ai = 0; ai < 2; ++ai)
#pragma unroll
      for (int m = 0; m < 4; ++m) {
        const int r = ROW256(ai, m);
#pragma unroll
        for (int bj = 0; bj < 2; ++bj)
#pragma unroll
          for (int n = 0; n < 2; ++n) {
            const int c = COL256(bj, n);
            const f32x4 v = acc[ai][bj][m][n];
            if (c < 2048) {
              if (r < TL) { u32x2 o; o.x = pack_bf16(gelu_tanh(v[0]), gelu_tanh(v[1])); o.y = pack_bf16(gelu_tanh(v[2]), gelu_tanh(v[3])); *(u32x2*)(GATE + (size_t)r * D + c) = o; }
            } else {
              u32x2 o; o.x = pack_bf16(v[0], v[1]); o.y = pack_bf16(v[2], v[3]); *(u32x2*)(UBR + (size_t)r * D + (c - 2048)) = o;
            }
          }
      }
  }
};
constexpr int NSB = 32;
template <class Epi>
__device__ __forceinline__ void gemm256(const Params& p, const bf16_t* A, const bf16_t* Bt, int M, int N, int K, unsigned char* lds, const Epi& e, const ItemRanges fill) {
  const bool streaming = fill.n1 + fill.n2 > 0;
  if (streaming && (int)blockIdx.x < NSB) {
    const int tid0 = tidx();
    for (int k = (int)blockIdx.x; k < fill.n1 + fill.n2; k += NSB) quant_rows_item(p, k < fill.n1 ? fill.lo1 + k : fill.lo2 + (k - fill.n1), tid0);
    return;
  }
  const int nsb = streaming ? NSB : 0;
  pg8::Gemm g{A, Bt, K, K}; pg8::StaticOrder S; S.init(M, N, K, K, (int)gridDim.x - nsb, (int)blockIdx.x - nsb);
  pg8::gemm_phase((PG8_LAS unsigned char*)lds, g, S, e);
}
struct EpiCoef256 {
  const float *b_a, *b_x, *SP; const bf16_t* UC; bf16_t* LAB;
  __device__ __forceinline__ void operator()(const f32x4 (&acc)[2][2][4][2], const pg8::Unit& u, int wr, int wc, int fr_, int fq_) const {
    int fr = fr_, fq = fq_; asm volatile("" : "+v"(fr), "+v"(fq));
    const int dir = u.pn >> 4, blk = (u.pn >> 1) & 7, half = u.pn & 1;
    bf16_t* LA = LAB + (size_t)(dir * 2) * TT * D; bf16_t* LB = LA + (size_t)TT * D;
#pragma unroll
    for (int n = 0; n < 2; ++n) {
      const int c = blk * 256 + half * 128 + 64 * (wc >> 1) + 16 * (wc & 1) + 32 * n + 4 * fq;
      const f32x4 ba = *(const f32x4*)(b_a + dir * D + c), bx = *(const f32x4*)(b_x + dir * D + c), sp = *(const f32x4*)(SP + dir * D + c);
#pragma unroll
      for (int ai = 0; ai < 2; ++ai)
#pragma unroll
        for (int m = 0; m < 4; ++m) {
          const int r = u.pm * 256 + ai * 128 + wr * 64 + m * 16 + fr;
          const u32x2 uu = *(const u32x2*)(UC + (size_t)r * D + c);
          const float uv[4] = {__uint_as_float(uu.x << 16), __uint_as_float(uu.x & 0xffff0000u), __uint_as_float(uu.y << 16), __uint_as_float(uu.y & 0xffff0000u)};
          float lav[4], bv[4];
#pragma unroll
          for (int j = 0; j < 4; ++j) {
            const float rg = __builtin_amdgcn_rcpf(1.0f + __expf(-(acc[ai][0][m][n][j] + ba[j])));
            const float ig = __builtin_amdgcn_rcpf(1.0f + __expf(-(acc[ai][1][m][n][j] + bx[j])));
            const float log_a = -8.0f * rg * sp[j];
            lav[j] = log_a;
            bv[j] = __builtin_amdgcn_sqrtf(fmaxf(1.0f - __expf(2.0f * log_a), 0.f)) * ig * uv[j];
          }
          u32x2 o1, o2; o1.x = pack_bf16(lav[0], lav[1]); o1.y = pack_bf16(lav[2], lav[3]); o2.x = pack_bf16(bv[0], bv[1]); o2.y = pack_bf16(bv[2], bv[3]);
          *(u32x2*)(LA + (size_t)r * D + c) = o1;
          *(u32x2*)(LB + (size_t)r * D + c) = o2;
        }
    }
  }
};
__device__ __forceinline__ void coef_phase(const Params& p, unsigned char* lds) {
  EpiCoef256 e{p.rec_b_a, p.rec_b_x, (const float*)(p.ws + OFF_SP), (const bf16_t*)(p.ws + OFF_O), (bf16_t*)(p.ws + OFF_LAB)};
  pg8::Gemm g{(const bf16_t*)(p.ws + OFF_O), (const bf16_t*)(p.ws + OFF_WA), 256, D}; pg8::CoefOrder S; S.init((int)gridDim.x, (int)blockIdx.x);
  pg8::gemm_phase((PG8_LAS unsigned char*)lds, g, S, e);
}

constexpr int KLD = 136, VLD = 72;
__device__ __forceinline__ void attn_phase(const Params& p, unsigned char* lds) {
  const bf16_t* Q = (const bf16_t*)(p.ws + OFF_Q); const bf16_t* Kg = (const bf16_t*)(p.ws + OFF_K); const bf16_t* VT = (const bf16_t*)(p.ws + OFF_VT);
  bf16_t* O = (bf16_t*)(p.ws + OFF_O);
  bf16_t* Ks = (bf16_t*)lds;
  bf16_t* Vs = Ks + 64 * KLD;
  const int tid = tidx(), wid = tid >> 6, lane = tid & 63, fr = lane & 15, fq = lane >> 4;
  const int g = wid >> 1, rh = wid & 1;
  const float scale = 0.08838834764831845f;
  for (int item = blockIdx.x; item < 1088; item += gridDim.x) {
    int b, hk, qb, qrow0, nlat, kt0;
    if (item < 1024) { b = item >> 8; hk = (item >> 6) & 3; qb = item & 63; qrow0 = b * S + qb * 64; kt0 = qb - 2 < 0 ? 0 : qb - 2; const int kt1 = qb + 2 > 63 ? 63 : qb + 2; nlat = kt1 - kt0 + 1; }
    else { const int ci = item - 1024; b = ci >> 4; hk = (ci >> 2) & 3; qb = ci & 3; qrow0 = TL + b * CL + qb * 64; kt0 = 0; nlat = 0; }
    const int head = hk * 4 + g;
    const float sink = p.attn_sink[head];
    bf16x8 qf[2][4];
#pragma unroll
    for (int rt = 0; rt < 2; ++rt)
#pragma unroll
      for (int ks = 0; ks < 4; ++ks) qf[rt][ks] = *(const bf16x8*)(Q + (size_t)(qrow0 + rh * 32 + rt * 16 + fr) * D + head * 128 + ks * 32 + fq * 8);
    f32x4 oacc[2][8]; float mst[2], lst[2];
#pragma unroll
    for (int rt = 0; rt < 2; ++rt) {
#pragma unroll
      for (int dt = 0; dt < 8; ++dt) oacc[rt][dt] = (f32x4){0.f, 0.f, 0.f, 0.f};
      mst[rt] = sink; lst[rt] = fq == 0 ? 1.0f : 0.f;
    }
    const int ntiles = nlat + 4;
    int kdst[2], vdst[2]; size_t ksrc[2], vsrc[2];
#pragma unroll
    for (int i = 0; i < 2; ++i) {
      const int id = tid + 512 * i;
      const int key = id >> 4, dc = (id & 15) * 8;
      const int kk = key & 31, prow = (key & 32) + ((kk >> 2) & 1) * 16 + (kk >> 3) * 4 + (kk & 3);
      kdst[i] = prow * KLD + dc; ksrc[i] = (size_t)key * 512 + hk * 128 + dc;
      const int d = id >> 3, kc = (id & 7) * 8;
      vdst[i] = d * VLD + kc; vsrc[i] = (size_t)(hk * 128 + d) * TT + kc;
    }
    u32x4 kreg[2], vreg[2];
    {
      const int krow0 = nlat > 0 ? (b * S + kt0 * 64) : (TL + b * CL);
#pragma unroll
      for (int i = 0; i < 2; ++i) { kreg[i] = *(const u32x4*)(Kg + (size_t)krow0 * 512 + ksrc[i]); vreg[i] = *(const u32x4*)(VT + vsrc[i] + krow0); }
    }
    for (int ti = 0; ti < ntiles; ++ti) {
      const bool lat = ti < nlat;
      __syncthreads();
#pragma unroll
      for (int i = 0; i < 2; ++i) { *(u32x4*)(Ks + kdst[i]) = kreg[i]; *(u32x4*)(Vs + vdst[i]) = vreg[i]; }
      if (ti + 1 < ntiles) {
        const int tn = ti + 1;
        const int krow0 = tn < nlat ? (b * S + (kt0 + tn) * 64) : (TL + b * CL + (tn - nlat) * 64);
#pragma unroll
        for (int i = 0; i < 2; ++i) { kreg[i] = *(const u32x4*)(Kg + (size_t)krow0 * 512 + ksrc[i]); vreg[i] = *(const u32x4*)(VT + vsrc[i] + krow0); }
      }
      __syncthreads();
      f32x4 st[2][2][2];
#pragma unroll
      for (int rt = 0; rt < 2; ++rt)
#pragma unroll
        for (int kp = 0; kp < 2; ++kp)
#pragma unroll
          for (int t = 0; t < 2; ++t) st[rt][kp][t] = (f32x4){0.f, 0.f, 0.f, 0.f};
#pragma unroll
      for (int kp = 0; kp < 2; ++kp)
#pragma unroll
        for (int t = 0; t < 2; ++t)
#pragma unroll
          for (int ks = 0; ks < 4; ++ks) {
            const bf16x8 kf = *(const bf16x8*)(Ks + (kp * 32 + t * 16 + fr) * KLD + ks * 32 + fq * 8);
            st[0][kp][t] = __builtin_amdgcn_mfma_f32_16x16x32_bf16(kf, qf[0][ks], st[0][kp][t], 0, 0, 0);
            st[1][kp][t] = __builtin_amdgcn_mfma_f32_16x16x32_bf16(kf, qf[1][ks], st[1][kp][t], 0, 0, 0);
          }
      unsigned pk[2][2][4];
#pragma unroll
      for (int rt = 0; rt < 2; ++rt) {
        const int ipos = qb * 64 + rh * 32 + rt * 16 + fr;
        float mx = -INFINITY;
#pragma unroll
        for (int kp = 0; kp < 2; ++kp)
#pragma unroll
          for (int t = 0; t < 2; ++t)
#pragma unroll
            for (int j = 0; j < 4; ++j) {
              float v = st[rt][kp][t][j] * scale;
              if (lat) { const int dd = ipos - ((kt0 + ti) * 64 + kp * 32 + fq * 8 + t * 4 + j); if (dd > 128 || dd < -128) v = -INFINITY; }
              st[rt][kp][t][j] = v; mx = fmaxf(mx, v);
            }
        mx = fmaxf(mx, __shfl_xor(mx, 16)); mx = fmaxf(mx, __shfl_xor(mx, 32));
        const float mn = fmaxf(mst[rt], mx);
        const float alpha = __expf(mst[rt] - mn);
        mst[rt] = mn;
        float rs = 0.f;
#pragma unroll
        for (int kp = 0; kp < 2; ++kp)
#pragma unroll
          for (int t = 0; t < 2; ++t) {
            const float p0 = __expf(st[rt][kp][t][0] - mn), p1 = __expf(st[rt][kp][t][1] - mn), p2 = __expf(st[rt][kp][t][2] - mn), p3 = __expf(st[rt][kp][t][3] - mn);
            rs += (p0 + p1) + (p2 + p3);
            pk[rt][kp][t * 2] = pack_bf16(p0, p1); pk[rt][kp][t * 2 + 1] = pack_bf16(p2, p3);
          }
        lst[rt] = lst[rt] * alpha + rs;
#pragma unroll
        for (int dt = 0; dt < 8; ++dt) oacc[rt][dt] *= alpha;
      }
#pragma unroll
      for (int kp = 0; kp < 2; ++kp) {
        const bf16x8 pf0 = __builtin_bit_cast(bf16x8, (u32x4){pk[0][kp][0], pk[0][kp][1], pk[0][kp][2], pk[0][kp][3]});
        const bf16x8 pf1 = __builtin_bit_cast(bf16x8, (u32x4){pk[1][kp][0], pk[1][kp][1], pk[1][kp][2], pk[1][kp][3]});
#pragma unroll
        for (int dt = 0; dt < 8; ++dt) {
          const bf16x8 vf = *(const bf16x8*)(Vs + (dt * 16 + fr) * VLD + kp * 32 + fq * 8);
          oacc[0][dt] = __builtin_amdgcn_mfma_f32_16x16x32_bf16(vf, pf0, oacc[0][dt], 0, 0, 0);
          oacc[1][dt] = __builtin_amdgcn_mfma_f32_16x16x32_bf16(vf, pf1, oacc[1][dt], 0, 0, 0);
        }
      }
    }
#pragma unroll
    for (int rt = 0; rt < 2; ++rt) {
      float l = lst[rt]; l += __shfl_xor(l, 16); l += __shfl_xor(l, 32);
      const float inv = 1.0f / l;
      bf16_t* orow = O + (size_t)(qrow0 + rh * 32 + rt * 16 + fr) * D + head * 128 + 4 * fq;
#pragma unroll
      for (int dt = 0; dt < 8; ++dt) {
        u32x2 o; o.x = pack_bf16(oacc[rt][dt][0] * inv, oacc[rt][dt][1] * inv); o.y = pack_bf16(oacc[rt][dt][2] * inv, oacc[rt][dt][3] * inv);
        *(u32x2*)(orow + dt * 16) = o;
      }
    }
  }
}

#define CE_DESC(a, b) { const float _hi = fmaxf(a, b), _lo = fminf(a, b); a = _hi; b = _lo; }
__device__ __forceinline__ void bitonic_sort_desc16(float (&a)[16]) {
#pragma unroll
  for (int ks = 1; ks <= 4; ++ks)
#pragma unroll
    for (int js = ks - 1; js >= 0; --js)
#pragma unroll
      for (int i = 0; i < 16; ++i) { const int k = 1 << ks, j = 1 << js, l = i ^ j; if (l > i) { if ((i & k) == 0) CE_DESC(a[i], a[l]) else CE_DESC(a[l], a[i]) } }
}
__device__ __forceinline__ void bitonic_merge_desc16(float (&a)[16]) {
#pragma unroll
  for (int js = 3; js >= 0; --js)
#pragma unroll
    for (int i = 0; i < 16; ++i) { const int j = 1 << js, l = i ^ j; if (l > i) CE_DESC(a[i], a[l]) }
}
__device__ __forceinline__ void top16_merge(float (&L)[16], float (&G)[16]) {
  bitonic_sort_desc16(G);
#pragma unroll
  for (int i = 0; i < 16; ++i) L[i] = fmaxf(L[i], G[15 - i]);
  bitonic_merge_desc16(L);
}
__host__ __device__ constexpr int cand_code(int c) {
  int n = 0;
  for (int i = 0; i < 16; ++i) for (int j = 0; j < 16 / (i + 1); ++j) { if (n == c) return (i << 4) | j; ++n; }
  return -1;
}
template <int C> struct CandCode { static constexpr int value = cand_code(C); };

__device__ __forceinline__ void peer_route_phase(const Params& p, int layer, int ntok, unsigned char* lds) {
  const int tid = tidx(), wid = tid >> 6, lane = tid & 63, fr = lane & 15, fq = lane >> 4;
  float* Sw = (float*)(lds + wid * 9216);
  const bf16_t* keysG = (const bf16_t*)(p.ws + OFF_KEYS) + (size_t)layer * 2 * 128 * 128;
  const bf16_t* PQ = (const bf16_t*)(p.ws + OFF_PQ);
  int* IDX = (int*)(p.ws + OFF_IDX); float* GW = (float*)(p.ws + OFF_GW);
  const int total = (ntok >> 6) * 8;
  for (int id = blockIdx.x * 8 + wid; id < total; id += gridDim.x * 8) {
    const int tile = id >> 3, head = id & 7, tok0 = tile * 64;
    float Lk[2][16];
#pragma unroll
    for (int pp = 0; pp < 2; ++pp) {
      bf16x8 qf[4][4];
#pragma unroll
      for (int mt = 0; mt < 4; ++mt)
#pragma unroll
        for (int ks = 0; ks < 4; ++ks) qf[mt][ks] = *(const bf16x8*)(PQ + (size_t)(tok0 + mt * 16 + fr) * D + head * 256 + pp * 128 + ks * 32 + fq * 8);
#pragma unroll
      for (int s2 = 0; s2 < 16; ++s2) Lk[pp][s2] = -INFINITY;
      bf16x8 kf[2][4], kfn[2][4];
#pragma unroll
      for (int nt = 0; nt < 2; ++nt)
#pragma unroll
        for (int ks = 0; ks < 4; ++ks) kf[nt][ks] = *(const bf16x8*)(keysG + (size_t)(pp * 128 + nt * 16 + fr) * 128 + ks * 32 + fq * 8);
#pragma unroll 1
      for (int pass = 0; pass < 4; ++pass) {
        const int pn = pass < 3 ? pass + 1 : 3;
#pragma unroll
        for (int nt = 0; nt < 2; ++nt)
#pragma unroll
          for (int ks = 0; ks < 4; ++ks) kfn[nt][ks] = *(const bf16x8*)(keysG + (size_t)(pp * 128 + pn * 32 + nt * 16 + fr) * 128 + ks * 32 + fq * 8);
        f32x4 acc[2][4];
#pragma unroll
        for (int nt = 0; nt < 2; ++nt)
#pragma unroll
          for (int mt = 0; mt < 4; ++mt) acc[nt][mt] = (f32x4){0.f, 0.f, 0.f, 0.f};
#pragma unroll
        for (int nt = 0; nt < 2; ++nt)
#pragma unroll
          for (int ks = 0; ks < 4; ++ks)
#pragma unroll
            for (int mt = 0; mt < 4; ++mt) acc[nt][mt] = __builtin_amdgcn_mfma_f32_16x16x32_bf16(kf[nt][ks], qf[mt][ks], acc[nt][mt], 0, 0, 0);
#pragma unroll
        for (int nt = 0; nt < 2; ++nt)
#pragma unroll
          for (int mt = 0; mt < 4; ++mt) *(f32x4*)(Sw + (mt * 16 + fr) * 36 + nt * 16 + 4 * fq) = acc[nt][mt];
        __builtin_amdgcn_fence(__ATOMIC_RELEASE, "wavefront"); __builtin_amdgcn_wave_barrier(); __builtin_amdgcn_fence(__ATOMIC_ACQUIRE, "wavefront");
#pragma unroll
        for (int g = 0; g < 2; ++g) {
          float G[16];
#pragma unroll
          for (int c = 0; c < 4; ++c) {
            const f32x4 sv = *(const f32x4*)(Sw + lane * 36 + g * 16 + c * 4);
#pragma unroll
            for (int e = 0; e < 4; ++e) G[c * 4 + e] = __uint_as_float((__float_as_uint(sv[e]) & ~0x7fu) | (unsigned)(pass * 32 + g * 16 + c * 4 + e));
          }
          top16_merge(Lk[pp], G);
        }
#pragma unroll
        for (int nt = 0; nt < 2; ++nt)
#pragma unroll
          for (int ks = 0; ks < 4; ++ks) kf[nt][ks] = kfn[nt][ks];
      }
    }
#pragma unroll
    for (int pp = 0; pp < 2; ++pp)
#pragma unroll
      for (int s2 = 0; s2 < 16; ++s2) Sw[(pp * 16 + s2) * 64 + lane] = Lk[pp][s2];
    float v1[16], v2[16];
#pragma unroll
    for (int s2 = 0; s2 < 16; ++s2) { v1[s2] = __uint_as_float(__float_as_uint(Lk[0][s2]) & ~0x7fu); v2[s2] = __uint_as_float(__float_as_uint(Lk[1][s2]) & ~0x7fu); }
    float T[16];
#pragma unroll
    for (int s2 = 0; s2 < 16; ++s2) T[s2] = -INFINITY;
#define ROUTE_GROUP(G0) { float G[16]; \
      _Pragma("unroll") for (int q = 0; q < 16; ++q) G[q] = -INFINITY; \
      ROUTE_FILL(G0 + 0) ROUTE_FILL(G0 + 1) ROUTE_FILL(G0 + 2) ROUTE_FILL(G0 + 3) ROUTE_FILL(G0 + 4) ROUTE_FILL(G0 + 5) ROUTE_FILL(G0 + 6) ROUTE_FILL(G0 + 7) \
      ROUTE_FILL(G0 + 8) ROUTE_FILL(G0 + 9) ROUTE_FILL(G0 + 10) ROUTE_FILL(G0 + 11) ROUTE_FILL(G0 + 12) ROUTE_FILL(G0 + 13) ROUTE_FILL(G0 + 14) ROUTE_FILL(G0 + 15) \
      top16_merge(T, G); }
#define ROUTE_FILL(C) { constexpr int code = CandCode<(C)>::value; if constexpr (code >= 0) G[(C) & 15] = __uint_as_float((__float_as_uint(v1[code >> 4] + v2[code & 15]) & ~0xffu) | (unsigned)code); }
    ROUTE_GROUP(0) ROUTE_GROUP(16) ROUTE_GROUP(32) ROUTE_GROUP(48)
#undef ROUTE_FILL
#undef ROUTE_GROUP
    asm volatile("s_waitcnt lgkmcnt(0)" ::: "memory");
    int E[16];
#pragma unroll
    for (int s2 = 0; s2 < 16; ++s2) {
      const unsigned code = __float_as_uint(T[s2]) & 0xffu;
      const unsigned k1 = __float_as_uint(Sw[(code >> 4) * 64 + lane]) & 0x7fu, k2 = __float_as_uint(Sw[(16 + (code & 15u)) * 64 + lane]) & 0x7fu;
      E[s2] = (int)(k1 * 128u + k2);
      T[s2] = __uint_as_float(__float_as_uint(T[s2]) & ~0xffu);
    }
    asm volatile("s_waitcnt lgkmcnt(0)" ::: "memory");
    const size_t o = ((size_t)(tok0 + lane) * 8 + head) * 16;
    const float tmax = T[0];
    float ssum = 0.f;
#pragma unroll
    for (int s2 = 0; s2 < 16; ++s2) { T[s2] = __expf(T[s2] - tmax); ssum += T[s2]; }
    const float inv = 1.0f / ssum;
#pragma unroll
    for (int c = 0; c < 4; ++c) {
      *(f32x4*)(GW + o + c * 4) = (f32x4){T[c * 4] * inv, T[c * 4 + 1] * inv, T[c * 4 + 2] * inv, T[c * 4 + 3] * inv};
      typedef int i32x4 __attribute__((ext_vector_type(4)));
      *(i32x4*)(IDX + o + c * 4) = (i32x4){E[c * 4], E[c * 4 + 1], E[c * 4 + 2], E[c * 4 + 3]};
    }
  }
}

constexpr int PG = 2;
struct PeerBuf { u32x4 u[PG][2], v[PG][2]; float su[PG], sv[PG], g[PG]; };
__device__ __forceinline__ void peer_load(PeerBuf& B, const unsigned char* UT8, const unsigned char* VT8, const float* USC, const float* VSC, int ireg, float greg, int k0, int lane) {
#pragma unroll
  for (int j = 0; j < PG; ++j) {
    const int e = __builtin_amdgcn_readlane(ireg, k0 + j);
    B.g[j] = __builtin_bit_cast(float, __builtin_amdgcn_readlane(__builtin_bit_cast(int, greg), k0 + j));
    const unsigned char* ur = UT8 + (size_t)e * D + lane * 16; const unsigned char* vr = VT8 + (size_t)e * D + lane * 16;
    B.u[j][0] = *(const u32x4*)ur; B.u[j][1] = *(const u32x4*)(ur + 1024);
    B.v[j][0] = *(const u32x4*)vr; B.v[j][1] = *(const u32x4*)(vr + 1024);
    B.su[j] = USC[e]; B.sv[j] = VSC[e];
  }
}
__device__ __forceinline__ void peer_compute(const PeerBuf& B, const int (&hq)[2][4], float hscale, float (&accv)[2][16], float& corr) {
#pragma unroll
  for (int j = 0; j < PG; ++j) {
    int d0 = 0, d1 = 0;
#pragma unroll
    for (int t = 0; t < 4; ++t) { d0 = __builtin_amdgcn_sdot4((int)B.u[j][0][t], hq[0][t], d0, false); d1 = __builtin_amdgcn_sdot4((int)B.u[j][1][t], hq[1][t], d1, false); }
    const float z = B.su[j] * hscale * wave_sum((float)(d0 + d1));
    const float act = gelu_tanh(z) * B.g[j] * B.sv[j];
    corr += act;
#pragma unroll
    for (int c = 0; c < 2; ++c)
#pragma unroll
      for (int t = 0; t < 4; ++t) {
        const unsigned w = B.v[j][c][t];
        accv[c][4 * t] += act * (float)(w & 0xffu); accv[c][4 * t + 1] += act * (float)((w >> 8) & 0xffu); accv[c][4 * t + 2] += act * (float)((w >> 16) & 0xffu); accv[c][4 * t + 3] += act * (float)(w >> 24);
      }
  }
}
__device__ __forceinline__ void peer_gather_phase(const Params& p, int layer, int ntok, int gate_layer, bool dry = false) {
  const int tid = tidx(), wid = tid >> 6, lane = tid & 63;
  const bf16_t* H = (const bf16_t*)(p.ws + OFF_H);
  const int* IDX = (const int*)(p.ws + OFF_IDX); const float* GW = (const float*)(p.ws + OFF_GW);
  const unsigned char* UT8 = p.ws + OFF_UTAB + (size_t)layer * NEXP * D; const unsigned char* VT8 = p.ws + OFF_VTAB + (size_t)layer * NEXP * D;
  const float* USC = (const float*)(p.ws + OFF_USC) + (size_t)layer * NEXP; const float* VSC = (const float*)(p.ws + OFF_VSC) + (size_t)layer * NEXP;
  float* XS = (float*)(p.ws + OFF_XS);
  const float* gate = (const float*)(p.ws + OFF_MODV) + (size_t)(gate_layer * 5) * NMOD + 5 * D;
  for (int tok = blockIdx.x * 8 + wid; tok < ntok; tok += gridDim.x * 8) {
    const int i0 = IDX[(size_t)tok * 128 + lane], i1 = IDX[(size_t)tok * 128 + 64 + lane];
    const float g0 = GW[(size_t)tok * 128 + lane], g1 = GW[(size_t)tok * 128 + 64 + lane];
    PeerBuf A, B;
    peer_load(A, UT8, VT8, USC, VSC, i0, g0, 0, lane);
    int hq[2][4]; float hscale;
    {
      float hreg[2][16]; float hmx = 0.f;
#pragma unroll
      for (int c = 0; c < 2; ++c)
#pragma unroll
        for (int hh = 0; hh < 2; ++hh) {
          const u32x4 hv = *(const u32x4*)(H + (size_t)tok * D + c * 1024 + lane * 16 + hh * 8);
#pragma unroll
          for (int t = 0; t < 4; ++t) { hreg[c][hh * 8 + 2 * t] = __uint_as_float(hv[t] << 16); hreg[c][hh * 8 + 2 * t + 1] = __uint_as_float(hv[t] & 0xffff0000u); hmx = fmaxf(hmx, fmaxf(fabsf(hreg[c][hh * 8 + 2 * t]), fabsf(hreg[c][hh * 8 + 2 * t + 1]))); }
        }
      hmx = wave_max(hmx);
      hscale = hmx > 0.f ? hmx * (1.0f / 127.0f) : 1.0f;
      const float hinv = 1.0f / hscale;
#pragma unroll
      for (int c = 0; c < 2; ++c)
#pragma unroll
        for (int t = 0; t < 4; ++t) {
          const unsigned q0 = (unsigned)(int)rintf(hreg[c][4 * t] * hinv) & 0xffu, q1 = (unsigned)(int)rintf(hreg[c][4 * t + 1] * hinv) & 0xffu;
          const unsigned q2 = (unsigned)(int)rintf(hreg[c][4 * t + 2] * hinv) & 0xffu, q3 = (unsigned)(int)rintf(hreg[c][4 * t + 3] * hinv) & 0xffu;
          hq[c][t] = (int)(q0 | (q1 << 8) | (q2 << 16) | (q3 << 24));
        }
    }
    float accv[2][16]; float corr = 0.f;
#pragma unroll
    for (int c = 0; c < 2; ++c)
#pragma unroll
      for (int j = 0; j < 16; ++j) accv[c][j] = 0.f;
#pragma unroll 1
    for (int half = 0; half < 2; ++half) {
      const int ireg = half ? i1 : i0; const float greg = half ? g1 : g0;
#pragma unroll 1
      for (int k0 = 0; k0 < 64; k0 += 2 * PG) {
        peer_load(B, UT8, VT8, USC, VSC, ireg, greg, k0 + PG, lane);
        peer_compute(A, hq, hscale, accv, corr);
        if (k0 + 2 * PG < 64) peer_load(A, UT8, VT8, USC, VSC, ireg, greg, k0 + 2 * PG, lane);
        else if (half == 0) peer_load(A, UT8, VT8, USC, VSC, i1, g1, 0, lane);
        peer_compute(B, hq, hscale, accv, corr);
      }
    }
    corr *= 128.0f;
    const int mrow = mod_row(tok);
    const float* gr = gate + (size_t)mrow * NMOD; float* xr = XS + (size_t)tok * D;
    float ss = 0.f;
#pragma unroll
    for (int c = 0; c < 2; ++c)
#pragma unroll
      for (int t = 0; t < 4; ++t) {
        const int col = c * 1024 + lane * 16 + 4 * t;
        const f32x4 gg = *(const f32x4*)(gr + col), xo = *(const f32x4*)(xr + col);
#pragma unroll
        for (int j = 0; j < 4; ++j) { const float xn = xo[j] + gg[j] * (accv[c][4 * t + j] - corr); accv[c][4 * t + j] = xn; ss += xn * xn; }
      }
    ss = wave_sum(ss);
    const float rs = rsqrtf(ss * (1.0f / D) + 1e-6f);
    if (dry && rs != 12345.678f) continue;
    if (layer == 0) {
      const float* mv = (const float*)(p.ws + OFF_MODV) + (size_t)(5 + mrow) * NMOD;
      const float* gn = p.norm_mix + D;
      bf16_t* hr = (bf16_t*)(p.ws + OFF_H) + (size_t)tok * D;
#pragma unroll
      for (int c = 0; c < 2; ++c)
#pragma unroll
        for (int t = 0; t < 4; ++t) {
          const int col = c * 1024 + lane * 16 + 4 * t;
          *(f32x4*)(xr + col) = (f32x4){accv[c][4 * t], accv[c][4 * t + 1], accv[c][4 * t + 2], accv[c][4 * t + 3]};
          const f32x4 g = *(const f32x4*)(gn + col), sh = *(const f32x4*)(mv + col), sc = *(const f32x4*)(mv + D + col);
          u32x2 o; o.x = pack_bf16(accv[c][4 * t] * rs * g[0] * (1.0f + sc[0]) + sh[0], accv[c][4 * t + 1] * rs * g[1] * (1.0f + sc[1]) + sh[1]);
          o.y = pack_bf16(accv[c][4 * t + 2] * rs * g[2] * (1.0f + sc[2]) + sh[2], accv[c][4 * t + 3] * rs * g[3] * (1.0f + sc[3]) + sh[3]);
          *(u32x2*)(hr + col) = o;
        }
    } else {
      float* orow = p.out + (size_t)tok * D;
#pragma unroll
      for (int c = 0; c < 2; ++c)
#pragma unroll
        for (int t = 0; t < 4; ++t) {
          const int col = c * 1024 + lane * 16 + 4 * t;
          const f32x4 g = *(const f32x4*)(p.norm_final + col);
          *(f32x4*)(orow + col) = (f32x4){accv[c][4 * t] * rs * g[0], accv[c][4 * t + 1] * rs * g[1], accv[c][4 * t + 2] * rs * g[2], accv[c][4 * t + 3] * rs * g[3]};
        }
    }
  }
}

__device__ __forceinline__ void conv_phase(const Params& p) {
  const bf16_t* UBR = (const bf16_t*)(p.ws + OFF_Q); bf16_t* UC = (bf16_t*)(p.ws + OFF_O);
  const int tid = tidx(), c = (tid & 255) * 8, hrow = tid >> 8;
  float w[4][8], bias[8];
#pragma unroll
  for (int k = 0; k < 4; ++k) { const float4 w0 = *(const float4*)(p.rec_conv_w + k * D + c), w1 = *(const float4*)(p.rec_conv_w + k * D + c + 4); w[k][0] = w0.x; w[k][1] = w0.y; w[k][2] = w0.z; w[k][3] = w0.w; w[k][4] = w1.x; w[k][5] = w1.y; w[k][6] = w1.z; w[k][7] = w1.w; }
  { const float4 b0 = *(const float4*)(p.rec_conv_b + c), b1 = *(const float4*)(p.rec_conv_b + c + 4); bias[0] = b0.x; bias[1] = b0.y; bias[2] = b0.z; bias[3] = b0.w; bias[4] = b1.x; bias[5] = b1.y; bias[6] = b1.z; bias[7] = b1.w; }
  const int nhalf = 2 * (int)gridDim.x, rows_per = (TT + nhalf - 1) / nhalf;
  const int r0 = ((int)blockIdx.x * 2 + hrow) * rows_per, r1 = r0 + rows_per < TT ? r0 + rows_per : TT;
  if (r0 < TT) {
    u32x4 win[4];
    const u32x4 zero = (u32x4){0u, 0u, 0u, 0u};
#pragma unroll
    for (int k = 0; k < 3; ++k) { const int rr = r0 - 1 + k; win[k] = (rr >= 0 && rr < TT) ? *(const u32x4*)(UBR + (size_t)rr * D + c) : zero; }
#pragma unroll 2
    for (int r = r0; r < r1; ++r) {
      const int rr = r + 2;
      win[3] = (rr < TT) ? *(const u32x4*)(UBR + (size_t)rr * D + c) : zero;
      const int seq_lo = r < TL ? (r & ~4095) : TL + ((r - TL) & ~255), seq_hi = seq_lo + (r < TL ? S : CL);
      float acc[8];
#pragma unroll
      for (int j = 0; j < 8; ++j) acc[j] = bias[j];
#pragma unroll
      for (int k = 0; k < 4; ++k) {
        const int rk = r - 1 + k; const bool ok = rk >= seq_lo && rk < seq_hi;
#pragma unroll
        for (int t = 0; t < 4; ++t) { const unsigned d = ok ? win[k][t] : 0u; acc[2 * t] += w[k][2 * t] * __uint_as_float(d << 16); acc[2 * t + 1] += w[k][2 * t + 1] * __uint_as_float(d & 0xffff0000u); }
      }
      u32x4 o; o.x = pack_bf16(acc[0], acc[1]); o.y = pack_bf16(acc[2], acc[3]); o.z = pack_bf16(acc[4], acc[5]); o.w = pack_bf16(acc[6], acc[7]);
      *(u32x4*)(UC + (size_t)r * D + c) = o;
      win[0] = win[1]; win[1] = win[2]; win[2] = win[3];
    }
  }
}

__device__ __forceinline__ void scan1_phase(const Params& p) {
  const bf16_t* LAB = (const bf16_t*)(p.ws + OFF_LAB);
  float* CHP = (float*)(p.ws + OFF_CHP); float* CHH = (float*)(p.ws + OFF_CHH);
  const int total = 2 * 272 * 4; const int tid = tidx();
  for (int item = blockIdx.x; item < total; item += gridDim.x) {
    const int cgp = item & 3, ch = (item >> 2) % 272, dir = item / (272 * 4);
    const int c = cgp * 512 + tid;
    const bf16_t* a = LAB + ((size_t)(dir * 2) * TT + ch * 64) * D + c; const bf16_t* b = LAB + ((size_t)(dir * 2 + 1) * TT + ch * 64) * D + c;
    float h = 0.f, ls = 0.f;
    if (dir == 0) {
#pragma unroll 16
      for (int t = 0; t < 64; ++t) { const float la = bf2f(a[(size_t)t * D]), bv = bf2f(b[(size_t)t * D]); h = __expf(la) * h + bv; ls += la; }
    } else {
#pragma unroll 16
      for (int t = 63; t >= 0; --t) { const float la = bf2f(a[(size_t)t * D]), bv = bf2f(b[(size_t)t * D]); h = __expf(la) * h + bv; ls += la; }
    }
    CHP[((size_t)dir * 272 + ch) * D + c] = __expf(ls); CHH[((size_t)dir * 272 + ch) * D + c] = h;
  }
}
__device__ __forceinline__ void scan2_phase(const Params& p) {
  const float* CHP = (const float*)(p.ws + OFF_CHP); const float* CHH = (const float*)(p.ws + OFF_CHH); float* CIN = (float*)(p.ws + OFF_CIN);
  for (int it = blockIdx.x * NT + tidx(); it < 2 * NB * D; it += gridDim.x * NT) {
    const int c = it & 2047, b = (it >> 11) & 3, dir = it >> 13;
    float carry = 0.f;
    for (int s = 0; s < 68; ++s) {
      int ch;
      if (dir == 0) ch = s < 4 ? (256 + 4 * b + s) : (64 * b + (s - 4));
      else ch = s < 4 ? (256 + 4 * b + (3 - s)) : (64 * b + (63 - (s - 4)));
      const size_t o = ((size_t)dir * 272 + ch) * D + c;
      CIN[o] = carry;
      carry = CHP[o] * carry + CHH[o];
    }
  }
}
__device__ __forceinline__ void scan3_phase(const Params& p, unsigned char* lds) {
  const bf16_t* LAB = (const bf16_t*)(p.ws + OFF_LAB); const float* CIN = (const float*)(p.ws + OFF_CIN);
  const bf16_t* GATE = (const bf16_t*)(p.ws + OFF_PQ); bf16_t* A2 = (bf16_t*)(p.ws + OFF_O);
  float* yf = (float*)lds;
  const int total = 256 * 4; const int tid = tidx();
  for (int item = blockIdx.x; item < total; item += gridDim.x) {
    const int cgp = item & 3, ch = item >> 2;
    const int c = cgp * 512 + tid;
    const size_t base = (size_t)ch * 64 * D + c;
    {
      const bf16_t* a = LAB + base; const bf16_t* b = LAB + (size_t)TT * D + base;
      float h = CIN[(size_t)ch * D + c];
#pragma unroll 1
      for (int t0 = 0; t0 < 64; t0 += 16) {
        bf16_t av[16], bv[16];
#pragma unroll
        for (int i = 0; i < 16; ++i) { av[i] = a[(size_t)(t0 + i) * D]; bv[i] = b[(size_t)(t0 + i) * D]; }
#pragma unroll
        for (int i = 0; i < 16; ++i) { h = __expf(bf2f(av[i])) * h + bf2f(bv[i]); yf[(t0 + i) * 512 + tid] = h; }
      }
    }
    {
      const bf16_t* a = LAB + (size_t)2 * TT * D + base; const bf16_t* b = LAB + (size_t)3 * TT * D + base;
      float h = CIN[((size_t)272 + ch) * D + c];
#pragma unroll 1
      for (int t0 = 48; t0 >= 0; t0 -= 16) {
        bf16_t av[16], bv[16], gv[16];
#pragma unroll
        for (int i = 0; i < 16; ++i) { av[i] = a[(size_t)(t0 + i) * D]; bv[i] = b[(size_t)(t0 + i) * D]; gv[i] = GATE[base + (size_t)(t0 + i) * D]; }
#pragma unroll
        for (int i = 15; i >= 0; --i) { h = __expf(bf2f(av[i])) * h + bf2f(bv[i]); A2[base + (size_t)(t0 + i) * D] = f2bf((yf[(t0 + i) * 512 + tid] + h) * bf2f(gv[i])); }
      }
    }
  }
}

#define XB_TMO      128
#define XB_XCNT(j)  (256  + 64 * (j))
#define XB_XSUB(j)  (1280 + 64 * (j))
#define XB_XGEN(j)  (2304 + 64 * (j))
#define XB_TOP      3328
#define XB_TOPGEN   3392
#define XCD_BAR_WORDS 3456
#define XB_SPIN_CAP (1u << 22)
#define LAS3 __attribute__((address_space(3)))
__device__ __forceinline__ unsigned xb_ld(unsigned* p)              { return __hip_atomic_load(p, __ATOMIC_RELAXED, __HIP_MEMORY_SCOPE_AGENT); }
__device__ __forceinline__ unsigned xb_add(unsigned* p, unsigned v) { return __hip_atomic_fetch_add(p, v, __ATOMIC_RELAXED, __HIP_MEMORY_SCOPE_AGENT); }
__device__ __forceinline__ unsigned xb_xcc_id() { return (unsigned)__builtin_amdgcn_s_getreg((3 << 11) | 20) & 0xFu; }
#define XB_SPIN(cond, bar) do { unsigned _sp = 0; while (cond) { __builtin_amdgcn_s_sleep(1); \
    if ((++_sp & 255u) == 0u) { if (xb_ld(&(bar)[XB_TMO])) break; if (_sp > XB_SPIN_CAP) { atomicAdd(&(bar)[XB_TMO], 1u); break; } } } } while (0)
struct XcdBarrier { unsigned* bar; unsigned x; volatile LAS3 unsigned* st; };
__device__ __forceinline__ XcdBarrier xcd_barrier_post(unsigned* bar, volatile LAS3 unsigned* st) {
  XcdBarrier b; b.bar = bar; b.x = xb_xcc_id(); b.st = st;
  if (threadIdx.x == 0) (void)xb_add(&bar[XB_XCNT(b.x)], 1u);
  return b;
}
__device__ __forceinline__ void xcd_barrier_complete(unsigned* bar, unsigned x, unsigned& nloc, unsigned& nx) {
  const unsigned G = gridDim.x * gridDim.y * gridDim.z;
  unsigned sum, cnt, mine, sp = 0u;
  for (;;) {
    sum = 0u; cnt = 0u; mine = 0u;
#pragma unroll
    for (unsigned j = 0; j < 16; ++j) { const unsigned c = xb_ld(&bar[XB_XCNT(j)]); sum += c; cnt += (c > 0u) ? 1u : 0u; mine = (j == x) ? c : mine; }
    if (sum == G) break;
    __builtin_amdgcn_s_sleep(1);
    if ((++sp & 255u) == 0u) { if (xb_ld(&bar[XB_TMO])) break; if (sp > XB_SPIN_CAP) { atomicAdd(&bar[XB_TMO], 1u); break; } }
  }
  nloc = mine > 0u ? mine : 1u; nx = cnt > 0u ? cnt : 1u;
}
__device__ __forceinline__ void xcd_barrier(const XcdBarrier& b) {
  asm volatile("s_waitcnt vmcnt(0)" ::: "memory");
  __syncthreads();
  if (threadIdx.x == 0) {
    unsigned* bar = b.bar;
    __builtin_amdgcn_s_waitcnt(0);
    unsigned nloc = b.st[0], nx = b.st[1];
    if (nloc == 0u) { xcd_barrier_complete(bar, b.x, nloc, nx); b.st[0] = nloc; b.st[1] = nx; }
    const unsigned old = xb_add(&bar[XB_XSUB(b.x)], 1u);
    const unsigned gen = old / nloc;
    if (old + 1u == (gen + 1u) * nloc) {
      __builtin_amdgcn_fence(__ATOMIC_RELEASE, "agent");
      asm volatile("s_waitcnt vmcnt(0)" ::: "memory");
      const unsigned og = xb_add(&bar[XB_TOP], 1u);
      const unsigned tg = og / nx;
      if (og + 1u == (tg + 1u) * nx) xb_add(&bar[XB_TOPGEN], 1u);
      else XB_SPIN(xb_ld(&bar[XB_TOPGEN]) == tg, bar);
      __builtin_amdgcn_fence(__ATOMIC_ACQUIRE, "agent");
      xb_add(&bar[XB_XGEN(b.x)], 1u);
      asm volatile("s_waitcnt vmcnt(0)" ::: "memory");
    } else {
      XB_SPIN(xb_ld(&bar[XB_XGEN(b.x)]) == gen, bar);
      __builtin_amdgcn_fence(__ATOMIC_ACQUIRE, "agent");
      asm volatile("s_waitcnt vmcnt(0)" ::: "memory");
    }
  }
  __syncthreads();
}

__global__ void __launch_bounds__(NT) fwd_megakernel(Params p) {
  extern __shared__ __attribute__((aligned(16))) unsigned char lds[];
  cg::grid_group grid = cg::this_grid();
  unsigned char* ws = p.ws;
  float* MODV = (float*)(ws + OFF_MODV);
  float* XS = (float*)(ws + OFF_XS);
  bf16_t* H = (bf16_t*)(ws + OFF_H);

  unsigned* bar = (unsigned*)(ws + OFF_BAR);
  if (blockIdx.x == 0) for (int i = threadIdx.x; i < XCD_BAR_WORDS; i += NT) bar[i] = 0u;
  volatile LAS3 unsigned* st = (volatile LAS3 unsigned*)((LAS3 unsigned char*)lds + 128 * 1024);
  if (threadIdx.x == 0) { st[0] = 0u; st[1] = 0u; }
  setup_phase(p, lds);
  if (PROBE == 1) { grid.sync(); setup_phase(p, lds); }
  grid.sync();
  const XcdBarrier xb = xcd_barrier_post(bar, st);
#define GSYNC() xcd_barrier(xb)
  {
    constexpr int ntok = TT;
    PH(2, norm_phase(p, 0, p.norm_mix + 0 * D, 0, TT, true, H));
    GSYNC();
      {
        EpiQKV256 e{(bf16_t*)(ws + OFF_Q), (bf16_t*)(ws + OFF_K), (bf16_t*)(ws + OFF_VT), (const float*)(ws + OFF_ROPE), (const float*)(ws + OFF_ROPE) + 2048};
        PH(3, gemm256(p, H, (const bf16_t*)(ws + OFF_WQKV), TT, 3072, D, lds, e, ItemRanges{0, 1024, 0, 0}));
      }
      GSYNC();
      PH(4, attn_phase(p, lds));
      GSYNC();
    {
      EpiResid256 e{p.x, p.ctx, XS, MODV + (size_t)(0 * 5) * NMOD + 2 * D, true};
      gemm256(p, (const bf16_t*)(ws + OFF_O), (const bf16_t*)(ws + (OFF_WO)), ntok, D, D, lds, e, ItemRanges{2048, 1024, 0, 0});
    }
    GSYNC();
    PH(6, norm_phase(p, 0, p.norm_ffn + 0 * D, 3, ntok, false, H));
    GSYNC();
    {
      EpiBf16_256 e{(bf16_t*)(ws + OFF_PQ), D};
      gemm256(p, H, (const bf16_t*)(ws + OFF_WPQ) + (size_t)0 * D * D, ntok, D, D, lds, e, ItemRanges{1024, 1024, 0, 0});
    }
    GSYNC();
    PH(8, peer_route_phase(p, 0, ntok, lds));
    GSYNC();
    if (DUP & 2) { peer_gather_phase(p, 0, ntok, 0, true); GSYNC(); }
    peer_gather_phase(p, 0, ntok, 0);
    GSYNC();
  }
  {
    constexpr int ntok = TL;
      {
        EpiWin256 e{(bf16_t*)(ws + OFF_PQ), (bf16_t*)(ws + OFF_Q)};
        PH(10, gemm256(p, H, (const bf16_t*)(ws + OFF_WIN), TT, 4096, D, lds, e, ItemRanges{3072, 1024, 0, 0}));
      }
      GSYNC();
      PH(11, conv_phase(p));
      GSYNC();
      PH(12, coef_phase(p, lds));
      GSYNC();
      PH(13, scan1_phase(p));
      GSYNC();
      PH(14, scan2_phase(p));
      GSYNC();
      if (DUP & 16) { scan1_phase(p); GSYNC(); scan2_phase(p); GSYNC(); }
      if (DUP & 32) { coef_phase(p, lds); GSYNC(); }
      if (DUP & 64) { for (int q = 0; q < 20; ++q) GSYNC(); }
      if (DUP & 128) { conv_phase(p); GSYNC(); }
      scan3_phase(p, lds);
      GSYNC();
    {
      EpiResid256 e{p.x, p.ctx, XS, MODV + (size_t)(1 * 5) * NMOD + 2 * D, false};
      gemm256(p, (const bf16_t*)(ws + OFF_O), (const bf16_t*)(ws + (OFF_WOUT)), ntok, D, D, lds, e, ItemRanges{0, 0, 0, 0});
    }
    GSYNC();
    norm_phase(p, 1, p.norm_ffn + 1 * D, 3, ntok, false, H);
    GSYNC();
    {
      EpiBf16_256 e{(bf16_t*)(ws + OFF_PQ), D};
      PH(18, gemm256(p, H, (const bf16_t*)(ws + OFF_WPQ) + (size_t)1 * D * D, ntok, D, D, lds, e, ItemRanges{0, 0, 0, 0}));
    }
    GSYNC();
    PH(19, peer_route_phase(p, 1, ntok, lds));
    GSYNC();
    if (DUP & 2) { peer_gather_phase(p, 1, ntok, 1, true); GSYNC(); }
    peer_gather_phase(p, 1, ntok, 1);
  }
}

__global__ void diag_fill(float* out, int n, float v) { for (int i = blockIdx.x * blockDim.x + threadIdx.x; i < n; i += gridDim.x * blockDim.x) out[i] = v; }

extern "C" void kernel_launch(void* const* d_in, const int* in_sizes, int n_in, void* d_out, int out_size, void* d_ws, size_t ws_size, hipStream_t stream) {
  static int grid_blocks = 0;
  if (!grid_blocks) {
    int dev = 0, cus = 0, per_cu = 0;
    (void)hipGetDevice(&dev);
    (void)hipDeviceGetAttribute(&cus, hipDeviceAttributeMultiprocessorCount, dev);
    (void)hipFuncSetAttribute((const void*)fwd_megakernel, hipFuncAttributeMaxDynamicSharedMemorySize, (int)kDynLds);
    (void)hipOccupancyMaxActiveBlocksPerMultiprocessor(&per_cu, fwd_megakernel, NT, kDynLds);
    if (per_cu > 1) per_cu = 1;
    if (per_cu < 1) per_cu = 1;
    grid_blocks = cus * per_cu;
  }
  if (ws_size < WS_NEED) { fprintf(stderr, "workspace too small: %zu < %zu\n", ws_size, (size_t)WS_NEED); diag_fill<<<1024, 256, 0, stream>>>((float*)d_out, out_size, 3.0f); return; }
  Params p{};
  const float* const* in = (const float* const*)d_in;
  p.x = in[0]; p.c = in[1]; p.ctx = in[2]; p.c_ctx = in[3]; p.w_mod = in[4]; p.b_mod = in[5]; p.norm_mix = in[6]; p.norm_ffn = in[7]; p.norm_final = in[8];
  p.attn_w_qkv = in[9]; p.attn_w_o = in[10]; p.attn_sink = in[11];
  p.rec_w_in = in[12]; p.rec_conv_w = in[13]; p.rec_conv_b = in[14]; p.rec_w_a = in[15]; p.rec_b_a = in[16]; p.rec_w_x = in[17]; p.rec_b_x = in[18]; p.rec_lambda = in[19]; p.rec_w_out = in[20];
  p.peer_w_q = in[21]; p.peer_keys = in[22]; p.peer_u = in[23]; p.peer_v = in[24];
  p.out = (float*)d_out; p.ws = (unsigned char*)d_ws;
  void* args[] = {&p};
  hipError_t e = hipLaunchCooperativeKernel((void*)fwd_megakernel, dim3(grid_blocks), dim3(NT), args, kDynLds, stream);
  if (e != hipSuccess) { fprintf(stderr, "cooperative launch failed: %s (grid %d)\n", hipGetErrorString(e), grid_blocks); diag_fill<<<1024, 256, 0, stream>>>((float*)d_out, out_size, 5.0f); }
}
```

```cpp
#include <hip/hip_runtime.h>
#include <hip/hip_cooperative_groups.h>
#include <cstdio>
namespace cg = cooperative_groups;

typedef unsigned short bf16_t;
typedef short bf16x8 __attribute__((ext_vector_type(8)));
typedef float f32x4 __attribute__((ext_vector_type(4)));
typedef unsigned u32x4 __attribute__((ext_vector_type(4)));
typedef unsigned u32x2 __attribute__((ext_vector_type(2)));
typedef __bf16 bf16x2_t __attribute__((ext_vector_type(2)));

constexpr int D = 2048, NB = 4, S = 4096, CL = 256;
constexpr int TL = NB * S, TC = NB * CL, TT = TL + TC;
constexpr int NT = 512;
constexpr int NMOD = 6 * D;
constexpr int NEXP = 16384;
constexpr size_t kDynLds = 128 * 1024 + 64;
#ifndef SKIP
#define SKIP 0
#endif
#ifndef DUP
#define DUP 0
#endif
#ifndef PROBE
#define PROBE 0
#endif
#define PH(k, ...) do { __VA_ARGS__; if (PROBE == (k)) { GSYNC(); __VA_ARGS__; } } while (0)

constexpr size_t al256(size_t x) { return (x + 255) & ~(size_t)255; }
constexpr size_t OFF_WQKV = 0;
constexpr size_t OFF_WO   = OFF_WQKV + al256((size_t)3072 * 2048 * 2);
constexpr size_t OFF_WPQ  = OFF_WO + al256((size_t)2048 * 2048 * 2);
constexpr size_t OFF_WIN  = OFF_WPQ + al256((size_t)2 * 2048 * 2048 * 2);
constexpr size_t OFF_WOUT = OFF_WIN + al256((size_t)4096 * 2048 * 2);
constexpr size_t OFF_WA   = OFF_WOUT + al256((size_t)2048 * 2048 * 2);
constexpr size_t OFF_SP   = OFF_WA + al256((size_t)32 * 256 * 256 * 2);
constexpr size_t OFF_KEYS = OFF_SP + al256((size_t)2 * 2048 * 4);
constexpr size_t OFF_UTAB = OFF_KEYS + al256((size_t)2 * 2 * 128 * 128 * 2);
constexpr size_t OFF_VTAB = OFF_UTAB + al256((size_t)2 * NEXP * D);
constexpr size_t OFF_USC  = OFF_VTAB + al256((size_t)2 * NEXP * D);
constexpr size_t OFF_VSC  = OFF_USC + al256((size_t)2 * NEXP * 4);
constexpr size_t OFF_MODV = OFF_VSC + al256((size_t)2 * NEXP * 4);
constexpr size_t OFF_ROPE = OFF_MODV + al256((size_t)2 * 5 * NMOD * 4);
constexpr size_t OFF_XS   = OFF_ROPE + al256((size_t)2 * 2048 * 4);
constexpr size_t SZ_ACT  = al256((size_t)TT * D * 2);
constexpr size_t OFF_H    = OFF_XS + al256((size_t)TT * D * 4);
constexpr size_t OFF_Q    = OFF_H + SZ_ACT;
constexpr size_t OFF_X    = OFF_Q + SZ_ACT;
constexpr size_t OFF_K    = OFF_X + 2 * SZ_ACT;
constexpr size_t OFF_VT   = OFF_K + al256((size_t)TT * 512 * 2);
constexpr size_t OFF_O    = OFF_VT + al256((size_t)TT * 512 * 2);
constexpr size_t OFF_PQ   = OFF_O + SZ_ACT;
constexpr size_t OFF_LAB  = OFF_H;
constexpr size_t OFF_CHP  = OFF_K;
constexpr size_t OFF_CHH  = OFF_CHP + al256((size_t)2 * 272 * D * 4);
constexpr size_t OFF_CIN  = OFF_CHH + al256((size_t)2 * 272 * D * 4);
constexpr size_t OFF_IDX  = OFF_PQ + SZ_ACT;
constexpr size_t OFF_GW   = OFF_IDX + al256((size_t)TT * 128 * 4);
constexpr size_t OFF_BAR  = OFF_GW + al256((size_t)TT * 128 * 4);
constexpr size_t WS_NEED  = OFF_BAR + 16384;
static_assert(OFF_CIN + al256((size_t)2 * 272 * D * 4) <= OFF_O, "scan carries must fit in the K/VT region");
static_assert(WS_NEED <= ((size_t)1 << 30), "workspace map exceeds 1 GiB");

struct Params {
  const float *x, *c, *ctx, *c_ctx, *w_mod, *b_mod, *norm_mix, *norm_ffn, *norm_final;
  const float *attn_w_qkv, *attn_w_o, *attn_sink;
  const float *rec_w_in, *rec_conv_w, *rec_conv_b, *rec_w_a, *rec_b_a, *rec_w_x, *rec_b_x, *rec_lambda, *rec_w_out;
  const float *peer_w_q, *peer_keys, *peer_u, *peer_v;
  float* out; unsigned char* ws;
};

__device__ __forceinline__ float bf2f(bf16_t v) { return __uint_as_float((unsigned)v << 16); }
__device__ __forceinline__ bf16_t f2bf(float f) { unsigned u = __float_as_uint(f); u += 0x7fffu + ((u >> 16) & 1u); return (bf16_t)(u >> 16); }
typedef float f32x2_t __attribute__((ext_vector_type(2)));
__device__ __forceinline__ unsigned pack_bf16(float lo, float hi) { const f32x2_t v = {lo, hi}; return __builtin_bit_cast(unsigned, __builtin_convertvector(v, bf16x2_t)); }
template <int CTRL, int RM, bool BC> __device__ __forceinline__ float dppf(float old, float src) {
  return __builtin_bit_cast(float, __builtin_amdgcn_update_dpp(__builtin_bit_cast(int, old), __builtin_bit_cast(int, src), CTRL, RM, 0xf, BC));
}
__device__ __forceinline__ float wave_sum(float v) {
  v += dppf<0x111, 0xf, true>(0.f, v); v += dppf<0x112, 0xf, true>(0.f, v); v += dppf<0x114, 0xf, true>(0.f, v); v += dppf<0x118, 0xf, true>(0.f, v);
  v += dppf<0x142, 0xa, false>(0.f, v); v += dppf<0x143, 0xc, false>(0.f, v);
  return __builtin_bit_cast(float, __builtin_amdgcn_readlane(__builtin_bit_cast(int, v), 63));
}
__device__ __forceinline__ float wave_max(float v) {
  v = fmaxf(v, dppf<0x111, 0xf, false>(v, v)); v = fmaxf(v, dppf<0x112, 0xf, false>(v, v)); v = fmaxf(v, dppf<0x114, 0xf, false>(v, v)); v = fmaxf(v, dppf<0x118, 0xf, false>(v, v));
  v = fmaxf(v, dppf<0x142, 0xa, false>(v, v)); v = fmaxf(v, dppf<0x143, 0xc, false>(v, v));
  return __builtin_bit_cast(float, __builtin_amdgcn_readlane(__builtin_bit_cast(int, v), 63));
}
__device__ __forceinline__ float gelu_tanh(float x) {
  const float y = 0.7978845608028654f * (x + 0.044715f * x * x * x);
  const float t = 1.0f - 2.0f / (1.0f + __expf(2.0f * y));
  return 0.5f * x * (1.0f + t);
}
__device__ __forceinline__ float sigmoid_f(float x) { return 1.0f / (1.0f + __expf(-x)); }
__device__ __forceinline__ int mod_row(int r) { return r < TL ? (r >> 12) : 4; }
__device__ __forceinline__ int tidx() { int t = threadIdx.x; asm volatile("" : "+v"(t)); return t; }

__device__ __forceinline__ void mod_item(const Params& p, int item, float* lds) {
  float* sil = lds;
  float* red = lds + 5 * 2048;
  const int tid = tidx(), wid = tid >> 6, lane = tid & 63;
  for (int i = tid; i < 5 * 2048; i += NT) {
    const int m = i >> 11, k = i & 2047;
    const float v = (m < 4) ? p.c[m * 2048 + k] : p.c_ctx[k];
    sil[i] = v / (1.0f + expf(-v));
  }
  __syncthreads();
  const int layer = item / 48, cgp = item % 48;
  const float* W = p.w_mod + (size_t)layer * 2048 * NMOD + cgp * 256 + lane * 4;
  float acc[5][4];
#pragma unroll
  for (int m = 0; m < 5; ++m)
#pragma unroll
    for (int j = 0; j < 4; ++j) acc[m][j] = 0.f;
  const int k0 = wid * 256;
  constexpr int MB = 10;
  float4 wa[MB], wb[MB];
#pragma unroll
  for (int i = 0; i < MB; ++i) wa[i] = *(const float4*)(W + (size_t)(k0 + i) * NMOD);
#pragma unroll 1
  for (int kk = k0; kk < k0 + 240; kk += 2 * MB) {
#pragma unroll
    for (int i = 0; i < MB; ++i) wb[i] = *(const float4*)(W + (size_t)(kk + MB + i) * NMOD);
#pragma unroll
    for (int i = 0; i < MB; ++i)
#pragma unroll
      for (int m = 0; m < 5; ++m) { const float sv = sil[m * 2048 + kk + i]; acc[m][0] += sv * wa[i].x; acc[m][1] += sv * wa[i].y; acc[m][2] += sv * wa[i].z; acc[m][3] += sv * wa[i].w; }
    if (kk + 2 * MB < k0 + 240) {
#pragma unroll
      for (int i = 0; i < MB; ++i) wa[i] = *(const float4*)(W + (size_t)(kk + 2 * MB + i) * NMOD);
    }
#pragma unroll
    for (int i = 0; i < MB; ++i)
#pragma unroll
      for (int m = 0; m < 5; ++m) { const float sv = sil[m * 2048 + kk + MB + i]; acc[m][0] += sv * wb[i].x; acc[m][1] += sv * wb[i].y; acc[m][2] += sv * wb[i].z; acc[m][3] += sv * wb[i].w; }
  }
#pragma unroll
  for (int i = 0; i < 16; ++i) {
    const float4 w = *(const float4*)(W + (size_t)(k0 + 240 + i) * NMOD);
#pragma unroll
    for (int m = 0; m < 5; ++m) { const float sv = sil[m * 2048 + k0 + 240 + i]; acc[m][0] += sv * w.x; acc[m][1] += sv * w.y; acc[m][2] += sv * w.z; acc[m][3] += sv * w.w; }
  }
#pragma unroll
  for (int m = 0; m < 5; ++m)
#pragma unroll
    for (int j = 0; j < 4; ++j) red[(wid * 5 + m) * 256 + lane * 4 + j] = acc[m][j];
  __syncthreads();
  float* MODV = (float*)(p.ws + OFF_MODV);
  for (int o = tid; o < 1280; o += NT) {
    const int m = o >> 8, n = o & 255;
    float s = 0.f;
#pragma unroll
    for (int w = 0; w < 8; ++w) s += red[(w * 5 + m) * 256 + n];
    const int col = cgp * 256 + n;
    MODV[(size_t)(layer * 5 + m) * NMOD + col] = s + p.b_mod[layer * NMOD + col];
  }
  __syncthreads();
}

__device__ __forceinline__ void transpose_quad(const Params& p, int q, float* lds) {
  const float* W; bf16_t* Wt; int K, N; int rnn = -1, isx = 0, mtx = 0;
  if (q < 384) { W = p.attn_w_qkv; Wt = (bf16_t*)(p.ws + OFF_WQKV); K = 2048; N = 3072; }
  else if ((q -= 384) < 256) { W = p.attn_w_o; Wt = (bf16_t*)(p.ws + OFF_WO); K = 2048; N = 2048; }
  else if ((q -= 256) < 512) { const int l = q >> 8; q &= 255; W = p.peer_w_q + (size_t)l * 2048 * 2048; Wt = (bf16_t*)(p.ws + OFF_WPQ) + (size_t)l * 2048 * 2048; K = 2048; N = 2048; }
  else if ((q -= 512) < 512) { W = p.rec_w_in; Wt = (bf16_t*)(p.ws + OFF_WIN); K = 2048; N = 4096; }
  else if ((q -= 512) < 256) { W = p.rec_w_out; Wt = (bf16_t*)(p.ws + OFF_WOUT); K = 2048; N = 2048; }
  else { q -= 256; isx = q >> 6; q &= 63; mtx = q >> 2; q &= 3; rnn = 1; W = (isx ? p.rec_w_x : p.rec_w_a) + (size_t)mtx * 65536; Wt = (bf16_t*)(p.ws + OFF_WA); K = 256; N = 256; }
  const int nq = N >> 8, k0 = (q / nq) * 64, n0 = (q % nq) * 256;
  const int tid = tidx();
  {
    const int r = tid >> 6, c4 = (tid & 63) * 4;
    float4 v[8];
#pragma unroll
    for (int i = 0; i < 8; ++i) v[i] = *(const float4*)(W + (size_t)(k0 + r + 8 * i) * N + n0 + c4);
#pragma unroll
    for (int i = 0; i < 8; ++i) { float* d = lds + (r + 8 * i) * 257 + c4; d[0] = v[i].x; d[1] = v[i].y; d[2] = v[i].z; d[3] = v[i].w; }
  }
  __syncthreads();
  {
    const int n = tid >> 1, kh = (tid & 1) * 32;
    bf16_t* drow = (rnn < 0) ? Wt + (size_t)(n0 + n) * K + k0 + kh : Wt + ((size_t)(mtx * 2 + (n >> 7)) * 256 + isx * 128 + (n & 127)) * 256 + k0 + kh;
#pragma unroll
    for (int c = 0; c < 4; ++c) {
      u32x4 o;
      o.x = pack_bf16(lds[(kh + c * 8 + 0) * 257 + n], lds[(kh + c * 8 + 1) * 257 + n]);
      o.y = pack_bf16(lds[(kh + c * 8 + 2) * 257 + n], lds[(kh + c * 8 + 3) * 257 + n]);
      o.z = pack_bf16(lds[(kh + c * 8 + 4) * 257 + n], lds[(kh + c * 8 + 5) * 257 + n]);
      o.w = pack_bf16(lds[(kh + c * 8 + 6) * 257 + n], lds[(kh + c * 8 + 7) * 257 + n]);
      *(u32x4*)(drow + c * 8) = o;
    }
  }
  __syncthreads();
}

__device__ __forceinline__ void convert8(const float* src, bf16_t* dst) {
  const float4 a = ((const float4*)src)[0], b = ((const float4*)src)[1];
  u32x4 o; o.x = pack_bf16(a.x, a.y); o.y = pack_bf16(a.z, a.w); o.z = pack_bf16(b.x, b.y); o.w = pack_bf16(b.z, b.w);
  *(u32x4*)dst = o;
}

constexpr int IT_MOD = 0, IT_TR = 96, IT_KEYS = IT_TR + 8192, IT_ROPE = IT_KEYS + 16, IT_TAB = IT_ROPE + 1;
struct ItemRanges { int lo1, n1, lo2, n2; };

__device__ __forceinline__ void quant_rows_item(const Params& p, int t, int tid0) {
  const int wid = tid0 >> 6, lane = tid0 & 63;
  float4 v[2][8]; float mx[2] = {0.f, 0.f};
#pragma unroll
  for (int h = 0; h < 2; ++h) {
    const int R = t * 16 + h * 8 + wid, tb = R >> 15, row = R & 32767;
    const float* src = (tb == 0 ? p.peer_u : p.peer_v) + (size_t)row * D;
#pragma unroll
    for (int i = 0; i < 8; ++i) v[h][i] = ((const float4*)src)[i * 64 + lane];
  }
#pragma unroll
  for (int h = 0; h < 2; ++h) {
    const int R = t * 16 + h * 8 + wid, tb = R >> 15, row = R & 32767;
    unsigned* dst = (unsigned*)(p.ws + (tb == 0 ? OFF_UTAB : OFF_VTAB) + (size_t)row * D);
    float* scp = (float*)(p.ws + (tb == 0 ? OFF_USC : OFF_VSC)) + row;
#pragma unroll
    for (int i = 0; i < 8; ++i) mx[h] = fmaxf(mx[h], fmaxf(fmaxf(fabsf(v[h][i].x), fabsf(v[h][i].y)), fmaxf(fabsf(v[h][i].z), fabsf(v[h][i].w))));
    mx[h] = wave_max(mx[h]);
    const float sc = mx[h] > 0.f ? mx[h] * (1.0f / 127.0f) : 1.0f, inv = 1.0f / sc;
    const int off = tb == 0 ? 0 : 128;
#pragma unroll
    for (int i = 0; i < 8; ++i) {
      const unsigned q0 = (unsigned)((int)fminf(fmaxf(rintf(v[h][i].x * inv), -127.f), 127.f) + off) & 0xffu, q1 = (unsigned)((int)fminf(fmaxf(rintf(v[h][i].y * inv), -127.f), 127.f) + off) & 0xffu;
      const unsigned q2 = (unsigned)((int)fminf(fmaxf(rintf(v[h][i].z * inv), -127.f), 127.f) + off) & 0xffu, q3 = (unsigned)((int)fminf(fmaxf(rintf(v[h][i].w * inv), -127.f), 127.f) + off) & 0xffu;
      dst[i * 64 + lane] = q0 | (q1 << 8) | (q2 << 16) | (q3 << 24);
    }
    if (lane == 0) *scp = sc;
  }
}

__device__ __forceinline__ void setup_phase(const Params& p, unsigned char* lds_raw) {
  float* lds = (float*)lds_raw;
  const int tid0 = tidx();
  const int b = (int)blockIdx.x;
  if (b < 48) { mod_item(p, b, lds); return; }
  for (int j = b - 48; j < 896 + 17; j += (int)gridDim.x - 48) {
    if (j < 896) { transpose_quad(p, j, lds); continue; }
    const int t = j - 896;
    if (t < 16) { const size_t e = (size_t)t * 4096 + tid0 * 8; convert8(p.peer_keys + e, (bf16_t*)(p.ws + OFF_KEYS) + e); continue; }
    float* cosT = (float*)(p.ws + OFF_ROPE); float* sinT = cosT + 2048;
    for (int e = tid0; e < 2048; e += NT) {
      const int pos = e >> 5, jj = e & 31;
      const float inv = powf(10000.0f, -(float)(2 * jj) / 64.0f);
      const float ang = (float)pos * inv;
      cosT[e] = cosf(ang); sinT[e] = sinf(ang);
    }
    float* SP = (float*)(p.ws + OFF_SP);
    for (int e = tid0; e < 2 * 2048; e += NT) SP[e] = log1pf(expf(-p.rec_lambda[e]));
  }
}
__device__ __forceinline__ void norm_phase(const Params& p, int layer, const float* gain, int shift_idx, int nrows, bool from_input, bf16_t* H, const bf16_t* DELTA = nullptr) {
  const int tid_ = tidx(), wid = tid_ >> 6, lane = tid_ & 63;
  const float* MODV = (const float*)(p.ws + OFF_MODV);
  float* XS = (float*)(p.ws + OFF_XS);
  for (int r = blockIdx.x * 8 + wid; r < nrows; r += gridDim.x * 8) {
    const float* src = from_input ? (r < TL ? p.x + (size_t)r * D : p.ctx + (size_t)(r - TL) * D) : XS + (size_t)r * D;
    const float* mv = MODV + (size_t)(layer * 5 + mod_row(r)) * NMOD;
    const float* sh = mv + shift_idx * D; const float* sc = sh + D;
    float4 v[8]; float ss = 0.f;
#pragma unroll
    for (int i = 0; i < 8; ++i) v[i] = ((const float4*)src)[i * 64 + lane];
    if (DELTA) {
#pragma unroll
      for (int i = 0; i < 8; ++i) {
        const u32x2 dd = *(const u32x2*)(DELTA + (size_t)r * D + i * 256 + lane * 4);
        v[i].x += __uint_as_float(dd.x << 16); v[i].y += __uint_as_float(dd.x & 0xffff0000u); v[i].z += __uint_as_float(dd.y << 16); v[i].w += __uint_as_float(dd.y & 0xffff0000u);
      }
    }
#pragma unroll
    for (int i = 0; i < 8; ++i) ss += v[i].x * v[i].x + v[i].y * v[i].y + v[i].z * v[i].z + v[i].w * v[i].w;
    ss = wave_sum(ss);
    const float rs = rsqrtf(ss * (1.0f / D) + 1e-6f);
#pragma unroll
    for (int i = 0; i < 8; ++i) {
      const float4 g = ((const float4*)gain)[i * 64 + lane], a = ((const float4*)sh)[i * 64 + lane], b = ((const float4*)sc)[i * 64 + lane];
      const float o0 = v[i].x * rs * g.x * (1.0f + b.x) + a.x, o1 = v[i].y * rs * g.y * (1.0f + b.y) + a.y;
      const float o2 = v[i].z * rs * g.z * (1.0f + b.z) + a.z, o3 = v[i].w * rs * g.w * (1.0f + b.w) + a.w;
      u32x2 o; o.x = pack_bf16(o0, o1); o.y = pack_bf16(o2, o3);
      *(u32x2*)(H + (size_t)r * D + i * 256 + lane * 4) = o;
    }
  }
}

__device__ __forceinline__ void final_norm_phase(const Params& p) {
  const int tid_ = tidx(), wid = tid_ >> 6, lane = tid_ & 63;
  const float* XS = (const float*)(p.ws + OFF_XS);
  for (int r = blockIdx.x * 8 + wid; r < TL; r += gridDim.x * 8) {
    const float4* xr = (const float4*)(XS + (size_t)r * D);
    float4 v[8]; float ss = 0.f;
#pragma unroll
    for (int i = 0; i < 8; ++i) { v[i] = xr[i * 64 + lane]; ss += v[i].x * v[i].x + v[i].y * v[i].y + v[i].z * v[i].z + v[i].w * v[i].w; }
    ss = wave_sum(ss);
    const float rs = rsqrtf(ss * (1.0f / D) + 1e-6f);
    float4* orow = (float4*)(p.out + (size_t)r * D);
#pragma unroll
    for (int i = 0; i < 8; ++i) { const float4 g = ((const float4*)p.norm_final)[i * 64 + lane]; float4 o; o.x = v[i].x * rs * g.x; o.y = v[i].y * rs * g.y; o.z = v[i].z * rs * g.z; o.w = v[i].w * rs * g.w; orow[i * 64 + lane] = o; }
  }
}

constexpr int GLD = 72;
template <bool DUAL, class Epi>
__device__ __forceinline__ void gemm_tile(const bf16_t* __restrict__ Ap, int lda, const bf16_t* __restrict__ Bp, const bf16_t* __restrict__ B2p, int ldb, int K,
                                          unsigned char* lds, const Epi& epi, int m0, int n0) {
  const int tid = tidx(), wid = tid >> 6, lane = tid & 63, wm = wid >> 1, wn = wid & 1, fr = lane & 15, fq = lane >> 4;
  bf16_t* As = (bf16_t*)lds; bf16_t* Bs = As + 2 * 128 * GLD; bf16_t* B2s = Bs + 2 * 128 * GLD;
  const int lr0 = tid >> 3, lc = (tid & 7) * 8;
  f32x4 acc[2][4], acc2[2][4];
#pragma unroll
  for (int i = 0; i < 2; ++i)
#pragma unroll
    for (int j = 0; j < 4; ++j) { acc[i][j] = (f32x4){0.f, 0.f, 0.f, 0.f}; acc2[i][j] = (f32x4){0.f, 0.f, 0.f, 0.f}; }
  u32x4 ra[2], rb[2], rb2[2];
  const int nk = K >> 6;
#pragma unroll
  for (int i = 0; i < 2; ++i) {
    ra[i] = *(const u32x4*)(Ap + (size_t)(lr0 + 64 * i) * lda + lc);
    rb[i] = *(const u32x4*)(Bp + (size_t)(lr0 + 64 * i) * ldb + lc);
    if (DUAL) rb2[i] = *(const u32x4*)(B2p + (size_t)(lr0 + 64 * i) * ldb + lc);
  }
#pragma unroll
  for (int i = 0; i < 2; ++i) {
    *(u32x4*)(As + (lr0 + 64 * i) * GLD + lc) = ra[i];
    *(u32x4*)(Bs + (lr0 + 64 * i) * GLD + lc) = rb[i];
    if (DUAL) *(u32x4*)(B2s + (lr0 + 64 * i) * GLD + lc) = rb2[i];
  }
  __syncthreads();
  for (int kt = 0; kt < nk; ++kt) {
    const int buf = kt & 1;
    if (kt + 1 < nk) {
#pragma unroll
      for (int i = 0; i < 2; ++i) {
        ra[i] = *(const u32x4*)(Ap + (size_t)(lr0 + 64 * i) * lda + (kt + 1) * 64 + lc);
        rb[i] = *(const u32x4*)(Bp + (size_t)(lr0 + 64 * i) * ldb + (kt + 1) * 64 + lc);
        if (DUAL) rb2[i] = *(const u32x4*)(B2p + (size_t)(lr0 + 64 * i) * ldb + (kt + 1) * 64 + lc);
      }
    }
    const bf16_t* Ab = As + buf * 128 * GLD; const bf16_t* Bb = Bs + buf * 128 * GLD; const bf16_t* B2b = B2s + buf * 128 * GLD;
#pragma unroll
    for (int ks = 0; ks < 2; ++ks) {
      bf16x8 af[2], bfr[4];
#pragma unroll
      for (int mi = 0; mi < 2; ++mi) af[mi] = *(const bf16x8*)(Ab + (wm * 32 + mi * 16 + fr) * GLD + ks * 32 + fq * 8);
#pragma unroll
      for (int ni = 0; ni < 4; ++ni) bfr[ni] = *(const bf16x8*)(Bb + (wn * 64 + ni * 16 + fr) * GLD + ks * 32 + fq * 8);
#pragma unroll
      for (int mi = 0; mi < 2; ++mi)
#pragma unroll
        for (int ni = 0; ni < 4; ++ni) acc[mi][ni] = __builtin_amdgcn_mfma_f32_16x16x32_bf16(bfr[ni], af[mi], acc[mi][ni], 0, 0, 0);
      if (DUAL) {
#pragma unroll
        for (int ni = 0; ni < 4; ++ni) bfr[ni] = *(const bf16x8*)(B2b + (wn * 64 + ni * 16 + fr) * GLD + ks * 32 + fq * 8);
#pragma unroll
        for (int mi = 0; mi < 2; ++mi)
#pragma unroll
          for (int ni = 0; ni < 4; ++ni) acc2[mi][ni] = __builtin_amdgcn_mfma_f32_16x16x32_bf16(bfr[ni], af[mi], acc2[mi][ni], 0, 0, 0);
      }
    }
    if (kt + 1 < nk) {
      const int nb = buf ^ 1;
#pragma unroll
      for (int i = 0; i < 2; ++i) {
        *(u32x4*)(As + nb * 128 * GLD + (lr0 + 64 * i) * GLD + lc) = ra[i];
        *(u32x4*)(Bs + nb * 128 * GLD + (lr0 + 64 * i) * GLD + lc) = rb[i];
        if (DUAL) *(u32x4*)(B2s + nb * 128 * GLD + (lr0 + 64 * i) * GLD + lc) = rb2[i];
      }
    }
    __syncthreads();
  }
  epi(acc, acc2, m0 + wm * 32 + fr, n0 + wn * 64 + fq * 4);
}

struct EpiQKV {
  bf16_t *Q, *Kb, *VT; const float *cosT, *sinT;
  __device__ __forceinline__ void operator()(const f32x4 (&acc)[2][4], const f32x4 (&)[2][4], int rbase, int cbase) const {
    const int n0 = cbase & ~127;
#pragma unroll
    for (int mi = 0; mi < 2; ++mi) {
      const int r = rbase + 16 * mi;
      if (n0 < 2560) {
        const bool latent = r < TL;
        const int s = r & 4095;
        const int pos = ((cbase & 64) == 0) ? (s >> 6) : (s & 63);
        const int cl = cbase & 63;
        bf16_t* dst = (n0 < 2048) ? (Q + (size_t)r * D + cbase) : (Kb + (size_t)r * 512 + (cbase - 2048));
#pragma unroll
        for (int ni = 0; ni < 2; ++ni) {
          f32x4 x1 = acc[mi][ni], x2 = acc[mi][ni + 2], y1 = x1, y2 = x2;
          if (latent) {
            const f32x4 cs = *(const f32x4*)(cosT + pos * 32 + ni * 16 + cl), sn = *(const f32x4*)(sinT + pos * 32 + ni * 16 + cl);
            y1 = x1 * cs - x2 * sn; y2 = x2 * cs + x1 * sn;
          }
          u32x2 o1, o2; o1.x = pack_bf16(y1[0], y1[1]); o1.y = pack_bf16(y1[2], y1[3]); o2.x = pack_bf16(y2[0], y2[1]); o2.y = pack_bf16(y2[2], y2[3]);
          *(u32x2*)(dst + ni * 16) = o1; *(u32x2*)(dst + (ni + 2) * 16) = o2;
        }
      } else {
#pragma unroll
        for (int ni = 0; ni < 4; ++ni)
#pragma unroll
          for (int j = 0; j < 4; ++j) VT[(size_t)(cbase - 2560 + ni * 16 + j) * TT + r] = f2bf(acc[mi][ni][j]);
      }
    }
  }
};
struct EpiResid {
  const float *x, *ctx; float* XS; const float* gate  ; bool from_input; float mul;
  __device__ __forceinline__ void operator()(const f32x4 (&acc)[2][4], const f32x4 (&)[2][4], int rbase, int cbase) const {
#pragma unroll
    for (int mi = 0; mi < 2; ++mi) {
      const int r = rbase + 16 * mi;
      const float* src = from_input ? (r < TL ? x + (size_t)r * D : ctx + (size_t)(r - TL) * D) : XS + (size_t)r * D;
      const float* g = gate + (size_t)mod_row(r) * NMOD;
#pragma unroll
      for (int ni = 0; ni < 4; ++ni) {
        const int c = cbase + ni * 16;
        const f32x4 b = *(const f32x4*)(src + c), gg = *(const f32x4*)(g + c);
        *(f32x4*)(XS + (size_t)r * D + c) = b + gg * acc[mi][ni] * mul;
      }
    }
  }
};
struct EpiBf16 {
  bf16_t* O; int ldo;
  __device__ __forceinline__ void operator()(const f32x4 (&acc)[2][4], const f32x4 (&)[2][4], int rbase, int cbase) const {
#pragma unroll
    for (int mi = 0; mi < 2; ++mi)
#pragma unroll
      for (int ni = 0; ni < 4; ++ni) {
        u32x2 o; o.x = pack_bf16(acc[mi][ni][0], acc[mi][ni][1]); o.y = pack_bf16(acc[mi][ni][2], acc[mi][ni][3]);
        *(u32x2*)(O + (size_t)(rbase + 16 * mi) * ldo + cbase + ni * 16) = o;
      }
  }
};
struct EpiWin {
  bf16_t *GATE, *UBR;
  __device__ __forceinline__ void operator()(const f32x4 (&acc)[2][4], const f32x4 (&)[2][4], int rbase, int cbase) const {
#pragma unroll
    for (int mi = 0; mi < 2; ++mi) {
      const int r = rbase + 16 * mi;
#pragma unroll
      for (int ni = 0; ni < 4; ++ni) {
        const int c = cbase + ni * 16;
        f32x4 v = acc[mi][ni];
        if (c < 2048) {
          if (r < TL) {
            u32x2 o; o.x = pack_bf16(gelu_tanh(v[0]), gelu_tanh(v[1])); o.y = pack_bf16(gelu_tanh(v[2]), gelu_tanh(v[3]));
            *(u32x2*)(GATE + (size_t)r * D + c) = o;
          }
        } else {
          u32x2 o; o.x = pack_bf16(v[0], v[1]); o.y = pack_bf16(v[2], v[3]);
          *(u32x2*)(UBR + (size_t)r * D + (c - 2048)) = o;
        }
      }
    }
  }
};
struct EpiCoef {
  const float *b_a, *b_x, *lam; const bf16_t* UC; bf16_t *LA, *LB;
  __device__ __forceinline__ void operator()(const f32x4 (&acc)[2][4], const f32x4 (&acc2)[2][4], int rbase, int cbase) const {
#pragma unroll
    for (int ni = 0; ni < 4; ++ni) {
      const int c = cbase + ni * 16;
      const f32x4 ba = *(const f32x4*)(b_a + c), bx = *(const f32x4*)(b_x + c), lm = *(const f32x4*)(lam + c);
      float sp[4];
#pragma unroll
      for (int j = 0; j < 4; ++j) sp[j] = log1pf(expf(-lm[j]));
#pragma unroll
      for (int mi = 0; mi < 2; ++mi) {
        const int r = rbase + 16 * mi;
        const u32x2 uu = *(const u32x2*)(UC + (size_t)r * D + c);
        const float uv[4] = {__uint_as_float(uu.x << 16), __uint_as_float(uu.x & 0xffff0000u), __uint_as_float(uu.y << 16), __uint_as_float(uu.y & 0xffff0000u)};
        float lav[4], bv[4];
#pragma unroll
        for (int j = 0; j < 4; ++j) {
          const float rg = sigmoid_f(acc[mi][ni][j] + ba[j]);
          const float ig = sigmoid_f(acc2[mi][ni][j] + bx[j]);
          const float log_a = -8.0f * rg * sp[j];
          lav[j] = log_a;
          bv[j] = sqrtf(-expm1f(2.0f * log_a)) * ig * uv[j];
        }
        u32x2 o1, o2; o1.x = pack_bf16(lav[0], lav[1]); o1.y = pack_bf16(lav[2], lav[3]); o2.x = pack_bf16(bv[0], bv[1]); o2.y = pack_bf16(bv[2], bv[3]);
        *(u32x2*)(LA + (size_t)r * D + c) = o1;
        *(u32x2*)(LB + (size_t)r * D + c) = o2;
      }
    }
  }
};

template <class Epi>
__device__ __forceinline__ void gemm_phase(const bf16_t* A, const bf16_t* Bt, int K, int mtiles, int ntiles, unsigned char* lds, const Epi& epi) {
  const int total = mtiles * ntiles;
  for (int item = blockIdx.x; item < total; item += gridDim.x) {
    const int nt = item % ntiles, mt = item / ntiles;
    gemm_tile<false>(A + (size_t)mt * 128 * K, K, Bt + (size_t)nt * 128 * K, nullptr, K, K, lds, epi, mt * 128, nt * 128);
  }
}


namespace pg8 {
#define PG8_LAS __attribute__((address_space(3)))
constexpr int BM = 256, BK = 64, HALF = 128, HTB = HALF * BK * 2, STAGE_BYTES = 8 * HTB, NXCD = 8, WGM = 8;
__device__ __forceinline__ int lds_byte(int r, int c) { const int st = (r >> 4) * 2 + (c >> 5), rr = r & 15, cc = c & 31, ob = rr * 64 + cc * 2; return st * 1024 + (ob ^ (((ob >> 9) & 1) << 5)); }
__device__ __forceinline__ void stage_rc(int b, int& R, int& C) { const int st = b / 1024, sb = b % 1024, swz = sb ^ (((sb >> 9) & 1) << 5); R = (st >> 1) * 16 + swz / 64; C = (st & 1) * 32 + (swz % 64) / 2; }
__device__ __forceinline__ int perm128(int rho) { const int w = rho >> 5, n = (rho >> 4) & 1, i = rho & 15; return 64 * (w >> 1) + 16 * (w & 1) + 32 * n + i; }
struct Unit { int pm, pn; unsigned aoff, boff; };
struct Gemm { const bf16_t* A; const bf16_t* Bt; int K, lda; };
struct StaticOrder {
  int nM, nN, nwg, G, c; unsigned tA, tB;
  __device__ void init(int M, int N, int K, int lda, int G_, int c_) { nM = M / BM; nN = N / BM; nwg = nM * nN; G = G_; c = c_; tA = (unsigned)(BM * lda * 2); tB = (unsigned)(BM * K * 2); }
  __device__ bool next(int i, Unit& u) const {
    const long L = (long)i * G + c; if (L >= nwg) return false;
    int wgid = (int)L; { const int q = nwg / NXCD, r = nwg % NXCD, xcd = wgid % NXCD, off = wgid / NXCD; wgid = (xcd < r ? xcd * (q + 1) : r * (q + 1) + (xcd - r) * q) + off; }
    const int nig = WGM * nN, gid = wgid / nig, fm = gid * WGM, gsz = (nM - fm) < WGM ? (nM - fm) : WGM;
    u.pm = fm + ((wgid % nig) % gsz); u.pn = (wgid % nig) / gsz; u.aoff = (unsigned)u.pm * tA; u.boff = (unsigned)u.pn * tB; return true;
  }
};
struct CoefOrder {
  int G, c;
  __device__ void init(int G_, int c_) { G = G_; c = c_; }
  __device__ bool next(int i, Unit& u) const {
    const long L = (long)i * G + c; if (L >= (long)(TT / 256) * 32) return false;
    u.pm = (int)(L >> 5); u.pn = (int)(L & 31); const int blk = (u.pn >> 1) & 7;
    u.aoff = (unsigned)((u.pm * 256 * D + blk * 256) * 2); u.boff = (unsigned)(u.pn * 256 * 256 * 2); return true;
  }
};
template <class Epi, class Sched>
__device__ __forceinline__ void gemm_phase(PG8_LAS unsigned char* lds, const Gemm g, const Sched& S, const Epi& E) {
  const int tid = tidx(), wid = __builtin_amdgcn_readfirstlane(tid >> 6), lane = tid & 63, wr = wid >> 2, wc = wid & 3, fr = lane & 15, fq = lane >> 4;
  const int K = g.K, nt = K / BK;
  unsigned voffA[2], voffB[2];
#pragma unroll
  for (int i = 0; i < 2; ++i) { int R, C; stage_rc(tid * 16 + i * 8192, R, C); const int Rb = perm128(R);
    voffA[i] = (unsigned)(R * g.lda + C) * 2u; voffB[i] = (unsigned)(Rb * K + C) * 2u; }
  const unsigned kstep = (unsigned)(BK * 2);
  const unsigned hstepA = (unsigned)(HALF * g.lda * 2), hstepB = (unsigned)(HALF * K * 2);
  const unsigned ldsw = (unsigned)wid * 1024u;
  const int aoff = lds_byte(wr * 64 + fr, fq * 8), boff = lds_byte(wc * 32 + fr, fq * 8);
#define PG8_SA(b, h) (((b) * 2 + (h)) * HTB)
#define PG8_SB(b, h) ((4 + (b) * 2 + (h)) * HTB)
#define PG8_STAGE(bufoff, gbase, voff) do { _Pragma("unroll") for (int _i = 0; _i < 2; ++_i) \
    __builtin_amdgcn_global_load_lds((const unsigned*)((const char*)(gbase) + (voff)[_i]), (PG8_LAS unsigned*)(lds + (bufoff) + ldsw + _i * 8192), 16, 0, 0); } while (0)
#define PG8_LDA(dst, b, h) do { _Pragma("unroll") for (int m = 0; m < 4; ++m) _Pragma("unroll") for (int k = 0; k < 2; ++k) dst[m][k] = *(const PG8_LAS bf16x8*)(lds + PG8_SA(b, h) + aoff + m * 2048 + k * 1024); } while (0)
#define PG8_LDB(dst, b, h) do { _Pragma("unroll") for (int n = 0; n < 2; ++n) _Pragma("unroll") for (int k = 0; k < 2; ++k) dst[n][k] = *(const PG8_LAS bf16x8*)(lds + PG8_SB(b, h) + boff + n * 2048 + k * 1024); } while (0)
#define PG8_MMA(ai, bj, At, Bt) do { __builtin_amdgcn_s_setprio(1); _Pragma("unroll") for (int m = 0; m < 4; ++m) _Pragma("unroll") for (int n = 0; n < 2; ++n) _Pragma("unroll") for (int k = 0; k < 2; ++k) \
    acc[ai][bj][m][n] = __builtin_amdgcn_mfma_f32_16x16x32_bf16(Bt[n][k], At[m][k], acc[ai][bj][m][n], 0, 0, 0); __builtin_amdgcn_s_setprio(0); } while (0)
#define PG8_WAIT_V(n) asm volatile("s_waitcnt vmcnt(" #n ")" ::: "memory")
#define PG8_WAIT_L(n) asm volatile("s_waitcnt lgkmcnt(" #n ")" ::: "memory")
#define PG8_BAR __builtin_amdgcn_s_barrier()
#define PG8_SCHED __builtin_amdgcn_sched_barrier(0)
  Unit cur, nxt; int ui = 0;
  if (!S.next(0, cur)) return;
  f32x4 acc[2][2][4][2];
#pragma unroll
  for (int a = 0; a < 2; ++a)
#pragma unroll
    for (int b = 0; b < 2; ++b)
#pragma unroll
      for (int m = 0; m < 4; ++m)
#pragma unroll
        for (int n = 0; n < 2; ++n) acc[a][b][m][n] = (f32x4){0.f, 0.f, 0.f, 0.f};
  bf16x8 At[4][2], B0[2][2], B1[2][2];
  const char* cA = (const char*)g.A + cur.aoff; const char* cB = (const char*)g.Bt + cur.boff;
  PG8_STAGE(PG8_SB(0, 0), cB, voffB); PG8_STAGE(PG8_SA(0, 0), cA, voffA); PG8_STAGE(PG8_SB(0, 1), cB + hstepB, voffB); PG8_STAGE(PG8_SA(0, 1), cA + hstepA, voffA);
  if (wr == 1) PG8_BAR;
  PG8_WAIT_V(4); PG8_BAR;
  PG8_STAGE(PG8_SB(1, 0), cB + kstep, voffB); PG8_STAGE(PG8_SA(1, 0), cA + kstep, voffA); PG8_STAGE(PG8_SB(1, 1), cB + hstepB + kstep, voffB);
  PG8_WAIT_V(6); PG8_BAR;
  for (;;) {
    const bool has_next = S.next(ui + 1, nxt);
    const char* nA = has_next ? (const char*)g.A + nxt.aoff : cA; const char* nB = has_next ? (const char*)g.Bt + nxt.boff : cB;
    for (int t = 0; t < nt; t += 2) {
      const bool last = (t == nt - 2);
      const char* a1 = cA + (unsigned)(t + 1) * kstep;
      const char* a2 = last ? nA : cA + (unsigned)(t + 2) * kstep; const char* b2 = last ? nB : cB + (unsigned)(t + 2) * kstep;
      const char* a3 = a2 + kstep; const char* b3 = b2 + kstep;
      PG8_LDB(B0, 0, 0); PG8_SCHED; PG8_LDA(At, 0, 0); PG8_STAGE(PG8_SA(1, 1), a1 + hstepA, voffA);
      PG8_WAIT_L(8); PG8_BAR; PG8_WAIT_L(0); PG8_MMA(0, 0, At, B0); PG8_BAR; PG8_SCHED;
      PG8_LDB(B1, 0, 1); PG8_STAGE(PG8_SB(0, 0), b2, voffB);
      PG8_BAR; PG8_WAIT_L(0); PG8_MMA(0, 1, At, B1); PG8_BAR;
      PG8_LDA(At, 0, 1); PG8_STAGE(PG8_SA(0, 0), a2, voffA);
      PG8_BAR; PG8_WAIT_L(0); PG8_MMA(1, 0, At, B0); PG8_BAR; PG8_SCHED;
      PG8_STAGE(PG8_SB(0, 1), b2 + hstepB, voffB);
      PG8_WAIT_V(6); PG8_BAR; PG8_MMA(1, 1, At, B1); PG8_BAR;
      PG8_LDB(B0, 1, 0); PG8_SCHED; PG8_LDA(At, 1, 0); PG8_STAGE(PG8_SA(0, 1), a2 + hstepA, voffA);
      PG8_WAIT_L(8); PG8_BAR; PG8_WAIT_L(0); PG8_MMA(0, 0, At, B0); PG8_BAR; PG8_SCHED;
      PG8_LDB(B1, 1, 1); PG8_STAGE(PG8_SB(1, 0), b3, voffB);
      PG8_BAR; PG8_WAIT_L(0); PG8_MMA(0, 1, At, B1); PG8_BAR;
      PG8_LDA(At, 1, 1); PG8_STAGE(PG8_SA(1, 0), a3, voffA);
      PG8_BAR; PG8_WAIT_L(0); PG8_MMA(1, 0, At, B0); PG8_BAR; PG8_SCHED;
      PG8_STAGE(PG8_SB(1, 1), b3 + hstepB, voffB);
      PG8_WAIT_V(6); PG8_BAR; PG8_MMA(1, 1, At, B1); PG8_BAR;
    }
    E(acc, cur, wr, wc, fr, fq);
    if (!has_next) break;
#pragma unroll
    for (int a = 0; a < 2; ++a)
#pragma unroll
      for (int b = 0; b < 2; ++b)
#pragma unroll
        for (int m = 0; m < 4; ++m)
#pragma unroll
          for (int n = 0; n < 2; ++n) acc[a][b][m][n] = (f32x4){0.f, 0.f, 0.f, 0.f};
    cur = nxt; cA = nA; cB = nB; ++ui;
  }
  PG8_WAIT_V(0);
  if (wr == 0) PG8_BAR;
  PG8_BAR;
#undef PG8_SA
#undef PG8_SB
#undef PG8_STAGE
#undef PG8_LDA
#undef PG8_LDB
#undef PG8_MMA
#undef PG8_WAIT_V
#undef PG8_WAIT_L
#undef PG8_BAR
#undef PG8_SCHED
}
}

#define ROW256(ai, m) (u.pm * 256 + (ai) * 128 + wr * 64 + (m) * 16 + fr)
#define COL256(bj, n) (u.pn * 256 + (bj) * 128 + 64 * (wc >> 1) + 16 * (wc & 1) + 32 * (n) + 4 * fq)
struct EpiQKV256 {
  bf16_t *Q, *Kb, *VT; const float *cosT, *sinT;
  __device__ __forceinline__ void operator()(const f32x4 (&acc)[2][2][4][2], const pg8::Unit& u, int wr, int wc, int fr, int fq) const {
#pragma unroll
    for (int bj = 0; bj < 2; ++bj) {
      const int n0 = u.pn * 256 + bj * 128;
      const int c0 = COL256(bj, 0);
      if (n0 < 2560) {
        const int iidx = 16 * (wc & 1) + 4 * fq;
#pragma unroll
        for (int ai = 0; ai < 2; ++ai)
#pragma unroll
          for (int m = 0; m < 4; ++m) {
            const int r = ROW256(ai, m);
            const f32x4 x1 = acc[ai][bj][m][0], x2 = acc[ai][bj][m][1]; f32x4 y1 = x1, y2 = x2;
            if (r < TL) {
              const int s = r & 4095; const int pos = (wc >> 1) ? (s & 63) : (s >> 6);
              const f32x4 cs = *(const f32x4*)(cosT + pos * 32 + iidx), sn = *(const f32x4*)(sinT + pos * 32 + iidx);
              y1 = x1 * cs - x2 * sn; y2 = x2 * cs + x1 * sn;
            }
            bf16_t* dst = (n0 < 2048) ? (Q + (size_t)r * D + c0) : (Kb + (size_t)r * 512 + (c0 - 2048));
            u32x2 o1, o2; o1.x = pack_bf16(y1[0], y1[1]); o1.y = pack_bf16(y1[2], y1[3]); o2.x = pack_bf16(y2[0], y2[1]); o2.y = pack_bf16(y2[2], y2[3]);
            *(u32x2*)dst = o1; *(u32x2*)(dst + 32) = o2;
          }
      } else {
#pragma unroll
        for (int ai = 0; ai < 2; ++ai)
#pragma unroll
          for (int m = 0; m < 4; ++m) {
            const int r = ROW256(ai, m);
#pragma unroll
            for (int n = 0; n < 2; ++n)
#pragma unroll
              for (int j = 0; j < 4; ++j) VT[(size_t)(c0 - 2560 + 32 * n + j) * TT + r] = f2bf(acc[ai][bj][m][n][j]);
          }
      }
    }
  }
};
struct EpiDelta256 {
  bf16_t* DELTA; const float* gate;
  __device__ __forceinline__ void operator()(const f32x4 (&acc)[2][2][4][2], const pg8::Unit& u, int wr, int wc, int fr, int fq) const {
#pragma unroll
    for (int ai = 0; ai < 2; ++ai)
#pragma unroll
      for (int m = 0; m < 4; ++m) {
        const int r = ROW256(ai, m);
        const float* g = gate + (size_t)mod_row(r) * NMOD;
#pragma unroll
        for (int bj = 0; bj < 2; ++bj)
#pragma unroll
          for (int n = 0; n < 2; ++n) {
            const int c = COL256(bj, n);
            const f32x4 v = *(const f32x4*)(g + c) * acc[ai][bj][m][n];
            u32x2 o; o.x = pack_bf16(v[0], v[1]); o.y = pack_bf16(v[2], v[3]);
            *(u32x2*)(DELTA + (size_t)r * D + c) = o;
          }
      }
  }
};
struct EpiBf16_256 {
  bf16_t* O; int ldo;
  __device__ __forceinline__ void operator()(const f32x4 (&acc)[2][2][4][2], const pg8::Unit& u, int wr, int wc, int fr, int fq) const {
#pragma unroll
    for (int ai = 0; ai < 2; ++ai)
#pragma unroll
      for (int m = 0; m < 4; ++m)
#pragma unroll
        for (int bj = 0; bj < 2; ++bj)
#pragma unroll
          for (int n = 0; n < 2; ++n) {
            const f32x4 v = acc[ai][bj][m][n];
            u32x2 o; o.x = pack_bf16(v[0], v[1]); o.y = pack_bf16(v[2], v[3]);
            *(u32x2*)(O + (size_t)ROW256(ai, m) * ldo + COL256(bj, n)) = o;
          }
  }
};
struct EpiWin256 {
  bf16_t *GATE, *UBR;
  __device__ __forceinline__ void operator()(const f32x4 (&acc)[2][2][4][2], const pg8::Unit& u, int wr, int wc, int fr, int fq) const {
#pragma unroll
    for (int ai = 0; ai < 2; ++ai)
#pragma unroll
      for (int m = 0; m < 4; ++m) {
        const int r = ROW256(ai, m);
#pragma unroll
        for (int bj = 0; bj < 2; ++bj)
#pragma unroll
          for (int n = 0; n < 2; ++n) {
            const int c = COL256(bj, n);
            const f32x4 v = acc[ai][bj][m][n];
            if (c < 2048) {
              if (r < TL) { u32x2 o; o.x = pack_bf16(gelu_tanh(v[0]), gelu_tanh(v[1])); o.y = pack_bf16(gelu_tanh(v[2]), gelu_tanh(v[3])); *(u32x2*)(GATE + (size_t)r * D + c) = o; }
            } else {
              u32x2 o; o.x = pack_bf16(v[0], v[1]); o.y = pack_bf16(v[2], v[3]); *(u32x2*)(UBR + (size_t)r * D + (c - 2048)) = o;
            }
          }
      }
  }
};
struct StreamJob { int nsb, m_lo, m_n, t_lo, t_n, q_lo, q_n; };
template <class Epi>
__device__ __forceinline__ void gemm256(const Params& p, const bf16_t* A, const bf16_t* Bt, int M, int N, int K, unsigned char* lds, const Epi& e, const StreamJob sj) {
  if ((int)blockIdx.x < sj.nsb) {
    const int tid0 = tidx();
    for (int k = (int)blockIdx.x; k < sj.m_n + sj.t_n + sj.q_n; k += sj.nsb) {
      if (k < sj.m_n) mod_item(p, sj.m_lo + k, (float*)lds);
      else if (k < sj.m_n + sj.t_n) transpose_quad(p, sj.t_lo + (k - sj.m_n), (float*)lds);
      else quant_rows_item(p, sj.q_lo + (k - sj.m_n - sj.t_n), tid0);
    }
    return;
  }
  pg8::Gemm g{A, Bt, K, K}; pg8::StaticOrder S; S.init(M, N, K, K, (int)gridDim.x - sj.nsb, (int)blockIdx.x - sj.nsb);
  pg8::gemm_phase((PG8_LAS unsigned char*)lds, g, S, e);
}
struct EpiCoef256 {
  const float *b_a, *b_x, *SP; const bf16_t* UC; bf16_t* LAB;
  __device__ __forceinline__ void operator()(const f32x4 (&acc)[2][2][4][2], const pg8::Unit& u, int wr, int wc, int fr_, int fq_) const {
    int fr = fr_, fq = fq_; asm volatile("" : "+v"(fr), "+v"(fq));
    const int dir = u.pn >> 4, blk = (u.pn >> 1) & 7, half = u.pn & 1;
    bf16_t* LA = LAB + (size_t)(dir * 2) * TT * D; bf16_t* LB = LA + (size_t)TT * D;
#pragma unroll
    for (int n = 0; n < 2; ++n) {
      const int c = blk * 256 + half * 128 + 64 * (wc >> 1) + 16 * (wc & 1) + 32 * n + 4 * fq;
      const f32x4 ba = *(const f32x4*)(b_a + dir * D + c), bx = *(const f32x4*)(b_x + dir * D + c), sp = *(const f32x4*)(SP + dir * D + c);
#pragma unroll
      for (int ai = 0; ai < 2; ++ai)
#pragma unroll
        for (int m = 0; m < 4; ++m) {
          const int r = u.pm * 256 + ai * 128 + wr * 64 + m * 16 + fr;
          const u32x2 uu = *(const u32x2*)(UC + (size_t)r * D + c);
          const float uv[4] = {__uint_as_float(uu.x << 16), __uint_as_float(uu.x & 0xffff0000u), __uint_as_float(uu.y << 16), __uint_as_float(uu.y & 0xffff0000u)};
          float lav[4], bv[4];
#pragma unroll
          for (int j = 0; j < 4; ++j) {
            const float rg = __builtin_amdgcn_rcpf(1.0f + __expf(-(acc[ai][0][m][n][j] + ba[j])));
            const float ig = __builtin_amdgcn_rcpf(1.0f + __expf(-(acc[ai][1][m][n][j] + bx[j])));
            const float log_a = -8.0f * rg * sp[j];
            lav[j] = log_a;
            bv[j] = __builtin_amdgcn_sqrtf(fmaxf(1.0f - __expf(2.0f * log_a), 0.f)) * ig * uv[j];
          }
          u32x2 o1, o2; o1.x = pack_bf16(lav[0], lav[1]); o1.y = pack_bf16(lav[2], lav[3]); o2.x = pack_bf16(bv[0], bv[1]); o2.y = pack_bf16(bv[2], bv[3]);
          *(u32x2*)(LA + (size_t)r * D + c) = o1;
          *(u32x2*)(LB + (size_t)r * D + c) = o2;
        }
    }
  }
};
__device__ __forceinline__ void coef_phase(const Params& p, unsigned char* lds) {
  EpiCoef256 e{p.rec_b_a, p.rec_b_x, (const float*)(p.ws + OFF_SP), (const bf16_t*)(p.ws + OFF_O), (bf16_t*)(p.ws + OFF_LAB)};
  pg8::Gemm g{(const bf16_t*)(p.ws + OFF_O), (const bf16_t*)(p.ws + OFF_WA), 256, D}; pg8::CoefOrder S; S.init((int)gridDim.x, (int)blockIdx.x);
  pg8::gemm_phase((PG8_LAS unsigned char*)lds, g, S, e);
}

constexpr int KLD = 136, VLD = 72;
__device__ __forceinline__ void attn_phase(const Params& p, unsigned char* lds) {
  const bf16_t* Q = (const bf16_t*)(p.ws + OFF_Q); const bf16_t* Kg = (const bf16_t*)(p.ws + OFF_K); const bf16_t* VT = (const bf16_t*)(p.ws + OFF_VT);
  bf16_t* O = (bf16_t*)(p.ws + OFF_O);
  bf16_t* Ks = (bf16_t*)lds;
  bf16_t* Vs = Ks + 64 * KLD;
  const int tid = tidx(), wid = tid >> 6, lane = tid & 63, fr = lane & 15, fq = lane >> 4;
  const int g = wid >> 1, rh = wid & 1;
  const float scale = 0.08838834764831845f;
  for (int item = blockIdx.x; item < 1088; item += gridDim.x) {
    int b, hk, qb, qrow0, nlat, kt0;
    if (item < 1024) { b = item >> 8; hk = (item >> 6) & 3; qb = item & 63; qrow0 = b * S + qb * 64; kt0 = qb - 2 < 0 ? 0 : qb - 2; const int kt1 = qb + 2 > 63 ? 63 : qb + 2; nlat = kt1 - kt0 + 1; }
    else { const int ci = item - 1024; b = ci >> 4; hk = (ci >> 2) & 3; qb = ci & 3; qrow0 = TL + b * CL + qb * 64; kt0 = 0; nlat = 0; }
    const int head = hk * 4 + g;
    const float sink = p.attn_sink[head];
    bf16x8 qf[2][4];
#pragma unroll
    for (int rt = 0; rt < 2; ++rt)
#pragma unroll
      for (int ks = 0; ks < 4; ++ks) qf[rt][ks] = *(const bf16x8*)(Q + (size_t)(qrow0 + rh * 32 + rt * 16 + fr) * D + head * 128 + ks * 32 + fq * 8);
    f32x4 oacc[2][8]; float mst[2], lst[2];
#pragma unroll
    for (int rt = 0; rt < 2; ++rt) {
#pragma unroll
      for (int dt = 0; dt < 8; ++dt) oacc[rt][dt] = (f32x4){0.f, 0.f, 0.f, 0.f};
      mst[rt] = sink; lst[rt] = fq == 0 ? 1.0f : 0.f;
    }
    const int ntiles = nlat + 4;
    int kdst[2], vdst[2]; size_t ksrc[2], vsrc[2];
#pragma unroll
    for (int i = 0; i < 2; ++i) {
      const int id = tid + 512 * i;
      const int key = id >> 4, dc = (id & 15) * 8;
      const int kk = key & 31, prow = (key & 32) + ((kk >> 2) & 1) * 16 + (kk >> 3) * 4 + (kk & 3);
      kdst[i] = prow * KLD + dc; ksrc[i] = (size_t)key * 512 + hk * 128 + dc;
      const int d = id >> 3, kc = (id & 7) * 8;
      vdst[i] = d * VLD + kc; vsrc[i] = (size_t)(hk * 128 + d) * TT + kc;
    }
    u32x4 kreg[2], vreg[2];
    {
      const int krow0 = nlat > 0 ? (b * S + kt0 * 64) : (TL + b * CL);
#pragma unroll
      for (int i = 0; i < 2; ++i) { kreg[i] = *(const u32x4*)(Kg + (size_t)krow0 * 512 + ksrc[i]); vreg[i] = *(const u32x4*)(VT + vsrc[i] + krow0); }
    }
    for (int ti = 0; ti < ntiles; ++ti) {
      const bool lat = ti < nlat;
      __syncthreads();
#pragma unroll
      for (int i = 0; i < 2; ++i) { *(u32x4*)(Ks + kdst[i]) = kreg[i]; *(u32x4*)(Vs + vdst[i]) = vreg[i]; }
      if (ti + 1 < ntiles) {
        const int tn = ti + 1;
        const int krow0 = tn < nlat ? (b * S + (kt0 + tn) * 64) : (TL + b * CL + (tn - nlat) * 64);
#pragma unroll
        for (int i = 0; i < 2; ++i) { kreg[i] = *(const u32x4*)(Kg + (size_t)krow0 * 512 + ksrc[i]); vreg[i] = *(const u32x4*)(VT + vsrc[i] + krow0); }
      }
      __syncthreads();
      f32x4 st[2][2][2];
#pragma unroll
      for (int rt = 0; rt < 2; ++rt)
#pragma unroll
        for (int kp = 0; kp < 2; ++kp)
#pragma unroll
          for (int t = 0; t < 2; ++t) st[rt][kp][t] = (f32x4){0.f, 0.f, 0.f, 0.f};
#pragma unroll
      for (int kp = 0; kp < 2; ++kp)
#pragma unroll
        for (int t = 0; t < 2; ++t)
#pragma unroll
          for (int ks = 0; ks < 4; ++ks) {
            const bf16x8 kf = *(const bf16x8*)(Ks + (kp * 32 + t * 16 + fr) * KLD + ks * 32 + fq * 8);
            st[0][kp][t] = __builtin_amdgcn_mfma_f32_16x16x32_bf16(kf, qf[0][ks], st[0][kp][t], 0, 0, 0);
            st[1][kp][t] = __builtin_amdgcn_mfma_f32_16x16x32_bf16(kf, qf[1][ks], st[1][kp][t], 0, 0, 0);
          }
      unsigned pk[2][2][4];
#pragma unroll
      for (int rt = 0; rt < 2; ++rt) {
        const int ipos = qb * 64 + rh * 32 + rt * 16 + fr;
        float mx = -INFINITY;
#pragma unroll
        for (int kp = 0; kp < 2; ++kp)
#pragma unroll
          for (int t = 0; t < 2; ++t)
#pragma unroll
            for (int j = 0; j < 4; ++j) {
              float v = st[rt][kp][t][j] * scale;
              if (lat) { const int dd = ipos - ((kt0 + ti) * 64 + kp * 32 + fq * 8 + t * 4 + j); if (dd > 128 || dd < -128) v = -INFINITY; }
              st[rt][kp][t][j] = v; mx = fmaxf(mx, v);
            }
        mx = fmaxf(mx, __shfl_xor(mx, 16)); mx = fmaxf(mx, __shfl_xor(mx, 32));
        const float mn = fmaxf(mst[rt], mx);
        const float alpha = __expf(mst[rt] - mn);
        mst[rt] = mn;
        float rs = 0.f;
#pragma unroll
        for (int kp = 0; kp < 2; ++kp)
#pragma unroll
          for (int t = 0; t < 2; ++t) {
            const float p0 = __expf(st[rt][kp][t][0] - mn), p1 = __expf(st[rt][kp][t][1] - mn), p2 = __expf(st[rt][kp][t][2] - mn), p3 = __expf(st[rt][kp][t][3] - mn);
            rs += (p0 + p1) + (p2 + p3);
            pk[rt][kp][t * 2] = pack_bf16(p0, p1); pk[rt][kp][t * 2 + 1] = pack_bf16(p2, p3);
          }
        lst[rt] = lst[rt] * alpha + rs;
#pragma unroll
        for (int dt = 0; dt < 8; ++dt) oacc[rt][dt] *= alpha;
      }
#pragma unroll
      for (int kp = 0; kp < 2; ++kp) {
        const bf16x8 pf0 = __builtin_bit_cast(bf16x8, (u32x4){pk[0][kp][0], pk[0][kp][1], pk[0][kp][2], pk[0][kp][3]});
        const bf16x8 pf1 = __builtin_bit_cast(bf16x8, (u32x4){pk[1][kp][0], pk[1][kp][1], pk[1][kp][2], pk[1][kp][3]});
#pragma unroll
        for (int dt = 0; dt < 8; ++dt) {
          const bf16x8 vf = *(const bf16x8*)(Vs + (dt * 16 + fr) * VLD + kp * 32 + fq * 8);
          oacc[0][dt] = __builtin_amdgcn_mfma_f32_16x16x32_bf16(vf, pf0, oacc[0][dt], 0, 0, 0);
          oacc[1][dt] = __builtin_amdgcn_mfma_f32_16x16x32_bf16(vf, pf1, oacc[1][dt], 0, 0, 0);
        }
      }
    }
#pragma unroll
    for (int rt = 0; rt < 2; ++rt) {
      float l = lst[rt]; l += __shfl_xor(l, 16); l += __shfl_xor(l, 32);
      const float inv = 1.0f / l;
      bf16_t* orow = O + (size_t)(qrow0 + rh * 32 + rt * 16 + fr) * D + head * 128 + 4 * fq;
#pragma unroll
      for (int dt = 0; dt < 8; ++dt) {
        u32x2 o; o.x = pack_bf16(oacc[rt][dt][0] * inv, oacc[rt][dt][1] * inv); o.y = pack_bf16(oacc[rt][dt][2] * inv, oacc[rt][dt][3] * inv);
        *(u32x2*)(orow + dt * 16) = o;
      }
    }
  }
}

#define CE_DESC(a, b) { const float _hi = fmaxf(a, b), _lo = fminf(a, b); a = _hi; b = _lo; }
__device__ __forceinline__ void bitonic_sort_desc16(float (&a)[16]) {
#pragma unroll
  for (int ks = 1; ks <= 4; ++ks)
#pragma unroll
    for (int js = ks - 1; js >= 0; --js)
#pragma unroll
      for (int i = 0; i < 16; ++i) { const int k = 1 << ks, j = 1 << js, l = i ^ j; if (l > i) { if ((i & k) == 0) CE_DESC(a[i], a[l]) else CE_DESC(a[l], a[i]) } }
}
__device__ __forceinline__ void bitonic_merge_desc16(float (&a)[16]) {
#pragma unroll
  for (int js = 3; js >= 0; --js)
#pragma unroll
    for (int i = 0; i < 16; ++i) { const int j = 1 << js, l = i ^ j; if (l > i) CE_DESC(a[i], a[l]) }
}
__device__ __forceinline__ void top16_merge(float (&L)[16], float (&G)[16]) {
  bitonic_sort_desc16(G);
#pragma unroll
  for (int i = 0; i < 16; ++i) L[i] = fmaxf(L[i], G[15 - i]);
  bitonic_merge_desc16(L);
}
__host__ __device__ constexpr int cand_code(int c) {
  int n = 0;
  for (int i = 0; i < 16; ++i) for (int j = 0; j < 16 / (i + 1); ++j) { if (n == c) return (i << 4) | j; ++n; }
  return -1;
}
template <int C> struct CandCode { static constexpr int value = cand_code(C); };

__device__ __forceinline__ void peer_route_phase(const Params& p, int layer, int ntok, unsigned char* lds) {
  const int tid = tidx(), wid = tid >> 6, lane = tid & 63, fr = lane & 15, fq = lane >> 4;
  float* Sw = (float*)(lds + wid * 9216);
  const bf16_t* keysG = (const bf16_t*)(p.ws + OFF_KEYS) + (size_t)layer * 2 * 128 * 128;
  const bf16_t* PQ = (const bf16_t*)(p.ws + OFF_PQ);
  int* IDX = (int*)(p.ws + OFF_IDX); float* GW = (float*)(p.ws + OFF_GW);
  const int total = (ntok >> 6) * 8;
  for (int id = blockIdx.x * 8 + wid; id < total; id += gridDim.x * 8) {
    const int tile = id >> 3, head = id & 7, tok0 = tile * 64;
    float Lk[2][16];
#pragma unroll
    for (int pp = 0; pp < 2; ++pp) {
      bf16x8 qf[4][4];
#pragma unroll
      for (int mt = 0; mt < 4; ++mt)
#pragma unroll
        for (int ks = 0; ks < 4; ++ks) qf[mt][ks] = *(const bf16x8*)(PQ + (size_t)(tok0 + mt * 16 + fr) * D + head * 256 + pp * 128 + ks * 32 + fq * 8);
#pragma unroll
      for (int s2 = 0; s2 < 16; ++s2) Lk[pp][s2] = -INFINITY;
      bf16x8 kf[2][4], kfn[2][4];
#pragma unroll
      for (int nt = 0; nt < 2; ++nt)
#pragma unroll
        for (int ks = 0; ks < 4; ++ks) kf[nt][ks] = *(const bf16x8*)(keysG + (size_t)(pp * 128 + nt * 16 + fr) * 128 + ks * 32 + fq * 8);
#pragma unroll 1
      for (int pass = 0; pass < 4; ++pass) {
        const int pn = pass < 3 ? pass + 1 : 3;
#pragma unroll
        for (int nt = 0; nt < 2; ++nt)
#pragma unroll
          for (int ks = 0; ks < 4; ++ks) kfn[nt][ks] = *(const bf16x8*)(keysG + (size_t)(pp * 128 + pn * 32 + nt * 16 + fr) * 128 + ks * 32 + fq * 8);
        f32x4 acc[2][4];
#pragma unroll
        for (int nt = 0; nt < 2; ++nt)
#pragma unroll
          for (int mt = 0; mt < 4; ++mt) acc[nt][mt] = (f32x4){0.f, 0.f, 0.f, 0.f};
#pragma unroll
        for (int nt = 0; nt < 2; ++nt)
#pragma unroll
          for (int ks = 0; ks < 4; ++ks)
#pragma unroll
            for (int mt = 0; mt < 4; ++mt) acc[nt][mt] = __builtin_amdgcn_mfma_f32_16x16x32_bf16(kf[nt][ks], qf[mt][ks], acc[nt][mt], 0, 0, 0);
#pragma unroll
        for (int nt = 0; nt < 2; ++nt)
#pragma unroll
          for (int mt = 0; mt < 4; ++mt) *(f32x4*)(Sw + (mt * 16 + fr) * 36 + nt * 16 + 4 * fq) = acc[nt][mt];
        __builtin_amdgcn_fence(__ATOMIC_RELEASE, "wavefront"); __builtin_amdgcn_wave_barrier(); __builtin_amdgcn_fence(__ATOMIC_ACQUIRE, "wavefront");
#pragma unroll
        for (int g = 0; g < 2; ++g) {
          float G[16];
#pragma unroll
          for (int c = 0; c < 4; ++c) {
            const f32x4 sv = *(const f32x4*)(Sw + lane * 36 + g * 16 + c * 4);
#pragma unroll
            for (int e = 0; e < 4; ++e) G[c * 4 + e] = __uint_as_float((__float_as_uint(sv[e]) & ~0x7fu) | (unsigned)(pass * 32 + g * 16 + c * 4 + e));
          }
          top16_merge(Lk[pp], G);
        }
#pragma unroll
        for (int nt = 0; nt < 2; ++nt)
#pragma unroll
          for (int ks = 0; ks < 4; ++ks) kf[nt][ks] = kfn[nt][ks];
      }
    }
#pragma unroll
    for (int pp = 0; pp < 2; ++pp)
#pragma unroll
      for (int s2 = 0; s2 < 16; ++s2) Sw[(pp * 16 + s2) * 64 + lane] = Lk[pp][s2];
    float v1[16], v2[16];
#pragma unroll
    for (int s2 = 0; s2 < 16; ++s2) { v1[s2] = __uint_as_float(__float_as_uint(Lk[0][s2]) & ~0x7fu); v2[s2] = __uint_as_float(__float_as_uint(Lk[1][s2]) & ~0x7fu); }
    float T[16];
#pragma unroll
    for (int s2 = 0; s2 < 16; ++s2) T[s2] = -INFINITY;
#define ROUTE_GROUP(G0) { float G[16]; \
      _Pragma("unroll") for (int q = 0; q < 16; ++q) G[q] = -INFINITY; \
      ROUTE_FILL(G0 + 0) ROUTE_FILL(G0 + 1) ROUTE_FILL(G0 + 2) ROUTE_FILL(G0 + 3) ROUTE_FILL(G0 + 4) ROUTE_FILL(G0 + 5) ROUTE_FILL(G0 + 6) ROUTE_FILL(G0 + 7) \
      ROUTE_FILL(G0 + 8) ROUTE_FILL(G0 + 9) ROUTE_FILL(G0 + 10) ROUTE_FILL(G0 + 11) ROUTE_FILL(G0 + 12) ROUTE_FILL(G0 + 13) ROUTE_FILL(G0 + 14) ROUTE_FILL(G0 + 15) \
      top16_merge(T, G); }
#define ROUTE_FILL(C) { constexpr int code = CandCode<(C)>::value; if constexpr (code >= 0) G[(C) & 15] = __uint_as_float((__float_as_uint(v1[code >> 4] + v2[code & 15]) & ~0xffu) | (unsigned)code); }
    ROUTE_GROUP(0) ROUTE_GROUP(16) ROUTE_GROUP(32) ROUTE_GROUP(48)
#undef ROUTE_FILL
#undef ROUTE_GROUP
    asm volatile("s_waitcnt lgkmcnt(0)" ::: "memory");
    int E[16];
#pragma unroll
    for (int s2 = 0; s2 < 16; ++s2) {
      const unsigned code = __float_as_uint(T[s2]) & 0xffu;
      const unsigned k1 = __float_as_uint(Sw[(code >> 4) * 64 + lane]) & 0x7fu, k2 = __float_as_uint(Sw[(16 + (code & 15u)) * 64 + lane]) & 0x7fu;
      E[s2] = (int)(k1 * 128u + k2);
      T[s2] = __uint_as_float(__float_as_uint(T[s2]) & ~0xffu);
    }
    asm volatile("s_waitcnt lgkmcnt(0)" ::: "memory");
    const size_t o = ((size_t)(tok0 + lane) * 8 + head) * 16;
    const float tmax = T[0];
    float ssum = 0.f;
#pragma unroll
    for (int s2 = 0; s2 < 16; ++s2) { T[s2] = __expf(T[s2] - tmax); ssum += T[s2]; }
    const float inv = 1.0f / ssum;
#pragma unroll
    for (int c = 0; c < 4; ++c) {
      *(f32x4*)(GW + o + c * 4) = (f32x4){T[c * 4] * inv, T[c * 4 + 1] * inv, T[c * 4 + 2] * inv, T[c * 4 + 3] * inv};
      typedef int i32x4 __attribute__((ext_vector_type(4)));
      *(i32x4*)(IDX + o + c * 4) = (i32x4){E[c * 4], E[c * 4 + 1], E[c * 4 + 2], E[c * 4 + 3]};
    }
  }
}

constexpr int PG = 2;
struct PeerBuf { u32x4 u[PG][2], v[PG][2]; float su[PG], sv[PG], g[PG]; };
__device__ __forceinline__ void peer_load(PeerBuf& B, const unsigned char* UT8, const unsigned char* VT8, const float* USC, const float* VSC, int ireg, float greg, int k0, int lane) {
#pragma unroll
  for (int j = 0; j < PG; ++j) {
    const int e = __builtin_amdgcn_readlane(ireg, k0 + j);
    B.g[j] = __builtin_bit_cast(float, __builtin_amdgcn_readlane(__builtin_bit_cast(int, greg), k0 + j));
    const unsigned char* ur = UT8 + (size_t)e * D + lane * 16; const unsigned char* vr = VT8 + (size_t)e * D + lane * 16;
    B.u[j][0] = *(const u32x4*)ur; B.u[j][1] = *(const u32x4*)(ur + 1024);
    B.v[j][0] = *(const u32x4*)vr; B.v[j][1] = *(const u32x4*)(vr + 1024);
    B.su[j] = USC[e]; B.sv[j] = VSC[e];
  }
}
__device__ __forceinline__ void peer_compute(const PeerBuf& B, const int (&hq)[2][4], float hscale, float (&accv)[2][16], float& corr) {
#pragma unroll
  for (int j = 0; j < PG; ++j) {
    int d0 = 0, d1 = 0;
#pragma unroll
    for (int t = 0; t < 4; ++t) { d0 = __builtin_amdgcn_sdot4((int)B.u[j][0][t], hq[0][t], d0, false); d1 = __builtin_amdgcn_sdot4((int)B.u[j][1][t], hq[1][t], d1, false); }
    const float z = B.su[j] * hscale * wave_sum((float)(d0 + d1));
    const float act = gelu_tanh(z) * B.g[j] * B.sv[j];
    corr += act;
#pragma unroll
    for (int c = 0; c < 2; ++c)
#pragma unroll
      for (int t = 0; t < 4; ++t) {
        const unsigned w = B.v[j][c][t];
        accv[c][4 * t] += act * (float)(w & 0xffu); accv[c][4 * t + 1] += act * (float)((w >> 8) & 0xffu); accv[c][4 * t + 2] += act * (float)((w >> 16) & 0xffu); accv[c][4 * t + 3] += act * (float)(w >> 24);
      }
  }
}
__device__ __forceinline__ void peer_gather_phase(const Params& p, int layer, int ntok, int gate_layer, unsigned char* lds, bool dry = false) {
  const int tid = tidx(), wid = tid >> 6, lane = tid & 63;
  const bf16_t* H = (const bf16_t*)(p.ws + OFF_H);
  const int* IDX = (const int*)(p.ws + OFF_IDX); const float* GW = (const float*)(p.ws + OFF_GW);
  const unsigned char* UT8 = p.ws + OFF_UTAB + (size_t)layer * NEXP * D; const unsigned char* VT8 = p.ws + OFF_VTAB + (size_t)layer * NEXP * D;
  const float* USC = (const float*)(p.ws + OFF_USC) + (size_t)layer * NEXP; const float* VSC = (const float*)(p.ws + OFF_VSC) + (size_t)layer * NEXP;
  float* XS = (float*)(p.ws + OFF_XS);
  const float* gate = (const float*)(p.ws + OFF_MODV) + (size_t)(gate_layer * 5) * NMOD + 5 * D;
  const int per_round = (int)gridDim.x * 8, nfull_rounds = ntok / per_round, nfull = nfull_rounds * per_round;
  const int nsplit_rounds = (ntok - nfull + (int)gridDim.x * 4 - 1) / ((int)gridDim.x * 4);
  float* part = (float*)lds + (wid >> 1) * 2112;
  for (int it = 0; it < nfull_rounds + nsplit_rounds; ++it) {
    const bool split = it >= nfull_rounds;
    const int tok = split ? nfull + (it - nfull_rounds) * (int)gridDim.x * 4 + (int)blockIdx.x * 4 + (wid >> 1) : it * per_round + (int)blockIdx.x * 8 + wid;
    const bool valid = tok < ntok;
    const int hbeg = split ? (wid & 1) : 0, hend = split ? (wid & 1) + 1 : 2;
    float accv[2][16]; float corr = 0.f;
#pragma unroll
    for (int c = 0; c < 2; ++c)
#pragma unroll
      for (int j = 0; j < 16; ++j) accv[c][j] = 0.f;
    if (valid) {
    const int i0 = IDX[(size_t)tok * 128 + lane], i1 = IDX[(size_t)tok * 128 + 64 + lane];
    const float g0 = GW[(size_t)tok * 128 + lane], g1 = GW[(size_t)tok * 128 + 64 + lane];
    PeerBuf A, B;
    peer_load(A, UT8, VT8, USC, VSC, hbeg ? i1 : i0, hbeg ? g1 : g0, 0, lane);
    int hq[2][4]; float hscale;
    {
      float hreg[2][16]; float hmx = 0.f;
#pragma unroll
      for (int c = 0; c < 2; ++c)
#pragma unroll
        for (int hh = 0; hh < 2; ++hh) {
          const u32x4 hv = *(const u32x4*)(H + (size_t)tok * D + c * 1024 + lane * 16 + hh * 8);
#pragma unroll
          for (int t = 0; t < 4; ++t) { hreg[c][hh * 8 + 2 * t] = __uint_as_float(hv[t] << 16); hreg[c][hh * 8 + 2 * t + 1] = __uint_as_float(hv[t] & 0xffff0000u); hmx = fmaxf(hmx, fmaxf(fabsf(hreg[c][hh * 8 + 2 * t]), fabsf(hreg[c][hh * 8 + 2 * t + 1]))); }
        }
      hmx = wave_max(hmx);
      hscale = hmx > 0.f ? hmx * (1.0f / 127.0f) : 1.0f;
      const float hinv = 1.0f / hscale;
#pragma unroll
      for (int c = 0; c < 2; ++c)
#pragma unroll
        for (int t = 0; t < 4; ++t) {
          const unsigned q0 = (unsigned)(int)rintf(hreg[c][4 * t] * hinv) & 0xffu, q1 = (unsigned)(int)rintf(hreg[c][4 * t + 1] * hinv) & 0xffu;
          const unsigned q2 = (unsigned)(int)rintf(hreg[c][4 * t + 2] * hinv) & 0xffu, q3 = (unsigned)(int)rintf(hreg[c][4 * t + 3] * hinv) & 0xffu;
          hq[c][t] = (int)(q0 | (q1 << 8) | (q2 << 16) | (q3 << 24));
        }
    }
#pragma unroll 1
    for (int half = hbeg; half < hend; ++half) {
      const int ireg = half ? i1 : i0; const float greg = half ? g1 : g0;
#pragma unroll 1
      for (int k0 = 0; k0 < 64; k0 += 2 * PG) {
        peer_load(B, UT8, VT8, USC, VSC, ireg, greg, k0 + PG, lane);
        peer_compute(A, hq, hscale, accv, corr);
        if (k0 + 2 * PG < 64) peer_load(A, UT8, VT8, USC, VSC, ireg, greg, k0 + 2 * PG, lane);
        else if (half + 1 < hend) peer_load(A, UT8, VT8, USC, VSC, i1, g1, 0, lane);
        peer_compute(B, hq, hscale, accv, corr);
      }
    }
    }
    if (split) {
      if (wid & 1) {
#pragma unroll
        for (int c = 0; c < 2; ++c)
#pragma unroll
          for (int t = 0; t < 4; ++t) *(f32x4*)(part + c * 1024 + lane * 16 + 4 * t) = (f32x4){accv[c][4 * t], accv[c][4 * t + 1], accv[c][4 * t + 2], accv[c][4 * t + 3]};
        if (lane == 0) part[2048] = corr;
      }
      __syncthreads();
      if (!(wid & 1)) {
#pragma unroll
        for (int c = 0; c < 2; ++c)
#pragma unroll
          for (int t = 0; t < 4; ++t) { const f32x4 o = *(const f32x4*)(part + c * 1024 + lane * 16 + 4 * t); accv[c][4 * t] += o[0]; accv[c][4 * t + 1] += o[1]; accv[c][4 * t + 2] += o[2]; accv[c][4 * t + 3] += o[3]; }
        corr += part[2048];
      }
      __syncthreads();
      if (wid & 1) continue;
    }
    if (!valid) continue;
    corr *= 128.0f;
    const int mrow = mod_row(tok);
    const float* gr = gate + (size_t)mrow * NMOD; float* xr = XS + (size_t)tok * D;
    const float* xb = layer == 0 ? (tok < TL ? p.x + (size_t)tok * D : p.ctx + (size_t)(tok - TL) * D) : xr;
    const bf16_t* dl = (const bf16_t*)(p.ws + OFF_Q) + (size_t)tok * D;
    float ss = 0.f;
#pragma unroll
    for (int c = 0; c < 2; ++c)
#pragma unroll
      for (int t = 0; t < 4; ++t) {
        const int col = c * 1024 + lane * 16 + 4 * t;
        const f32x4 gg = *(const f32x4*)(gr + col); f32x4 xo = *(const f32x4*)(xb + col);
        const u32x2 dd = *(const u32x2*)(dl + col);
        xo[0] += __uint_as_float(dd.x << 16); xo[1] += __uint_as_float(dd.x & 0xffff0000u); xo[2] += __uint_as_float(dd.y << 16); xo[3] += __uint_as_float(dd.y & 0xffff0000u);
#pragma unroll
        for (int j = 0; j < 4; ++j) { const float xn = xo[j] + gg[j] * (accv[c][4 * t + j] - corr); accv[c][4 * t + j] = xn; ss += xn * xn; }
      }
    ss = wave_sum(ss);
    const float rs = rsqrtf(ss * (1.0f / D) + 1e-6f);
    if (dry && rs != 12345.678f) continue;
    if (layer == 0) {
      const float* mv = (const float*)(p.ws + OFF_MODV) + (size_t)(5 + mrow) * NMOD;
      const float* gn = p.norm_mix + D;
      bf16_t* hr = (bf16_t*)(p.ws + OFF_H) + (size_t)tok * D;
#pragma unroll
      for (int c = 0; c < 2; ++c)
#pragma unroll
        for (int t = 0; t < 4; ++t) {
          const int col = c * 1024 + lane * 16 + 4 * t;
          *(f32x4*)(xr + col) = (f32x4){accv[c][4 * t], accv[c][4 * t + 1], accv[c][4 * t + 2], accv[c][4 * t + 3]};
          const f32x4 g = *(const f32x4*)(gn + col), sh = *(const f32x4*)(mv + col), sc = *(const f32x4*)(mv + D + col);
          u32x2 o; o.x = pack_bf16(accv[c][4 * t] * rs * g[0] * (1.0f + sc[0]) + sh[0], accv[c][4 * t + 1] * rs * g[1] * (1.0f + sc[1]) + sh[1]);
          o.y = pack_bf16(accv[c][4 * t + 2] * rs * g[2] * (1.0f + sc[2]) + sh[2], accv[c][4 * t + 3] * rs * g[3] * (1.0f + sc[3]) + sh[3]);
          *(u32x2*)(hr + col) = o;
        }
    } else {
      float* orow = p.out + (size_t)tok * D;
#pragma unroll
      for (int c = 0; c < 2; ++c)
#pragma unroll
        for (int t = 0; t < 4; ++t) {
          const int col = c * 1024 + lane * 16 + 4 * t;
          const f32x4 g = *(const f32x4*)(p.norm_final + col);
          *(f32x4*)(orow + col) = (f32x4){accv[c][4 * t] * rs * g[0], accv[c][4 * t + 1] * rs * g[1], accv[c][4 * t + 2] * rs * g[2], accv[c][4 * t + 3] * rs * g[3]};
        }
    }
  }
}

__device__ __forceinline__ void conv_phase(const Params& p) {
  const bf16_t* UBR = (const bf16_t*)(p.ws + OFF_Q); bf16_t* UC = (bf16_t*)(p.ws + OFF_O);
  const int tid = tidx(), c = (tid & 255) * 8, hrow = tid >> 8;
  float w[4][8], bias[8];
#pragma unroll
  for (int k = 0; k < 4; ++k) { const float4 w0 = *(const float4*)(p.rec_conv_w + k * D + c), w1 = *(const float4*)(p.rec_conv_w + k * D + c + 4); w[k][0] = w0.x; w[k][1] = w0.y; w[k][2] = w0.z; w[k][3] = w0.w; w[k][4] = w1.x; w[k][5] = w1.y; w[k][6] = w1.z; w[k][7] = w1.w; }
  { const float4 b0 = *(const float4*)(p.rec_conv_b + c), b1 = *(const float4*)(p.rec_conv_b + c + 4); bias[0] = b0.x; bias[1] = b0.y; bias[2] = b0.z; bias[3] = b0.w; bias[4] = b1.x; bias[5] = b1.y; bias[6] = b1.z; bias[7] = b1.w; }
  const int nhalf = 2 * (int)gridDim.x, rows_per = (TT + nhalf - 1) / nhalf;
  const int r0 = ((int)blockIdx.x * 2 + hrow) * rows_per, r1 = r0 + rows_per < TT ? r0 + rows_per : TT;
  if (r0 < TT) {
    u32x4 win[4];
    const u32x4 zero = (u32x4){0u, 0u, 0u, 0u};
#pragma unroll
    for (int k = 0; k < 3; ++k) { const int rr = r0 - 1 + k; win[k] = (rr >= 0 && rr < TT) ? *(const u32x4*)(UBR + (size_t)rr * D + c) : zero; }
#pragma unroll 2
    for (int r = r0; r < r1; ++r) {
      const int rr = r + 2;
      win[3] = (rr < TT) ? *(const u32x4*)(UBR + (size_t)rr * D + c) : zero;
      const int seq_lo = r < TL ? (r & ~4095) : TL + ((r - TL) & ~255), seq_hi = seq_lo + (r < TL ? S : CL);
      float acc[8];
#pragma unroll
      for (int j = 0; j < 8; ++j) acc[j] = bias[j];
#pragma unroll
      for (int k = 0; k < 4; ++k) {
        const int rk = r - 1 + k; const bool ok = rk >= seq_lo && rk < seq_hi;
#pragma unroll
        for (int t = 0; t < 4; ++t) { const unsigned d = ok ? win[k][t] : 0u; acc[2 * t] += w[k][2 * t] * __uint_as_float(d << 16); acc[2 * t + 1] += w[k][2 * t + 1] * __uint_as_float(d & 0xffff0000u); }
      }
      u32x4 o; o.x = pack_bf16(acc[0], acc[1]); o.y = pack_bf16(acc[2], acc[3]); o.z = pack_bf16(acc[4], acc[5]); o.w = pack_bf16(acc[6], acc[7]);
      *(u32x4*)(UC + (size_t)r * D + c) = o;
      win[0] = win[1]; win[1] = win[2]; win[2] = win[3];
    }
  }
}

__device__ __forceinline__ void scan1_phase(const Params& p) {
  const bf16_t* LAB = (const bf16_t*)(p.ws + OFF_LAB);
  float* CHP = (float*)(p.ws + OFF_CHP); float* CHH = (float*)(p.ws + OFF_CHH);
  const int total = 2 * 272 * 2; const int tid = tidx();
  for (int item = blockIdx.x; item < total; item += gridDim.x) {
    const int cgp = item & 1, ch = (item >> 1) % 272, dir = item / (272 * 2);
    const int c = cgp * 1024 + tid * 2;
    const bf16_t* a = LAB + ((size_t)(dir * 2) * TT + ch * 64) * D + c; const bf16_t* b = LAB + ((size_t)(dir * 2 + 1) * TT + ch * 64) * D + c;
    float h0 = 0.f, h1 = 0.f, ls0 = 0.f, ls1 = 0.f;
#pragma unroll 1
    for (int q = 0; q < 4; ++q) {
      unsigned av[16], bv[16];
      const int t0 = dir == 0 ? q * 16 : 48 - q * 16;
#pragma unroll
      for (int i = 0; i < 16; ++i) { av[i] = *(const unsigned*)(a + (size_t)(t0 + i) * D); bv[i] = *(const unsigned*)(b + (size_t)(t0 + i) * D); }
#pragma unroll
      for (int ii = 0; ii < 16; ++ii) {
        const int i = dir == 0 ? ii : 15 - ii;
        const float la0 = __uint_as_float(av[i] << 16), la1 = __uint_as_float(av[i] & 0xffff0000u);
        h0 = __expf(la0) * h0 + __uint_as_float(bv[i] << 16); h1 = __expf(la1) * h1 + __uint_as_float(bv[i] & 0xffff0000u);
        ls0 += la0; ls1 += la1;
      }
    }
    const size_t o = ((size_t)dir * 272 + ch) * D + c;
    *(float2*)(CHP + o) = make_float2(__expf(ls0), __expf(ls1)); *(float2*)(CHH + o) = make_float2(h0, h1);
  }
}
__device__ __forceinline__ void scan2_phase(const Params& p) {
  const float* CHP = (const float*)(p.ws + OFF_CHP); const float* CHH = (const float*)(p.ws + OFF_CHH); float* CIN = (float*)(p.ws + OFF_CIN);
  for (int it = blockIdx.x * NT + tidx(); it < 2 * NB * D; it += gridDim.x * NT) {
    const int c = it & 2047, b = (it >> 11) & 3, dir = it >> 13;
    float carry = 0.f;
    for (int s = 0; s < 68; ++s) {
      int ch;
      if (dir == 0) ch = s < 4 ? (256 + 4 * b + s) : (64 * b + (s - 4));
      else ch = s < 4 ? (256 + 4 * b + (3 - s)) : (64 * b + (63 - (s - 4)));
      const size_t o = ((size_t)dir * 272 + ch) * D + c;
      CIN[o] = carry;
      carry = CHP[o] * carry + CHH[o];
    }
  }
}
__device__ __forceinline__ void scan3_phase(const Params& p, unsigned char* lds) {
  const bf16_t* LAB = (const bf16_t*)(p.ws + OFF_LAB); const float* CIN = (const float*)(p.ws + OFF_CIN);
  const bf16_t* GATE = (const bf16_t*)(p.ws + OFF_PQ); bf16_t* A2 = (bf16_t*)(p.ws + OFF_O);
  unsigned* yf = (unsigned*)lds;
  const int total = 256 * 2; const int tid = tidx();
  for (int item = blockIdx.x; item < total; item += gridDim.x) {
    const int cgp = item & 1, ch = item >> 1;
    const int c = cgp * 1024 + tid * 2;
    const size_t base = (size_t)ch * 64 * D + c;
    {
      const bf16_t* a = LAB + base; const bf16_t* b = LAB + (size_t)TT * D + base;
      const float2 hc = *(const float2*)(CIN + (size_t)ch * D + c);
      float h0 = hc.x, h1 = hc.y;
#pragma unroll 1
      for (int t0 = 0; t0 < 64; t0 += 16) {
        unsigned av[16], bv[16];
#pragma unroll
        for (int i = 0; i < 16; ++i) { av[i] = *(const unsigned*)(a + (size_t)(t0 + i) * D); bv[i] = *(const unsigned*)(b + (size_t)(t0 + i) * D); }
#pragma unroll
        for (int i = 0; i < 16; ++i) {
          h0 = __expf(__uint_as_float(av[i] << 16)) * h0 + __uint_as_float(bv[i] << 16); h1 = __expf(__uint_as_float(av[i] & 0xffff0000u)) * h1 + __uint_as_float(bv[i] & 0xffff0000u);
          yf[(t0 + i) * 512 + tid] = pack_bf16(h0, h1);
        }
      }
    }
    {
      const bf16_t* a = LAB + (size_t)2 * TT * D + base; const bf16_t* b = LAB + (size_t)3 * TT * D + base;
      const float2 hc = *(const float2*)(CIN + ((size_t)272 + ch) * D + c);
      float h0 = hc.x, h1 = hc.y;
#pragma unroll 1
      for (int t0 = 48; t0 >= 0; t0 -= 16) {
        unsigned av[16], bv[16], gv[16];
#pragma unroll
        for (int i = 0; i < 16; ++i) { av[i] = *(const unsigned*)(a + (size_t)(t0 + i) * D); bv[i] = *(const unsigned*)(b + (size_t)(t0 + i) * D); gv[i] = *(const unsigned*)(GATE + base + (size_t)(t0 + i) * D); }
#pragma unroll
        for (int i = 15; i >= 0; --i) {
          h0 = __expf(__uint_as_float(av[i] << 16)) * h0 + __uint_as_float(bv[i] << 16); h1 = __expf(__uint_as_float(av[i] & 0xffff0000u)) * h1 + __uint_as_float(bv[i] & 0xffff0000u);
          const unsigned f = yf[(t0 + i) * 512 + tid];
          *(unsigned*)(A2 + base + (size_t)(t0 + i) * D) = pack_bf16((__uint_as_float(f << 16) + h0) * __uint_as_float(gv[i] << 16), (__uint_as_float(f & 0xffff0000u) + h1) * __uint_as_float(gv[i] & 0xffff0000u));
        }
      }
    }
  }
}

#define XB_TMO      128
#define XB_XCNT(j)  (256  + 64 * (j))
#define XB_XSUB(j)  (1280 + 64 * (j))
#define XB_XGEN(j)  (2304 + 64 * (j))
#define XB_TOP      3328
#define XB_TOPGEN   3392
#define XCD_BAR_WORDS 3456
#define XB_SPIN_CAP (1u << 22)
#define LAS3 __attribute__((address_space(3)))
__device__ __forceinline__ unsigned xb_ld(unsigned* p)              { return __hip_atomic_load(p, __ATOMIC_RELAXED, __HIP_MEMORY_SCOPE_AGENT); }
__device__ __forceinline__ unsigned xb_add(unsigned* p, unsigned v) { return __hip_atomic_fetch_add(p, v, __ATOMIC_RELAXED, __HIP_MEMORY_SCOPE_AGENT); }
__device__ __forceinline__ unsigned xb_xcc_id() { return (unsigned)__builtin_amdgcn_s_getreg((3 << 11) | 20) & 0xFu; }
#define XB_SPIN(cond, bar) do { unsigned _sp = 0; while (cond) { __builtin_amdgcn_s_sleep(1); \
    if ((++_sp & 255u) == 0u) { if (xb_ld(&(bar)[XB_TMO])) break; if (_sp > XB_SPIN_CAP) { atomicAdd(&(bar)[XB_TMO], 1u); break; } } } } while (0)
struct XcdBarrier { unsigned* bar; unsigned x; volatile LAS3 unsigned* st; };
__device__ __forceinline__ XcdBarrier xcd_barrier_post(unsigned* bar, volatile LAS3 unsigned* st) {
  XcdBarrier b; b.bar = bar; b.x = xb_xcc_id(); b.st = st;
  if (threadIdx.x == 0) (void)xb_add(&bar[XB_XCNT(b.x)], 1u);
  return b;
}
__device__ __forceinline__ void xcd_barrier_complete(unsigned* bar, unsigned x, unsigned& nloc, unsigned& nx) {
  const unsigned G = gridDim.x * gridDim.y * gridDim.z;
  unsigned sum, cnt, mine, sp = 0u;
  for (;;) {
    sum = 0u; cnt = 0u; mine = 0u;
#pragma unroll
    for (unsigned j = 0; j < 16; ++j) { const unsigned c = xb_ld(&bar[XB_XCNT(j)]); sum += c; cnt += (c > 0u) ? 1u : 0u; mine = (j == x) ? c : mine; }
    if (sum == G) break;
    __builtin_amdgcn_s_sleep(1);
    if ((++sp & 255u) == 0u) { if (xb_ld(&bar[XB_TMO])) break; if (sp > XB_SPIN_CAP) { atomicAdd(&bar[XB_TMO], 1u); break; } }
  }
  nloc = mine > 0u ? mine : 1u; nx = cnt > 0u ? cnt : 1u;
}
__device__ __forceinline__ void xcd_barrier(const XcdBarrier& b) {
  asm volatile("s_waitcnt vmcnt(0)" ::: "memory");
  __syncthreads();
  if (threadIdx.x == 0) {
    unsigned* bar = b.bar;
    __builtin_amdgcn_s_waitcnt(0);
    unsigned nloc = b.st[0], nx = b.st[1];
    if (nloc == 0u) { xcd_barrier_complete(bar, b.x, nloc, nx); b.st[0] = nloc; b.st[1] = nx; }
    const unsigned old = xb_add(&bar[XB_XSUB(b.x)], 1u);
    const unsigned gen = old / nloc;
    if (old + 1u == (gen + 1u) * nloc) {
      __builtin_amdgcn_fence(__ATOMIC_RELEASE, "agent");
      asm volatile("s_waitcnt vmcnt(0)" ::: "memory");
      const unsigned og = xb_add(&bar[XB_TOP], 1u);
      const unsigned tg = og / nx;
      if (og + 1u == (tg + 1u) * nx) xb_add(&bar[XB_TOPGEN], 1u);
      else XB_SPIN(xb_ld(&bar[XB_TOPGEN]) == tg, bar);
      __builtin_amdgcn_fence(__ATOMIC_ACQUIRE, "agent");
      xb_add(&bar[XB_XGEN(b.x)], 1u);
      asm volatile("s_waitcnt vmcnt(0)" ::: "memory");
    } else {
      XB_SPIN(xb_ld(&bar[XB_XGEN(b.x)]) == gen, bar);
      __builtin_amdgcn_fence(__ATOMIC_ACQUIRE, "agent");
      asm volatile("s_waitcnt vmcnt(0)" ::: "memory");
    }
  }
  __syncthreads();
}

__global__ void __launch_bounds__(NT) fwd_megakernel(Params p) {
  extern __shared__ __attribute__((aligned(16))) unsigned char lds[];
  cg::grid_group grid = cg::this_grid();
  unsigned char* ws = p.ws;
  float* MODV = (float*)(ws + OFF_MODV);
  float* XS = (float*)(ws + OFF_XS);
  bf16_t* H = (bf16_t*)(ws + OFF_H);

  unsigned* bar = (unsigned*)(ws + OFF_BAR);
  if (blockIdx.x == 0) for (int i = threadIdx.x; i < XCD_BAR_WORDS; i += NT) bar[i] = 0u;
  volatile LAS3 unsigned* st = (volatile LAS3 unsigned*)((LAS3 unsigned char*)lds + 128 * 1024);
  if (threadIdx.x == 0) { st[0] = 0u; st[1] = 0u; }
  setup_phase(p, lds);
  if (PROBE == 1) { grid.sync(); setup_phase(p, lds); }
  grid.sync();
  const XcdBarrier xb = xcd_barrier_post(bar, st);
#define GSYNC() xcd_barrier(xb)
  {
    constexpr int ntok = TT;
    PH(2, norm_phase(p, 0, p.norm_mix + 0 * D, 0, TT, true, H));
    GSYNC();
      {
        EpiQKV256 e{(bf16_t*)(ws + OFF_Q), (bf16_t*)(ws + OFF_K), (bf16_t*)(ws + OFF_VT), (const float*)(ws + OFF_ROPE), (const float*)(ws + OFF_ROPE) + 2048};
        PH(3, gemm256(p, H, (const bf16_t*)(ws + OFF_WQKV), TT, 3072, D, lds, e, StreamJob{48, 0, 0, 896, 576, 0, 1024}));
      }
      GSYNC();
      PH(4, attn_phase(p, lds));
      GSYNC();
    {
      EpiDelta256 e{(bf16_t*)(ws + OFF_Q), MODV + (size_t)(0 * 5) * NMOD + 2 * D};
      gemm256(p, (const bf16_t*)(ws + OFF_O), (const bf16_t*)(ws + (OFF_WO)), ntok, D, D, lds, e, StreamJob{64, 48, 48, 0, 0, 2048, 1024});
    }
    GSYNC();
    norm_phase(p, 0, p.norm_ffn + 0 * D, 3, ntok, true, H, (const bf16_t*)(ws + OFF_Q));
    GSYNC();
    {
      EpiBf16_256 e{(bf16_t*)(ws + OFF_PQ), D};
      gemm256(p, H, (const bf16_t*)(ws + OFF_WPQ) + (size_t)0 * D * D, ntok, D, D, lds, e, StreamJob{64, 0, 0, 1472, 576, 1024, 1024});
    }
    GSYNC();
    PH(8, peer_route_phase(p, 0, ntok, lds));
    GSYNC();
    if (DUP & 2) { peer_gather_phase(p, 0, ntok, 0, lds, true); GSYNC(); }
    peer_gather_phase(p, 0, ntok, 0, lds);
    GSYNC();
  }
  {
    constexpr int ntok = TL;
      {
        EpiWin256 e{(bf16_t*)(ws + OFF_PQ), (bf16_t*)(ws + OFF_Q)};
        PH(10, gemm256(p, H, (const bf16_t*)(ws + OFF_WIN), TT, 4096, D, lds, e, StreamJob{32, 0, 0, 0, 0, 3072, 1024}));
      }
      GSYNC();
      PH(11, conv_phase(p));
      GSYNC();
      PH(12, coef_phase(p, lds));
      GSYNC();
      PH(13, scan1_phase(p));
      GSYNC();
      PH(14, scan2_phase(p));
      GSYNC();
      if (DUP & 16) { scan1_phase(p); GSYNC(); scan2_phase(p); GSYNC(); }
      if (DUP & 32) { coef_phase(p, lds); GSYNC(); }
      if (DUP & 64) { for (int q = 0; q < 20; ++q) GSYNC(); }
      if (DUP & 128) { conv_phase(p); GSYNC(); }
      scan3_phase(p, lds);
      GSYNC();
    {
      EpiDelta256 e{(bf16_t*)(ws + OFF_Q), MODV + (size_t)(1 * 5) * NMOD + 2 * D};
      gemm256(p, (const bf16_t*)(ws + OFF_O), (const bf16_t*)(ws + (OFF_WOUT)), ntok, D, D, lds, e, StreamJob{0, 0, 0, 0, 0, 0, 0});
    }
    GSYNC();
    norm_phase(p, 1, p.norm_ffn + 1 * D, 3, ntok, false, H, (const bf16_t*)(ws + OFF_Q));
    GSYNC();
    {
      EpiBf16_256 e{(bf16_t*)(ws + OFF_PQ), D};
      PH(18, gemm256(p, H, (const bf16_t*)(ws + OFF_WPQ) + (size_t)1 * D * D, ntok, D, D, lds, e, StreamJob{0, 0, 0, 0, 0, 0, 0}));
    }
    GSYNC();
    PH(19, peer_route_phase(p, 1, ntok, lds));
    GSYNC();
    if (DUP & 2) { peer_gather_phase(p, 1, ntok, 1, lds, true); GSYNC(); }
    peer_gather_phase(p, 1, ntok, 1, lds);
  }
}

__global__ void diag_fill(float* out, int n, float v) { for (int i = blockIdx.x * blockDim.x + threadIdx.x; i < n; i += gridDim.x * blockDim.x) out[i] = v; }

extern "C" void kernel_launch(void* const* d_in, const int* in_sizes, int n_in, void* d_out, int out_size, void* d_ws, size_t ws_size, hipStream_t stream) {
  static int grid_blocks = 0;
  if (!grid_blocks) {
    int dev = 0, cus = 0, per_cu = 0;
    (void)hipGetDevice(&dev);
    (void)hipDeviceGetAttribute(&cus, hipDeviceAttributeMultiprocessorCount, dev);
    (void)hipFuncSetAttribute((const void*)fwd_megakernel, hipFuncAttributeMaxDynamicSharedMemorySize, (int)kDynLds);
    (void)hipOccupancyMaxActiveBlocksPerMultiprocessor(&per_cu, fwd_megakernel, NT, kDynLds);
    if (per_cu > 1) per_cu = 1;
    if (per_cu < 1) per_cu = 1;
    grid_blocks = cus * per_cu;
  }
  if (ws_size < WS_NEED) { fprintf(stderr, "workspace too small: %zu < %zu\n", ws_size, (size_t)WS_NEED); diag_fill<<<1024, 256, 0, stream>>>((float*)d_out, out_size, 3.0f); return; }
  Params p{};
  const float* const* in = (const float* const*)d_in;
  p.x = in[0]; p.c = in[1]; p.ctx = in[2]; p.c_ctx = in[3]; p.w_mod = in[4]; p.b_mod = in[5]; p.norm_mix = in[6]; p.norm_ffn = in[7]; p.norm_final = in[8];
  p.attn_w_qkv = in[9]; p.attn_w_o = in[10]; p.attn_sink = in[11];
  p.rec_w_in = in[12]; p.rec_conv_w = in[13]; p.rec_conv_b = in[14]; p.rec_w_a = in[15]; p.rec_b_a = in[16]; p.rec_w_x = in[17]; p.rec_b_x = in[18]; p.rec_lambda = in[19]; p.rec_w_out = in[20];
  p.peer_w_q = in[21]; p.peer_keys = in[22]; p.peer_u = in[23]; p.peer_v = in[24];
  p.out = (float*)d_out; p.ws = (unsigned char*)d_ws;
  void* args[] = {&p};
  hipError_t e = hipLaunchCooperativeKernel((void*)fwd_megakernel, dim3(grid_blocks), dim3(NT), args, kDynLds, stream);
  if (e != hipSuccess) { fprintf(stderr, "cooperative launch failed: %s (grid %d)\n", hipGetErrorString(e), grid_blocks); diag_fill<<<1024, 256, 0, stream>>>((float*)d_out, out_size, 5.0f); }
}
```

```cpp
#include <hip/hip_runtime.h>
#include <hip/hip_cooperative_groups.h>
#include <cstdio>
namespace cg = cooperative_groups;

typedef unsigned short bf16_t;
typedef short bf16x8 __attribute__((ext_vector_type(8)));
typedef float f32x4 __attribute__((ext_vector_type(4)));
typedef unsigned u32x4 __attribute__((ext_vector_type(4)));
typedef unsigned u32x2 __attribute__((ext_vector_type(2)));
typedef __bf16 bf16x2_t __attribute__((ext_vector_type(2)));

constexpr int D = 2048, NB = 4, S = 4096, CL = 256;
constexpr int TL = NB * S, TC = NB * CL, TT = TL + TC;
constexpr int NT = 512;
constexpr int NMOD = 6 * D;
constexpr int NEXP = 16384;
constexpr size_t kDynLds = 128 * 1024 + 64;
#ifndef SKIP
#define SKIP 0
#endif
#ifndef DUP
#define DUP 0
#endif
#ifndef PROBE
#define PROBE 0
#endif
#define PH(k, ...) do { __VA_ARGS__; if (PROBE == (k)) { GSYNC(); __VA_ARGS__; } } while (0)

constexpr size_t al256(size_t x) { return (x + 255) & ~(size_t)255; }
constexpr size_t OFF_WQKV = 0;
constexpr size_t OFF_WO   = OFF_WQKV + al256((size_t)3072 * 2048 * 2);
constexpr size_t OFF_WPQ  = OFF_WO + al256((size_t)2048 * 2048 * 2);
constexpr size_t OFF_WIN  = OFF_WPQ + al256((size_t)2 * 2048 * 2048 * 2);
constexpr size_t OFF_WOUT = OFF_WIN + al256((size_t)4096 * 2048 * 2);
constexpr size_t OFF_WA   = OFF_WOUT + al256((size_t)2048 * 2048 * 2);
constexpr size_t OFF_SP   = OFF_WA + al256((size_t)32 * 256 * 256 * 2);
constexpr size_t OFF_KEYS = OFF_SP + al256((size_t)2 * 2048 * 4);
constexpr size_t OFF_UTAB = OFF_KEYS + al256((size_t)2 * 2 * 128 * 128 * 2);
constexpr size_t OFF_VTAB = OFF_UTAB + al256((size_t)2 * NEXP * D);
constexpr size_t OFF_USC  = OFF_VTAB + al256((size_t)2 * NEXP * D);
constexpr size_t OFF_VSC  = OFF_USC + al256((size_t)2 * NEXP * 4);
constexpr size_t OFF_MODV = OFF_VSC + al256((size_t)2 * NEXP * 4);
constexpr size_t OFF_ROPE = OFF_MODV + al256((size_t)2 * 5 * NMOD * 4);
constexpr size_t OFF_XS   = OFF_ROPE + al256((size_t)2 * 2048 * 4);
constexpr size_t SZ_ACT  = al256((size_t)TT * D * 2);
constexpr size_t OFF_H    = OFF_XS + al256((size_t)TT * D * 4);
constexpr size_t OFF_Q    = OFF_H + SZ_ACT;
constexpr size_t OFF_X    = OFF_Q + SZ_ACT;
constexpr size_t OFF_K    = OFF_X + 2 * SZ_ACT;
constexpr size_t OFF_VT   = OFF_K + al256((size_t)TT * 512 * 2);
constexpr size_t OFF_O    = OFF_VT + al256((size_t)TT * 512 * 2);
constexpr size_t OFF_PQ   = OFF_O + SZ_ACT;
constexpr size_t OFF_LAB  = OFF_H;
constexpr size_t OFF_CHP  = OFF_K;
constexpr size_t OFF_CHH  = OFF_CHP + al256((size_t)2 * 272 * D * 4);
constexpr size_t OFF_CIN  = OFF_CHH + al256((size_t)2 * 272 * D * 4);
constexpr size_t OFF_IDX  = OFF_PQ + SZ_ACT;
constexpr size_t OFF_GW   = OFF_IDX + al256((size_t)TT * 128 * 4);
constexpr size_t OFF_BAR  = OFF_GW + al256((size_t)TT * 128 * 4);
constexpr size_t WS_NEED  = OFF_BAR + 16384;
static_assert(OFF_CIN + al256((size_t)2 * 272 * D * 4) <= OFF_O, "scan carries must fit in the K/VT region");
static_assert(WS_NEED <= ((size_t)1 << 30), "workspace map exceeds 1 GiB");

struct Params {
  const float *x, *c, *ctx, *c_ctx, *w_mod, *b_mod, *norm_mix, *norm_ffn, *norm_final;
  const float *attn_w_qkv, *attn_w_o, *attn_sink;
  const float *rec_w_in, *rec_conv_w, *rec_conv_b, *rec_w_a, *rec_b_a, *rec_w_x, *rec_b_x, *rec_lambda, *rec_w_out;
  const float *peer_w_q, *peer_keys, *peer_u, *peer_v;
  float* out; unsigned char* ws;
};

__device__ __forceinline__ float bf2f(bf16_t v) { return __uint_as_float((unsigned)v << 16); }
__device__ __forceinline__ bf16_t f2bf(float f) { unsigned u = __float_as_uint(f); u += 0x7fffu + ((u >> 16) & 1u); return (bf16_t)(u >> 16); }
typedef float f32x2_t __attribute__((ext_vector_type(2)));
__device__ __forceinline__ unsigned pack_bf16(float lo, float hi) { const f32x2_t v = {lo, hi}; return __builtin_bit_cast(unsigned, __builtin_convertvector(v, bf16x2_t)); }
template <int CTRL, int RM, bool BC> __device__ __forceinline__ float dppf(float old, float src) {
  return __builtin_bit_cast(float, __builtin_amdgcn_update_dpp(__builtin_bit_cast(int, old), __builtin_bit_cast(int, src), CTRL, RM, 0xf, BC));
}
__device__ __forceinline__ float wave_sum(float v) {
  v += dppf<0x111, 0xf, true>(0.f, v); v += dppf<0x112, 0xf, true>(0.f, v); v += dppf<0x114, 0xf, true>(0.f, v); v += dppf<0x118, 0xf, true>(0.f, v);
  v += dppf<0x142, 0xa, false>(0.f, v); v += dppf<0x143, 0xc, false>(0.f, v);
  return __builtin_bit_cast(float, __builtin_amdgcn_readlane(__builtin_bit_cast(int, v), 63));
}
__device__ __forceinline__ float wave_max(float v) {
  v = fmaxf(v, dppf<0x111, 0xf, false>(v, v)); v = fmaxf(v, dppf<0x112, 0xf, false>(v, v)); v = fmaxf(v, dppf<0x114, 0xf, false>(v, v)); v = fmaxf(v, dppf<0x118, 0xf, false>(v, v));
  v = fmaxf(v, dppf<0x142, 0xa, false>(v, v)); v = fmaxf(v, dppf<0x143, 0xc, false>(v, v));
  return __builtin_bit_cast(float, __builtin_amdgcn_readlane(__builtin_bit_cast(int, v), 63));
}
__device__ __forceinline__ float gelu_tanh(float x) {
  const float y = 0.7978845608028654f * (x + 0.044715f * x * x * x);
  const float t = 1.0f - 2.0f / (1.0f + __expf(2.0f * y));
  return 0.5f * x * (1.0f + t);
}
__device__ __forceinline__ int mod_row(int r) { return r < TL ? (r >> 12) : 4; }
__device__ __forceinline__ int tidx() { int t = threadIdx.x; asm volatile("" : "+v"(t)); return t; }

template <int NC>
__device__ __forceinline__ void mod_item(const Params& p, int item, float* lds) {
  constexpr int VW = NC / 64;
  constexpr int NG = NMOD / NC;
  float* sil = lds;
  float* red = lds + 5 * 2048;
  const int tid = tidx(), wid = tid >> 6, lane = tid & 63;
  for (int i = tid; i < 5 * 2048; i += NT) {
    const int m = i >> 11, k = i & 2047;
    const float v = (m < 4) ? p.c[m * 2048 + k] : p.c_ctx[k];
    sil[i] = v / (1.0f + expf(-v));
  }
  __syncthreads();
  const int layer = item / NG, cgp = item % NG;
  const float* W = p.w_mod + (size_t)layer * 2048 * NMOD + cgp * NC + lane * VW;
  typedef float vecw __attribute__((ext_vector_type(VW)));
  float acc[5][VW];
#pragma unroll
  for (int m = 0; m < 5; ++m)
#pragma unroll
    for (int j = 0; j < VW; ++j) acc[m][j] = 0.f;
  const int k0 = wid * 256;
  constexpr int MB = 10;
  vecw wa[MB], wb[MB];
#pragma unroll
  for (int i = 0; i < MB; ++i) wa[i] = *(const vecw*)(W + (size_t)(k0 + i) * NMOD);
#pragma unroll 1
  for (int kk = k0; kk < k0 + 240; kk += 2 * MB) {
#pragma unroll
    for (int i = 0; i < MB; ++i) wb[i] = *(const vecw*)(W + (size_t)(kk + MB + i) * NMOD);
#pragma unroll
    for (int i = 0; i < MB; ++i)
#pragma unroll
      for (int m = 0; m < 5; ++m) { const float sv = sil[m * 2048 + kk + i];
#pragma unroll
        for (int j = 0; j < VW; ++j) acc[m][j] += sv * wa[i][j]; }
    if (kk + 2 * MB < k0 + 240) {
#pragma unroll
      for (int i = 0; i < MB; ++i) wa[i] = *(const vecw*)(W + (size_t)(kk + 2 * MB + i) * NMOD);
    }
#pragma unroll
    for (int i = 0; i < MB; ++i)
#pragma unroll
      for (int m = 0; m < 5; ++m) { const float sv = sil[m * 2048 + kk + MB + i];
#pragma unroll
        for (int j = 0; j < VW; ++j) acc[m][j] += sv * wb[i][j]; }
  }
#pragma unroll
  for (int i = 0; i < 16; ++i) {
    const vecw w = *(const vecw*)(W + (size_t)(k0 + 240 + i) * NMOD);
#pragma unroll
    for (int m = 0; m < 5; ++m) { const float sv = sil[m * 2048 + k0 + 240 + i];
#pragma unroll
      for (int j = 0; j < VW; ++j) acc[m][j] += sv * w[j]; }
  }
#pragma unroll
  for (int m = 0; m < 5; ++m)
#pragma unroll
    for (int j = 0; j < VW; ++j) red[(wid * 5 + m) * NC + lane * VW + j] = acc[m][j];
  __syncthreads();
  float* MODV = (float*)(p.ws + OFF_MODV);
  for (int o = tid; o < 5 * NC; o += NT) {
    const int m = o / NC, n = o % NC;
    float s = 0.f;
#pragma unroll
    for (int w = 0; w < 8; ++w) s += red[(w * 5 + m) * NC + n];
    const int col = cgp * NC + n;
    MODV[(size_t)(layer * 5 + m) * NMOD + col] = s + p.b_mod[layer * NMOD + col];
  }
  __syncthreads();
}

__device__ __forceinline__ void transpose_quad(const Params& p, int q, float* lds) {
  const float* W; bf16_t* Wt; int K, N; int rnn = -1, isx = 0, mtx = 0;
  if (q < 384) { W = p.attn_w_qkv; Wt = (bf16_t*)(p.ws + OFF_WQKV); K = 2048; N = 3072; }
  else if ((q -= 384) < 256) { W = p.attn_w_o; Wt = (bf16_t*)(p.ws + OFF_WO); K = 2048; N = 2048; }
  else if ((q -= 256) < 512) { const int l = q >> 8; q &= 255; W = p.peer_w_q + (size_t)l * 2048 * 2048; Wt = (bf16_t*)(p.ws + OFF_WPQ) + (size_t)l * 2048 * 2048; K = 2048; N = 2048; }
  else if ((q -= 512) < 512) { W = p.rec_w_in; Wt = (bf16_t*)(p.ws + OFF_WIN); K = 2048; N = 4096; }
  else if ((q -= 512) < 256) { W = p.rec_w_out; Wt = (bf16_t*)(p.ws + OFF_WOUT); K = 2048; N = 2048; }
  else { q -= 256; isx = q >> 6; q &= 63; mtx = q >> 2; q &= 3; rnn = 1; W = (isx ? p.rec_w_x : p.rec_w_a) + (size_t)mtx * 65536; Wt = (bf16_t*)(p.ws + OFF_WA); K = 256; N = 256; }
  const int nq = N >> 8, k0 = (q / nq) * 64, n0 = (q % nq) * 256;
  const int tid = tidx();
  {
    const int r = tid >> 6, c4 = (tid & 63) * 4;
    float4 v[8];
#pragma unroll
    for (int i = 0; i < 8; ++i) v[i] = *(const float4*)(W + (size_t)(k0 + r + 8 * i) * N + n0 + c4);
#pragma unroll
    for (int i = 0; i < 8; ++i) { float* d = lds + (r + 8 * i) * 257 + c4; d[0] = v[i].x; d[1] = v[i].y; d[2] = v[i].z; d[3] = v[i].w; }
  }
  __syncthreads();
  {
    const int n = tid >> 1, kh = (tid & 1) * 32;
    bf16_t* drow = (rnn < 0) ? Wt + (size_t)(n0 + n) * K + k0 + kh : Wt + ((size_t)(mtx * 2 + (n >> 7)) * 256 + isx * 128 + (n & 127)) * 256 + k0 + kh;
#pragma unroll
    for (int c = 0; c < 4; ++c) {
      u32x4 o;
      o.x = pack_bf16(lds[(kh + c * 8 + 0) * 257 + n], lds[(kh + c * 8 + 1) * 257 + n]);
      o.y = pack_bf16(lds[(kh + c * 8 + 2) * 257 + n], lds[(kh + c * 8 + 3) * 257 + n]);
      o.z = pack_bf16(lds[(kh + c * 8 + 4) * 257 + n], lds[(kh + c * 8 + 5) * 257 + n]);
      o.w = pack_bf16(lds[(kh + c * 8 + 6) * 257 + n], lds[(kh + c * 8 + 7) * 257 + n]);
      *(u32x4*)(drow + c * 8) = o;
    }
  }
  __syncthreads();
}

__device__ __forceinline__ void convert8(const float* src, bf16_t* dst) {
  const float4 a = ((const float4*)src)[0], b = ((const float4*)src)[1];
  u32x4 o; o.x = pack_bf16(a.x, a.y); o.y = pack_bf16(a.z, a.w); o.z = pack_bf16(b.x, b.y); o.w = pack_bf16(b.z, b.w);
  *(u32x4*)dst = o;
}

constexpr int ROWV = 1536;
__device__ __forceinline__ void quant_rows_item(const Params& p, int t, int tid0, unsigned char* lds_raw) {
  const int wid = tid0 >> 6, lane = tid0 & 63;
  const int tb = (t * 16) >> 15;
  float4 v[2][8];
#pragma unroll
  for (int h = 0; h < 2; ++h) {
    const int row = (t * 16 + h * 8 + wid) & 32767;
    const float* src = (tb == 0 ? p.peer_u : p.peer_v) + (size_t)row * D;
#pragma unroll
    for (int i = 0; i < 8; ++i) v[h][i] = ((const float4*)src)[i * 64 + lane];
  }
#pragma unroll
  for (int h = 0; h < 2; ++h) {
    const int row = (t * 16 + h * 8 + wid) & 32767;
    float mx = 0.f;
#pragma unroll
    for (int i = 0; i < 8; ++i) mx = fmaxf(mx, fmaxf(fmaxf(fabsf(v[h][i].x), fabsf(v[h][i].y)), fmaxf(fabsf(v[h][i].z), fabsf(v[h][i].w))));
    mx = wave_max(mx);
    if (tb == 0) {
      const float sc = mx > 0.f ? mx * (1.0f / 127.0f) : 1.0f, inv = 1.0f / sc;
      unsigned* dst = (unsigned*)(p.ws + OFF_UTAB + (size_t)row * D);
#pragma unroll
      for (int i = 0; i < 8; ++i) {
        const unsigned q0 = (unsigned)(int)fminf(fmaxf(rintf(v[h][i].x * inv), -127.f), 127.f) & 0xffu, q1 = (unsigned)(int)fminf(fmaxf(rintf(v[h][i].y * inv), -127.f), 127.f) & 0xffu;
        const unsigned q2 = (unsigned)(int)fminf(fmaxf(rintf(v[h][i].z * inv), -127.f), 127.f) & 0xffu, q3 = (unsigned)(int)fminf(fmaxf(rintf(v[h][i].w * inv), -127.f), 127.f) & 0xffu;
        dst[i * 64 + lane] = q0 | (q1 << 8) | (q2 << 16) | (q3 << 24);
      }
      if (lane == 0) ((float*)(p.ws + OFF_USC))[row] = sc;
    } else {
      const float sc = mx > 0.f ? mx * (1.0f / 31.0f) : 1.0f, inv = 1.0f / sc;
      float* T = (float*)lds_raw + wid * 2112;
      unsigned char* dst = p.ws + OFF_VTAB + (size_t)row * ROWV;
#pragma unroll
      for (int i = 0; i < 8; ++i) { const int e = (i * 64 + lane) * 4, pos = e + (e >> 5); T[pos] = v[h][i].x; T[pos + 1] = v[h][i].y; T[pos + 2] = v[h][i].z; T[pos + 3] = v[h][i].w; }
      asm volatile("s_waitcnt lgkmcnt(0)" ::: "memory");
      unsigned d[6] = {0u, 0u, 0u, 0u, 0u, 0u};
#pragma unroll
      for (int j = 0; j < 32; ++j) {
        const unsigned q = (unsigned)((int)fminf(fmaxf(rintf(T[lane * 33 + j] * inv), -31.f), 31.f) + 32);
        const int g = j >> 4, r = j & 15;
        if (r < 12) d[3 * g + (r >> 2)] |= q << (8 * (r & 3));
        else { const int k = r - 12; d[3 * g] |= (q & 3u) << (8 * k + 6); d[3 * g + 1] |= ((q >> 2) & 3u) << (8 * k + 6); d[3 * g + 2] |= (q >> 4) << (8 * k + 6); }
      }
      asm volatile("s_waitcnt lgkmcnt(0)" ::: "memory");
      *(u32x4*)(dst + lane * 16) = (u32x4){d[0], d[1], d[2], d[3]};
      *(u32x2*)(dst + 1024 + lane * 8) = (u32x2){d[4], d[5]};
      if (lane == 0) ((float*)(p.ws + OFF_VSC))[row] = sc;
    }
  }
}

__device__ __forceinline__ void setup_phase(const Params& p, unsigned char* lds_raw) {
  float* lds = (float*)lds_raw;
  const int tid0 = tidx();
  const int b = (int)blockIdx.x;
  if (b < 96) { mod_item<128>(p, b, lds); return; }
  for (int j = b - 96; j < 896 + 17; j += (int)gridDim.x - 96) {
    if (j < 896) { transpose_quad(p, j, lds); continue; }
    const int t = j - 896;
    if (t < 16) { const size_t e = (size_t)t * 4096 + tid0 * 8; convert8(p.peer_keys + e, (bf16_t*)(p.ws + OFF_KEYS) + e); continue; }
    float* cosT = (float*)(p.ws + OFF_ROPE); float* sinT = cosT + 2048;
    for (int e = tid0; e < 2048; e += NT) {
      const int pos = e >> 5, jj = e & 31;
      const float inv = powf(10000.0f, -(float)(2 * jj) / 64.0f);
      const float ang = (float)pos * inv;
      cosT[e] = cosf(ang); sinT[e] = sinf(ang);
    }
    float* SP = (float*)(p.ws + OFF_SP);
    for (int e = tid0; e < 2 * 2048; e += NT) SP[e] = log1pf(expf(-p.rec_lambda[e]));
  }
}
__device__ __forceinline__ void norm_phase(const Params& p, int layer, const float* gain, int shift_idx, int nrows, bool from_input, bf16_t* H, const bf16_t* DELTA = nullptr) {
  const int tid_ = tidx(), wid = tid_ >> 6, lane = tid_ & 63;
  const float* MODV = (const float*)(p.ws + OFF_MODV);
  float* XS = (float*)(p.ws + OFF_XS);
  for (int r = blockIdx.x * 8 + wid; r < nrows; r += gridDim.x * 8) {
    const float* src = from_input ? (r < TL ? p.x + (size_t)r * D : p.ctx + (size_t)(r - TL) * D) : XS + (size_t)r * D;
    const float* mv = MODV + (size_t)(layer * 5 + mod_row(r)) * NMOD;
    const float* sh = mv + shift_idx * D; const float* sc = sh + D;
    float4 v[8]; float ss = 0.f;
#pragma unroll
    for (int i = 0; i < 8; ++i) v[i] = ((const float4*)src)[i * 64 + lane];
    if (DELTA) {
#pragma unroll
      for (int i = 0; i < 8; ++i) {
        const u32x2 dd = *(const u32x2*)(DELTA + (size_t)r * D + i * 256 + lane * 4);
        v[i].x += __uint_as_float(dd.x << 16); v[i].y += __uint_as_float(dd.x & 0xffff0000u); v[i].z += __uint_as_float(dd.y << 16); v[i].w += __uint_as_float(dd.y & 0xffff0000u);
      }
    }
#pragma unroll
    for (int i = 0; i < 8; ++i) ss += v[i].x * v[i].x + v[i].y * v[i].y + v[i].z * v[i].z + v[i].w * v[i].w;
    ss = wave_sum(ss);
    const float rs = rsqrtf(ss * (1.0f / D) + 1e-6f);
#pragma unroll
    for (int i = 0; i < 8; ++i) {
      const float4 g = ((const float4*)gain)[i * 64 + lane], a = ((const float4*)sh)[i * 64 + lane], b = ((const float4*)sc)[i * 64 + lane];
      const float o0 = v[i].x * rs * g.x * (1.0f + b.x) + a.x, o1 = v[i].y * rs * g.y * (1.0f + b.y) + a.y;
      const float o2 = v[i].z * rs * g.z * (1.0f + b.z) + a.z, o3 = v[i].w * rs * g.w * (1.0f + b.w) + a.w;
      u32x2 o; o.x = pack_bf16(o0, o1); o.y = pack_bf16(o2, o3);
      *(u32x2*)(H + (size_t)r * D + i * 256 + lane * 4) = o;
    }
  }
}

namespace pg8 {
#define PG8_LAS __attribute__((address_space(3)))
constexpr int BM = 256, BK = 64, HALF = 128, HTB = HALF * BK * 2, STAGE_BYTES = 8 * HTB, NXCD = 8, WGM = 8;
__device__ __forceinline__ int lds_byte(int r, int c) { const int st = (r >> 4) * 2 + (c >> 5), rr = r & 15, cc = c & 31, ob = rr * 64 + cc * 2; return st * 1024 + (ob ^ (((ob >> 9) & 1) << 5)); }
__device__ __forceinline__ void stage_rc(int b, int& R, int& C) { const int st = b / 1024, sb = b % 1024, swz = sb ^ (((sb >> 9) & 1) << 5); R = (st >> 1) * 16 + swz / 64; C = (st & 1) * 32 + (swz % 64) / 2; }
__device__ __forceinline__ int perm128(int rho) { const int w = rho >> 5, n = (rho >> 4) & 1, i = rho & 15; return 64 * (w >> 1) + 16 * (w & 1) + 32 * n + i; }
struct Unit { int pm, pn; unsigned aoff, boff; };
struct Gemm { const bf16_t* A; const bf16_t* Bt; int K, lda; };
struct StaticOrder {
  int nM, nN, nwg, G, c; unsigned tA, tB;
  __device__ void init(int M, int N, int K, int lda, int G_, int c_) { nM = M / BM; nN = N / BM; nwg = nM * nN; G = G_; c = c_; tA = (unsigned)(BM * lda * 2); tB = (unsigned)(BM * K * 2); }
  __device__ bool next(int i, Unit& u) const {
    const long L = (long)i * G + c; if (L >= nwg) return false;
    int wgid = (int)L; { const int q = nwg / NXCD, r = nwg % NXCD, xcd = wgid % NXCD, off = wgid / NXCD; wgid = (xcd < r ? xcd * (q + 1) : r * (q + 1) + (xcd - r) * q) + off; }
    const int nig = WGM * nN, gid = wgid / nig, fm = gid * WGM, gsz = (nM - fm) < WGM ? (nM - fm) : WGM;
    u.pm = fm + ((wgid % nig) % gsz); u.pn = (wgid % nig) / gsz; u.aoff = (unsigned)u.pm * tA; u.boff = (unsigned)u.pn * tB; return true;
  }
};
struct CoefOrder {
  int G, c;
  __device__ void init(int G_, int c_) { G = G_; c = c_; }
  __device__ bool next(int i, Unit& u) const {
    const long L = (long)i * G + c; if (L >= (long)(TT / 256) * 32) return false;
    u.pm = (int)(L >> 5); u.pn = (int)(L & 31); const int blk = (u.pn >> 1) & 7;
    u.aoff = (unsigned)((u.pm * 256 * D + blk * 256) * 2); u.boff = (unsigned)(u.pn * 256 * 256 * 2); return true;
  }
};
template <class Epi, class Sched>
__device__ __forceinline__ void gemm_phase(PG8_LAS unsigned char* lds, const Gemm g, const Sched& S, const Epi& E) {
  const int tid = tidx(), wid = __builtin_amdgcn_readfirstlane(tid >> 6), lane = tid & 63, wr = wid >> 2, wc = wid & 3, fr = lane & 15, fq = lane >> 4;
  const int K = g.K, nt = K / BK;
  unsigned voffA[2], voffB[2];
#pragma unroll
  for (int i = 0; i < 2; ++i) { int R, C; stage_rc(tid * 16 + i * 8192, R, C); const int Rb = perm128(R);
    voffA[i] = (unsigned)(R * g.lda + C) * 2u; voffB[i] = (unsigned)(Rb * K + C) * 2u; }
  const unsigned kstep = (unsigned)(BK * 2);
  const unsigned hstepA = (unsigned)(HALF * g.lda * 2), hstepB = (unsigned)(HALF * K * 2);
  const unsigned ldsw = (unsigned)wid * 1024u;
  const int aoff = lds_byte(wr * 64 + fr, fq * 8), boff = lds_byte(wc * 32 + fr, fq * 8);
#define PG8_SA(b, h) (((b) * 2 + (h)) * HTB)
#define PG8_SB(b, h) ((4 + (b) * 2 + (h)) * HTB)
#define PG8_STAGE(bufoff, gbase, voff) do { _Pragma("unroll") for (int _i = 0; _i < 2; ++_i) \
    __builtin_amdgcn_global_load_lds((const unsigned*)((const char*)(gbase) + (voff)[_i]), (PG8_LAS unsigned*)(lds + (bufoff) + ldsw + _i * 8192), 16, 0, 0); } while (0)
#define PG8_LDA(dst, b, h) do { _Pragma("unroll") for (int m = 0; m < 4; ++m) _Pragma("unroll") for (int k = 0; k < 2; ++k) dst[m][k] = *(const PG8_LAS bf16x8*)(lds + PG8_SA(b, h) + aoff + m * 2048 + k * 1024); } while (0)
#define PG8_LDB(dst, b, h) do { _Pragma("unroll") for (int n = 0; n < 2; ++n) _Pragma("unroll") for (int k = 0; k < 2; ++k) dst[n][k] = *(const PG8_LAS bf16x8*)(lds + PG8_SB(b, h) + boff + n * 2048 + k * 1024); } while (0)
#define PG8_MMA(ai, bj, At, Bt) do { __builtin_amdgcn_s_setprio(1); _Pragma("unroll") for (int m = 0; m < 4; ++m) _Pragma("unroll") for (int n = 0; n < 2; ++n) _Pragma("unroll") for (int k = 0; k < 2; ++k) \
    acc[ai][bj][m][n] = __builtin_amdgcn_mfma_f32_16x16x32_bf16(Bt[n][k], At[m][k], acc[ai][bj][m][n], 0, 0, 0); __builtin_amdgcn_s_setprio(0); } while (0)
#define PG8_WAIT_V(n) asm volatile("s_waitcnt vmcnt(" #n ")" ::: "memory")
#define PG8_WAIT_L(n) asm volatile("s_waitcnt lgkmcnt(" #n ")" ::: "memory")
#define PG8_BAR __builtin_amdgcn_s_barrier()
#define PG8_SCHED __builtin_amdgcn_sched_barrier(0)
  Unit cur, nxt; int ui = 0;
  if (!S.next(0, cur)) return;
  f32x4 acc[2][2][4][2];
#pragma unroll
  for (int a = 0; a < 2; ++a)
#pragma unroll
    for (int b = 0; b < 2; ++b)
#pragma unroll
      for (int m = 0; m < 4; ++m)
#pragma unroll
        for (int n = 0; n < 2; ++n) acc[a][b][m][n] = (f32x4){0.f, 0.f, 0.f, 0.f};
  bf16x8 At[4][2], B0[2][2], B1[2][2];
  const char* cA = (const char*)g.A + cur.aoff; const char* cB = (const char*)g.Bt + cur.boff;
  PG8_STAGE(PG8_SB(0, 0), cB, voffB); PG8_STAGE(PG8_SA(0, 0), cA, voffA); PG8_STAGE(PG8_SB(0, 1), cB + hstepB, voffB); PG8_STAGE(PG8_SA(0, 1), cA + hstepA, voffA);
  if (wr == 1) PG8_BAR;
  PG8_WAIT_V(4); PG8_BAR;
  PG8_STAGE(PG8_SB(1, 0), cB + kstep, voffB); PG8_STAGE(PG8_SA(1, 0), cA + kstep, voffA); PG8_STAGE(PG8_SB(1, 1), cB + hstepB + kstep, voffB);
  PG8_WAIT_V(6); PG8_BAR;
  for (;;) {
    const bool has_next = S.next(ui + 1, nxt);
    const char* nA = has_next ? (const char*)g.A + nxt.aoff : cA; const char* nB = has_next ? (const char*)g.Bt + nxt.boff : cB;
    for (int t = 0; t < nt; t += 2) {
      const bool last = (t == nt - 2);
      const char* a1 = cA + (unsigned)(t + 1) * kstep;
      const char* a2 = last ? nA : cA + (unsigned)(t + 2) * kstep; const char* b2 = last ? nB : cB + (unsigned)(t + 2) * kstep;
      const char* a3 = a2 + kstep; const char* b3 = b2 + kstep;
      PG8_LDB(B0, 0, 0); PG8_SCHED; PG8_LDA(At, 0, 0); PG8_STAGE(PG8_SA(1, 1), a1 + hstepA, voffA);
      PG8_WAIT_L(8); PG8_BAR; PG8_WAIT_L(0); PG8_MMA(0, 0, At, B0); PG8_BAR; PG8_SCHED;
      PG8_LDB(B1, 0, 1); PG8_STAGE(PG8_SB(0, 0), b2, voffB);
      PG8_BAR; PG8_WAIT_L(0); PG8_MMA(0, 1, At, B1); PG8_BAR;
      PG8_LDA(At, 0, 1); PG8_STAGE(PG8_SA(0, 0), a2, voffA);
      PG8_BAR; PG8_WAIT_L(0); PG8_MMA(1, 0, At, B0); PG8_BAR; PG8_SCHED;
      PG8_STAGE(PG8_SB(0, 1), b2 + hstepB, voffB);
      PG8_WAIT_V(6); PG8_BAR; PG8_MMA(1, 1, At, B1); PG8_BAR;
      PG8_LDB(B0, 1, 0); PG8_SCHED; PG8_LDA(At, 1, 0); PG8_STAGE(PG8_SA(0, 1), a2 + hstepA, voffA);
      PG8_WAIT_L(8); PG8_BAR; PG8_WAIT_L(0); PG8_MMA(0, 0, At, B0); PG8_BAR; PG8_SCHED;
      PG8_LDB(B1, 1, 1); PG8_STAGE(PG8_SB(1, 0), b3, voffB);
      PG8_BAR; PG8_WAIT_L(0); PG8_MMA(0, 1, At, B1); PG8_BAR;
      PG8_LDA(At, 1, 1); PG8_STAGE(PG8_SA(1, 0), a3, voffA);
      PG8_BAR; PG8_WAIT_L(0); PG8_MMA(1, 0, At, B0); PG8_BAR; PG8_SCHED;
      PG8_STAGE(PG8_SB(1, 1), b3 + hstepB, voffB);
      PG8_WAIT_V(6); PG8_BAR; PG8_MMA(1, 1, At, B1); PG8_BAR;
    }
    E(acc, cur, wr, wc, fr, fq);
    if (!has_next) break;
#pragma unroll
    for (int a = 0; a < 2; ++a)
#pragma unroll
      for (int b = 0; b < 2; ++b)
#pragma unroll
        for (int m = 0; m < 4; ++m)
#pragma unroll
          for (int n = 0; n < 2; ++n) acc[a][b][m][n] = (f32x4){0.f, 0.f, 0.f, 0.f};
    cur = nxt; cA = nA; cB = nB; ++ui;
  }
  PG8_WAIT_V(0);
  if (wr == 0) PG8_BAR;
  PG8_BAR;
#undef PG8_SA
#undef PG8_SB
#undef PG8_STAGE
#undef PG8_LDA
#undef PG8_LDB
#undef PG8_MMA
#undef PG8_WAIT_V
#undef PG8_WAIT_L
#undef PG8_BAR
#undef PG8_SCHED
}
}

#define ROW256(ai, m) (u.pm * 256 + (ai) * 128 + wr * 64 + (m) * 16 + fr)
#define COL256(bj, n) (u.pn * 256 + (bj) * 128 + 64 * (wc >> 1) + 16 * (wc & 1) + 32 * (n) + 4 * fq)
struct EpiQKV256 {
  bf16_t *Q, *Kb, *VT; const float *cosT, *sinT;
  __device__ __forceinline__ void operator()(const f32x4 (&acc)[2][2][4][2], const pg8::Unit& u, int wr, int wc, int fr, int fq) const {
#pragma unroll
    for (int bj = 0; bj < 2; ++bj) {
      const int n0 = u.pn * 256 + bj * 128;
      const int c0 = COL256(bj, 0);
      if (n0 < 2560) {
        const int iidx = 16 * (wc & 1) + 4 * fq;
#pragma unroll
        for (int ai = 0; ai < 2; ++ai)
#pragma unroll
          for (int m = 0; m < 4; ++m) {
            const int r = ROW256(ai, m);
            const f32x4 x1 = acc[ai][bj][m][0], x2 = acc[ai][bj][m][1]; f32x4 y1 = x1, y2 = x2;
            if (r < TL) {
              const int s = r & 4095; const int pos = (wc >> 1) ? (s & 63) : (s >> 6);
              const f32x4 cs = *(const f32x4*)(cosT + pos * 32 + iidx), sn = *(const f32x4*)(sinT + pos * 32 + iidx);
              y1 = x1 * cs - x2 * sn; y2 = x2 * cs + x1 * sn;
            }
            bf16_t* dst = (n0 < 2048) ? (Q + (size_t)r * D + c0) : (Kb + (size_t)r * 512 + (c0 - 2048));
            u32x2 o1, o2; o1.x = pack_bf16(y1[0], y1[1]); o1.y = pack_bf16(y1[2], y1[3]); o2.x = pack_bf16(y2[0], y2[1]); o2.y = pack_bf16(y2[2], y2[3]);
            *(u32x2*)dst = o1; *(u32x2*)(dst + 32) = o2;
          }
      } else {
#pragma unroll
        for (int ai = 0; ai < 2; ++ai)
#pragma unroll
          for (int m = 0; m < 4; ++m) {
            const int r = ROW256(ai, m);
#pragma unroll
            for (int n = 0; n < 2; ++n)
#pragma unroll
              for (int j = 0; j < 4; ++j) VT[(size_t)(c0 - 2560 + 32 * n + j) * TT + r] = f2bf(acc[ai][bj][m][n][j]);
          }
      }
    }
  }
};
struct EpiDelta256 {
  bf16_t* DELTA; const float* gate;
  __device__ __forceinline__ void operator()(const f32x4 (&acc)[2][2][4][2], const pg8::Unit& u, int wr, int wc, int fr, int fq) const {
#pragma unroll
    for (int ai = 0; ai < 2; ++ai)
#pragma unroll
      for (int m = 0; m < 4; ++m) {
        const int r = ROW256(ai, m);
        const float* g = gate + (size_t)mod_row(r) * NMOD;
#pragma unroll
        for (int bj = 0; bj < 2; ++bj)
#pragma unroll
          for (int n = 0; n < 2; ++n) {
            const int c = COL256(bj, n);
            const f32x4 v = *(const f32x4*)(g + c) * acc[ai][bj][m][n];
            u32x2 o; o.x = pack_bf16(v[0], v[1]); o.y = pack_bf16(v[2], v[3]);
            *(u32x2*)(DELTA + (size_t)r * D + c) = o;
          }
      }
  }
};
struct EpiBf16_256 {
  bf16_t* O; int ldo;
  __device__ __forceinline__ void operator()(const f32x4 (&acc)[2][2][4][2], const pg8::Unit& u, int wr, int wc, int fr, int fq) const {
#pragma unroll
    for (int ai = 0; ai < 2; ++ai)
#pragma unroll
      for (int m = 0; m < 4; ++m)
#pragma unroll
        for (int bj = 0; bj < 2; ++bj)
#pragma unroll
          for (int n = 0; n < 2; ++n) {
            const f32x4 v = acc[ai][bj][m][n];
            u32x2 o; o.x = pack_bf16(v[0], v[1]); o.y = pack_bf16(v[2], v[3]);
            *(u32x2*)(O + (size_t)ROW256(ai, m) * ldo + COL256(bj, n)) = o;
          }
  }
};
struct EpiWin256 {
  bf16_t *GATE, *UBR;
  __device__ __forceinline__ void operator()(const f32x4 (&acc)[2][2][4][2], const pg8::Unit& u, int wr, int wc, int fr, int fq) const {
#pragma unroll
    for (int ai = 0; ai < 2; ++ai)
#pragma unroll
      for (int m = 0; m < 4; ++m) {
        const int r = ROW256(ai, m);
#pragma unroll
        for (int bj = 0; bj < 2; ++bj)
#pragma unroll
          for (int n = 0; n < 2; ++n) {
            const int c = COL256(bj, n);
            const f32x4 v = acc[ai][bj][m][n];
            if (c < 2048) {
              if (r < TL) { u32x2 o; o.x = pack_bf16(gelu_tanh(v[0]), gelu_tanh(v[1])); o.y = pack_bf16(gelu_tanh(v[2]), gelu_tanh(v[3])); *(u32x2*)(GATE + (size_t)r * D + c) = o; }
            } else {
              u32x2 o; o.x = pack_bf16(v[0], v[1]); o.y = pack_bf16(v[2], v[3]); *(u32x2*)(UBR + (size_t)r * D + (c - 2048)) = o;
            }
          }
      }
  }
};
struct StreamJob { int nsb, m_lo, m_n, t_lo, t_n, q_lo, q_n; };
template <class Epi>
__device__ __forceinline__ void gemm256(const Params& p, const bf16_t* A, const bf16_t* Bt, int M, int N, int K, unsigned char* lds, const Epi& e, const StreamJob sj) {
  if ((int)blockIdx.x < sj.nsb) {
    const int tid0 = tidx();
    for (int k = (int)blockIdx.x; k < sj.m_n + sj.t_n + sj.q_n; k += sj.nsb) {
      if (k < sj.m_n) mod_item<256>(p, sj.m_lo + k, (float*)lds);
      else if (k < sj.m_n + sj.t_n) transpose_quad(p, sj.t_lo + (k - sj.m_n), (float*)lds);
      else quant_rows_item(p, sj.q_lo + (k - sj.m_n - sj.t_n), tid0, lds);
    }
    return;
  }
  pg8::Gemm g{A, Bt, K, K}; pg8::StaticOrder S; S.init(M, N, K, K, (int)gridDim.x - sj.nsb, (int)blockIdx.x - sj.nsb);
  pg8::gemm_phase((PG8_LAS unsigned char*)lds, g, S, e);
}
struct EpiCoef256 {
  const float *b_a, *b_x, *SP; const bf16_t* UC; bf16_t* LAB;
  __device__ __forceinline__ void operator()(const f32x4 (&acc)[2][2][4][2], const pg8::Unit& u, int wr, int wc, int fr_, int fq_) const {
    int fr = fr_, fq = fq_; asm volatile("" : "+v"(fr), "+v"(fq));
    const int dir = u.pn >> 4, blk = (u.pn >> 1) & 7, half = u.pn & 1;
    bf16_t* LA = LAB + (size_t)(dir * 2) * TT * D; bf16_t* LB = LA + (size_t)TT * D;
#pragma unroll
    for (int n = 0; n < 2; ++n) {
      const int c = blk * 256 + half * 128 + 64 * (wc >> 1) + 16 * (wc & 1) + 32 * n + 4 * fq;
      const f32x4 ba = *(const f32x4*)(b_a + dir * D + c), bx = *(const f32x4*)(b_x + dir * D + c), sp = *(const f32x4*)(SP + dir * D + c);
#pragma unroll
      for (int ai = 0; ai < 2; ++ai)
#pragma unroll
        for (int m = 0; m < 4; ++m) {
          const int r = u.pm * 256 + ai * 128 + wr * 64 + m * 16 + fr;
          const u32x2 uu = *(const u32x2*)(UC + (size_t)r * D + c);
          const float uv[4] = {__uint_as_float(uu.x << 16), __uint_as_float(uu.x & 0xffff0000u), __uint_as_float(uu.y << 16), __uint_as_float(uu.y & 0xffff0000u)};
          float lav[4], bv[4];
#pragma unroll
          for (int j = 0; j < 4; ++j) {
            const float rg = __builtin_amdgcn_rcpf(1.0f + __expf(-(acc[ai][0][m][n][j] + ba[j])));
            const float ig = __builtin_amdgcn_rcpf(1.0f + __expf(-(acc[ai][1][m][n][j] + bx[j])));
            const float log_a = -8.0f * rg * sp[j];
            lav[j] = log_a;
            bv[j] = __builtin_amdgcn_sqrtf(fmaxf(1.0f - __expf(2.0f * log_a), 0.f)) * ig * uv[j];
          }
          u32x2 o1, o2; o1.x = pack_bf16(lav[0], lav[1]); o1.y = pack_bf16(lav[2], lav[3]); o2.x = pack_bf16(bv[0], bv[1]); o2.y = pack_bf16(bv[2], bv[3]);
          *(u32x2*)(LA + (size_t)r * D + c) = o1;
          *(u32x2*)(LB + (size_t)r * D + c) = o2;
        }
    }
  }
};
__device__ __forceinline__ void coef_phase(const Params& p, unsigned char* lds) {
  EpiCoef256 e{p.rec_b_a, p.rec_b_x, (const float*)(p.ws + OFF_SP), (const bf16_t*)(p.ws + OFF_O), (bf16_t*)(p.ws + OFF_LAB)};
  pg8::Gemm g{(const bf16_t*)(p.ws + OFF_O), (const bf16_t*)(p.ws + OFF_WA), 256, D}; pg8::CoefOrder S; S.init((int)gridDim.x, (int)blockIdx.x);
  pg8::gemm_phase((PG8_LAS unsigned char*)lds, g, S, e);
}

constexpr int KLD = 136, VLD = 72;
__device__ __forceinline__ void attn_phase(const Params& p, unsigned char* lds) {
  const bf16_t* Q = (const bf16_t*)(p.ws + OFF_Q); const bf16_t* Kg = (const bf16_t*)(p.ws + OFF_K); const bf16_t* VT = (const bf16_t*)(p.ws + OFF_VT);
  bf16_t* O = (bf16_t*)(p.ws + OFF_O);
  bf16_t* Ks = (bf16_t*)lds;
  bf16_t* Vs = Ks + 64 * KLD;
  const int tid = tidx(), wid = tid >> 6, lane = tid & 63, fr = lane & 15, fq = lane >> 4;
  const int g = wid >> 1, rh = wid & 1;
  const float scale = 0.08838834764831845f;
  for (int item = blockIdx.x; item < 1088; item += gridDim.x) {
    int b, hk, qb, qrow0, nlat, kt0;
    if (item < 1024) { b = item >> 8; hk = (item >> 6) & 3; qb = item & 63; qrow0 = b * S + qb * 64; kt0 = qb - 2 < 0 ? 0 : qb - 2; const int kt1 = qb + 2 > 63 ? 63 : qb + 2; nlat = kt1 - kt0 + 1; }
    else { const int ci = item - 1024; b = ci >> 4; hk = (ci >> 2) & 3; qb = ci & 3; qrow0 = TL + b * CL + qb * 64; kt0 = 0; nlat = 0; }
    const int head = hk * 4 + g;
    const float sink = p.attn_sink[head];
    bf16x8 qf[2][4];
#pragma unroll
    for (int rt = 0; rt < 2; ++rt)
#pragma unroll
      for (int ks = 0; ks < 4; ++ks) qf[rt][ks] = *(const bf16x8*)(Q + (size_t)(qrow0 + rh * 32 + rt * 16 + fr) * D + head * 128 + ks * 32 + fq * 8);
    f32x4 oacc[2][8]; float mst[2], lst[2];
#pragma unroll
    for (int rt = 0; rt < 2; ++rt) {
#pragma unroll
      for (int dt = 0; dt < 8; ++dt) oacc[rt][dt] = (f32x4){0.f, 0.f, 0.f, 0.f};
      mst[rt] = sink; lst[rt] = fq == 0 ? 1.0f : 0.f;
    }
    const int ntiles = nlat + 4;
    int kdst[2], vdst[2]; size_t ksrc[2], vsrc[2];
#pragma unroll
    for (int i = 0; i < 2; ++i) {
      const int id = tid + 512 * i;
      const int key = id >> 4, dc = (id & 15) * 8;
      const int kk = key & 31, prow = (key & 32) + ((kk >> 2) & 1) * 16 + (kk >> 3) * 4 + (kk & 3);
      kdst[i] = prow * KLD + dc; ksrc[i] = (size_t)key * 512 + hk * 128 + dc;
      const int d = id >> 3, kc = (id & 7) * 8;
      vdst[i] = d * VLD + kc; vsrc[i] = (size_t)(hk * 128 + d) * TT + kc;
    }
    u32x4 kreg[2], vreg[2];
    {
      const int krow0 = nlat > 0 ? (b * S + kt0 * 64) : (TL + b * CL);
#pragma unroll
      for (int i = 0; i < 2; ++i) { kreg[i] = *(const u32x4*)(Kg + (size_t)krow0 * 512 + ksrc[i]); vreg[i] = *(const u32x4*)(VT + vsrc[i] + krow0); }
    }
    for (int ti = 0; ti < ntiles; ++ti) {
      const bool lat = ti < nlat;
      __syncthreads();
#pragma unroll
      for (int i = 0; i < 2; ++i) { *(u32x4*)(Ks + kdst[i]) = kreg[i]; *(u32x4*)(Vs + vdst[i]) = vreg[i]; }
      if (ti + 1 < ntiles) {
        const int tn = ti + 1;
        const int krow0 = tn < nlat ? (b * S + (kt0 + tn) * 64) : (TL + b * CL + (tn - nlat) * 64);
#pragma unroll
        for (int i = 0; i < 2; ++i) { kreg[i] = *(const u32x4*)(Kg + (size_t)krow0 * 512 + ksrc[i]); vreg[i] = *(const u32x4*)(VT + vsrc[i] + krow0); }
      }
      __syncthreads();
      f32x4 st[2][2][2];
#pragma unroll
      for (int rt = 0; rt < 2; ++rt)
#pragma unroll
        for (int kp = 0; kp < 2; ++kp)
#pragma unroll
          for (int t = 0; t < 2; ++t) st[rt][kp][t] = (f32x4){0.f, 0.f, 0.f, 0.f};
#pragma unroll
      for (int kp = 0; kp < 2; ++kp)
#pragma unroll
        for (int t = 0; t < 2; ++t)
#pragma unroll
          for (int ks = 0; ks < 4; ++ks) {
            const bf16x8 kf = *(const bf16x8*)(Ks + (kp * 32 + t * 16 + fr) * KLD + ks * 32 + fq * 8);
            st[0][kp][t] = __builtin_amdgcn_mfma_f32_16x16x32_bf16(kf, qf[0][ks], st[0][kp][t], 0, 0, 0);
            st[1][kp][t] = __builtin_amdgcn_mfma_f32_16x16x32_bf16(kf, qf[1][ks], st[1][kp][t], 0, 0, 0);
          }
      unsigned pk[2][2][4];
#pragma unroll
      for (int rt = 0; rt < 2; ++rt) {
        const int ipos = qb * 64 + rh * 32 + rt * 16 + fr;
        float mx = -INFINITY;
#pragma unroll
        for (int kp = 0; kp < 2; ++kp)
#pragma unroll
          for (int t = 0; t < 2; ++t)
#pragma unroll
            for (int j = 0; j < 4; ++j) {
              float v = st[rt][kp][t][j] * scale;
              if (lat) { const int dd = ipos - ((kt0 + ti) * 64 + kp * 32 + fq * 8 + t * 4 + j); if (dd > 128 || dd < -128) v = -INFINITY; }
              st[rt][kp][t][j] = v; mx = fmaxf(mx, v);
            }
        mx = fmaxf(mx, __shfl_xor(mx, 16)); mx = fmaxf(mx, __shfl_xor(mx, 32));
        const float mn = fmaxf(mst[rt], mx);
        const float alpha = __expf(mst[rt] - mn);
        mst[rt] = mn;
        float rs = 0.f;
#pragma unroll
        for (int kp = 0; kp < 2; ++kp)
#pragma unroll
          for (int t = 0; t < 2; ++t) {
            const float p0 = __expf(st[rt][kp][t][0] - mn), p1 = __expf(st[rt][kp][t][1] - mn), p2 = __expf(st[rt][kp][t][2] - mn), p3 = __expf(st[rt][kp][t][3] - mn);
            rs += (p0 + p1) + (p2 + p3);
            pk[rt][kp][t * 2] = pack_bf16(p0, p1); pk[rt][kp][t * 2 + 1] = pack_bf16(p2, p3);
          }
        lst[rt] = lst[rt] * alpha + rs;
#pragma unroll
        for (int dt = 0; dt < 8; ++dt) oacc[rt][dt] *= alpha;
      }
#pragma unroll
      for (int kp = 0; kp < 2; ++kp) {
        const bf16x8 pf0 = __builtin_bit_cast(bf16x8, (u32x4){pk[0][kp][0], pk[0][kp][1], pk[0][kp][2], pk[0][kp][3]});
        const bf16x8 pf1 = __builtin_bit_cast(bf16x8, (u32x4){pk[1][kp][0], pk[1][kp][1], pk[1][kp][2], pk[1][kp][3]});
#pragma unroll
        for (int dt = 0; dt < 8; ++dt) {
          const bf16x8 vf = *(const bf16x8*)(Vs + (dt * 16 + fr) * VLD + kp * 32 + fq * 8);
          oacc[0][dt] = __builtin_amdgcn_mfma_f32_16x16x32_bf16(vf, pf0, oacc[0][dt], 0, 0, 0);
          oacc[1][dt] = __builtin_amdgcn_mfma_f32_16x16x32_bf16(vf, pf1, oacc[1][dt], 0, 0, 0);
        }
      }
    }
#pragma unroll
    for (int rt = 0; rt < 2; ++rt) {
      float l = lst[rt]; l += __shfl_xor(l, 16); l += __shfl_xor(l, 32);
      const float inv = 1.0f / l;
      bf16_t* orow = O + (size_t)(qrow0 + rh * 32 + rt * 16 + fr) * D + head * 128 + 4 * fq;
#pragma unroll
      for (int dt = 0; dt < 8; ++dt) {
        u32x2 o; o.x = pack_bf16(oacc[rt][dt][0] * inv, oacc[rt][dt][1] * inv); o.y = pack_bf16(oacc[rt][dt][2] * inv, oacc[rt][dt][3] * inv);
        *(u32x2*)(orow + dt * 16) = o;
      }
    }
  }
}

#define CE_DESC(a, b) { const float _hi = fmaxf(a, b), _lo = fminf(a, b); a = _hi; b = _lo; }
__device__ __forceinline__ void bitonic_sort_desc16(float (&a)[16]) {
#pragma unroll
  for (int ks = 1; ks <= 4; ++ks)
#pragma unroll
    for (int js = ks - 1; js >= 0; --js)
#pragma unroll
      for (int i = 0; i < 16; ++i) { const int k = 1 << ks, j = 1 << js, l = i ^ j; if (l > i) { if ((i & k) == 0) CE_DESC(a[i], a[l]) else CE_DESC(a[l], a[i]) } }
}
__device__ __forceinline__ void bitonic_merge_desc16(float (&a)[16]) {
#pragma unroll
  for (int js = 3; js >= 0; --js)
#pragma unroll
    for (int i = 0; i < 16; ++i) { const int j = 1 << js, l = i ^ j; if (l > i) CE_DESC(a[i], a[l]) }
}
__device__ __forceinline__ void top16_merge(float (&L)[16], float (&G)[16]) {
  bitonic_sort_desc16(G);
#pragma unroll
  for (int i = 0; i < 16; ++i) L[i] = fmaxf(L[i], G[15 - i]);
  bitonic_merge_desc16(L);
}
__host__ __device__ constexpr int cand_code(int c) {
  int n = 0;
  for (int i = 0; i < 16; ++i) for (int j = 0; j < 16 / (i + 1); ++j) { if (n == c) return (i << 4) | j; ++n; }
  return -1;
}
template <int C> struct CandCode { static constexpr int value = cand_code(C); };

__device__ __forceinline__ void peer_route_phase(const Params& p, int layer, int ntok, unsigned char* lds) {
  const int tid = tidx(), wid = tid >> 6, lane = tid & 63, fr = lane & 15, fq = lane >> 4;
  float* Sw = (float*)(lds + wid * 9216);
  const bf16_t* keysG = (const bf16_t*)(p.ws + OFF_KEYS) + (size_t)layer * 2 * 128 * 128;
  const bf16_t* PQ = (const bf16_t*)(p.ws + OFF_PQ);
  int* IDX = (int*)(p.ws + OFF_IDX); float* GW = (float*)(p.ws + OFF_GW);
  const int total = (ntok >> 6) * 8;
  for (int id = blockIdx.x * 8 + wid; id < total; id += gridDim.x * 8) {
    const int tile = id >> 3, head = id & 7, tok0 = tile * 64;
    float Lk[2][16];
#pragma unroll
    for (int pp = 0; pp < 2; ++pp) {
      bf16x8 qf[4][4];
#pragma unroll
      for (int mt = 0; mt < 4; ++mt)
#pragma unroll
        for (int ks = 0; ks < 4; ++ks) qf[mt][ks] = *(const bf16x8*)(PQ + (size_t)(tok0 + mt * 16 + fr) * D + head * 256 + pp * 128 + ks * 32 + fq * 8);
#pragma unroll
      for (int s2 = 0; s2 < 16; ++s2) Lk[pp][s2] = -INFINITY;
      bf16x8 kf[2][4], kfn[2][4];
#pragma unroll
      for (int nt = 0; nt < 2; ++nt)
#pragma unroll
        for (int ks = 0; ks < 4; ++ks) kf[nt][ks] = *(const bf16x8*)(keysG + (size_t)(pp * 128 + nt * 16 + fr) * 128 + ks * 32 + fq * 8);
#pragma unroll 1
      for (int pass = 0; pass < 4; ++pass) {
        const int pn = pass < 3 ? pass + 1 : 3;
#pragma unroll
        for (int nt = 0; nt < 2; ++nt)
#pragma unroll
          for (int ks = 0; ks < 4; ++ks) kfn[nt][ks] = *(const bf16x8*)(keysG + (size_t)(pp * 128 + pn * 32 + nt * 16 + fr) * 128 + ks * 32 + fq * 8);
        f32x4 acc[2][4];
#pragma unroll
        for (int nt = 0; nt < 2; ++nt)
#pragma unroll
          for (int mt = 0; mt < 4; ++mt) acc[nt][mt] = (f32x4){0.f, 0.f, 0.f, 0.f};
#pragma unroll
        for (int nt = 0; nt < 2; ++nt)
#pragma unroll
          for (int ks = 0; ks < 4; ++ks)
#pragma unroll
            for (int mt = 0; mt < 4; ++mt) acc[nt][mt] = __builtin_amdgcn_mfma_f32_16x16x32_bf16(kf[nt][ks], qf[mt][ks], acc[nt][mt], 0, 0, 0);
#pragma unroll
        for (int nt = 0; nt < 2; ++nt)
#pragma unroll
          for (int mt = 0; mt < 4; ++mt) *(f32x4*)(Sw + (mt * 16 + fr) * 36 + nt * 16 + 4 * fq) = acc[nt][mt];
        __builtin_amdgcn_fence(__ATOMIC_RELEASE, "wavefront"); __builtin_amdgcn_wave_barrier(); __builtin_amdgcn_fence(__ATOMIC_ACQUIRE, "wavefront");
#pragma unroll
        for (int g = 0; g < 2; ++g) {
          float G[16];
#pragma unroll
          for (int c = 0; c < 4; ++c) {
            const f32x4 sv = *(const f32x4*)(Sw + lane * 36 + g * 16 + c * 4);
#pragma unroll
            for (int e = 0; e < 4; ++e) G[c * 4 + e] = __uint_as_float((__float_as_uint(sv[e]) & ~0x7fu) | (unsigned)(pass * 32 + g * 16 + c * 4 + e));
          }
          top16_merge(Lk[pp], G);
        }
#pragma unroll
        for (int nt = 0; nt < 2; ++nt)
#pragma unroll
          for (int ks = 0; ks < 4; ++ks) kf[nt][ks] = kfn[nt][ks];
      }
    }
#pragma unroll
    for (int pp = 0; pp < 2; ++pp)
#pragma unroll
      for (int s2 = 0; s2 < 16; ++s2) Sw[(pp * 16 + s2) * 64 + lane] = Lk[pp][s2];
    float v1[16], v2[16];
#pragma unroll
    for (int s2 = 0; s2 < 16; ++s2) { v1[s2] = __uint_as_float(__float_as_uint(Lk[0][s2]) & ~0x7fu); v2[s2] = __uint_as_float(__float_as_uint(Lk[1][s2]) & ~0x7fu); }
    float T[16];
#pragma unroll
    for (int s2 = 0; s2 < 16; ++s2) T[s2] = -INFINITY;
#define ROUTE_GROUP(G0) { float G[16]; \
      _Pragma("unroll") for (int q = 0; q < 16; ++q) G[q] = -INFINITY; \
      ROUTE_FILL(G0 + 0) ROUTE_FILL(G0 + 1) ROUTE_FILL(G0 + 2) ROUTE_FILL(G0 + 3) ROUTE_FILL(G0 + 4) ROUTE_FILL(G0 + 5) ROUTE_FILL(G0 + 6) ROUTE_FILL(G0 + 7) \
      ROUTE_FILL(G0 + 8) ROUTE_FILL(G0 + 9) ROUTE_FILL(G0 + 10) ROUTE_FILL(G0 + 11) ROUTE_FILL(G0 + 12) ROUTE_FILL(G0 + 13) ROUTE_FILL(G0 + 14) ROUTE_FILL(G0 + 15) \
      top16_merge(T, G); }
#define ROUTE_FILL(C) { constexpr int code = CandCode<(C)>::value; if constexpr (code >= 0) G[(C) & 15] = __uint_as_float((__float_as_uint(v1[code >> 4] + v2[code & 15]) & ~0xffu) | (unsigned)code); }
    ROUTE_GROUP(0) ROUTE_GROUP(16) ROUTE_GROUP(32) ROUTE_GROUP(48)
#undef ROUTE_FILL
#undef ROUTE_GROUP
    asm volatile("s_waitcnt lgkmcnt(0)" ::: "memory");
    int E[16];
#pragma unroll
    for (int s2 = 0; s2 < 16; ++s2) {
      const unsigned code = __float_as_uint(T[s2]) & 0xffu;
      const unsigned k1 = __float_as_uint(Sw[(code >> 4) * 64 + lane]) & 0x7fu, k2 = __float_as_uint(Sw[(16 + (code & 15u)) * 64 + lane]) & 0x7fu;
      E[s2] = (int)(k1 * 128u + k2);
      T[s2] = __uint_as_float(__float_as_uint(T[s2]) & ~0xffu);
    }
    asm volatile("s_waitcnt lgkmcnt(0)" ::: "memory");
    const size_t o = ((size_t)(tok0 + lane) * 8 + head) * 16;
    const float tmax = T[0];
    float ssum = 0.f;
#pragma unroll
    for (int s2 = 0; s2 < 16; ++s2) { T[s2] = __expf(T[s2] - tmax); ssum += T[s2]; }
    const float inv = 1.0f / ssum;
#pragma unroll
    for (int c = 0; c < 4; ++c) {
      *(f32x4*)(GW + o + c * 4) = (f32x4){T[c * 4] * inv, T[c * 4 + 1] * inv, T[c * 4 + 2] * inv, T[c * 4 + 3] * inv};
      typedef int i32x4 __attribute__((ext_vector_type(4)));
      *(i32x4*)(IDX + o + c * 4) = (i32x4){E[c * 4], E[c * 4 + 1], E[c * 4 + 2], E[c * 4 + 3]};
    }
  }
}

struct PeerBuf { u32x4 u0, u1, va; u32x2 vb; float su, sv, g; };
__device__ __forceinline__ void peer_load(PeerBuf& B, const unsigned char* UT8, const unsigned char* VT6, const float* USC, const float* VSC, int ireg, float greg, int k0, int lane) {
  const int e = __builtin_amdgcn_readlane(ireg, k0);
  B.g = __builtin_bit_cast(float, __builtin_amdgcn_readlane(__builtin_bit_cast(int, greg), k0));
  const unsigned char* ur = UT8 + (size_t)e * D + lane * 16; const unsigned char* vr = VT6 + (size_t)e * ROWV;
  B.u0 = *(const u32x4*)ur; B.u1 = *(const u32x4*)(ur + 1024);
  B.va = *(const u32x4*)(vr + lane * 16); B.vb = *(const u32x2*)(vr + 1024 + lane * 8);
  B.su = USC[e]; B.sv = VSC[e];
}
__device__ __forceinline__ void peer_compute(const PeerBuf& B, const int (&hq)[2][4], float hscale, float (&accv)[32], float& corr) {
  int d0i = 0, d1i = 0;
#pragma unroll
  for (int t = 0; t < 4; ++t) { d0i = __builtin_amdgcn_sdot4((int)B.u0[t], hq[0][t], d0i, false); d1i = __builtin_amdgcn_sdot4((int)B.u1[t], hq[1][t], d1i, false); }
  const float z = B.su * hscale * wave_sum((float)(d0i + d1i));
  const float act = gelu_tanh(z) * B.g * B.sv;
  corr += act;
#define V6_GROUP(G, DA, DB, DC) { \
    const unsigned c0 = (DA) & 0x3f3f3f3fu, c1 = (DB) & 0x3f3f3f3fu, c2 = (DC) & 0x3f3f3f3fu; \
    const unsigned st = (((DA) >> 6) & 0x03030303u) | ((((DB) >> 6) & 0x03030303u) << 2) | ((((DC) >> 6) & 0x03030303u) << 4); \
    _Pragma("unroll") for (int k = 0; k < 4; ++k) { \
      accv[16 * (G) + k] += act * (float)((c0 >> (8 * k)) & 0xffu); \
      accv[16 * (G) + 4 + k] += act * (float)((c1 >> (8 * k)) & 0xffu); \
      accv[16 * (G) + 8 + k] += act * (float)((c2 >> (8 * k)) & 0xffu); \
      accv[16 * (G) + 12 + k] += act * (float)((st >> (8 * k)) & 0xffu); } }
  V6_GROUP(0, B.va[0], B.va[1], B.va[2])
  V6_GROUP(1, B.va[3], B.vb[0], B.vb[1])
#undef V6_GROUP
}
__device__ __forceinline__ void peer_gather_phase(const Params& p, int layer, int ntok, int gate_layer, unsigned char* lds, bool dry = false) {
  const int tid = tidx(), wid = tid >> 6, lane = tid & 63;
  const bf16_t* H = (const bf16_t*)(p.ws + OFF_H);
  const int* IDX = (const int*)(p.ws + OFF_IDX); const float* GW = (const float*)(p.ws + OFF_GW);
  const unsigned char* UT8 = p.ws + OFF_UTAB + (size_t)layer * NEXP * D; const unsigned char* VT6 = p.ws + OFF_VTAB + (size_t)layer * NEXP * ROWV;
  const float* USC = (const float*)(p.ws + OFF_USC) + (size_t)layer * NEXP; const float* VSC = (const float*)(p.ws + OFF_VSC) + (size_t)layer * NEXP;
  float* XS = (float*)(p.ws + OFF_XS);
  const float* gate = (const float*)(p.ws + OFF_MODV) + (size_t)(gate_layer * 5) * NMOD + 5 * D;
  const int per_round = (int)gridDim.x * 8, nfull_rounds = ntok / per_round, nfull = nfull_rounds * per_round;
  const int nsplit_rounds = (ntok - nfull + (int)gridDim.x * 4 - 1) / ((int)gridDim.x * 4);
  float* part = (float*)lds + (wid >> 1) * 2112;
  for (int it = 0; it < nfull_rounds + nsplit_rounds; ++it) {
    const bool split = it >= nfull_rounds;
    const int tok = split ? nfull + (it - nfull_rounds) * (int)gridDim.x * 4 + (int)blockIdx.x * 4 + (wid >> 1) : it * per_round + (int)blockIdx.x * 8 + wid;
    const bool valid = tok < ntok;
    const int hbeg = split ? (wid & 1) : 0, hend = split ? (wid & 1) + 1 : 2;
    float accv[32]; float corr = 0.f;
#pragma unroll
    for (int j = 0; j < 32; ++j) accv[j] = 0.f;
    if (valid) {
      const int i0 = IDX[(size_t)tok * 128 + lane], i1 = IDX[(size_t)tok * 128 + 64 + lane];
      const float g0 = GW[(size_t)tok * 128 + lane], g1 = GW[(size_t)tok * 128 + 64 + lane];
      PeerBuf A, B;
      peer_load(A, UT8, VT6, USC, VSC, hbeg ? i1 : i0, hbeg ? g1 : g0, 0, lane);
      int hq[2][4]; float hscale;
      {
        float hreg[2][16]; float hmx = 0.f;
#pragma unroll
        for (int c = 0; c < 2; ++c)
#pragma unroll
          for (int hh = 0; hh < 2; ++hh) {
            const u32x4 hv = *(const u32x4*)(H + (size_t)tok * D + c * 1024 + lane * 16 + hh * 8);
#pragma unroll
            for (int t = 0; t < 4; ++t) { hreg[c][hh * 8 + 2 * t] = __uint_as_float(hv[t] << 16); hreg[c][hh * 8 + 2 * t + 1] = __uint_as_float(hv[t] & 0xffff0000u); hmx = fmaxf(hmx, fmaxf(fabsf(hreg[c][hh * 8 + 2 * t]), fabsf(hreg[c][hh * 8 + 2 * t + 1]))); }
          }
        hmx = wave_max(hmx);
        hscale = hmx > 0.f ? hmx * (1.0f / 127.0f) : 1.0f;
        const float hinv = 1.0f / hscale;
#pragma unroll
        for (int c = 0; c < 2; ++c)
#pragma unroll
          for (int t = 0; t < 4; ++t) {
            const unsigned q0 = (unsigned)(int)rintf(hreg[c][4 * t] * hinv) & 0xffu, q1 = (unsigned)(int)rintf(hreg[c][4 * t + 1] * hinv) & 0xffu;
            const unsigned q2 = (unsigned)(int)rintf(hreg[c][4 * t + 2] * hinv) & 0xffu, q3 = (unsigned)(int)rintf(hreg[c][4 * t + 3] * hinv) & 0xffu;
            hq[c][t] = (int)(q0 | (q1 << 8) | (q2 << 16) | (q3 << 24));
          }
      }
#pragma unroll 1
      for (int half = hbeg; half < hend; ++half) {
        const int ireg = half ? i1 : i0; const float greg = half ? g1 : g0;
#pragma unroll 1
        for (int k0 = 0; k0 < 64; k0 += 2) {
          peer_load(B, UT8, VT6, USC, VSC, ireg, greg, k0 + 1, lane);
          peer_compute(A, hq, hscale, accv, corr);
          if (k0 + 2 < 64) peer_load(A, UT8, VT6, USC, VSC, ireg, greg, k0 + 2, lane);
          else if (half + 1 < hend) peer_load(A, UT8, VT6, USC, VSC, i1, g1, 0, lane);
          peer_compute(B, hq, hscale, accv, corr);
        }
      }
    }
    if (split) {
      if (wid & 1) {
#pragma unroll
        for (int t = 0; t < 8; ++t) *(f32x4*)(part + lane * 32 + 4 * t) = (f32x4){accv[4 * t], accv[4 * t + 1], accv[4 * t + 2], accv[4 * t + 3]};
        if (lane == 0) part[2048] = corr;
      }
      __syncthreads();
      if (!(wid & 1)) {
#pragma unroll
        for (int t = 0; t < 8; ++t) { const f32x4 o = *(const f32x4*)(part + lane * 32 + 4 * t); accv[4 * t] += o[0]; accv[4 * t + 1] += o[1]; accv[4 * t + 2] += o[2]; accv[4 * t + 3] += o[3]; }
        corr += part[2048];
      }
      __syncthreads();
      if (wid & 1) continue;
    }
    if (!valid) continue;
    corr *= 32.0f;
    const int mrow = mod_row(tok);
    const float* gr = gate + (size_t)mrow * NMOD + lane * 32; float* xr = XS + (size_t)tok * D + lane * 32;
    const float* xb = layer == 0 ? (tok < TL ? p.x + (size_t)tok * D : p.ctx + (size_t)(tok - TL) * D) + lane * 32 : xr;
    const bf16_t* dl = (const bf16_t*)(p.ws + OFF_Q) + (size_t)tok * D + lane * 32;
    float ss = 0.f;
#pragma unroll
    for (int t = 0; t < 8; ++t) {
      const f32x4 gg = *(const f32x4*)(gr + 4 * t); f32x4 xo = *(const f32x4*)(xb + 4 * t);
      const u32x2 dd = *(const u32x2*)(dl + 4 * t);
      xo[0] += __uint_as_float(dd.x << 16); xo[1] += __uint_as_float(dd.x & 0xffff0000u); xo[2] += __uint_as_float(dd.y << 16); xo[3] += __uint_as_float(dd.y & 0xffff0000u);
#pragma unroll
      for (int j = 0; j < 4; ++j) { const float xn = xo[j] + gg[j] * (accv[4 * t + j] - corr); accv[4 * t + j] = xn; ss += xn * xn; }
    }
    ss = wave_sum(ss);
    const float rs = rsqrtf(ss * (1.0f / D) + 1e-6f);
    if (dry && rs != 12345.678f) continue;
    if (layer == 0) {
      const float* mv = (const float*)(p.ws + OFF_MODV) + (size_t)(5 + mrow) * NMOD + lane * 32;
      const float* gn = p.norm_mix + D + lane * 32;
      bf16_t* hr = (bf16_t*)(p.ws + OFF_H) + (size_t)tok * D + lane * 32;
#pragma unroll
      for (int t = 0; t < 8; ++t) {
        *(f32x4*)(xr + 4 * t) = (f32x4){accv[4 * t], accv[4 * t + 1], accv[4 * t + 2], accv[4 * t + 3]};
        const f32x4 g = *(const f32x4*)(gn + 4 * t), sh = *(const f32x4*)(mv + 4 * t), sc = *(const f32x4*)(mv + D + 4 * t);
        u32x2 o; o.x = pack_bf16(accv[4 * t] * rs * g[0] * (1.0f + sc[0]) + sh[0], accv[4 * t + 1] * rs * g[1] * (1.0f + sc[1]) + sh[1]);
        o.y = pack_bf16(accv[4 * t + 2] * rs * g[2] * (1.0f + sc[2]) + sh[2], accv[4 * t + 3] * rs * g[3] * (1.0f + sc[3]) + sh[3]);
        *(u32x2*)(hr + 4 * t) = o;
      }
    } else {
      float* orow = p.out + (size_t)tok * D + lane * 32;
#pragma unroll
      for (int t = 0; t < 8; ++t) {
        const f32x4 g = *(const f32x4*)(p.norm_final + lane * 32 + 4 * t);
        *(f32x4*)(orow + 4 * t) = (f32x4){accv[4 * t] * rs * g[0], accv[4 * t + 1] * rs * g[1], accv[4 * t + 2] * rs * g[2], accv[4 * t + 3] * rs * g[3]};
      }
    }
  }
}

__device__ __forceinline__ void conv_phase(const Params& p) {
  const bf16_t* UBR = (const bf16_t*)(p.ws + OFF_Q); bf16_t* UC = (bf16_t*)(p.ws + OFF_O);
  const int tid = tidx(), c = (tid & 255) * 8, hrow = tid >> 8;
  float w[4][8], bias[8];
#pragma unroll
  for (int k = 0; k < 4; ++k) { const float4 w0 = *(const float4*)(p.rec_conv_w + k * D + c), w1 = *(const float4*)(p.rec_conv_w + k * D + c + 4); w[k][0] = w0.x; w[k][1] = w0.y; w[k][2] = w0.z; w[k][3] = w0.w; w[k][4] = w1.x; w[k][5] = w1.y; w[k][6] = w1.z; w[k][7] = w1.w; }
  { const float4 b0 = *(const float4*)(p.rec_conv_b + c), b1 = *(const float4*)(p.rec_conv_b + c + 4); bias[0] = b0.x; bias[1] = b0.y; bias[2] = b0.z; bias[3] = b0.w; bias[4] = b1.x; bias[5] = b1.y; bias[6] = b1.z; bias[7] = b1.w; }
  const int nhalf = 2 * (int)gridDim.x, rows_per = (TT + nhalf - 1) / nhalf;
  const int r0 = ((int)blockIdx.x * 2 + hrow) * rows_per, r1 = r0 + rows_per < TT ? r0 + rows_per : TT;
  if (r0 < TT) {
    u32x4 win[4];
    const u32x4 zero = (u32x4){0u, 0u, 0u, 0u};
#pragma unroll
    for (int k = 0; k < 3; ++k) { const int rr = r0 - 1 + k; win[k] = (rr >= 0 && rr < TT) ? *(const u32x4*)(UBR + (size_t)rr * D + c) : zero; }
#pragma unroll 2
    for (int r = r0; r < r1; ++r) {
      const int rr = r + 2;
      win[3] = (rr < TT) ? *(const u32x4*)(UBR + (size_t)rr * D + c) : zero;
      const int seq_lo = r < TL ? (r & ~4095) : TL + ((r - TL) & ~255), seq_hi = seq_lo + (r < TL ? S : CL);
      float acc[8];
#pragma unroll
      for (int j = 0; j < 8; ++j) acc[j] = bias[j];
#pragma unroll
      for (int k = 0; k < 4; ++k) {
        const int rk = r - 1 + k; const bool ok = rk >= seq_lo && rk < seq_hi;
#pragma unroll
        for (int t = 0; t < 4; ++t) { const unsigned d = ok ? win[k][t] : 0u; acc[2 * t] += w[k][2 * t] * __uint_as_float(d << 16); acc[2 * t + 1] += w[k][2 * t + 1] * __uint_as_float(d & 0xffff0000u); }
      }
      u32x4 o; o.x = pack_bf16(acc[0], acc[1]); o.y = pack_bf16(acc[2], acc[3]); o.z = pack_bf16(acc[4], acc[5]); o.w = pack_bf16(acc[6], acc[7]);
      *(u32x4*)(UC + (size_t)r * D + c) = o;
      win[0] = win[1]; win[1] = win[2]; win[2] = win[3];
    }
  }
}

__device__ __forceinline__ void scan1_phase(const Params& p) {
  const bf16_t* LAB = (const bf16_t*)(p.ws + OFF_LAB);
  float* CHP = (float*)(p.ws + OFF_CHP); float* CHH = (float*)(p.ws + OFF_CHH);
  const int total = 2 * 272 * 2; const int tid = tidx();
  for (int item = blockIdx.x; item < total; item += gridDim.x) {
    const int cgp = item & 1, ch = (item >> 1) % 272, dir = item / (272 * 2);
    const int c = cgp * 1024 + tid * 2;
    const bf16_t* a = LAB + ((size_t)(dir * 2) * TT + ch * 64) * D + c; const bf16_t* b = LAB + ((size_t)(dir * 2 + 1) * TT + ch * 64) * D + c;
    float h0 = 0.f, h1 = 0.f, ls0 = 0.f, ls1 = 0.f;
#pragma unroll 1
    for (int q = 0; q < 4; ++q) {
      unsigned av[16], bv[16];
      const int t0 = dir == 0 ? q * 16 : 48 - q * 16;
#pragma unroll
      for (int i = 0; i < 16; ++i) { av[i] = *(const unsigned*)(a + (size_t)(t0 + i) * D); bv[i] = *(const unsigned*)(b + (size_t)(t0 + i) * D); }
#pragma unroll
      for (int ii = 0; ii < 16; ++ii) {
        const int i = dir == 0 ? ii : 15 - ii;
        const float la0 = __uint_as_float(av[i] << 16), la1 = __uint_as_float(av[i] & 0xffff0000u);
        h0 = __expf(la0) * h0 + __uint_as_float(bv[i] << 16); h1 = __expf(la1) * h1 + __uint_as_float(bv[i] & 0xffff0000u);
        ls0 += la0; ls1 += la1;
      }
    }
    const size_t o = ((size_t)dir * 272 + ch) * D + c;
    *(float2*)(CHP + o) = make_float2(__expf(ls0), __expf(ls1)); *(float2*)(CHH + o) = make_float2(h0, h1);
  }
}
__device__ __forceinline__ void scan2_phase(const Params& p) {
  const float* CHP = (const float*)(p.ws + OFF_CHP); const float* CHH = (const float*)(p.ws + OFF_CHH); float* CIN = (float*)(p.ws + OFF_CIN);
  for (int it = blockIdx.x * NT + tidx(); it < 2 * NB * D; it += gridDim.x * NT) {
    const int c = it & 2047, b = (it >> 11) & 3, dir = it >> 13;
    float carry = 0.f;
    for (int s = 0; s < 68; ++s) {
      int ch;
      if (dir == 0) ch = s < 4 ? (256 + 4 * b + s) : (64 * b + (s - 4));
      else ch = s < 4 ? (256 + 4 * b + (3 - s)) : (64 * b + (63 - (s - 4)));
      const size_t o = ((size_t)dir * 272 + ch) * D + c;
      CIN[o] = carry;
      carry = CHP[o] * carry + CHH[o];
    }
  }
}
__device__ __forceinline__ void scan3_phase(const Params& p, unsigned char* lds) {
  const bf16_t* LAB = (const bf16_t*)(p.ws + OFF_LAB); const float* CIN = (const float*)(p.ws + OFF_CIN);
  const bf16_t* GATE = (const bf16_t*)(p.ws + OFF_PQ); bf16_t* A2 = (bf16_t*)(p.ws + OFF_O);
  unsigned* yf = (unsigned*)lds;
  const int total = 256 * 2; const int tid = tidx();
  for (int item = blockIdx.x; item < total; item += gridDim.x) {
    const int cgp = item & 1, ch = item >> 1;
    const int c = cgp * 1024 + tid * 2;
    const size_t base = (size_t)ch * 64 * D + c;
    {
      const bf16_t* a = LAB + base; const bf16_t* b = LAB + (size_t)TT * D + base;
      const float2 hc = *(const float2*)(CIN + (size_t)ch * D + c);
      float h0 = hc.x, h1 = hc.y;
#pragma unroll 1
      for (int t0 = 0; t0 < 64; t0 += 16) {
        unsigned av[16], bv[16];
#pragma unroll
        for (int i = 0; i < 16; ++i) { av[i] = *(const unsigned*)(a + (size_t)(t0 + i) * D); bv[i] = *(const unsigned*)(b + (size_t)(t0 + i) * D); }
#pragma unroll
        for (int i = 0; i < 16; ++i) {
          h0 = __expf(__uint_as_float(av[i] << 16)) * h0 + __uint_as_float(bv[i] << 16); h1 = __expf(__uint_as_float(av[i] & 0xffff0000u)) * h1 + __uint_as_float(bv[i] & 0xffff0000u);
          yf[(t0 + i) * 512 + tid] = pack_bf16(h0, h1);
        }
      }
    }
    {
      const bf16_t* a = LAB + (size_t)2 * TT * D + base; const bf16_t* b = LAB + (size_t)3 * TT * D + base;
      const float2 hc = *(const float2*)(CIN + ((size_t)272 + ch) * D + c);
      float h0 = hc.x, h1 = hc.y;
#pragma unroll 1
      for (int t0 = 48; t0 >= 0; t0 -= 16) {
        unsigned av[16], bv[16], gv[16];
#pragma unroll
        for (int i = 0; i < 16; ++i) { av[i] = *(const unsigned*)(a + (size_t)(t0 + i) * D); bv[i] = *(const unsigned*)(b + (size_t)(t0 + i) * D); gv[i] = *(const unsigned*)(GATE + base + (size_t)(t0 + i) * D); }
#pragma unroll
        for (int i = 15; i >= 0; --i) {
          h0 = __expf(__uint_as_float(av[i] << 16)) * h0 + __uint_as_float(bv[i] << 16); h1 = __expf(__uint_as_float(av[i] & 0xffff0000u)) * h1 + __uint_as_float(bv[i] & 0xffff0000u);
          const unsigned f = yf[(t0 + i) * 512 + tid];
          *(unsigned*)(A2 + base + (size_t)(t0 + i) * D) = pack_bf16((__uint_as_float(f << 16) + h0) * __uint_as_float(gv[i] << 16), (__uint_as_float(f & 0xffff0000u) + h1) * __uint_as_float(gv[i] & 0xffff0000u));
        }
      }
    }
  }
}

#define XB_TMO      128
#define XB_XCNT(j)  (256  + 64 * (j))
#define XB_XSUB(j)  (1280 + 64 * (j))
#define XB_XGEN(j)  (2304 + 64 * (j))
#define XB_TOP      3328
#define XB_TOPGEN   3392
#define XCD_BAR_WORDS 3456
#define XB_SPIN_CAP (1u << 22)
#define LAS3 __attribute__((address_space(3)))
__device__ __forceinline__ unsigned xb_ld(unsigned* p)              { return __hip_atomic_load(p, __ATOMIC_RELAXED, __HIP_MEMORY_SCOPE_AGENT); }
__device__ __forceinline__ unsigned xb_add(unsigned* p, unsigned v) { return __hip_atomic_fetch_add(p, v, __ATOMIC_RELAXED, __HIP_MEMORY_SCOPE_AGENT); }
__device__ __forceinline__ unsigned xb_xcc_id() { return (unsigned)__builtin_amdgcn_s_getreg((3 << 11) | 20) & 0xFu; }
#define XB_SPIN(cond, bar) do { unsigned _sp = 0; while (cond) { __builtin_amdgcn_s_sleep(1); \
    if ((++_sp & 255u) == 0u) { if (xb_ld(&(bar)[XB_TMO])) break; if (_sp > XB_SPIN_CAP) { atomicAdd(&(bar)[XB_TMO], 1u); break; } } } } while (0)
struct XcdBarrier { unsigned* bar; unsigned x; volatile LAS3 unsigned* st; };
__device__ __forceinline__ XcdBarrier xcd_barrier_post(unsigned* bar, volatile LAS3 unsigned* st) {
  XcdBarrier b; b.bar = bar; b.x = xb_xcc_id(); b.st = st;
  if (threadIdx.x == 0) (void)xb_add(&bar[XB_XCNT(b.x)], 1u);
  return b;
}
__device__ __forceinline__ void xcd_barrier_complete(unsigned* bar, unsigned x, unsigned& nloc, unsigned& nx) {
  const unsigned G = gridDim.x * gridDim.y * gridDim.z;
  unsigned sum, cnt, mine, sp = 0u;
  for (;;) {
    sum = 0u; cnt = 0u; mine = 0u;
#pragma unroll
    for (unsigned j = 0; j < 16; ++j) { const unsigned c = xb_ld(&bar[XB_XCNT(j)]); sum += c; cnt += (c > 0u) ? 1u : 0u; mine = (j == x) ? c : mine; }
    if (sum == G) break;
    __builtin_amdgcn_s_sleep(1);
    if ((++sp & 255u) == 0u) { if (xb_ld(&bar[XB_TMO])) break; if (sp > XB_SPIN_CAP) { atomicAdd(&bar[XB_TMO], 1u); break; } }
  }
  nloc = mine > 0u ? mine : 1u; nx = cnt > 0u ? cnt : 1u;
}
__device__ __forceinline__ void xcd_barrier(const XcdBarrier& b) {
  asm volatile("s_waitcnt vmcnt(0)" ::: "memory");
  __syncthreads();
  if (threadIdx.x == 0) {
    unsigned* bar = b.bar;
    __builtin_amdgcn_s_waitcnt(0);
    unsigned nloc = b.st[0], nx = b.st[1];
    if (nloc == 0u) { xcd_barrier_complete(bar, b.x, nloc, nx); b.st[0] = nloc; b.st[1] = nx; }
    const unsigned old = xb_add(&bar[XB_XSUB(b.x)], 1u);
    const unsigned gen = old / nloc;
    if (old + 1u == (gen + 1u) * nloc) {
      __builtin_amdgcn_fence(__ATOMIC_RELEASE, "agent");
      asm volatile("s_waitcnt vmcnt(0)" ::: "memory");
      const unsigned og = xb_add(&bar[XB_TOP], 1u);
      const unsigned tg = og / nx;
      if (og + 1u == (tg + 1u) * nx) xb_add(&bar[XB_TOPGEN], 1u);
      else XB_SPIN(xb_ld(&bar[XB_TOPGEN]) == tg, bar);
      __builtin_amdgcn_fence(__ATOMIC_ACQUIRE, "agent");
      xb_add(&bar[XB_XGEN(b.x)], 1u);
      asm volatile("s_waitcnt vmcnt(0)" ::: "memory");
    } else {
      XB_SPIN(xb_ld(&bar[XB_XGEN(b.x)]) == gen, bar);
      __builtin_amdgcn_fence(__ATOMIC_ACQUIRE, "agent");
      asm volatile("s_waitcnt vmcnt(0)" ::: "memory");
    }
  }
  __syncthreads();
}

__global__ void __launch_bounds__(NT) fwd_megakernel(Params p) {
  extern __shared__ __attribute__((aligned(16))) unsigned char lds[];
  cg::grid_group grid = cg::this_grid();
  unsigned char* ws = p.ws;
  float* MODV = (float*)(ws + OFF_MODV);
  float* XS = (float*)(ws + OFF_XS);
  bf16_t* H = (bf16_t*)(ws + OFF_H);

  unsigned* bar = (unsigned*)(ws + OFF_BAR);
  if (blockIdx.x == 0) for (int i = threadIdx.x; i < XCD_BAR_WORDS; i += NT) bar[i] = 0u;
  volatile LAS3 unsigned* st = (volatile LAS3 unsigned*)((LAS3 unsigned char*)lds + 128 * 1024);
  if (threadIdx.x == 0) { st[0] = 0u; st[1] = 0u; }
  setup_phase(p, lds);
  if (PROBE == 1) { grid.sync(); setup_phase(p, lds); }
  grid.sync();
  const XcdBarrier xb = xcd_barrier_post(bar, st);
#define GSYNC() xcd_barrier(xb)
  {
    constexpr int ntok = TT;
    PH(2, norm_phase(p, 0, p.norm_mix + 0 * D, 0, TT, true, H));
    GSYNC();
      {
        EpiQKV256 e{(bf16_t*)(ws + OFF_Q), (bf16_t*)(ws + OFF_K), (bf16_t*)(ws + OFF_VT), (const float*)(ws + OFF_ROPE), (const float*)(ws + OFF_ROPE) + 2048};
        PH(3, gemm256(p, H, (const bf16_t*)(ws + OFF_WQKV), TT, 3072, D, lds, e, StreamJob{48, 0, 0, 896, 576, 0, 1024}));
      }
      GSYNC();
      PH(4, attn_phase(p, lds));
      GSYNC();
    {
      EpiDelta256 e{(bf16_t*)(ws + OFF_Q), MODV + (size_t)(0 * 5) * NMOD + 2 * D};
      gemm256(p, (const bf16_t*)(ws + OFF_O), (const bf16_t*)(ws + (OFF_WO)), ntok, D, D, lds, e, StreamJob{64, 48, 48, 0, 0, 2048, 1024});
    }
    GSYNC();
    norm_phase(p, 0, p.norm_ffn + 0 * D, 3, ntok, true, H, (const bf16_t*)(ws + OFF_Q));
    GSYNC();
    {
      EpiBf16_256 e{(bf16_t*)(ws + OFF_PQ), D};
      gemm256(p, H, (const bf16_t*)(ws + OFF_WPQ) + (size_t)0 * D * D, ntok, D, D, lds, e, StreamJob{64, 0, 0, 1472, 576, 1024, 1024});
    }
    GSYNC();
    PH(8, peer_route_phase(p, 0, ntok, lds));
    GSYNC();
    if (DUP & 2) { peer_gather_phase(p, 0, ntok, 0, lds, true); GSYNC(); }
    peer_gather_phase(p, 0, ntok, 0, lds);
    GSYNC();
  }
  {
    constexpr int ntok = TL;
      {
        EpiWin256 e{(bf16_t*)(ws + OFF_PQ), (bf16_t*)(ws + OFF_Q)};
        PH(10, gemm256(p, H, (const bf16_t*)(ws + OFF_WIN), TT, 4096, D, lds, e, StreamJob{32, 0, 0, 0, 0, 3072, 1024}));
      }
      GSYNC();
      PH(11, conv_phase(p));
      GSYNC();
      PH(12, coef_phase(p, lds));
      GSYNC();
      PH(13, scan1_phase(p));
      GSYNC();
      PH(14, scan2_phase(p));
      GSYNC();
      if (DUP & 16) { scan1_phase(p); GSYNC(); scan2_phase(p); GSYNC(); }
      if (DUP & 32) { coef_phase(p, lds); GSYNC(); }
      if (DUP & 64) { for (int q = 0; q < 20; ++q) GSYNC(); }
      if (DUP & 128) { conv_phase(p); GSYNC(); }
      scan3_phase(p, lds);
      GSYNC();
    {
      EpiDelta256 e{(bf16_t*)(ws + OFF_Q), MODV + (size_t)(1 * 5) * NMOD + 2 * D};
      gemm256(p, (const bf16_t*)(ws + OFF_O), (const bf16_t*)(ws + (OFF_WOUT)), ntok, D, D, lds, e, StreamJob{0, 0, 0, 0, 0, 0, 0});
    }
    GSYNC();
    norm_phase(p, 1, p.norm_ffn + 1 * D, 3, ntok, false, H, (const bf16_t*)(ws + OFF_Q));
    GSYNC();
    {
      EpiBf16_256 e{(bf16_t*)(ws + OFF_PQ), D};
      PH(18, gemm256(p, H, (const bf16_t*)(ws + OFF_WPQ) + (size_t)1 * D * D, ntok, D, D, lds, e, StreamJob{0, 0, 0, 0, 0, 0, 0}));
    }
    GSYNC();
    PH(19, peer_route_phase(p, 1, ntok, lds));
    GSYNC();
    if (DUP & 2) { peer_gather_phase(p, 1, ntok, 1, lds, true); GSYNC(); }
    peer_gather_phase(p, 1, ntok, 1, lds);
  }
}

__global__ void diag_fill(float* out, int n, float v) { for (int i = blockIdx.x * blockDim.x + threadIdx.x; i < n; i += gridDim.x * blockDim.x) out[i] = v; }

extern "C" void kernel_launch(void* const* d_in, const int* in_sizes, int n_in, void* d_out, int out_size, void* d_ws, size_t ws_size, hipStream_t stream) {
  static int grid_blocks = 0;
  if (!grid_blocks) {
    int dev = 0, cus = 0, per_cu = 0;
    (void)hipGetDevice(&dev);
    (void)hipDeviceGetAttribute(&cus, hipDeviceAttributeMultiprocessorCount, dev);
    (void)hipFuncSetAttribute((const void*)fwd_megakernel, hipFuncAttributeMaxDynamicSharedMemorySize, (int)kDynLds);
    (void)hipOccupancyMaxActiveBlocksPerMultiprocessor(&per_cu, fwd_megakernel, NT, kDynLds);
    if (per_cu > 1) per_cu = 1;
    if (per_cu < 1) per_cu = 1;
    grid_blocks = cus * per_cu;
  }
  if (ws_size < WS_NEED) { fprintf(stderr, "workspace too small: %zu < %zu\n", ws_size, (size_t)WS_NEED); diag_fill<<<1024, 256, 0, stream>>>((float*)d_out, out_size, 3.0f); return; }
  Params p{};
  const float* const* in = (const float* const*)d_in;
  p.x = in[0]; p.c = in[1]; p.ctx = in[2]; p.c_ctx = in[3]; p.w_mod = in[4]; p.b_mod = in[5]; p.norm_mix = in[6]; p.norm_ffn = in[7]; p.norm_final = in[8];
  p.attn_w_qkv = in[9]; p.attn_w_o = in[10]; p.attn_sink = in[11];
  p.rec_w_in = in[12]; p.rec_conv_w = in[13]; p.rec_conv_b = in[14]; p.rec_w_a = in[15]; p.rec_b_a = in[16]; p.rec_w_x = in[17]; p.rec_b_x = in[18]; p.rec_lambda = in[19]; p.rec_w_out = in[20];
  p.peer_w_q = in[21]; p.peer_keys = in[22]; p.peer_u = in[23]; p.peer_v = in[24];
  p.out = (float*)d_out; p.ws = (unsigned char*)d_ws;
  void* args[] = {&p};
  hipError_t e = hipLaunchCooperativeKernel((void*)fwd_megakernel, dim3(grid_blocks), dim3(NT), args, kDynLds, stream);
  if (e != hipSuccess) { fprintf(stderr, "cooperative launch failed: %s (grid %d)\n", hipGetErrorString(e), grid_blocks); diag_fill<<<1024, 256, 0, stream>>>((float*)d_out, out_size, 5.0f); }
}
```

```cpp
#include <hip/hip_runtime.h>
#include <hip/hip_cooperative_groups.h>
#include <cstdio>
namespace cg = cooperative_groups;

typedef unsigned short bf16_t;
typedef short bf16x8 __attribute__((ext_vector_type(8)));
typedef float f32x4 __attribute__((ext_vector_type(4)));
typedef unsigned u32x4 __attribute__((ext_vector_type(4)));
typedef unsigned u32x2 __attribute__((ext_vector_type(2)));
typedef __bf16 bf16x2_t __attribute__((ext_vector_type(2)));

constexpr int D = 2048, NB = 4, S = 4096, CL = 256;
constexpr int TL = NB * S, TC = NB * CL, TT = TL + TC;
constexpr int NT = 512;
constexpr int NMOD = 6 * D;
constexpr int NEXP = 16384;
constexpr size_t kDynLds = 128 * 1024 + 64;

constexpr size_t al256(size_t x) { return (x + 255) & ~(size_t)255; }
constexpr size_t OFF_WQKV = 0;
constexpr size_t OFF_WO   = OFF_WQKV + al256((size_t)3072 * 2048 * 2);
constexpr size_t OFF_WPQ  = OFF_WO + al256((size_t)2048 * 2048 * 2);
constexpr size_t OFF_WIN  = OFF_WPQ + al256((size_t)2 * 2048 * 2048 * 2);
constexpr size_t OFF_WOUT = OFF_WIN + al256((size_t)4096 * 2048 * 2);
constexpr size_t OFF_WA   = OFF_WOUT + al256((size_t)2048 * 2048 * 2);
constexpr size_t OFF_SP   = OFF_WA + al256((size_t)32 * 256 * 256 * 2);
constexpr size_t OFF_KEYS = OFF_SP + al256((size_t)2 * 2048 * 4);
constexpr size_t OFF_UTAB = OFF_KEYS + al256((size_t)2 * 2 * 128 * 128 * 2);
constexpr size_t OFF_VTAB = OFF_UTAB + al256((size_t)2 * NEXP * D);
constexpr size_t OFF_USC  = OFF_VTAB + al256((size_t)2 * NEXP * D);
constexpr size_t OFF_VSC  = OFF_USC + al256((size_t)2 * NEXP * 4);
static_assert(OFF_VSC == OFF_USC + (size_t)2 * NEXP * 4, "the step arrays must be contiguous");
constexpr size_t OFF_MODV = OFF_VSC + al256((size_t)2 * NEXP * 4);
constexpr size_t OFF_ROPE = OFF_MODV + al256((size_t)2 * 5 * NMOD * 4);
constexpr size_t OFF_XS   = OFF_ROPE + al256((size_t)2 * 2048 * 4);
constexpr size_t SZ_ACT  = al256((size_t)TT * D * 2);
constexpr size_t OFF_H    = OFF_XS + al256((size_t)TT * D * 4);
constexpr size_t OFF_Q    = OFF_H + SZ_ACT;
constexpr size_t OFF_X    = OFF_Q + SZ_ACT;
constexpr size_t OFF_K    = OFF_X + 2 * SZ_ACT;
constexpr size_t OFF_VT   = OFF_K + al256((size_t)TT * 512 * 2);
constexpr size_t OFF_O    = OFF_VT + al256((size_t)TT * 512 * 2);
constexpr size_t OFF_PQ   = OFF_O + SZ_ACT;
constexpr size_t OFF_LAB  = OFF_H;
constexpr size_t OFF_CHP  = OFF_K;
constexpr size_t OFF_CHH  = OFF_CHP + al256((size_t)2 * 272 * D * 4);
constexpr size_t OFF_CIN  = OFF_CHH + al256((size_t)2 * 272 * D * 4);
constexpr size_t OFF_IDX  = OFF_PQ + SZ_ACT;
constexpr size_t OFF_GW   = OFF_IDX + al256((size_t)TT * 128 * 4);
constexpr size_t OFF_BAR  = OFF_GW + al256((size_t)TT * 128 * 4);
constexpr size_t WS_NEED  = OFF_BAR + 16384;
static_assert(OFF_CIN + al256((size_t)2 * 272 * D * 4) <= OFF_O, "scan carries must fit in the K/VT region");
static_assert(WS_NEED <= ((size_t)1 << 30), "workspace map exceeds 1 GiB");

struct Params {
  const float *x, *c, *ctx, *c_ctx, *w_mod, *b_mod, *norm_mix, *norm_ffn, *norm_final;
  const float *attn_w_qkv, *attn_w_o, *attn_sink;
  const float *rec_w_in, *rec_conv_w, *rec_conv_b, *rec_w_a, *rec_b_a, *rec_w_x, *rec_b_x, *rec_lambda, *rec_w_out;
  const float *peer_w_q, *peer_keys, *peer_u, *peer_v;
  float* out; unsigned char* ws;
};

__device__ __forceinline__ float bf2f(bf16_t v) { return __uint_as_float((unsigned)v << 16); }
__device__ __forceinline__ bf16_t f2bf(float f) { unsigned u = __float_as_uint(f); u += 0x7fffu + ((u >> 16) & 1u); return (bf16_t)(u >> 16); }
typedef float f32x2_t __attribute__((ext_vector_type(2)));
__device__ __forceinline__ unsigned pack_bf16(float lo, float hi) { const f32x2_t v = {lo, hi}; return __builtin_bit_cast(unsigned, __builtin_convertvector(v, bf16x2_t)); }
template <int CTRL, int RM, bool BC> __device__ __forceinline__ float dppf(float old, float src) {
  return __builtin_bit_cast(float, __builtin_amdgcn_update_dpp(__builtin_bit_cast(int, old), __builtin_bit_cast(int, src), CTRL, RM, 0xf, BC));
}
__device__ __forceinline__ float wave_sum(float v) {
  v += dppf<0x111, 0xf, true>(0.f, v); v += dppf<0x112, 0xf, true>(0.f, v); v += dppf<0x114, 0xf, true>(0.f, v); v += dppf<0x118, 0xf, true>(0.f, v);
  v += dppf<0x142, 0xa, false>(0.f, v); v += dppf<0x143, 0xc, false>(0.f, v);
  return __builtin_bit_cast(float, __builtin_amdgcn_readlane(__builtin_bit_cast(int, v), 63));
}
__device__ __forceinline__ float wave_max(float v) {
  v = fmaxf(v, dppf<0x111, 0xf, false>(v, v)); v = fmaxf(v, dppf<0x112, 0xf, false>(v, v)); v = fmaxf(v, dppf<0x114, 0xf, false>(v, v)); v = fmaxf(v, dppf<0x118, 0xf, false>(v, v));
  v = fmaxf(v, dppf<0x142, 0xa, false>(v, v)); v = fmaxf(v, dppf<0x143, 0xc, false>(v, v));
  return __builtin_bit_cast(float, __builtin_amdgcn_readlane(__builtin_bit_cast(int, v), 63));
}
__device__ __forceinline__ float gelu_tanh(float x) {
  const float a = x * __builtin_fmaf(x * x, -0.10294324f, -2.3022082f);
  return x * __builtin_amdgcn_rcpf(1.0f + __builtin_amdgcn_exp2f(a));
}
__device__ __forceinline__ int mod_row(int r) { return r < TL ? (r >> 12) : 4; }
__device__ __forceinline__ int tidx() { int t = threadIdx.x; asm volatile("" : "+v"(t)); return t; }

template <int NC>
__device__ __forceinline__ void mod_item(const Params& p, int item, float* lds) {
  constexpr int VW = NC / 64;
  constexpr int NG = NMOD / NC;
  float* sil = lds;
  float* red = lds + 5 * 2048;
  const int tid = tidx(), wid = tid >> 6, lane = tid & 63;
  for (int i = tid; i < 5 * 2048; i += NT) {
    const int m = i >> 11, k = i & 2047;
    const float v = (m < 4) ? p.c[m * 2048 + k] : p.c_ctx[k];
    sil[i] = v / (1.0f + expf(-v));
  }
  __syncthreads();
  const int layer = item / NG, cgp = item % NG;
  const float* W = p.w_mod + (size_t)layer * 2048 * NMOD + cgp * NC + lane * VW;
  typedef float vecw __attribute__((ext_vector_type(VW)));
  float acc[5][VW];
#pragma unroll
  for (int m = 0; m < 5; ++m)
#pragma unroll
    for (int j = 0; j < VW; ++j) acc[m][j] = 0.f;
  const int k0 = wid * 256;
  constexpr int MB = 10;
  vecw wa[MB], wb[MB];
#pragma unroll
  for (int i = 0; i < MB; ++i) wa[i] = *(const vecw*)(W + (size_t)(k0 + i) * NMOD);
#pragma unroll 1
  for (int kk = k0; kk < k0 + 240; kk += 2 * MB) {
#pragma unroll
    for (int i = 0; i < MB; ++i) wb[i] = *(const vecw*)(W + (size_t)(kk + MB + i) * NMOD);
#pragma unroll
    for (int i = 0; i < MB; ++i)
#pragma unroll
      for (int m = 0; m < 5; ++m) { const float sv = sil[m * 2048 + kk + i];
#pragma unroll
        for (int j = 0; j < VW; ++j) acc[m][j] += sv * wa[i][j]; }
    if (kk + 2 * MB < k0 + 240) {
#pragma unroll
      for (int i = 0; i < MB; ++i) wa[i] = *(const vecw*)(W + (size_t)(kk + 2 * MB + i) * NMOD);
    }
#pragma unroll
    for (int i = 0; i < MB; ++i)
#pragma unroll
      for (int m = 0; m < 5; ++m) { const float sv = sil[m * 2048 + kk + MB + i];
#pragma unroll
        for (int j = 0; j < VW; ++j) acc[m][j] += sv * wb[i][j]; }
  }
#pragma unroll
  for (int i = 0; i < 16; ++i) {
    const vecw w = *(const vecw*)(W + (size_t)(k0 + 240 + i) * NMOD);
#pragma unroll
    for (int m = 0; m < 5; ++m) { const float sv = sil[m * 2048 + k0 + 240 + i];
#pragma unroll
      for (int j = 0; j < VW; ++j) acc[m][j] += sv * w[j]; }
  }
#pragma unroll
  for (int m = 0; m < 5; ++m)
#pragma unroll
    for (int j = 0; j < VW; ++j) red[(wid * 5 + m) * NC + lane * VW + j] = acc[m][j];
  __syncthreads();
  float* MODV = (float*)(p.ws + OFF_MODV);
  for (int o = tid; o < 5 * NC; o += NT) {
    const int m = o / NC, n = o % NC;
    float s = 0.f;
#pragma unroll
    for (int w = 0; w < 8; ++w) s += red[(w * 5 + m) * NC + n];
    const int col = cgp * NC + n;
    MODV[(size_t)(layer * 5 + m) * NMOD + col] = s + p.b_mod[layer * NMOD + col];
  }
  __syncthreads();
}

__device__ __forceinline__ void transpose_quad(const Params& p, int q, float* lds) {
  const float* W; bf16_t* Wt; int K, N; int rnn = -1, isx = 0, mtx = 0;
  if (q < 384) { W = p.attn_w_qkv; Wt = (bf16_t*)(p.ws + OFF_WQKV); K = 2048; N = 3072; }
  else if ((q -= 384) < 256) { W = p.attn_w_o; Wt = (bf16_t*)(p.ws + OFF_WO); K = 2048; N = 2048; }
  else if ((q -= 256) < 512) { const int l = q >> 8; q &= 255; W = p.peer_w_q + (size_t)l * 2048 * 2048; Wt = (bf16_t*)(p.ws + OFF_WPQ) + (size_t)l * 2048 * 2048; K = 2048; N = 2048; }
  else if ((q -= 512) < 512) { W = p.rec_w_in; Wt = (bf16_t*)(p.ws + OFF_WIN); K = 2048; N = 4096; }
  else if ((q -= 512) < 256) { W = p.rec_w_out; Wt = (bf16_t*)(p.ws + OFF_WOUT); K = 2048; N = 2048; }
  else { q -= 256; isx = q >> 6; q &= 63; mtx = q >> 2; q &= 3; rnn = 1; W = (isx ? p.rec_w_x : p.rec_w_a) + (size_t)mtx * 65536; Wt = (bf16_t*)(p.ws + OFF_WA); K = 256; N = 256; }
  const int nq = N >> 8, k0 = (q / nq) * 64, n0 = (q % nq) * 256;
  const int tid = tidx();
  {
    const int r = tid >> 6, c4 = (tid & 63) * 4;
    float4 v[8];
#pragma unroll
    for (int i = 0; i < 8; ++i) v[i] = *(const float4*)(W + (size_t)(k0 + r + 8 * i) * N + n0 + c4);
#pragma unroll
    for (int i = 0; i < 8; ++i) { float* d = lds + (r + 8 * i) * 257 + c4; d[0] = v[i].x; d[1] = v[i].y; d[2] = v[i].z; d[3] = v[i].w; }
  }
  __syncthreads();
  {
    const int n = tid >> 1, kh = (tid & 1) * 32;
    bf16_t* drow = (rnn < 0) ? Wt + (size_t)(n0 + n) * K + k0 + kh : Wt + ((size_t)(mtx * 2 + (n >> 7)) * 256 + isx * 128 + (n & 127)) * 256 + k0 + kh;
#pragma unroll
    for (int c = 0; c < 4; ++c) {
      u32x4 o;
      o.x = pack_bf16(lds[(kh + c * 8 + 0) * 257 + n], lds[(kh + c * 8 + 1) * 257 + n]);
      o.y = pack_bf16(lds[(kh + c * 8 + 2) * 257 + n], lds[(kh + c * 8 + 3) * 257 + n]);
      o.z = pack_bf16(lds[(kh + c * 8 + 4) * 257 + n], lds[(kh + c * 8 + 5) * 257 + n]);
      o.w = pack_bf16(lds[(kh + c * 8 + 6) * 257 + n], lds[(kh + c * 8 + 7) * 257 + n]);
      *(u32x4*)(drow + c * 8) = o;
    }
  }
  __syncthreads();
}

__device__ __forceinline__ void convert8(const float* src, bf16_t* dst) {
  const float4 a = ((const float4*)src)[0], b = ((const float4*)src)[1];
  u32x4 o; o.x = pack_bf16(a.x, a.y); o.y = pack_bf16(a.z, a.w); o.z = pack_bf16(b.x, b.y); o.w = pack_bf16(b.z, b.w);
  *(u32x4*)dst = o;
}

constexpr int ROWV = 1024;
__device__ __forceinline__ void quant_rows_load(const Params& p, int t, int tid0, float4 (&v)[2][8]) {
  const int wid = tid0 >> 6, lane = tid0 & 63;
  const int tb = (t * 16) >> 15;
#pragma unroll
  for (int h = 0; h < 2; ++h) {
    const int row = (t * 16 + h * 8 + wid) & 32767;
    const float* src = (tb == 0 ? p.peer_u : p.peer_v) + (size_t)row * D;
#pragma unroll
    for (int i = 0; i < 8; ++i) v[h][i] = ((const float4*)src)[i * 64 + lane];
  }
}
__device__ __forceinline__ void quant_rows_process(const Params& p, int t, int tid0, const float4 (&v)[2][8]) {
  const int wid = tid0 >> 6, lane = tid0 & 63;
  const int tb = (t * 16) >> 15;
#pragma unroll
  for (int h = 0; h < 2; ++h) {
    const int row = (t * 16 + h * 8 + wid) & 32767;
    float mx = 0.f;
#pragma unroll
    for (int i = 0; i < 8; ++i) mx = fmaxf(mx, fmaxf(fmaxf(fabsf(v[h][i].x), fabsf(v[h][i].y)), fmaxf(fabsf(v[h][i].z), fabsf(v[h][i].w))));
    mx = wave_max(mx);
    float sq = 0.f;
#pragma unroll
    for (int i = 0; i < 8; ++i) sq += (v[h][i].x * v[h][i].x + v[h][i].y * v[h][i].y) + (v[h][i].z * v[h][i].z + v[h][i].w * v[h][i].w);
    sq = wave_sum(sq);
    {
      const float sc = fminf(0.3352f * sqrtf(sq * (1.0f / 2048.0f)), mx * 0.125f), inv = sc > 0.f ? 1.0f / sc : 0.f;
      unsigned char* dst = p.ws + (tb == 0 ? OFF_UTAB : OFF_VTAB) + (size_t)row * ROWV;
      unsigned d[4] = {0u, 0u, 0u, 0u};
#pragma unroll
      for (int tv = 0; tv < 8; ++tv) {
        const float xv[4] = {v[h][tv].x, v[h][tv].y, v[h][tv].z, v[h][tv].w};
#pragma unroll
        for (int b = 0; b < 4; ++b) {
          const int f = (int)fminf(fmaxf(floorf(xv[b] * inv), -8.f), 7.f);
          const unsigned q = (tb == 1 && (tv & 1)) ? (unsigned)(f & 15) : (unsigned)(f + 8);
          d[tv >> 1] |= q << (8 * b + 4 * (tv & 1));
        }
      }
      *(u32x4*)(dst + lane * 16) = (u32x4){d[0], d[1], d[2], d[3]};
      if (lane == 0) ((float*)(p.ws + OFF_USC))[row * 2 + tb] = sc;
    }
  }
}

__device__ __forceinline__ void setup_phase(const Params& p, unsigned char* lds_raw) {
  float* lds = (float*)lds_raw;
  const int tid0 = tidx();
  const int b = (int)blockIdx.x;
  if (b < 96) { mod_item<128>(p, b, lds); return; }
  for (int j = b - 96; j < 896 + 17; j += (int)gridDim.x - 96) {
    if (j < 896) { transpose_quad(p, j, lds); continue; }
    const int t = j - 896;
    if (t < 16) { const size_t e = (size_t)t * 4096 + tid0 * 8; convert8(p.peer_keys + e, (bf16_t*)(p.ws + OFF_KEYS) + e); continue; }
    float* cosT = (float*)(p.ws + OFF_ROPE); float* sinT = cosT + 2048;
    for (int e = tid0; e < 2048; e += NT) {
      const int pos = e >> 5, jj = e & 31;
      const float inv = powf(10000.0f, -(float)(2 * jj) / 64.0f);
      const float ang = (float)pos * inv;
      cosT[e] = cosf(ang); sinT[e] = sinf(ang);
    }
    float* SP = (float*)(p.ws + OFF_SP);
    for (int e = tid0; e < 2 * 2048; e += NT) SP[e] = log1pf(expf(-p.rec_lambda[e]));
  }
}
__device__ __forceinline__ void norm_phase(const Params& p, int layer, const float* gain, int shift_idx, int nrows, bool from_input, bf16_t* H, float* lds, const bf16_t* DELTA = nullptr) {
  const int tid_ = tidx(), wid = tid_ >> 6, lane = tid_ & 63;
  const float* MODV = (const float*)(p.ws + OFF_MODV);
  float* XS = (float*)(p.ws + OFF_XS);
  float4 g[8];
#pragma unroll
  for (int i = 0; i < 8; ++i) g[i] = ((const float4*)gain)[i * 64 + lane];
  const int rstep = (int)gridDim.x * 8;
  auto row_src = [&](int r) -> const float* { return from_input ? (r < TL ? p.x + (size_t)r * D : p.ctx + (size_t)(r - TL) * D) : XS + (size_t)r * D; };
  float4 nv[8]; u32x2 nd[8];
  int r = blockIdx.x * 8 + wid;
  if (r < nrows) {
    const float* src = row_src(r);
#pragma unroll
    for (int i = 0; i < 8; ++i) { nv[i] = ((const float4*)src)[i * 64 + lane]; nd[i] = DELTA ? *(const u32x2*)(DELTA + (size_t)r * D + i * 256 + lane * 4) : (u32x2){0u, 0u}; }
  }
  int cur_m = -1;
  for (int rb = blockIdx.x * 8; rb < nrows; rb += rstep, r += rstep) {
    const int m_it = mod_row(rb);
    if (m_it != cur_m) {
      __syncthreads();
      const float* mv = MODV + (size_t)(layer * 5 + m_it) * NMOD + shift_idx * D;
      *(float4*)(lds + tid_ * 4) = *(const float4*)(mv + tid_ * 4); *(float4*)(lds + 2048 + tid_ * 4) = *(const float4*)(mv + 2048 + tid_ * 4);
      cur_m = m_it;
      __syncthreads();
    }
    if (r >= nrows) continue;
    float4 v[8]; float ss = 0.f;
#pragma unroll
    for (int i = 0; i < 8; ++i) {
      v[i] = nv[i];
      if (DELTA) { v[i].x += __uint_as_float(nd[i].x << 16); v[i].y += __uint_as_float(nd[i].x & 0xffff0000u); v[i].z += __uint_as_float(nd[i].y << 16); v[i].w += __uint_as_float(nd[i].y & 0xffff0000u); }
    }
    const int rn = r + rstep;
    if (rn < nrows) {
      const float* src = row_src(rn);
#pragma unroll
      for (int i = 0; i < 8; ++i) { nv[i] = ((const float4*)src)[i * 64 + lane]; if (DELTA) nd[i] = *(const u32x2*)(DELTA + (size_t)rn * D + i * 256 + lane * 4); }
    }
#pragma unroll
    for (int i = 0; i < 8; ++i) ss += v[i].x * v[i].x + v[i].y * v[i].y + v[i].z * v[i].z + v[i].w * v[i].w;
    ss = wave_sum(ss);
    const float rs = rsqrtf(ss * (1.0f / D) + 1e-6f);
#pragma unroll
    for (int i = 0; i < 8; ++i) {
      const float4 a = *(const float4*)(lds + (i * 64 + lane) * 4), b = *(const float4*)(lds + 2048 + (i * 64 + lane) * 4);
      const float o0 = v[i].x * rs * g[i].x * (1.0f + b.x) + a.x, o1 = v[i].y * rs * g[i].y * (1.0f + b.y) + a.y;
      const float o2 = v[i].z * rs * g[i].z * (1.0f + b.z) + a.z, o3 = v[i].w * rs * g[i].w * (1.0f + b.w) + a.w;
      u32x2 o; o.x = pack_bf16(o0, o1); o.y = pack_bf16(o2, o3);
      *(u32x2*)(H + (size_t)r * D + i * 256 + lane * 4) = o;
    }
  }
}

namespace pg8 {
#define PG8_LAS __attribute__((address_space(3)))
constexpr int BM = 256, BK = 64, HALF = 128, HTB = HALF * BK * 2, STAGE_BYTES = 8 * HTB, NXCD = 8, WGM = 8;
__device__ __forceinline__ int lds_byte(int r, int c) { const int st = (r >> 4) * 2 + (c >> 5), rr = r & 15, cc = c & 31, ob = rr * 64 + cc * 2; return st * 1024 + (ob ^ (((ob >> 9) & 1) << 5)); }
__device__ __forceinline__ void stage_rc(int b, int& R, int& C) { const int st = b / 1024, sb = b % 1024, swz = sb ^ (((sb >> 9) & 1) << 5); R = (st >> 1) * 16 + swz / 64; C = (st & 1) * 32 + (swz % 64) / 2; }
__device__ __forceinline__ int perm_adj(int rho) { const int w = rho >> 5, n = (rho >> 4) & 1, i = rho & 15; return 32 * w + 8 * (i >> 2) + 4 * n + (i & 3); }
__device__ __forceinline__ int perm128(int rho) { const int w = rho >> 5, n = (rho >> 4) & 1, i = rho & 15; return 64 * (w >> 1) + 16 * (w & 1) + 32 * n + i; }
struct Unit { int pm, pn; unsigned aoff, boff; };
struct Gemm { const bf16_t* A; const bf16_t* Bt; int K, lda; };
struct StaticOrder {
  int nM, nN, nwg, G, c; unsigned tA, tB;
  __device__ void init(int M, int N, int K, int lda, int G_, int c_) { nM = M / BM; nN = N / BM; nwg = nM * nN; G = G_; c = c_; tA = (unsigned)(BM * lda * 2); tB = (unsigned)(BM * K * 2); }
  __device__ bool next(int i, Unit& u) const {
    const long L = (long)i * G + c; if (L >= nwg) return false;
    int wgid = (int)L; { const int q = nwg / NXCD, r = nwg % NXCD, xcd = wgid % NXCD, off = wgid / NXCD; wgid = (xcd < r ? xcd * (q + 1) : r * (q + 1) + (xcd - r) * q) + off; }
    const int nig = WGM * nN, gid = wgid / nig, fm = gid * WGM, gsz = (nM - fm) < WGM ? (nM - fm) : WGM;
    u.pm = fm + ((wgid % nig) % gsz); u.pn = (wgid % nig) / gsz; u.aoff = (unsigned)u.pm * tA; u.boff = (unsigned)u.pn * tB; return true;
  }
};
struct CtxOwnOrder {
  int pm, pn0; unsigned tA, tB;
  __device__ void init(int K, int lda, int b) { pm = TL / BM + (b >> 2); pn0 = 2 * (b & 3); tA = (unsigned)(BM * lda * 2); tB = (unsigned)(BM * K * 2); }
  __device__ bool next(int i, Unit& u) const { if (i >= 2) return false; u.pm = pm; u.pn = pn0 + i; u.aoff = (unsigned)u.pm * tA; u.boff = (unsigned)u.pn * tB; return true; }
};
struct CoefOrder {
  int G, c;
  __device__ void init(int G_, int c_) { G = G_; c = c_; }
  __device__ bool next(int i, Unit& u) const {
    const long L = (long)i * G + c; if (L >= (long)(TT / 256) * 32) return false;
    u.pm = (int)(L >> 5); u.pn = (int)(L & 31); const int blk = (u.pn >> 1) & 7;
    u.aoff = (unsigned)((u.pm * 256 * D + blk * 256) * 2); u.boff = (unsigned)(u.pn * 256 * 256 * 2); return true;
  }
};
template <class Epi, class Sched>
__device__ __forceinline__ void gemm_phase(PG8_LAS unsigned char* lds, const Gemm g, const Sched& S, const Epi& E) {
  const int tid = tidx(), wid = __builtin_amdgcn_readfirstlane(tid >> 6), lane = tid & 63, wr = wid >> 2, wc = wid & 3, fr = lane & 15, fq = lane >> 4;
  const int K = g.K, nt = K / BK;
  unsigned voffA[2], voffB[2];
#pragma unroll
  for (int i = 0; i < 2; ++i) { int R, C; stage_rc(tid * 16 + i * 8192, R, C); const int Rb = Epi::ADJ ? perm_adj(R) : perm128(R);
    voffA[i] = (unsigned)(R * g.lda + C) * 2u; voffB[i] = (unsigned)(Rb * K + C) * 2u; }
  const unsigned kstep = (unsigned)(BK * 2);
  const unsigned hstepA = (unsigned)(HALF * g.lda * 2), hstepB = (unsigned)(HALF * K * 2);
  const unsigned ldsw = (unsigned)wid * 1024u;
  const int aoff = lds_byte(wr * 64 + fr, fq * 8), boff = lds_byte(wc * 32 + fr, fq * 8);
#define PG8_SA(b, h) (((b) * 2 + (h)) * HTB)
#define PG8_SB(b, h) ((4 + (b) * 2 + (h)) * HTB)
#define PG8_STAGE(bufoff, gbase, voff) do { _Pragma("unroll") for (int _i = 0; _i < 2; ++_i) \
    __builtin_amdgcn_global_load_lds((const unsigned*)((const char*)(gbase) + (voff)[_i]), (PG8_LAS unsigned*)(lds + (bufoff) + ldsw + _i * 8192), 16, 0, 0); } while (0)
#define PG8_LDA(dst, b, h) do { _Pragma("unroll") for (int m = 0; m < 4; ++m) _Pragma("unroll") for (int k = 0; k < 2; ++k) dst[m][k] = *(const PG8_LAS bf16x8*)(lds + PG8_SA(b, h) + aoff + m * 2048 + k * 1024); } while (0)
#define PG8_LDB(dst, b, h) do { _Pragma("unroll") for (int n = 0; n < 2; ++n) _Pragma("unroll") for (int k = 0; k < 2; ++k) dst[n][k] = *(const PG8_LAS bf16x8*)(lds + PG8_SB(b, h) + boff + n * 2048 + k * 1024); } while (0)
#define PG8_MMA(ai, bj, At, Bt) do { __builtin_amdgcn_s_setprio(1); _Pragma("unroll") for (int m = 0; m < 4; ++m) _Pragma("unroll") for (int n = 0; n < 2; ++n) _Pragma("unroll") for (int k = 0; k < 2; ++k) \
    acc[ai][bj][m][n] = __builtin_amdgcn_mfma_f32_16x16x32_bf16(Bt[n][k], At[m][k], acc[ai][bj][m][n], 0, 0, 0); __builtin_amdgcn_s_setprio(0); } while (0)
#define PG8_WAIT_V(n) asm volatile("s_waitcnt vmcnt(" #n ")" ::: "memory")
#define PG8_WAIT_L(n) asm volatile("s_waitcnt lgkmcnt(" #n ")" ::: "memory")
#define PG8_BAR __builtin_amdgcn_s_barrier()
#define PG8_SCHED __builtin_amdgcn_sched_barrier(0)
  Unit cur, nxt; int ui = 0;
  if (!S.next(0, cur)) return;
  f32x4 acc[2][2][4][2];
#pragma unroll
  for (int a = 0; a < 2; ++a)
#pragma unroll
    for (int b = 0; b < 2; ++b)
#pragma unroll
      for (int m = 0; m < 4; ++m)
#pragma unroll
        for (int n = 0; n < 2; ++n) acc[a][b][m][n] = (f32x4){0.f, 0.f, 0.f, 0.f};
  bf16x8 At[4][2], B0[2][2], B1[2][2];
  const char* cA = (const char*)g.A + cur.aoff; const char* cB = (const char*)g.Bt + cur.boff;
  PG8_STAGE(PG8_SB(0, 0), cB, voffB); PG8_STAGE(PG8_SA(0, 0), cA, voffA); PG8_STAGE(PG8_SB(0, 1), cB + hstepB, voffB); PG8_STAGE(PG8_SA(0, 1), cA + hstepA, voffA);
  if (wr == 1) PG8_BAR;
  PG8_WAIT_V(4); PG8_BAR;
  PG8_STAGE(PG8_SB(1, 0), cB + kstep, voffB); PG8_STAGE(PG8_SA(1, 0), cA + kstep, voffA); PG8_STAGE(PG8_SB(1, 1), cB + hstepB + kstep, voffB);
  PG8_WAIT_V(6); PG8_BAR;
  for (;;) {
    const bool has_next = S.next(ui + 1, nxt);
    const char* nA = has_next ? (const char*)g.A + nxt.aoff : cA; const char* nB = has_next ? (const char*)g.Bt + nxt.boff : cB;
    for (int t = 0; t < nt; t += 2) {
      const bool last = (t == nt - 2);
      const char* a1 = cA + (unsigned)(t + 1) * kstep;
      const char* a2 = last ? nA : cA + (unsigned)(t + 2) * kstep; const char* b2 = last ? nB : cB + (unsigned)(t + 2) * kstep;
      const char* a3 = a2 + kstep; const char* b3 = b2 + kstep;
      PG8_LDB(B0, 0, 0); PG8_SCHED; PG8_LDA(At, 0, 0); PG8_STAGE(PG8_SA(1, 1), a1 + hstepA, voffA);
      PG8_WAIT_L(8); PG8_BAR; PG8_WAIT_L(0); PG8_MMA(0, 0, At, B0); PG8_BAR; PG8_SCHED;
      PG8_LDB(B1, 0, 1); PG8_STAGE(PG8_SB(0, 0), b2, voffB);
      PG8_BAR; PG8_WAIT_L(0); PG8_MMA(0, 1, At, B1); PG8_BAR;
      PG8_LDA(At, 0, 1); PG8_STAGE(PG8_SA(0, 0), a2, voffA);
      PG8_BAR; PG8_WAIT_L(0); PG8_MMA(1, 0, At, B0); PG8_BAR; PG8_SCHED;
      PG8_STAGE(PG8_SB(0, 1), b2 + hstepB, voffB);
      PG8_WAIT_V(6); PG8_BAR; PG8_MMA(1, 1, At, B1); PG8_BAR;
      PG8_LDB(B0, 1, 0); PG8_SCHED; PG8_LDA(At, 1, 0); PG8_STAGE(PG8_SA(0, 1), a2 + hstepA, voffA);
      PG8_WAIT_L(8); PG8_BAR; PG8_WAIT_L(0); PG8_MMA(0, 0, At, B0); PG8_BAR; PG8_SCHED;
      PG8_LDB(B1, 1, 1); PG8_STAGE(PG8_SB(1, 0), b3, voffB);
      PG8_BAR; PG8_WAIT_L(0); PG8_MMA(0, 1, At, B1); PG8_BAR;
      PG8_LDA(At, 1, 1); PG8_STAGE(PG8_SA(1, 0), a3, voffA);
      PG8_BAR; PG8_WAIT_L(0); PG8_MMA(1, 0, At, B0); PG8_BAR; PG8_SCHED;
      PG8_STAGE(PG8_SB(1, 1), b3 + hstepB, voffB);
      PG8_WAIT_V(6); PG8_BAR; PG8_MMA(1, 1, At, B1); PG8_BAR;
    }
    E(acc, cur, wr, wc, fr, fq);
    if (!has_next) break;
#pragma unroll
    for (int a = 0; a < 2; ++a)
#pragma unroll
      for (int b = 0; b < 2; ++b)
#pragma unroll
        for (int m = 0; m < 4; ++m)
#pragma unroll
          for (int n = 0; n < 2; ++n) acc[a][b][m][n] = (f32x4){0.f, 0.f, 0.f, 0.f};
    cur = nxt; cA = nA; cB = nB; ++ui;
  }
  PG8_WAIT_V(0);
  if (wr == 0) PG8_BAR;
  PG8_BAR;
#undef PG8_SA
#undef PG8_SB
#undef PG8_STAGE
#undef PG8_LDA
#undef PG8_LDB
#undef PG8_MMA
#undef PG8_WAIT_V
#undef PG8_WAIT_L
#undef PG8_BAR
#undef PG8_SCHED
}
}

#define ROW256(ai, m) (u.pm * 256 + (ai) * 128 + wr * 64 + (m) * 16 + fr)
#define COL256(bj, n) (u.pn * 256 + (bj) * 128 + 64 * (wc >> 1) + 16 * (wc & 1) + 32 * (n) + 4 * fq)
#define COL256A(bj) (u.pn * 256 + (bj) * 128 + 32 * wc + 8 * fq)
struct EpiQKV256 {
  static constexpr bool ADJ = false;
  bf16_t *Q, *Kb, *VT; const float *cosT, *sinT;
  __device__ __forceinline__ void operator()(const f32x4 (&acc)[2][2][4][2], const pg8::Unit& u, int wr, int wc, int fr, int fq) const {
#pragma unroll
    for (int bj = 0; bj < 2; ++bj) {
      const int n0 = u.pn * 256 + bj * 128;
      const int c0 = COL256(bj, 0);
      if (n0 < 2560) {
        const int iidx = 16 * (wc & 1) + 4 * fq;
        const bool rope = u.pm * 256 < TL;
        auto emit = [&](int ai, int m, const f32x4& cs, const f32x4& sn) {
          const int r = ROW256(ai, m);
          const f32x4 x1 = acc[ai][bj][m][0], x2 = acc[ai][bj][m][1]; f32x4 y1 = x1, y2 = x2;
          if (rope) { y1 = x1 * cs - x2 * sn; y2 = x2 * cs + x1 * sn; }
          const int cst = c0 + 28 * (fq & 1);
          bf16_t* dst = (n0 < 2048) ? (Q + (size_t)r * D + cst) : (Kb + (size_t)r * 512 + (cst - 2048));
          const auto sx = __builtin_amdgcn_permlane16_swap(pack_bf16(y1[0], y1[1]), pack_bf16(y2[0], y2[1]), false, false);
          const auto sy = __builtin_amdgcn_permlane16_swap(pack_bf16(y1[2], y1[3]), pack_bf16(y2[2], y2[3]), false, false);
          *(u32x4*)dst = (u32x4){sx[0], sy[0], sx[1], sy[1]};
        };
        if ((wc >> 1) == 0) {
#pragma unroll
          for (int ai = 0; ai < 2; ++ai) {
            const int pos = ((u.pm * 256 + ai * 128 + wr * 64) & 4095) >> 6;
            const f32x4 cs = *(const f32x4*)(cosT + pos * 32 + iidx), sn = *(const f32x4*)(sinT + pos * 32 + iidx);
#pragma unroll
            for (int m = 0; m < 4; ++m) emit(ai, m, cs, sn);
          }
        } else {
#pragma unroll
          for (int m = 0; m < 4; ++m) {
            const int pos = m * 16 + fr;
            const f32x4 cs = *(const f32x4*)(cosT + pos * 32 + iidx), sn = *(const f32x4*)(sinT + pos * 32 + iidx);
#pragma unroll
            for (int ai = 0; ai < 2; ++ai) emit(ai, m, cs, sn);
          }
        }
      } else {
#pragma unroll
        for (int ai = 0; ai < 2; ++ai)
#pragma unroll
          for (int m = 0; m < 4; ++m) {
            const int r = ROW256(ai, m);
#pragma unroll
            for (int n = 0; n < 2; ++n)
#pragma unroll
              for (int j = 0; j < 4; ++j) VT[(size_t)(c0 - 2560 + 32 * n + j) * TT + r] = f2bf(acc[ai][bj][m][n][j]);
          }
      }
    }
  }
};
struct EpiDelta256 {
  static constexpr bool ADJ = true;
  bf16_t* DELTA; const float* gate;
  __device__ __forceinline__ void operator()(const f32x4 (&acc)[2][2][4][2], const pg8::Unit& u, int wr, int wc, int fr, int fq) const {
    const float* g = gate + (size_t)mod_row(u.pm * 256) * NMOD;
    f32x4 gv[2][2];
#pragma unroll
    for (int bj = 0; bj < 2; ++bj) { const int c = COL256A(bj); gv[bj][0] = *(const f32x4*)(g + c); gv[bj][1] = *(const f32x4*)(g + c + 4); }
#pragma unroll
    for (int ai = 0; ai < 2; ++ai)
#pragma unroll
      for (int m = 0; m < 4; ++m) {
        const int r = ROW256(ai, m);
#pragma unroll
        for (int bj = 0; bj < 2; ++bj) {
          const int c = COL256A(bj);
          const f32x4 v0 = gv[bj][0] * acc[ai][bj][m][0], v1 = gv[bj][1] * acc[ai][bj][m][1];
          *(u32x4*)(DELTA + (size_t)r * D + c) = (u32x4){pack_bf16(v0[0], v0[1]), pack_bf16(v0[2], v0[3]), pack_bf16(v1[0], v1[1]), pack_bf16(v1[2], v1[3])};
        }
      }
  }
};
struct EpiBf16_256 {
  static constexpr bool ADJ = true;
  bf16_t* O; int ldo;
  __device__ __forceinline__ void operator()(const f32x4 (&acc)[2][2][4][2], const pg8::Unit& u, int wr, int wc, int fr, int fq) const {
#pragma unroll
    for (int ai = 0; ai < 2; ++ai)
#pragma unroll
      for (int m = 0; m < 4; ++m)
#pragma unroll
        for (int bj = 0; bj < 2; ++bj) {
          const f32x4 v0 = acc[ai][bj][m][0], v1 = acc[ai][bj][m][1];
          *(u32x4*)(O + (size_t)ROW256(ai, m) * ldo + COL256A(bj)) = (u32x4){pack_bf16(v0[0], v0[1]), pack_bf16(v0[2], v0[3]), pack_bf16(v1[0], v1[1]), pack_bf16(v1[2], v1[3])};
        }
  }
};
struct EpiWin256 {
  static constexpr bool ADJ = true;
  bf16_t *GATE, *UBR;
  __device__ __forceinline__ void operator()(const f32x4 (&acc)[2][2][4][2], const pg8::Unit& u, int wr, int wc, int fr, int fq) const {
#pragma unroll
    for (int ai = 0; ai < 2; ++ai)
#pragma unroll
      for (int m = 0; m < 4; ++m) {
        const int r = ROW256(ai, m);
#pragma unroll
        for (int bj = 0; bj < 2; ++bj) {
          const int c = COL256A(bj);
          const f32x4 v0 = acc[ai][bj][m][0], v1 = acc[ai][bj][m][1];
          if (c < 2048) {
            if (r < TL) *(u32x4*)(GATE + (size_t)r * D + c) = (u32x4){pack_bf16(gelu_tanh(v0[0]), gelu_tanh(v0[1])), pack_bf16(gelu_tanh(v0[2]), gelu_tanh(v0[3])), pack_bf16(gelu_tanh(v1[0]), gelu_tanh(v1[1])), pack_bf16(gelu_tanh(v1[2]), gelu_tanh(v1[3]))};
          } else {
            *(u32x4*)(UBR + (size_t)r * D + (c - 2048)) = (u32x4){pack_bf16(v0[0], v0[1]), pack_bf16(v0[2], v0[3]), pack_bf16(v1[0], v1[1]), pack_bf16(v1[2], v1[3])};
          }
        }
      }
  }
};
struct StreamJob { int nsb, m_lo, m_n, t_lo, t_n, q_lo, q_n; };
__device__ __forceinline__ void peer_route_phase(const Params& p, int layer, int id_lo, int id_hi, int nblk, unsigned char* lds);
template <bool CTXFIRST = false, class Epi>
__device__ __forceinline__ void gemm256(const Params& p, const bf16_t* A, const bf16_t* Bt, int M, int N, int K, unsigned char* lds, const Epi& e, const StreamJob sj) {
  if ((int)blockIdx.x < sj.nsb) {
    const int tid0 = tidx();
    constexpr int NRB = CTXFIRST ? (TT - TL) / 64 : 0;
    if constexpr (CTXFIRST) {
      if ((int)blockIdx.x < NRB) {
        pg8::Gemm g{A, Bt, K, K}; pg8::CtxOwnOrder S; S.init(K, K, (int)blockIdx.x);
        pg8::gemm_phase((PG8_LAS unsigned char*)lds, g, S, e);
        asm volatile("s_waitcnt vmcnt(0)" ::: "memory");
        __syncthreads();
        __builtin_amdgcn_fence(__ATOMIC_ACQUIRE, "agent");
        peer_route_phase(p, 0, -1, 0, 0, lds);
        return;
      }
    }
    const int qb = sj.m_n + sj.t_n, total = qb + sj.q_n, nstr = sj.nsb - NRB;
    int k = (int)blockIdx.x - NRB;
    {
      for (; k < qb; k += nstr) {
        if (k < sj.m_n) mod_item<256>(p, sj.m_lo + k, (float*)lds);
        else transpose_quad(p, sj.t_lo + (k - sj.m_n), (float*)lds);
      }
      if (k < total) {
        float4 va[2][8], vb[2][8];
        quant_rows_load(p, sj.q_lo + (k - qb), tid0, va);
        for (;;) {
          int k2 = k + nstr;
          if (k2 < total) quant_rows_load(p, sj.q_lo + (k2 - qb), tid0, vb);
          quant_rows_process(p, sj.q_lo + (k - qb), tid0, va);
          if (k2 >= total) break;
          k = k2; k2 = k + nstr;
          if (k2 < total) quant_rows_load(p, sj.q_lo + (k2 - qb), tid0, va);
          quant_rows_process(p, sj.q_lo + (k - qb), tid0, vb);
          if (k2 >= total) break;
          k = k2;
        }
      }
    }
    return;
  }
  pg8::Gemm g{A, Bt, K, K}; pg8::StaticOrder S; S.init(CTXFIRST ? TL : M, N, K, K, (int)gridDim.x - sj.nsb, (int)blockIdx.x - sj.nsb);
  pg8::gemm_phase((PG8_LAS unsigned char*)lds, g, S, e);
}
struct EpiCoef256 {
  static constexpr bool ADJ = true;
  const float *b_a, *b_x, *SP; const bf16_t* UC; bf16_t* LAB;
  __device__ __forceinline__ void operator()(const f32x4 (&acc)[2][2][4][2], const pg8::Unit& u, int wr, int wc, int fr_, int fq_) const {
    int fr = fr_, fq = fq_; asm volatile("" : "+v"(fr), "+v"(fq));
    const int dir = u.pn >> 4, blk = (u.pn >> 1) & 7, half = u.pn & 1;
    bf16_t* LA = LAB + (size_t)(dir * 2) * TT * D; bf16_t* LB = LA + (size_t)TT * D;
    const int c = blk * 256 + half * 128 + 32 * wc + 8 * fq;
    const int coff = dir * D + c;
#pragma unroll
    for (int ai = 0; ai < 2; ++ai)
#pragma unroll
      for (int m = 0; m < 4; ++m) {
        const int r = u.pm * 256 + ai * 128 + wr * 64 + m * 16 + fr;
        const u32x4 uu = *(const u32x4*)(UC + (size_t)r * D + c);
        u32x4 o1, o2;
#pragma unroll
        for (int n = 0; n < 2; ++n) {
          const unsigned u0 = uu[2 * n], u1 = uu[2 * n + 1];
          const f32x4 uv = (f32x4){__uint_as_float(u0 << 16), __uint_as_float(u0 & 0xffff0000u), __uint_as_float(u1 << 16), __uint_as_float(u1 & 0xffff0000u)};
          f32x4 lav, bv;
          const f32x4 ba = *(const f32x4*)(b_a + coff + 4 * n), bx = *(const f32x4*)(b_x + coff + 4 * n), sp = *(const f32x4*)(SP + coff + 4 * n);
#pragma unroll
          for (int j = 0; j < 4; ++j) {
            const float rg = __builtin_amdgcn_rcpf(1.0f + __expf(-(acc[ai][0][m][n][j] + ba[j])));
            const float ig = __builtin_amdgcn_rcpf(1.0f + __expf(-(acc[ai][1][m][n][j] + bx[j])));
            const float log_a = -8.0f * rg * sp[j];
            lav[j] = log_a;
            bv[j] = __builtin_amdgcn_sqrtf(fmaxf(1.0f - __expf(2.0f * log_a), 0.f)) * ig * uv[j];
          }
          o1[2 * n] = pack_bf16(lav[0], lav[1]); o1[2 * n + 1] = pack_bf16(lav[2], lav[3]); o2[2 * n] = pack_bf16(bv[0], bv[1]); o2[2 * n + 1] = pack_bf16(bv[2], bv[3]);
        }
        *(u32x4*)(LA + (size_t)r * D + c) = o1;
        *(u32x4*)(LB + (size_t)r * D + c) = o2;
      }
  }
};
__device__ __forceinline__ void coef_phase(const Params& p, unsigned char* lds) {
  EpiCoef256 e{p.rec_b_a, p.rec_b_x, (const float*)(p.ws + OFF_SP), (const bf16_t*)(p.ws + OFF_O), (bf16_t*)(p.ws + OFF_LAB)};
  pg8::Gemm g{(const bf16_t*)(p.ws + OFF_O), (const bf16_t*)(p.ws + OFF_WA), 256, D}; pg8::CoefOrder S; S.init((int)gridDim.x, (int)blockIdx.x);
  pg8::gemm_phase((PG8_LAS unsigned char*)lds, g, S, e);
}

constexpr int KLD = 136, VLD = 72;
__device__ __forceinline__ void attn_phase(const Params& p, unsigned char* lds) {
  const bf16_t* Q = (const bf16_t*)(p.ws + OFF_Q); const bf16_t* Kg = (const bf16_t*)(p.ws + OFF_K); const bf16_t* VT = (const bf16_t*)(p.ws + OFF_VT);
  bf16_t* O = (bf16_t*)(p.ws + OFF_O);
  bf16_t* Ks = (bf16_t*)lds;
  bf16_t* Vs = Ks + 64 * KLD;
  const int tid = tidx(), wid = tid >> 6, lane = tid & 63, fr = lane & 15, fq = lane >> 4;
  const int g = wid >> 1, rh = wid & 1;
  const float scale = 0.08838834764831845f * 1.4426950408889634f;
  for (int item = blockIdx.x; item < 1088; item += gridDim.x) {
    int b, hk, qb, qrow0, nlat, kt0;
    if (item < 1024) { b = item >> 8; hk = (item >> 6) & 3; qb = item & 63; qrow0 = b * S + qb * 64; kt0 = qb - 2 < 0 ? 0 : qb - 2; const int kt1 = qb + 2 > 63 ? 63 : qb + 2; nlat = kt1 - kt0 + 1; }
    else { const int ci = item - 1024; b = ci >> 4; hk = (ci >> 2) & 3; qb = ci & 3; qrow0 = TL + b * CL + qb * 64; kt0 = 0; nlat = 0; }
    const int head = hk * 4 + g;
    const float sink = p.attn_sink[head];
    bf16x8 qf[2][4];
#pragma unroll
    for (int rt = 0; rt < 2; ++rt)
#pragma unroll
      for (int ks = 0; ks < 4; ++ks) qf[rt][ks] = *(const bf16x8*)(Q + (size_t)(qrow0 + rh * 32 + rt * 16 + fr) * D + head * 128 + ks * 32 + fq * 8);
    f32x4 oacc[2][8]; float mst[2], lst[2];
#pragma unroll
    for (int rt = 0; rt < 2; ++rt) {
#pragma unroll
      for (int dt = 0; dt < 8; ++dt) oacc[rt][dt] = (f32x4){0.f, 0.f, 0.f, 0.f};
      mst[rt] = sink * 1.4426950408889634f; lst[rt] = fq == 0 ? 1.0f : 0.f;
    }
    const int ntiles = nlat + 4;
    int kdst[2], vdst[2]; size_t ksrc[2], vsrc[2];
#pragma unroll
    for (int i = 0; i < 2; ++i) {
      const int id = tid + 512 * i;
      const int key = id >> 4, dc = (id & 15) * 8;
      const int kk = key & 31, prow = (key & 32) + ((kk >> 2) & 1) * 16 + (kk >> 3) * 4 + (kk & 3);
      kdst[i] = prow * KLD + dc; ksrc[i] = (size_t)key * 512 + hk * 128 + dc;
      const int d = id >> 3, kc = (id & 7) * 8;
      vdst[i] = d * VLD + kc; vsrc[i] = (size_t)(hk * 128 + d) * TT + kc;
    }
    u32x4 kreg[2], vreg[2];
    {
      const int krow0 = nlat > 0 ? (b * S + kt0 * 64) : (TL + b * CL);
#pragma unroll
      for (int i = 0; i < 2; ++i) { kreg[i] = *(const u32x4*)(Kg + (size_t)krow0 * 512 + ksrc[i]); vreg[i] = *(const u32x4*)(VT + vsrc[i] + krow0); }
    }
    for (int ti = 0; ti < ntiles; ++ti) {
      const bool lat = ti < nlat;
      __syncthreads();
#pragma unroll
      for (int i = 0; i < 2; ++i) { *(u32x4*)(Ks + kdst[i]) = kreg[i]; *(u32x4*)(Vs + vdst[i]) = vreg[i]; }
      if (ti + 1 < ntiles) {
        const int tn = ti + 1;
        const int krow0 = tn < nlat ? (b * S + (kt0 + tn) * 64) : (TL + b * CL + (tn - nlat) * 64);
#pragma unroll
        for (int i = 0; i < 2; ++i) { kreg[i] = *(const u32x4*)(Kg + (size_t)krow0 * 512 + ksrc[i]); vreg[i] = *(const u32x4*)(VT + vsrc[i] + krow0); }
      }
      __syncthreads();
      f32x4 st[2][2][2];
#pragma unroll
      for (int rt = 0; rt < 2; ++rt)
#pragma unroll
        for (int kp = 0; kp < 2; ++kp)
#pragma unroll
          for (int t = 0; t < 2; ++t) st[rt][kp][t] = (f32x4){0.f, 0.f, 0.f, 0.f};
#pragma unroll
      for (int kp = 0; kp < 2; ++kp)
#pragma unroll
        for (int t = 0; t < 2; ++t)
#pragma unroll
          for (int ks = 0; ks < 4; ++ks) {
            const bf16x8 kf = *(const bf16x8*)(Ks + (kp * 32 + t * 16 + fr) * KLD + ks * 32 + fq * 8);
            st[0][kp][t] = __builtin_amdgcn_mfma_f32_16x16x32_bf16(kf, qf[0][ks], st[0][kp][t], 0, 0, 0);
            st[1][kp][t] = __builtin_amdgcn_mfma_f32_16x16x32_bf16(kf, qf[1][ks], st[1][kp][t], 0, 0, 0);
          }
      unsigned pk[2][2][4];
      const bool edge = lat && (kt0 + ti == qb - 2 || kt0 + ti == qb + 2);
#pragma unroll
      for (int rt = 0; rt < 2; ++rt) {
        float mx = -INFINITY;
        if (edge) {
          const int dbase = (qb * 64 + rh * 32 + rt * 16 + fr) - ((kt0 + ti) * 64 + fq * 8);
#pragma unroll
          for (int kp = 0; kp < 2; ++kp)
#pragma unroll
            for (int t = 0; t < 2; ++t)
#pragma unroll
              for (int j = 0; j < 4; ++j) {
                const int dd = dbase - (kp * 32 + t * 4 + j);
                const float v = (dd > 128 || dd < -128) ? -INFINITY : st[rt][kp][t][j];
                st[rt][kp][t][j] = v; mx = fmaxf(mx, v);
              }
        } else {
#pragma unroll
          for (int kp = 0; kp < 2; ++kp)
#pragma unroll
            for (int t = 0; t < 2; ++t)
#pragma unroll
              for (int j = 0; j < 4; ++j) mx = fmaxf(mx, st[rt][kp][t][j]);
        }
        { const auto r = __builtin_amdgcn_permlane16_swap(__float_as_uint(mx), __float_as_uint(mx), false, false); mx = fmaxf(__uint_as_float(r[0]), __uint_as_float(r[1])); }
        { const auto r = __builtin_amdgcn_permlane32_swap(__float_as_uint(mx), __float_as_uint(mx), false, false); mx = fmaxf(__uint_as_float(r[0]), __uint_as_float(r[1])); }
        const float mo = mst[rt], mn = fmaxf(mo, mx * scale), nmn = -mn;
        const float alpha = __builtin_amdgcn_exp2f(mo - mn);
        mst[rt] = mn;
        float rs = 0.f;
#pragma unroll
        for (int kp = 0; kp < 2; ++kp)
#pragma unroll
          for (int t = 0; t < 2; ++t) {
            const float p0 = __builtin_amdgcn_exp2f(__builtin_fmaf(st[rt][kp][t][0], scale, nmn)), p1 = __builtin_amdgcn_exp2f(__builtin_fmaf(st[rt][kp][t][1], scale, nmn)), p2 = __builtin_amdgcn_exp2f(__builtin_fmaf(st[rt][kp][t][2], scale, nmn)), p3 = __builtin_amdgcn_exp2f(__builtin_fmaf(st[rt][kp][t][3], scale, nmn));
            rs += (p0 + p1) + (p2 + p3);
            pk[rt][kp][t * 2] = pack_bf16(p0, p1); pk[rt][kp][t * 2 + 1] = pack_bf16(p2, p3);
          }
        lst[rt] = lst[rt] * alpha + rs;
        if (__builtin_amdgcn_ballot_w64(mn > mo) != 0ull) {
#pragma unroll
          for (int dt = 0; dt < 8; ++dt) oacc[rt][dt] *= alpha;
        }
      }
#pragma unroll
      for (int kp = 0; kp < 2; ++kp) {
        const bf16x8 pf0 = __builtin_bit_cast(bf16x8, (u32x4){pk[0][kp][0], pk[0][kp][1], pk[0][kp][2], pk[0][kp][3]});
        const bf16x8 pf1 = __builtin_bit_cast(bf16x8, (u32x4){pk[1][kp][0], pk[1][kp][1], pk[1][kp][2], pk[1][kp][3]});
#pragma unroll
        for (int dt = 0; dt < 8; ++dt) {
          const bf16x8 vf = *(const bf16x8*)(Vs + (dt * 16 + fr) * VLD + kp * 32 + fq * 8);
          oacc[0][dt] = __builtin_amdgcn_mfma_f32_16x16x32_bf16(vf, pf0, oacc[0][dt], 0, 0, 0);
          oacc[1][dt] = __builtin_amdgcn_mfma_f32_16x16x32_bf16(vf, pf1, oacc[1][dt], 0, 0, 0);
        }
      }
    }
#pragma unroll
    for (int rt = 0; rt < 2; ++rt) {
      float l = lst[rt]; l += __shfl_xor(l, 16); l += __shfl_xor(l, 32);
      const float inv = 1.0f / l;
      bf16_t* orow = O + (size_t)(qrow0 + rh * 32 + rt * 16 + fr) * D + head * 128 + 4 * (fq & ~1) + 16 * (fq & 1);
#pragma unroll
      for (int dt = 0; dt < 8; dt += 2) {
        const auto sx = __builtin_amdgcn_permlane16_swap(pack_bf16(oacc[rt][dt][0] * inv, oacc[rt][dt][1] * inv), pack_bf16(oacc[rt][dt + 1][0] * inv, oacc[rt][dt + 1][1] * inv), false, false);
        const auto sy = __builtin_amdgcn_permlane16_swap(pack_bf16(oacc[rt][dt][2] * inv, oacc[rt][dt][3] * inv), pack_bf16(oacc[rt][dt + 1][2] * inv, oacc[rt][dt + 1][3] * inv), false, false);
        *(u32x4*)(orow + dt * 16) = (u32x4){sx[0], sy[0], sx[1], sy[1]};
      }
    }
  }
}

#define CE_DESC(a, b) { const float _hi = fmaxf(a, b), _lo = fminf(a, b); a = _hi; b = _lo; }
__device__ __forceinline__ void bitonic_sort_desc16(float (&a)[16]) {
#pragma unroll
  for (int ks = 1; ks <= 4; ++ks)
#pragma unroll
    for (int js = ks - 1; js >= 0; --js)
#pragma unroll
      for (int i = 0; i < 16; ++i) { const int k = 1 << ks, j = 1 << js, l = i ^ j; if (l > i) { if ((i & k) == 0) CE_DESC(a[i], a[l]) else CE_DESC(a[l], a[i]) } }
}
__device__ __forceinline__ void bitonic_merge_desc16(float (&a)[16]) {
#pragma unroll
  for (int js = 3; js >= 0; --js)
#pragma unroll
    for (int i = 0; i < 16; ++i) { const int j = 1 << js, l = i ^ j; if (l > i) CE_DESC(a[i], a[l]) }
}
__device__ __forceinline__ void top16_merge(float (&L)[16], float (&G)[16]) {
  bitonic_sort_desc16(G);
#pragma unroll
  for (int i = 0; i < 16; ++i) L[i] = fmaxf(L[i], G[15 - i]);
  bitonic_merge_desc16(L);
}
__host__ __device__ constexpr int cand_code(int c) {
  int n = 0;
  for (int i = 0; i < 16; ++i) for (int j = 0; j < 16 / (i + 1); ++j) { if (n == c) return (i << 4) | j; ++n; }
  return -1;
}
template <int C> struct CandCode { static constexpr int value = cand_code(C); };

__device__ __forceinline__ void peer_route_phase(const Params& p, int layer, int id_lo, int id_hi, int nblk, unsigned char* lds) {
  const int tid = tidx(), wid = tid >> 6, lane = tid & 63, fr = lane & 15, fq = lane >> 4;
  float* Sw = (float*)(lds + wid * 9216);
  const bf16_t* keysG = (const bf16_t*)(p.ws + OFF_KEYS) + (size_t)layer * 2 * 128 * 128;
  const bf16_t* PQ = (const bf16_t*)(p.ws + OFF_PQ);
  int* IDX = (int*)(p.ws + OFF_IDX); float* GW = (float*)(p.ws + OFF_GW);
  const bool own = id_lo < 0;
  const int id0 = own ? (TL / 64 + 4 * ((int)blockIdx.x >> 2) + (wid >> 1)) * 8 + 2 * ((int)blockIdx.x & 3) + (wid & 1) : id_lo + (int)blockIdx.x * 8 + wid;
  const int id1 = own ? id0 + 1 : id_hi, idstep = own ? (1 << 30) : nblk * 8;
  for (int id = id0; id < id1; id += idstep) {
    const int tile = id >> 3, head = id & 7, tok0 = tile * 64;
    float Lk[2][16];
#pragma unroll
    for (int pp = 0; pp < 2; ++pp) {
      bf16x8 qf[4][4];
#pragma unroll
      for (int mt = 0; mt < 4; ++mt)
#pragma unroll
        for (int ks = 0; ks < 4; ++ks) qf[mt][ks] = *(const bf16x8*)(PQ + (size_t)(tok0 + mt * 16 + fr) * D + head * 256 + pp * 128 + ks * 32 + fq * 8);
#pragma unroll
      for (int s2 = 0; s2 < 16; ++s2) Lk[pp][s2] = -INFINITY;
      bf16x8 kf[2][4], kfn[2][4];
#pragma unroll
      for (int nt = 0; nt < 2; ++nt)
#pragma unroll
        for (int ks = 0; ks < 4; ++ks) kf[nt][ks] = *(const bf16x8*)(keysG + (size_t)(pp * 128 + nt * 16 + fr) * 128 + ks * 32 + fq * 8);
#pragma unroll 1
      for (int pass = 0; pass < 4; ++pass) {
        const int pn = pass < 3 ? pass + 1 : 3;
#pragma unroll
        for (int nt = 0; nt < 2; ++nt)
#pragma unroll
          for (int ks = 0; ks < 4; ++ks) kfn[nt][ks] = *(const bf16x8*)(keysG + (size_t)(pp * 128 + pn * 32 + nt * 16 + fr) * 128 + ks * 32 + fq * 8);
        f32x4 acc[2][4];
#pragma unroll
        for (int nt = 0; nt < 2; ++nt)
#pragma unroll
          for (int mt = 0; mt < 4; ++mt) acc[nt][mt] = (f32x4){0.f, 0.f, 0.f, 0.f};
#pragma unroll
        for (int nt = 0; nt < 2; ++nt)
#pragma unroll
          for (int ks = 0; ks < 4; ++ks)
#pragma unroll
            for (int mt = 0; mt < 4; ++mt) acc[nt][mt] = __builtin_amdgcn_mfma_f32_16x16x32_bf16(kf[nt][ks], qf[mt][ks], acc[nt][mt], 0, 0, 0);
#pragma unroll
        for (int nt = 0; nt < 2; ++nt)
#pragma unroll
          for (int mt = 0; mt < 4; ++mt) *(f32x4*)(Sw + (mt * 16 + fr) * 36 + nt * 16 + 4 * fq) = acc[nt][mt];
        __builtin_amdgcn_fence(__ATOMIC_RELEASE, "wavefront"); __builtin_amdgcn_wave_barrier(); __builtin_amdgcn_fence(__ATOMIC_ACQUIRE, "wavefront");
#pragma unroll
        for (int g = 0; g < 2; ++g) {
          float G[16];
#pragma unroll
          for (int c = 0; c < 4; ++c) {
            const f32x4 sv = *(const f32x4*)(Sw + lane * 36 + g * 16 + c * 4);
#pragma unroll
            for (int e = 0; e < 4; ++e) G[c * 4 + e] = __uint_as_float((__float_as_uint(sv[e]) & ~0x7fu) | (unsigned)(pass * 32 + g * 16 + c * 4 + e));
          }
          top16_merge(Lk[pp], G);
        }
#pragma unroll
        for (int nt = 0; nt < 2; ++nt)
#pragma unroll
          for (int ks = 0; ks < 4; ++ks) kf[nt][ks] = kfn[nt][ks];
      }
    }
#pragma unroll
    for (int pp = 0; pp < 2; ++pp)
#pragma unroll
      for (int s2 = 0; s2 < 16; ++s2) Sw[(pp * 16 + s2) * 64 + lane] = Lk[pp][s2];
    float v1[16], v2[16];
#pragma unroll
    for (int s2 = 0; s2 < 16; ++s2) { v1[s2] = __uint_as_float(__float_as_uint(Lk[0][s2]) & ~0x7fu); v2[s2] = __uint_as_float(__float_as_uint(Lk[1][s2]) & ~0x7fu); }
    float T[16];
#pragma unroll
    for (int s2 = 0; s2 < 16; ++s2) T[s2] = -INFINITY;
#define ROUTE_GROUP(G0) { float G[16]; \
      _Pragma("unroll") for (int q = 0; q < 16; ++q) G[q] = -INFINITY; \
      ROUTE_FILL(G0 + 0) ROUTE_FILL(G0 + 1) ROUTE_FILL(G0 + 2) ROUTE_FILL(G0 + 3) ROUTE_FILL(G0 + 4) ROUTE_FILL(G0 + 5) ROUTE_FILL(G0 + 6) ROUTE_FILL(G0 + 7) \
      ROUTE_FILL(G0 + 8) ROUTE_FILL(G0 + 9) ROUTE_FILL(G0 + 10) ROUTE_FILL(G0 + 11) ROUTE_FILL(G0 + 12) ROUTE_FILL(G0 + 13) ROUTE_FILL(G0 + 14) ROUTE_FILL(G0 + 15) \
      top16_merge(T, G); }
#define ROUTE_FILL(C) { constexpr int code = CandCode<(C)>::value; if constexpr (code >= 0) G[(C) & 15] = __uint_as_float((__float_as_uint(v1[code >> 4] + v2[code & 15]) & ~0xffu) | (unsigned)code); }
    ROUTE_GROUP(0) ROUTE_GROUP(16) ROUTE_GROUP(32) ROUTE_GROUP(48)
#undef ROUTE_FILL
#undef ROUTE_GROUP
    asm volatile("s_waitcnt lgkmcnt(0)" ::: "memory");
    int E[16];
#pragma unroll
    for (int s2 = 0; s2 < 16; ++s2) {
      const unsigned code = __float_as_uint(T[s2]) & 0xffu;
      const unsigned k1 = __float_as_uint(Sw[(code >> 4) * 64 + lane]) & 0x7fu, k2 = __float_as_uint(Sw[(16 + (code & 15u)) * 64 + lane]) & 0x7fu;
      E[s2] = (int)(k1 * 128u + k2);
      T[s2] = __uint_as_float(__float_as_uint(T[s2]) & ~0xffu);
    }
    asm volatile("s_waitcnt lgkmcnt(0)" ::: "memory");
    const size_t o = ((size_t)(tok0 + lane) * 8 + head) * 16;
    const float tmax = T[0];
    float ssum = 0.f;
#pragma unroll
    for (int s2 = 0; s2 < 16; ++s2) { T[s2] = __expf(T[s2] - tmax); ssum += T[s2]; }
    const float inv = 1.0f / ssum;
#pragma unroll
    for (int c = 0; c < 4; ++c) {
      *(f32x4*)(GW + o + c * 4) = (f32x4){T[c * 4] * inv, T[c * 4 + 1] * inv, T[c * 4 + 2] * inv, T[c * 4 + 3] * inv};
      typedef int i32x4 __attribute__((ext_vector_type(4)));
      *(i32x4*)(IDX + o + c * 4) = (i32x4){E[c * 4], E[c * 4 + 1], E[c * 4 + 2], E[c * 4 + 3]};
    }
  }
}

struct PeerU4 { u32x4 ua[4]; };
__device__ __forceinline__ u32x4 peer_load_u(const unsigned char* UT4, int ireg, int k0, int lane) {
  const int e = __builtin_amdgcn_readlane(ireg, k0);
  return *(const u32x4*)(UT4 + (size_t)e * ROWV + lane * 16);
}
__device__ __forceinline__ void peer_load_u4(PeerU4& B, const unsigned char* UT4, int ireg, int k0, int lane) {
#pragma unroll
  for (int j = 0; j < 4; ++j) B.ua[j] = peer_load_u(UT4, ireg, k0 + j, lane);
}
template <int CTRL> __device__ __forceinline__ int dppi(int src) { return __builtin_amdgcn_update_dpp(0, src, CTRL, 0xf, 0xf, true); }
__device__ __forceinline__ int peer_rowdot(const u32x4& ua, const int (&hq)[2][4]) {
  int d0i = 0, d1i = 0;
#pragma unroll
  for (int i = 0; i < 4; ++i) {
    const unsigned lo = ua[i] & 0x0f0f0f0fu, hi = (ua[i] >> 4) & 0x0f0f0f0fu;
    d0i = __builtin_amdgcn_sdot4((int)lo, hq[i >> 1][2 * (i & 1)], d0i, false);
    d1i = __builtin_amdgcn_sdot4((int)hi, hq[i >> 1][2 * (i & 1) + 1], d1i, false);
  }
  return d0i + d1i;
}
__device__ __forceinline__ float peer_gate4(const PeerU4& B, const int (&hq)[2][4], float hscale_half, int hsumtot15, float su_lane, float gs_lane, int lane) {
  const int x0 = peer_rowdot(B.ua[0], hq), x1 = peer_rowdot(B.ua[1], hq), x2 = peer_rowdot(B.ua[2], hq), x3 = peer_rowdot(B.ua[3], hq);
  const bool b0 = lane & 1, b1 = lane & 2;
  const int t01 = (b0 ? x1 : x0) + dppi<0xB1>(b0 ? x0 : x1);
  const int t23 = (b0 ? x3 : x2) + dppi<0xB1>(b0 ? x2 : x3);
  int u = (b1 ? t23 : t01) + dppi<0x4E>(b1 ? t01 : t23);
  u += dppi<0x124>(u); u += dppi<0x128>(u);
  { const auto r = __builtin_amdgcn_permlane16_swap((unsigned)u, (unsigned)u, false, false); u = (int)(r[0] + r[1]); }
  { const auto r = __builtin_amdgcn_permlane32_swap((unsigned)u, (unsigned)u, false, false); u = (int)(r[0] + r[1]); }
  const float z = su_lane * hscale_half * (float)(2 * u - hsumtot15);
  return gelu_tanh(z) * gs_lane;
}
struct PeerV4 { u32x4 va[4]; };
__device__ __forceinline__ void peer_load_v4(PeerV4& B, const unsigned char* VT6, int ireg, int k0, int lane) {
#pragma unroll
  for (int j = 0; j < 4; ++j) {
    const int e = __builtin_amdgcn_readlane(ireg, k0 + j);
    const unsigned char* vr = VT6 + (size_t)e * ROWV;
    B.va[j] = *(const u32x4*)(vr + lane * 16);
  }
}
#define PERM(S0, S1, SEL) __builtin_amdgcn_perm((S0), (S1), (SEL))
#define V4_DOT(D0, D1, D2, D3, ACC0, ACC1, ACC2, ACC3) { \
    const unsigned p01l = PERM(D1, D0, 0x05010400u), p01h = PERM(D1, D0, 0x07030602u), p23l = PERM(D3, D2, 0x05010400u), p23h = PERM(D3, D2, 0x07030602u); \
    ACC0 = __builtin_amdgcn_sdot4((int)PERM(p23l, p01l, 0x05040100u), a4, ACC0, false); ACC1 = __builtin_amdgcn_sdot4((int)PERM(p23l, p01l, 0x07060302u), a4, ACC1, false); \
    ACC2 = __builtin_amdgcn_sdot4((int)PERM(p23h, p01h, 0x05040100u), a4, ACC2, false); ACC3 = __builtin_amdgcn_sdot4((int)PERM(p23h, p01h, 0x07060302u), a4, ACC3, false); }
__device__ __forceinline__ void peer_accum_v4(const PeerV4& B, int a4, int (&acc)[32]) {
#pragma unroll
  for (int i = 0; i < 4; ++i) {
    const unsigned D0 = B.va[0][i], D1 = B.va[1][i], D2 = B.va[2][i], D3 = B.va[3][i];
    const unsigned p01l = PERM(D1, D0, 0x05010400u), p01h = PERM(D1, D0, 0x07030602u), p23l = PERM(D3, D2, 0x05010400u), p23h = PERM(D3, D2, 0x07030602u);
    const unsigned c0 = PERM(p23l, p01l, 0x05040100u), c1 = PERM(p23l, p01l, 0x07060302u), c2 = PERM(p23h, p01h, 0x05040100u), c3 = PERM(p23h, p01h, 0x07060302u);
    acc[8 * i + 4] = __builtin_amdgcn_sdot4((int)c0, a4, acc[8 * i + 4], false); acc[8 * i + 0] = __builtin_amdgcn_sdot4((int)(c0 & 0x0f0f0f0fu), a4, acc[8 * i + 0], false);
    acc[8 * i + 5] = __builtin_amdgcn_sdot4((int)c1, a4, acc[8 * i + 5], false); acc[8 * i + 1] = __builtin_amdgcn_sdot4((int)(c1 & 0x0f0f0f0fu), a4, acc[8 * i + 1], false);
    acc[8 * i + 6] = __builtin_amdgcn_sdot4((int)c2, a4, acc[8 * i + 6], false); acc[8 * i + 2] = __builtin_amdgcn_sdot4((int)(c2 & 0x0f0f0f0fu), a4, acc[8 * i + 2], false);
    acc[8 * i + 7] = __builtin_amdgcn_sdot4((int)c3, a4, acc[8 * i + 7], false); acc[8 * i + 3] = __builtin_amdgcn_sdot4((int)(c3 & 0x0f0f0f0fu), a4, acc[8 * i + 3], false);
  }
}
__device__ __forceinline__ void peer_gather_phase(const Params& p, int layer, int ntok, int gate_layer, unsigned char* lds) {
  const int tid = tidx(), wid = tid >> 6, lane = tid & 63;
  const bf16_t* H = (const bf16_t*)(p.ws + OFF_H);
  const int* IDX = (const int*)(p.ws + OFF_IDX); const float* GW = (const float*)(p.ws + OFF_GW);
  const unsigned char* UT8 = p.ws + OFF_UTAB + (size_t)layer * NEXP * ROWV; const unsigned char* VT6 = p.ws + OFF_VTAB + (size_t)layer * NEXP * ROWV;
  const float2* SC2 = (const float2*)(p.ws + OFF_USC) + (size_t)layer * NEXP;
  float* XS = (float*)(p.ws + OFF_XS);
  const float* gate = (const float*)(p.ws + OFF_MODV) + (size_t)(gate_layer * 5) * NMOD + 5 * D;
  const int per_round = (int)gridDim.x * 8, nfull_rounds = ntok / per_round, nfull = nfull_rounds * per_round;
  const int nsplit_rounds = (ntok - nfull + (int)gridDim.x * 4 - 1) / ((int)gridDim.x * 4);
  float* part = (float*)lds + (wid >> 1) * 2112;
  const int nit = nfull_rounds + nsplit_rounds;
  auto token_of = [&](int it_) -> int {
    return it_ >= nfull_rounds ? nfull + (it_ - nfull_rounds) * (int)gridDim.x * 4 + (int)blockIdx.x * 4 + (wid >> 1) : it_ * per_round + (int)blockIdx.x * 8 + wid;
  };
  int ni0 = 0, ni1 = 0; float ng0 = 0.f, ng1 = 0.f; u32x2 nh[8];
#pragma unroll
  for (int c = 0; c < 8; ++c) nh[c] = (u32x2){0u, 0u};
  {
    const int t0 = token_of(0);
    if (nit > 0 && t0 < ntok) {
      ni0 = IDX[(size_t)t0 * 128 + lane]; ni1 = IDX[(size_t)t0 * 128 + 64 + lane]; ng0 = GW[(size_t)t0 * 128 + lane]; ng1 = GW[(size_t)t0 * 128 + 64 + lane];
#pragma unroll
      for (int c = 0; c < 8; ++c) nh[c] = *(const u32x2*)(H + (size_t)t0 * D + 256 * c + lane * 4);
    }
  }
  float* LV = (float*)lds + 9216;
  int cur_mrow = -1;
  for (int it = 0; it < nit; ++it) {
    const bool split = it >= nfull_rounds;
    const int tok = token_of(it);
    {
      const int m_it = mod_row(tok);
      if (m_it != cur_mrow) {
        __syncthreads();
        const int i4 = tid * 4;
        *(float4*)(LV + i4) = *(const float4*)(gate + (size_t)m_it * NMOD + i4);
        if (layer == 0) {
          const float* mvs = (const float*)(p.ws + OFF_MODV) + (size_t)(5 + m_it) * NMOD;
          *(float4*)(LV + 2048 + i4) = *(const float4*)(mvs + i4); *(float4*)(LV + 4096 + i4) = *(const float4*)(mvs + D + i4);
          if (cur_mrow < 0) *(float4*)(LV + 6144 + i4) = *(const float4*)(p.norm_mix + D + i4);
        } else if (cur_mrow < 0) *(float4*)(LV + 6144 + i4) = *(const float4*)(p.norm_final + i4);
        cur_mrow = m_it;
        __syncthreads();
      }
    }
    const bool valid = tok < ntok;
    const int hbeg = split ? (wid & 1) : 0, hend = split ? (wid & 1) + 1 : 2;
    float accv[32]; float corr = 0.f;
#pragma unroll
    for (int j = 0; j < 32; ++j) accv[j] = 0.f;
    f32x4 xo[8]; u32x2 dd[8];
#pragma unroll
    for (int t = 0; t < 8; ++t) { xo[t] = (f32x4){0.f, 0.f, 0.f, 0.f}; dd[t] = (u32x2){0u, 0u}; }
    const float* xb = layer == 0 ? (tok < TL ? p.x + (size_t)tok * D : p.ctx + (size_t)(tok - TL) * D) + lane * 4 : XS + (size_t)tok * D + lane * 4;
    const bf16_t* dl = (const bf16_t*)(p.ws + OFF_Q) + (size_t)tok * D + lane * 4;
    const int i0 = ni0, i1 = ni1; const float g0 = ng0, g1 = ng1;
    u32x2 hv[8];
#pragma unroll
    for (int c = 0; c < 8; ++c) hv[c] = nh[c];
    u32x4 A = (u32x4){0u, 0u, 0u, 0u}; float su0 = 0.f, su1 = 0.f, gs0 = 0.f, gs1 = 0.f;
    if (valid) {
      A = peer_load_u(UT8, hbeg ? i1 : i0, 0, lane);
      { const float2 s0 = SC2[i0], s1 = SC2[i1]; su0 = s0.x; gs0 = s0.y; su1 = s1.x; gs1 = s1.y; }
    }
    if (it + 1 < nit) {
      const int tn = token_of(it + 1);
      if (tn < ntok) {
        ni0 = IDX[(size_t)tn * 128 + lane]; ni1 = IDX[(size_t)tn * 128 + 64 + lane]; ng0 = GW[(size_t)tn * 128 + lane]; ng1 = GW[(size_t)tn * 128 + 64 + lane];
#pragma unroll
        for (int c = 0; c < 8; ++c) nh[c] = *(const u32x2*)(H + (size_t)tn * D + 256 * c + lane * 4);
      }
    }
    if (valid) {
      int hq[2][4]; float hscale; int hsum15;
      gs0 *= g0; gs1 *= g1;
      {
        float hreg[32]; float hmx = 0.f;
#pragma unroll
        for (int c = 0; c < 8; ++c) {
          hreg[4 * c] = __uint_as_float(hv[c].x << 16); hreg[4 * c + 1] = __uint_as_float(hv[c].x & 0xffff0000u); hreg[4 * c + 2] = __uint_as_float(hv[c].y << 16); hreg[4 * c + 3] = __uint_as_float(hv[c].y & 0xffff0000u);
          hmx = fmaxf(hmx, fmaxf(fmaxf(fabsf(hreg[4 * c]), fabsf(hreg[4 * c + 1])), fmaxf(fabsf(hreg[4 * c + 2]), fabsf(hreg[4 * c + 3]))));
        }
        hmx = wave_max(hmx);
        hscale = hmx > 0.f ? hmx * (1.0f / 127.0f) : 1.0f;
        const float hinv = 1.0f / hscale;
        int hs = 0;
#pragma unroll
        for (int g = 0; g < 2; ++g)
#pragma unroll
          for (int t = 0; t < 4; ++t) {
            const int q0 = (int)rintf(hreg[16 * g + 4 * t] * hinv), q1 = (int)rintf(hreg[16 * g + 4 * t + 1] * hinv), q2 = (int)rintf(hreg[16 * g + 4 * t + 2] * hinv), q3 = (int)rintf(hreg[16 * g + 4 * t + 3] * hinv);
            hs += (q0 + q1) + (q2 + q3);
            hq[g][t] = (int)(((unsigned)q0 & 0xffu) | (((unsigned)q1 & 0xffu) << 8) | (((unsigned)q2 & 0xffu) << 16) | (((unsigned)q3 & 0xffu) << 24));
          }
        hsum15 = 15 * (int)wave_sum((float)hs); hscale *= 0.5f;
      }
      float act0 = 0.f, act1 = 0.f;
      const int ngroups = (hend - hbeg) * 16;
      {
        PeerU4 UA, UB;
        UA.ua[0] = A;
#pragma unroll
        for (int j = 1; j < 4; ++j) UA.ua[j] = peer_load_u(UT8, hbeg ? i1 : i0, j, lane);
#pragma unroll 1
        for (int gi = 0; gi < ngroups; gi += 2) {
          { const int half = hbeg + ((gi + 1) >> 4), k0 = ((gi + 1) & 15) * 4; peer_load_u4(UB, UT8, half ? i1 : i0, k0, lane); }
          {
            const int half = hbeg + (gi >> 4), kq = gi & 15;
            const float ga = peer_gate4(UA, hq, hscale, hsum15, half ? su1 : su0, half ? gs1 : gs0, lane);
            if (half) act1 = (lane >> 2) == kq ? ga : act1; else act0 = (lane >> 2) == kq ? ga : act0;
          }
          if (gi + 2 < ngroups) { const int half = hbeg + ((gi + 2) >> 4), k0 = ((gi + 2) & 15) * 4; peer_load_u4(UA, UT8, half ? i1 : i0, k0, lane); }
          {
            const int half = hbeg + ((gi + 1) >> 4), kq = (gi + 1) & 15;
            const float gb = peer_gate4(UB, hq, hscale, hsum15, half ? su1 : su0, half ? gs1 : gs0, lane);
            if (half) act1 = (lane >> 2) == kq ? gb : act1; else act0 = (lane >> 2) == kq ? gb : act0;
          }
        }
      }
      const float amax = wave_max(fmaxf(fabsf(act0), fabsf(act1)));
      const float ascale = amax > 0.f ? amax * (1.0f / 127.0f) : 1.0f, ainv = 1.0f / ascale;
      const int a8_0 = (int)rintf(act0 * ainv), a8_1 = (int)rintf(act1 * ainv);
      corr = ascale * wave_sum((float)(a8_0 + a8_1));
      int acc[32];
#pragma unroll
      for (int j = 0; j < 32; ++j) acc[j] = 0;
      PeerV4 VA, VB;
      peer_load_v4(VA, VT6, hbeg ? i1 : i0, 0, lane);
#pragma unroll 1
      for (int gi = 0; gi < ngroups; gi += 2) {
        {
          const int half = hbeg + ((gi + 1) >> 4), k0 = ((gi + 1) & 15) * 4;
          peer_load_v4(VB, VT6, half ? i1 : i0, k0, lane);
        }
        if (gi == ngroups - 2) {
#pragma unroll
          for (int t = 0; t < 8; ++t) { xo[t] = *(const f32x4*)(xb + 256 * t); dd[t] = *(const u32x2*)(dl + 256 * t); }
        }
        {
          const int half = hbeg + (gi >> 4), k0 = (gi & 15) * 4; const int areg = half ? a8_1 : a8_0;
          const int a4 = (__builtin_amdgcn_readlane(areg, k0) & 0xff) | ((__builtin_amdgcn_readlane(areg, k0 + 1) & 0xff) << 8) | ((__builtin_amdgcn_readlane(areg, k0 + 2) & 0xff) << 16) | ((__builtin_amdgcn_readlane(areg, k0 + 3) & 0xff) << 24);
          peer_accum_v4(VA, a4, acc);
        }
        if (gi + 2 < ngroups) { const int half = hbeg + ((gi + 2) >> 4), k0 = ((gi + 2) & 15) * 4; peer_load_v4(VA, VT6, half ? i1 : i0, k0, lane); }
        {
          const int half = hbeg + ((gi + 1) >> 4), k0 = ((gi + 1) & 15) * 4; const int areg = half ? a8_1 : a8_0;
          const int a4 = (__builtin_amdgcn_readlane(areg, k0) & 0xff) | ((__builtin_amdgcn_readlane(areg, k0 + 1) & 0xff) << 8) | ((__builtin_amdgcn_readlane(areg, k0 + 2) & 0xff) << 16) | ((__builtin_amdgcn_readlane(areg, k0 + 3) & 0xff) << 24);
          peer_accum_v4(VB, a4, acc);
        }
      }
#pragma unroll
      for (int i = 0; i < 4; ++i)
#pragma unroll
        for (int b = 0; b < 4; ++b) {
          const int lo = acc[8 * i + b], raw = acc[8 * i + 4 + b];
          accv[8 * i + b] = ascale * (float)lo;
          accv[8 * i + 4 + b] = ascale * (float)((raw - lo) >> 4) + 8.0f * corr;
        }
    }
    if (split) {
      if (wid & 1) {
#pragma unroll
        for (int t = 0; t < 8; ++t) *(f32x4*)(part + lane * 32 + 4 * t) = (f32x4){accv[4 * t], accv[4 * t + 1], accv[4 * t + 2], accv[4 * t + 3]};
        if (lane == 0) part[2048] = corr;
      }
      __syncthreads();
      if (!(wid & 1)) {
#pragma unroll
        for (int t = 0; t < 8; ++t) { const f32x4 o = *(const f32x4*)(part + lane * 32 + 4 * t); accv[4 * t] += o[0]; accv[4 * t + 1] += o[1]; accv[4 * t + 2] += o[2]; accv[4 * t + 3] += o[3]; }
        corr += part[2048];
      }
      __syncthreads();
      if (wid & 1) continue;
    }
    if (!valid) continue;
    corr *= 7.5f;
    const int mrow = mod_row(tok);
    const float* gr = LV + lane * 4; float* xr = XS + (size_t)tok * D + lane * 4;
    float ss = 0.f;
#pragma unroll
    for (int t = 0; t < 8; ++t) {
      const f32x4 gg = *(const f32x4*)(gr + 256 * t); f32x4 xv = xo[t];
      xv[0] += __uint_as_float(dd[t].x << 16); xv[1] += __uint_as_float(dd[t].x & 0xffff0000u); xv[2] += __uint_as_float(dd[t].y << 16); xv[3] += __uint_as_float(dd[t].y & 0xffff0000u);
#pragma unroll
      for (int j = 0; j < 4; ++j) { const float xn = xv[j] + gg[j] * (accv[4 * t + j] - corr); accv[4 * t + j] = xn; ss += xn * xn; }
    }
    ss = wave_sum(ss);
    const float rs = rsqrtf(ss * (1.0f / D) + 1e-6f);
    if (layer == 0) {
      const float* mv = LV + 2048 + lane * 4;
      const float* gn = LV + 6144 + lane * 4;
      bf16_t* hr = (bf16_t*)(p.ws + OFF_H) + (size_t)tok * D + lane * 4;
#pragma unroll
      for (int t = 0; t < 8; ++t) {
        *(f32x4*)(xr + 256 * t) = (f32x4){accv[4 * t], accv[4 * t + 1], accv[4 * t + 2], accv[4 * t + 3]};
        const f32x4 g = *(const f32x4*)(gn + 256 * t), sh = *(const f32x4*)(mv + 256 * t), sc = *(const f32x4*)(mv + D + 256 * t);
        u32x2 o; o.x = pack_bf16(accv[4 * t] * rs * g[0] * (1.0f + sc[0]) + sh[0], accv[4 * t + 1] * rs * g[1] * (1.0f + sc[1]) + sh[1]);
        o.y = pack_bf16(accv[4 * t + 2] * rs * g[2] * (1.0f + sc[2]) + sh[2], accv[4 * t + 3] * rs * g[3] * (1.0f + sc[3]) + sh[3]);
        *(u32x2*)(hr + 256 * t) = o;
      }
    } else {
      float* orow = p.out + (size_t)tok * D + lane * 4;
#pragma unroll
      for (int t = 0; t < 8; ++t) {
        const f32x4 g = *(const f32x4*)(LV + 6144 + lane * 4 + 256 * t);
        *(f32x4*)(orow + 256 * t) = (f32x4){accv[4 * t] * rs * g[0], accv[4 * t + 1] * rs * g[1], accv[4 * t + 2] * rs * g[2], accv[4 * t + 3] * rs * g[3]};
      }
    }
  }
}

__device__ __forceinline__ void conv_phase(const Params& p) {
  const bf16_t* UBR = (const bf16_t*)(p.ws + OFF_Q); bf16_t* UC = (bf16_t*)(p.ws + OFF_O);
  const int tid = tidx(), c = (tid & 255) * 8, hrow = tid >> 8;
  float w[4][8], bias[8];
#pragma unroll
  for (int k = 0; k < 4; ++k) { const float4 w0 = *(const float4*)(p.rec_conv_w + k * D + c), w1 = *(const float4*)(p.rec_conv_w + k * D + c + 4); w[k][0] = w0.x; w[k][1] = w0.y; w[k][2] = w0.z; w[k][3] = w0.w; w[k][4] = w1.x; w[k][5] = w1.y; w[k][6] = w1.z; w[k][7] = w1.w; }
  { const float4 b0 = *(const float4*)(p.rec_conv_b + c), b1 = *(const float4*)(p.rec_conv_b + c + 4); bias[0] = b0.x; bias[1] = b0.y; bias[2] = b0.z; bias[3] = b0.w; bias[4] = b1.x; bias[5] = b1.y; bias[6] = b1.z; bias[7] = b1.w; }
  const int nhalf = 2 * (int)gridDim.x, rows_per = (TT + nhalf - 1) / nhalf;
  const int r0 = ((int)blockIdx.x * 2 + hrow) * rows_per, r1 = r0 + rows_per < TT ? r0 + rows_per : TT;
  if (r0 < TT) {
    const u32x4 zero = (u32x4){0u, 0u, 0u, 0u};
    u32x4 w0, w1, w2;
    { const int ra = r0 - 1; w0 = (ra >= 0) ? *(const u32x4*)(UBR + (size_t)ra * D + c) : zero; w1 = *(const u32x4*)(UBR + (size_t)r0 * D + c); w2 = (r0 + 1 < TT) ? *(const u32x4*)(UBR + (size_t)(r0 + 1) * D + c) : zero; }
    u32x4 na[8], nb[8];
    auto fetch = [&](u32x4 (&buf)[8], int base) {
#pragma unroll
      for (int i = 0; i < 8; ++i) { const int rr = base + 2 + i; buf[i] = (base + i < r1 && rr < TT) ? *(const u32x4*)(UBR + (size_t)rr * D + c) : zero; }
    };
    auto run = [&](const u32x4 (&buf)[8], int base) {
#pragma unroll
      for (int i = 0; i < 8; ++i) {
        const int r = base + i;
        if (r < r1) {
          const int seq_lo = r < TL ? (r & ~4095) : TL + ((r - TL) & ~255), seq_hi = seq_lo + (r < TL ? S : CL);
          float acc[8];
#pragma unroll
          for (int j = 0; j < 8; ++j) acc[j] = bias[j];
#pragma unroll
          for (int k = 0; k < 4; ++k) {
            const int rk = r - 1 + k; const bool ok = rk >= seq_lo && rk < seq_hi;
            const u32x4 wk = k == 0 ? w0 : k == 1 ? w1 : k == 2 ? w2 : buf[i];
#pragma unroll
            for (int t = 0; t < 4; ++t) { const unsigned d = ok ? wk[t] : 0u; acc[2 * t] += w[k][2 * t] * __uint_as_float(d << 16); acc[2 * t + 1] += w[k][2 * t + 1] * __uint_as_float(d & 0xffff0000u); }
          }
          u32x4 o; o.x = pack_bf16(acc[0], acc[1]); o.y = pack_bf16(acc[2], acc[3]); o.z = pack_bf16(acc[4], acc[5]); o.w = pack_bf16(acc[6], acc[7]);
          *(u32x4*)(UC + (size_t)r * D + c) = o;
        }
        w0 = w1; w1 = w2; w2 = buf[i];
      }
    };
    fetch(na, r0);
#pragma unroll 1
    for (int rb = r0; rb < r1; rb += 16) {
      fetch(nb, rb + 8);
      run(na, rb);
      fetch(na, rb + 16);
      run(nb, rb + 8);
    }
  }
}

__device__ __forceinline__ void scan1_phase(const Params& p) {
  const bf16_t* LAB = (const bf16_t*)(p.ws + OFF_LAB);
  float* CHP = (float*)(p.ws + OFF_CHP); float* CHH = (float*)(p.ws + OFF_CHH);
  const int total = 2 * 272 * 2; const int tid = tidx();
  const int nitems = ((int)blockIdx.x < total) ? (total - 1 - (int)blockIdx.x) / (int)gridDim.x + 1 : 0, nsteps = nitems * 4;
  float h0 = 0.f, h1 = 0.f, ls0 = 0.f, ls1 = 0.f;
  auto fetch = [&](unsigned (&av)[16], unsigned (&bv)[16], int step) {
    const int item = (int)blockIdx.x + (step >> 2) * (int)gridDim.x, q = step & 3;
    const int cgp = item & 1, ch = (item >> 1) % 272, dir = item / (272 * 2);
    const int c = cgp * 1024 + tid * 2, t0 = dir == 0 ? q * 16 : 48 - q * 16;
    const bf16_t* a = LAB + ((size_t)(dir * 2) * TT + ch * 64 + t0) * D + c; const bf16_t* b = LAB + ((size_t)(dir * 2 + 1) * TT + ch * 64 + t0) * D + c;
#pragma unroll
    for (int i = 0; i < 16; ++i) { av[i] = *(const unsigned*)(a + (size_t)i * D); bv[i] = *(const unsigned*)(b + (size_t)i * D); }
  };
  auto run = [&](const unsigned (&av)[16], const unsigned (&bv)[16], int step) {
    const int item = (int)blockIdx.x + (step >> 2) * (int)gridDim.x, q = step & 3;
    const int cgp = item & 1, ch = (item >> 1) % 272, dir = item / (272 * 2);
    if (q == 0) { h0 = 0.f; h1 = 0.f; ls0 = 0.f; ls1 = 0.f; }
#pragma unroll
    for (int ii = 0; ii < 16; ++ii) {
      const unsigned aw = dir == 0 ? av[ii] : av[15 - ii], bw = dir == 0 ? bv[ii] : bv[15 - ii];
      const float la0 = __uint_as_float(aw << 16), la1 = __uint_as_float(aw & 0xffff0000u);
      h0 = __expf(la0) * h0 + __uint_as_float(bw << 16); h1 = __expf(la1) * h1 + __uint_as_float(bw & 0xffff0000u);
      ls0 += la0; ls1 += la1;
    }
    if (q == 3) {
      const size_t o = ((size_t)dir * 272 + ch) * D + cgp * 1024 + tid * 2;
      *(float2*)(CHP + o) = make_float2(__expf(ls0), __expf(ls1)); *(float2*)(CHH + o) = make_float2(h0, h1);
    }
  };
  unsigned a0[16], b0[16], a1[16], b1[16];
  if (nsteps > 0) fetch(a0, b0, 0);
#pragma unroll 1
  for (int st = 0; st < nsteps; st += 2) {
    fetch(a1, b1, st + 1);
    run(a0, b0, st);
    if (st + 2 < nsteps) fetch(a0, b0, st + 2);
    run(a1, b1, st + 1);
  }
}
__device__ __forceinline__ void scan2_phase(const Params& p) {
  const float* CHP = (const float*)(p.ws + OFF_CHP); const float* CHH = (const float*)(p.ws + OFF_CHH); float* CIN = (float*)(p.ws + OFF_CIN);
  for (int it = blockIdx.x * NT + tidx(); it < 2 * NB * D; it += gridDim.x * NT) {
    const int c = it & 2047, b = (it >> 11) & 3, dir = it >> 13;
    float carry = 0.f;
    for (int s = 0; s < 68; ++s) {
      int ch;
      if (dir == 0) ch = s < 4 ? (256 + 4 * b + s) : (64 * b + (s - 4));
      else ch = s < 4 ? (256 + 4 * b + (3 - s)) : (64 * b + (63 - (s - 4)));
      const size_t o = ((size_t)dir * 272 + ch) * D + c;
      CIN[o] = carry;
      carry = CHP[o] * carry + CHH[o];
    }
  }
}
__device__ __forceinline__ void scan3_phase(const Params& p, unsigned char* lds) {
  const bf16_t* LAB = (const bf16_t*)(p.ws + OFF_LAB); const float* CIN = (const float*)(p.ws + OFF_CIN);
  const bf16_t* GATE = (const bf16_t*)(p.ws + OFF_PQ); bf16_t* A2 = (bf16_t*)(p.ws + OFF_O);
  unsigned* yf = (unsigned*)lds;
  const int total = 256 * 2; const int tid = tidx();
  const int nitems = ((int)blockIdx.x < total) ? (total - 1 - (int)blockIdx.x) / (int)gridDim.x + 1 : 0, nsteps = nitems * 8;
  float h0 = 0.f, h1 = 0.f;
  struct Buf { unsigned av[16], bv[16], gv[16]; float2 hc; };
  auto fetch = [&](Buf& B, int step) {
    const int item = (int)blockIdx.x + (step >> 3) * (int)gridDim.x, ph = step & 7;
    const int cgp = item & 1, ch = item >> 1, c = cgp * 1024 + tid * 2;
    const bool bwd = ph >= 4; const int t0 = bwd ? 48 - (ph - 4) * 16 : ph * 16;
    const size_t base = ((size_t)ch * 64 + t0) * D + c;
    const bf16_t* a = LAB + (bwd ? (size_t)2 * TT * D : 0) + base; const bf16_t* b = a + (size_t)TT * D;
#pragma unroll
    for (int i = 0; i < 16; ++i) { B.av[i] = *(const unsigned*)(a + (size_t)i * D); B.bv[i] = *(const unsigned*)(b + (size_t)i * D); }
    if (bwd) {
#pragma unroll
      for (int i = 0; i < 16; ++i) B.gv[i] = *(const unsigned*)(GATE + base + (size_t)i * D);
    }
    if ((ph & 3) == 0) B.hc = *(const float2*)(CIN + ((size_t)(bwd ? 272 : 0) + ch) * D + c);
  };
  auto run = [&](const Buf& B, int step) {
    const int item = (int)blockIdx.x + (step >> 3) * (int)gridDim.x, ph = step & 7;
    const int cgp = item & 1, ch = item >> 1, c = cgp * 1024 + tid * 2;
    const bool bwd = ph >= 4; const int t0 = bwd ? 48 - (ph - 4) * 16 : ph * 16;
    if ((ph & 3) == 0) { h0 = B.hc.x; h1 = B.hc.y; }
    if (!bwd) {
#pragma unroll
      for (int i = 0; i < 16; ++i) {
        h0 = __expf(__uint_as_float(B.av[i] << 16)) * h0 + __uint_as_float(B.bv[i] << 16); h1 = __expf(__uint_as_float(B.av[i] & 0xffff0000u)) * h1 + __uint_as_float(B.bv[i] & 0xffff0000u);
        yf[(t0 + i) * 512 + tid] = pack_bf16(h0, h1);
      }
    } else {
      const size_t base = ((size_t)ch * 64 + t0) * D + c;
#pragma unroll
      for (int i = 15; i >= 0; --i) {
        h0 = __expf(__uint_as_float(B.av[i] << 16)) * h0 + __uint_as_float(B.bv[i] << 16); h1 = __expf(__uint_as_float(B.av[i] & 0xffff0000u)) * h1 + __uint_as_float(B.bv[i] & 0xffff0000u);
        const unsigned f = yf[(t0 + i) * 512 + tid];
        *(unsigned*)(A2 + base + (size_t)i * D) = pack_bf16((__uint_as_float(f << 16) + h0) * __uint_as_float(B.gv[i] << 16), (__uint_as_float(f & 0xffff0000u) + h1) * __uint_as_float(B.gv[i] & 0xffff0000u));
      }
    }
  };
  Buf P, Q;
#pragma unroll
  for (int i = 0; i < 16; ++i) { P.gv[i] = 0u; Q.gv[i] = 0u; }
  P.hc = make_float2(0.f, 0.f); Q.hc = make_float2(0.f, 0.f);
  if (nsteps > 0) fetch(P, 0);
#pragma unroll 1
  for (int st = 0; st < nsteps; st += 2) {
    fetch(Q, st + 1);
    run(P, st);
    if (st + 2 < nsteps) fetch(P, st + 2);
    run(Q, st + 1);
  }
}

#define XB_TMO      128
#define XB_XCNT(j)  (256  + 64 * (j))
#define XB_XSUB(j)  (1280 + 64 * (j))
#define XB_XGEN(j)  (2304 + 64 * (j))
#define XB_TOP      3328
#define XB_TOPGEN   3392
#define XCD_BAR_WORDS 3456
#define XB_SPIN_CAP (1u << 22)
#define LAS3 __attribute__((address_space(3)))
__device__ __forceinline__ unsigned xb_ld(unsigned* p)              { return __hip_atomic_load(p, __ATOMIC_RELAXED, __HIP_MEMORY_SCOPE_AGENT); }
__device__ __forceinline__ unsigned xb_add(unsigned* p, unsigned v) { return __hip_atomic_fetch_add(p, v, __ATOMIC_RELAXED, __HIP_MEMORY_SCOPE_AGENT); }
__device__ __forceinline__ unsigned xb_xcc_id() { return (unsigned)__builtin_amdgcn_s_getreg((3 << 11) | 20) & 0xFu; }
#define XB_SPIN(cond, bar) do { unsigned _sp = 0; while (cond) { __builtin_amdgcn_s_sleep(1); \
    if ((++_sp & 255u) == 0u) { if (xb_ld(&(bar)[XB_TMO])) break; if (_sp > XB_SPIN_CAP) { atomicAdd(&(bar)[XB_TMO], 1u); break; } } } } while (0)
struct XcdBarrier { unsigned* bar; unsigned x; volatile LAS3 unsigned* st; };
__device__ __forceinline__ XcdBarrier xcd_barrier_post(unsigned* bar, volatile LAS3 unsigned* st) {
  XcdBarrier b; b.bar = bar; b.x = xb_xcc_id(); b.st = st;
  if (threadIdx.x == 0) (void)xb_add(&bar[XB_XCNT(b.x)], 1u);
  return b;
}
__device__ __forceinline__ void xcd_barrier_complete(unsigned* bar, unsigned x, unsigned& nloc, unsigned& nx) {
  const unsigned G = gridDim.x * gridDim.y * gridDim.z;
  unsigned sum, cnt, mine, sp = 0u;
  for (;;) {
    sum = 0u; cnt = 0u; mine = 0u;
#pragma unroll
    for (unsigned j = 0; j < 16; ++j) { const unsigned c = xb_ld(&bar[XB_XCNT(j)]); sum += c; cnt += (c > 0u) ? 1u : 0u; mine = (j == x) ? c : mine; }
    if (sum == G) break;
    __builtin_amdgcn_s_sleep(1);
    if ((++sp & 255u) == 0u) { if (xb_ld(&bar[XB_TMO])) break; if (sp > XB_SPIN_CAP) { atomicAdd(&bar[XB_TMO], 1u); break; } }
  }
  nloc = mine > 0u ? mine : 1u; nx = cnt > 0u ? cnt : 1u;
}
__device__ __forceinline__ void xcd_barrier(const XcdBarrier& b) {
  asm volatile("s_waitcnt vmcnt(0)" ::: "memory");
  __syncthreads();
  if (threadIdx.x == 0) {
    unsigned* bar = b.bar;
    __builtin_amdgcn_s_waitcnt(0);
    unsigned nloc = b.st[0], nx = b.st[1];
    if (nloc == 0u) { xcd_barrier_complete(bar, b.x, nloc, nx); b.st[0] = nloc; b.st[1] = nx; }
    const unsigned old = xb_add(&bar[XB_XSUB(b.x)], 1u);
    const unsigned gen = old / nloc;
    if (old + 1u == (gen + 1u) * nloc) {
      __builtin_amdgcn_fence(__ATOMIC_RELEASE, "agent");
      asm volatile("s_waitcnt vmcnt(0)" ::: "memory");
      const unsigned og = xb_add(&bar[XB_TOP], 1u);
      const unsigned tg = og / nx;
      if (og + 1u == (tg + 1u) * nx) xb_add(&bar[XB_TOPGEN], 1u);
      else XB_SPIN(xb_ld(&bar[XB_TOPGEN]) == tg, bar);
      __builtin_amdgcn_fence(__ATOMIC_ACQUIRE, "agent");
      xb_add(&bar[XB_XGEN(b.x)], 1u);
      asm volatile("s_waitcnt vmcnt(0)" ::: "memory");
    } else {
      XB_SPIN(xb_ld(&bar[XB_XGEN(b.x)]) == gen, bar);
      __builtin_amdgcn_fence(__ATOMIC_ACQUIRE, "agent");
      asm volatile("s_waitcnt vmcnt(0)" ::: "memory");
    }
  }
  __syncthreads();
}

__global__ void __launch_bounds__(NT) fwd_megakernel(Params p) {
  extern __shared__ __attribute__((aligned(16))) unsigned char lds[];
  cg::grid_group grid = cg::this_grid();
  unsigned char* ws = p.ws;
  float* MODV = (float*)(ws + OFF_MODV);
  float* XS = (float*)(ws + OFF_XS);
  bf16_t* H = (bf16_t*)(ws + OFF_H);

  unsigned* bar = (unsigned*)(ws + OFF_BAR);
  if (blockIdx.x == 0) for (int i = threadIdx.x; i < XCD_BAR_WORDS; i += NT) bar[i] = 0u;
  volatile LAS3 unsigned* st = (volatile LAS3 unsigned*)((LAS3 unsigned char*)lds + 128 * 1024);
  if (threadIdx.x == 0) { st[0] = 0u; st[1] = 0u; }
  setup_phase(p, lds);
  grid.sync();
  const XcdBarrier xb = xcd_barrier_post(bar, st);
#define GSYNC() xcd_barrier(xb)
  {
    constexpr int ntok = TT;
    norm_phase(p, 0, p.norm_mix + 0 * D, 0, TT, true, H, (float*)lds);
    GSYNC();
      {
        EpiQKV256 e{(bf16_t*)(ws + OFF_Q), (bf16_t*)(ws + OFF_K), (bf16_t*)(ws + OFF_VT), (const float*)(ws + OFF_ROPE), (const float*)(ws + OFF_ROPE) + 2048};
        gemm256(p, H, (const bf16_t*)(ws + OFF_WQKV), TT, 3072, D, lds, e, StreamJob{48, 0, 0, 896, 576, 0, 1024});
      }
      GSYNC();
      attn_phase(p, lds);
      GSYNC();
    {
      EpiDelta256 e{(bf16_t*)(ws + OFF_Q), MODV + (size_t)(0 * 5) * NMOD + 2 * D};
      gemm256(p, (const bf16_t*)(ws + OFF_O), (const bf16_t*)(ws + (OFF_WO)), ntok, D, D, lds, e, StreamJob{64, 48, 48, 0, 0, 2048, 1024});
    }
    GSYNC();
    norm_phase(p, 0, p.norm_ffn + 0 * D, 3, ntok, true, H, (float*)lds, (const bf16_t*)(ws + OFF_Q));
    GSYNC();
    {
      EpiBf16_256 e{(bf16_t*)(ws + OFF_PQ), D};
      gemm256<true>(p, H, (const bf16_t*)(ws + OFF_WPQ) + (size_t)0 * D * D, ntok, D, D, lds, e, StreamJob{64, 0, 0, 1472, 192, 1024, 1024});
    }
    GSYNC();
    peer_route_phase(p, 0, 0, TL / 64 * 8, (int)gridDim.x, lds);
    GSYNC();
    peer_gather_phase(p, 0, ntok, 0, lds);
    GSYNC();
  }
  {
    constexpr int ntok = TL;
      {
        EpiWin256 e{(bf16_t*)(ws + OFF_PQ), (bf16_t*)(ws + OFF_Q)};
        gemm256(p, H, (const bf16_t*)(ws + OFF_WIN), TT, 4096, D, lds, e, StreamJob{32, 0, 0, 1664, 384, 3072, 1024});
      }
      GSYNC();
      conv_phase(p);
      GSYNC();
      coef_phase(p, lds);
      GSYNC();
      scan1_phase(p);
      GSYNC();
      scan2_phase(p);
      GSYNC();
      scan3_phase(p, lds);
      GSYNC();
    {
      EpiDelta256 e{(bf16_t*)(ws + OFF_Q), MODV + (size_t)(1 * 5) * NMOD + 2 * D};
      gemm256(p, (const bf16_t*)(ws + OFF_O), (const bf16_t*)(ws + (OFF_WOUT)), ntok, D, D, lds, e, StreamJob{0, 0, 0, 0, 0, 0, 0});
    }
    GSYNC();
    norm_phase(p, 1, p.norm_ffn + 1 * D, 3, ntok, false, H, (float*)lds, (const bf16_t*)(ws + OFF_Q));
    GSYNC();
    {
      EpiBf16_256 e{(bf16_t*)(ws + OFF_PQ), D};
      gemm256(p, H, (const bf16_t*)(ws + OFF_WPQ) + (size_t)1 * D * D, ntok, D, D, lds, e, StreamJob{0, 0, 0, 0, 0, 0, 0});
    }
    GSYNC();
    peer_route_phase(p, 1, 0, ntok / 64 * 8, (int)gridDim.x, lds);
    GSYNC();
    peer_gather_phase(p, 1, ntok, 1, lds);
  }
}

__global__ void diag_fill(float* out, int n, float v) { for (int i = blockIdx.x * blockDim.x + threadIdx.x; i < n; i += gridDim.x * blockDim.x) out[i] = v; }

extern "C" void kernel_launch(void* const* d_in, const int* in_sizes, int n_in, void* d_out, int out_size, void* d_ws, size_t ws_size, hipStream_t stream) {
  static int grid_blocks = 0;
  if (!grid_blocks) {
    int dev = 0, cus = 0, per_cu = 0;
    (void)hipGetDevice(&dev);
    (void)hipDeviceGetAttribute(&cus, hipDeviceAttributeMultiprocessorCount, dev);
    (void)hipFuncSetAttribute((const void*)fwd_megakernel, hipFuncAttributeMaxDynamicSharedMemorySize, (int)kDynLds);
    (void)hipOccupancyMaxActiveBlocksPerMultiprocessor(&per_cu, fwd_megakernel, NT, kDynLds);
    if (per_cu > 1) per_cu = 1;
    if (per_cu < 1) per_cu = 1;
    grid_blocks = cus * per_cu;
  }
  if (ws_size < WS_NEED) { fprintf(stderr, "workspace too small: %zu < %zu\n", ws_size, (size_t)WS_NEED); diag_fill<<<1024, 256, 0, stream>>>((float*)d_out, out_size, 3.0f); return; }
  Params p{};
  const float* const* in = (const float* const*)d_in;
  p.x = in[0]; p.c = in[1]; p.ctx = in[2]; p.c_ctx = in[3]; p.w_mod = in[4]; p.b_mod = in[5]; p.norm_mix = in[6]; p.norm_ffn = in[7]; p.norm_final = in[8];
  p.attn_w_qkv = in[9]; p.attn_w_o = in[10]; p.attn_sink = in[11];
  p.rec_w_in = in[12]; p.rec_conv_w = in[13]; p.rec_conv_b = in[14]; p.rec_w_a = in[15]; p.rec_b_a = in[16]; p.rec_w_x = in[17]; p.rec_b_x = in[18]; p.rec_lambda = in[19]; p.rec_w_out = in[20];
  p.peer_w_q = in[21]; p.peer_keys = in[22]; p.peer_u = in[23]; p.peer_v = in[24];
  p.out = (float*)d_out; p.ws = (unsigned char*)d_ws;
  void* args[] = {&p};
  hipError_t e = hipLaunchCooperativeKernel((void*)fwd_megakernel, dim3(grid_blocks), dim3(NT), args, kDynLds, stream);
  if (e != hipSuccess) { fprintf(stderr, "cooperative launch failed: %s (grid %d)\n", hipGetErrorString(e), grid_blocks); diag_fill<<<1024, 256, 0, stream>>>((float*)d_out, out_size, 5.0f); }
}
```
